# Optimizing an MI355X kernel written in HIP

```python
import math
import jax, jax.numpy as jnp
from jax import lax
import numpy as np

D_MODEL = 2048
BATCH = 8
SEQ = 2048
DEPTH = 2

CTX_LEN = 256
GRID_W = 64
HEAD_DIM = 64
MIX_WIDTH = D_MODEL
GROUP_WIDTH = MIX_WIDTH // 4
RET_HEADS = GROUP_WIDTH // HEAD_DIM
RET_CHUNK = 128
CONV_CH = GROUP_WIDTH
SWA_HEADS = GROUP_WIDTH // HEAD_DIM
SWA_KV_HEADS = 2
SWA_WINDOW = 128
SWA_BLOCK = 128
NA_HEADS = GROUP_WIDTH // HEAD_DIM
NA_ROWS = 8
NA_COLS = 16
N_EXPERTS = 16
EXPERT_FF = D_MODEL // 2
EC_CAPACITY_FACTOR = 2
ROPE_BASE = 10000.0
EPS = 1e-6
NEG_INF = -1e30
F32 = jnp.float32

COL_SPLITS = (
    [GROUP_WIDTH] * 4
    + [CONV_CH] * 3
    + [SWA_HEADS * HEAD_DIM, SWA_KV_HEADS * HEAD_DIM, SWA_KV_HEADS * HEAD_DIM]
    + [NA_HEADS * HEAD_DIM] * 3
)
IN_COLS = 4 * GROUP_WIDTH + 3 * CONV_CH + (SWA_HEADS + 2 * SWA_KV_HEADS) * HEAD_DIM + 3 * NA_HEADS * HEAD_DIM

kernel_name = "hybrid_parallel_heads_diffusion_block"


def rmsnorm(x, g):
    xf = x.astype(F32)
    y = xf * lax.rsqrt(jnp.mean(xf * xf, axis=-1, keepdims=True) + EPS)
    return (y * g.astype(F32)).astype(x.dtype)


def head_groupnorm(y):
    yf = y.astype(F32)
    mu = jnp.mean(yf, axis=-1, keepdims=True)
    var = jnp.mean(jnp.square(yf - mu), axis=-1, keepdims=True)
    return (yf - mu) * lax.rsqrt(var + EPS)


def axial_rope(x):
    L, hd = x.shape[1], x.shape[-1]
    half = hd // 2
    nf = half // 2
    t = jnp.arange(L)
    row = (t // GRID_W).astype(F32)
    col = (t % GRID_W).astype(F32)
    inv = ROPE_BASE ** (-jnp.arange(nf, dtype=F32) / nf)
    ang = jnp.concatenate([row[:, None] * inv, col[:, None] * inv], axis=-1)[:, None, :]
    cos, sin = jnp.cos(ang), jnp.sin(ang)
    xf = x.astype(F32)
    x1, x2 = xf[..., :half], xf[..., half:]
    return jnp.concatenate([x1 * cos - x2 * sin, x1 * sin + x2 * cos], axis=-1).astype(x.dtype)


def retention_scan(q, k, v, log_gamma, s0, include_diag):
    B, T, H, d = q.shape
    n = T // RET_CHUNK
    q, k, v = q.astype(F32), k.astype(F32), v.astype(F32)

    def chunks(a):
        return a.reshape(B, n, RET_CHUNK, H, d).transpose(1, 0, 3, 2, 4)

    pos = jnp.arange(RET_CHUNK, dtype=F32)
    diff = pos[:, None] - pos[None, :]
    tri = diff >= 0 if include_diag else diff > 0
    lg = log_gamma.astype(F32)
    dmat = jnp.where(tri, jnp.exp(lg[:, None, None] * jnp.maximum(diff, 0.0)), 0.0)
    xi = jnp.exp(lg[:, None] * (pos + 1.0))[..., None]
    zeta = jnp.exp(lg[:, None] * (RET_CHUNK - 1.0 - pos))[..., None]
    cdecay = jnp.exp(lg * RET_CHUNK)[:, None, None]

    def step(state, inp):
        qi, ki, vi = inp
        inner = jnp.einsum('bhqd,bhkd->bhqk', qi, ki) * dmat
        y = jnp.einsum('bhqk,bhkv->bhqv', inner, vi) + jnp.einsum('bhqd,bhdv->bhqv', qi, state) * xi
        state = state * cdecay + jnp.einsum('bhkd,bhkv->bhdv', ki * zeta, vi)
        return state, y

    state, ys = lax.scan(step, s0, (chunks(q), chunks(k), chunks(v)))
    return ys.transpose(1, 0, 3, 2, 4).reshape(B, T, H, d), state


def retention_mixer(q, k, v, g, qc, kc, vc, gc, logit_f, logit_b, need_ctx):
    B, L, _ = q.shape
    kscale = HEAD_DIM ** -0.5

    def heads(a):
        return a.reshape(a.shape[0], a.shape[1], RET_HEADS, HEAD_DIM)

    q, k, v = axial_rope(heads(q)), axial_rope(heads(k)) * kscale, heads(v)
    qc, kc, vc = heads(qc), heads(kc) * kscale, heads(vc)
    lg_f = jax.nn.log_sigmoid(logit_f.astype(F32))
    lg_b = jax.nn.log_sigmoid(logit_b.astype(F32))
    s0 = jnp.zeros((B, RET_HEADS, HEAD_DIM, HEAD_DIM), F32)

    def flip(a):
        return a[:, ::-1]

    yc_f, st_f = retention_scan(qc, kc, vc, lg_f, s0, True)
    yc_b, st_b = retention_scan(flip(qc), flip(kc), flip(vc), lg_b, s0, False)
    y_f, _ = retention_scan(q, k, v, lg_f, st_f, True)
    y_b, _ = retention_scan(flip(q), flip(k), flip(v), lg_b, st_b, False)
    y = (jax.nn.silu(g.astype(F32)) * head_groupnorm(y_f + flip(y_b)).reshape(B, L, -1)).astype(g.dtype)
    yc = None
    if need_ctx:
        T = qc.shape[1]
        yc = (jax.nn.silu(gc.astype(F32)) * head_groupnorm(yc_f + flip(yc_b)).reshape(B, T, -1)).astype(gc.dtype)
    return y, yc


def short_conv(bg, cg, hin, w):
    u = cg * hin
    up = jnp.pad(u, ((0, 0), (1, 1), (0, 0)))
    y = up[:, :-2] * w[0] + up[:, 1:-1] * w[1] + up[:, 2:] * w[2]
    return bg * y


def dense_ctx_attention(qc, kc, vc, sink):
    B, T = qc.shape[0], qc.shape[1]
    s = jnp.einsum('bqkgd,bckd->bkgqc', qc, kc).astype(F32) * (HEAD_DIM ** -0.5)
    if sink is not None:
        s = jnp.concatenate([s, jnp.broadcast_to(sink.astype(F32)[None, :, :, None, None], s.shape[:-1] + (1,))], axis=-1)
    p = jax.nn.softmax(s, axis=-1)[..., :kc.shape[1]].astype(vc.dtype)
    return jnp.einsum('bkgqc,bckd->bqkgd', p, vc).reshape(B, T, -1)


def swa_mixer(q, k, v, qc, kc, vc, sink, need_ctx):
    B, L, _ = q.shape
    T = qc.shape[1]
    KV, G = SWA_KV_HEADS, SWA_HEADS // SWA_KV_HEADS
    scale = HEAD_DIM ** -0.5
    q = axial_rope(q.reshape(B, L, SWA_HEADS, HEAD_DIM)).reshape(B, L, KV, G, HEAD_DIM)
    k = axial_rope(k.reshape(B, L, KV, HEAD_DIM))
    v = v.reshape(B, L, KV, HEAD_DIM)
    qc = qc.reshape(B, T, KV, G, HEAD_DIM)
    kc = kc.reshape(B, T, KV, HEAD_DIM)
    vc = vc.reshape(B, T, KV, HEAD_DIM)
    nb = L // SWA_BLOCK
    qb = q.reshape(B, nb, SWA_BLOCK, KV, G, HEAD_DIM)

    def band(a):
        ap = jnp.pad(a, ((0, 0), (SWA_BLOCK, SWA_BLOCK), (0, 0), (0, 0))).reshape(B, nb + 2, SWA_BLOCK, KV, HEAD_DIM)
        return jnp.concatenate([ap[:, :-2], ap[:, 1:-1], ap[:, 2:]], axis=2)

    kw, vw = band(k), band(v)
    W = 3 * SWA_BLOCK
    blk = jnp.arange(nb)[:, None, None] * SWA_BLOCK
    qpos = blk + jnp.arange(SWA_BLOCK)[None, :, None]
    kpos = blk - SWA_BLOCK + jnp.arange(W)[None, None, :]
    valid = (jnp.abs(kpos - qpos) <= SWA_WINDOW) & (kpos >= 0) & (kpos < L)
    s_win = jnp.einsum('bnqkgd,bnjkd->bnkgqj', qb, kw).astype(F32) * scale
    s_win = jnp.where(valid[None, :, None, None], s_win, NEG_INF)
    s_ctx = jnp.einsum('bnqkgd,bckd->bnkgqc', qb, kc).astype(F32) * scale
    s_sink = jnp.broadcast_to(sink.astype(F32).reshape(KV, G)[None, None, :, :, None, None], s_win.shape[:-1] + (1,))
    p = jax.nn.softmax(jnp.concatenate([s_win, s_ctx, s_sink], axis=-1), axis=-1).astype(v.dtype)
    o = (jnp.einsum('bnkgqj,bnjkd->bnqkgd', p[..., :W], vw)
         + jnp.einsum('bnkgqc,bckd->bnqkgd', p[..., W:W + T], vc))
    y = o.reshape(B, L, SWA_HEADS * HEAD_DIM)
    yc = dense_ctx_attention(qc, kc, vc, sink.reshape(KV, G)) if need_ctx else None
    return y, yc


def na_mixer(q, k, v, qc, kc, vc, rpb, need_ctx):
    B, L, _ = q.shape
    T = qc.shape[1]
    H = NA_HEADS
    scale = HEAD_DIM ** -0.5
    rows = L // GRID_W
    wr, wc = min(NA_ROWS, rows), NA_COLS
    qg = q.reshape(B, rows, GRID_W, H, HEAD_DIM)
    kg = k.reshape(B, rows, GRID_W, H, HEAD_DIM)
    vg = v.reshape(B, rows, GRID_W, H, HEAD_DIM)
    kc4 = kc.reshape(B, T, H, HEAD_DIM)
    vc4 = vc.reshape(B, T, H, HEAD_DIM)
    r = jnp.arange(rows)
    row_idx = jnp.clip(r - wr // 2, 0, rows - wr)[:, None] + jnp.arange(wr)[None, :]
    nk = wr * GRID_W
    kb = kg[:, row_idx].reshape(B, rows, nk, H, HEAD_DIM)
    vb = vg[:, row_idx].reshape(B, rows, nk, H, HEAD_DIM)
    cq = jnp.arange(GRID_W)
    col_start = jnp.clip(cq - wc // 2, 0, GRID_W - wc)
    col_ok = (cq[None, :] >= col_start[:, None]) & (cq[None, :] < col_start[:, None] + wc)
    dr = row_idx - r[:, None] + (NA_ROWS - 1)
    dc = jnp.clip(cq[None, :] - cq[:, None], -(wc - 1), wc - 1) + (NA_COLS - 1)
    bias = rpb.astype(F32)[:, dr[:, :, None, None], dc[None, None, :, :]]
    bias = jnp.where(col_ok[None, None, None], bias, NEG_INF)
    bias = bias.transpose(1, 0, 3, 2, 4).reshape(rows, H, GRID_W, nk)
    s_nb = jnp.einsum('brqhd,brkhd->brhqk', qg, kb).astype(F32) * scale + bias[None]
    s_ctx = jnp.einsum('brqhd,bchd->brhqc', qg, kc4).astype(F32) * scale
    p = jax.nn.softmax(jnp.concatenate([s_nb, s_ctx], axis=-1), axis=-1).astype(v.dtype)
    o = (jnp.einsum('brhqk,brkhd->brqhd', p[..., :nk], vb)
         + jnp.einsum('brhqc,bchd->brqhd', p[..., nk:], vc4))
    y = o.reshape(B, L, H * HEAD_DIM)
    yc = dense_ctx_attention(qc.reshape(B, T, H, 1, HEAD_DIM), kc4, vc4, None) if need_ctx else None
    return y, yc


def split_cols(z):
    idx = [int(i) for i in np.cumsum(COL_SPLITS)[:-1]]
    return jnp.split(z, idx, axis=-1)


def token_mix(h, hc, w_in, w_out, logit_f, logit_b, conv_w, sink, rpb, need_ctx):
    p = split_cols(h @ w_in)
    pc = split_cols(hc @ w_in)
    y_ret, yc_ret = retention_mixer(*p[0:4], *pc[0:4], logit_f, logit_b, need_ctx)
    y_conv = short_conv(*p[4:7], conv_w)
    y_swa, yc_swa = swa_mixer(*p[7:10], *pc[7:10], sink, need_ctx)
    y_na, yc_na = na_mixer(*p[10:13], *pc[10:13], rpb, need_ctx)
    y = jnp.concatenate([y_ret, y_conv, y_swa, y_na], axis=-1) @ w_out
    yc = None
    if need_ctx:
        yc_conv = short_conv(*pc[4:7], conv_w)
        yc = jnp.concatenate([yc_ret, yc_conv, yc_swa, yc_na], axis=-1) @ w_out
    return y, yc


def expert_choice_ffn(h, w_router, w_gate, w_up, w_down):
    B, T, D = h.shape
    cap = EC_CAPACITY_FACTOR * T // N_EXPERTS
    aff = jax.nn.softmax((h @ w_router).astype(F32), axis=-1)
    gate, idx = lax.top_k(jnp.swapaxes(aff, 1, 2), cap)
    xs = jax.vmap(lambda hb, ib: hb[ib])(h, idx)
    a = jnp.einsum('becd,edf->becf', xs, w_gate)
    u = jnp.einsum('becd,edf->becf', xs, w_up)
    ye = jnp.einsum('becf,efd->becd', jax.nn.silu(a) * u, w_down) * gate[..., None].astype(h.dtype)
    return jax.vmap(lambda yb, ib: jnp.zeros((T, D), yb.dtype).at[ib.reshape(-1)].add(yb.reshape(-1, D)))(ye, idx)


def setup_inputs(seed: int = 0) -> dict:
    key = jax.random.key(seed)
    ks = jax.random.split(key, 24)
    D = D_MODEL
    nrm = jax.random.normal
    gamma0 = 1.0 - 2.0 ** (-5.0 - jnp.arange(RET_HEADS, dtype=F32))
    logit0 = jnp.log(gamma0) - jnp.log1p(-gamma0)
    return {
        "x": nrm(ks[0], (BATCH, SEQ, D), F32),
        "c": nrm(ks[1], (BATCH, D), F32),
        "ctx": nrm(ks[2], (BATCH, CTX_LEN, D), F32),
        "c_ctx": nrm(ks[3], (D,), F32),
        "w_ada": nrm(ks[4], (DEPTH, D, 6 * D), F32) * (0.5 * D ** -0.5),
        "b_ada": nrm(ks[5], (DEPTH, 6 * D), F32) * 0.01,
        "norm_mix": 1.0 + 0.02 * nrm(ks[6], (DEPTH, D), F32),
        "norm_ffn": 1.0 + 0.02 * nrm(ks[7], (DEPTH, D), F32),
        "w_in": nrm(ks[8], (DEPTH, D, IN_COLS), F32) * D ** -0.5,
        "w_out": nrm(ks[9], (DEPTH, MIX_WIDTH, D), F32) * MIX_WIDTH ** -0.5,
        "ret_decay_fwd": logit0[None] + 0.1 * nrm(ks[10], (DEPTH, RET_HEADS), F32),
        "ret_decay_bwd": logit0[None] + 0.1 * nrm(ks[11], (DEPTH, RET_HEADS), F32),
        "conv_w": nrm(ks[12], (DEPTH, 3, CONV_CH), F32) * 3.0 ** -0.5,
        "swa_sink": 0.5 * nrm(ks[13], (DEPTH, SWA_HEADS), F32),
        "na_rpb": 0.1 * nrm(ks[14], (DEPTH, NA_HEADS, 2 * NA_ROWS - 1, 2 * NA_COLS - 1), F32),
        "w_router": nrm(ks[15], (DEPTH, D, N_EXPERTS), F32) * D ** -0.5,
        "w_gate": nrm(ks[16], (DEPTH, N_EXPERTS, D, EXPERT_FF), F32) * D ** -0.5,
        "w_up": nrm(ks[17], (DEPTH, N_EXPERTS, D, EXPERT_FF), F32) * D ** -0.5,
        "w_down": nrm(ks[18], (DEPTH, N_EXPERTS, EXPERT_FF, D), F32) * EXPERT_FF ** -0.5,
        "norm_final": 1.0 + 0.02 * nrm(ks[19], (D,), F32),
    }


def reference(x, c, ctx, c_ctx, w_ada, b_ada, norm_mix, norm_ffn, w_in, w_out, ret_decay_fwd, ret_decay_bwd,
              conv_w, swa_sink, na_rpb, w_router, w_gate, w_up, w_down, norm_final):
    xc = ctx
    for l in range(DEPTH):
        need_ctx = l < DEPTH - 1
        ada = jax.nn.silu(c) @ w_ada[l] + b_ada[l]
        ada_c = jax.nn.silu(c_ctx) @ w_ada[l] + b_ada[l]
        sh1, sc1, g1, sh2, sc2, g2 = [a[:, None, :] for a in jnp.split(ada, 6, axis=-1)]
        sh1c, sc1c, g1c, sh2c, sc2c, g2c = jnp.split(ada_c, 6, axis=-1)
        h = rmsnorm(x, norm_mix[l]) * (1.0 + sc1) + sh1
        hc = rmsnorm(xc, norm_mix[l]) * (1.0 + sc1c) + sh1c
        y, yc = token_mix(h, hc, w_in[l], w_out[l], ret_decay_fwd[l], ret_decay_bwd[l], conv_w[l],
                          swa_sink[l], na_rpb[l], need_ctx)
        x = x + g1 * y
        h = rmsnorm(x, norm_ffn[l]) * (1.0 + sc2) + sh2
        x = x + g2 * expert_choice_ffn(h, w_router[l], w_gate[l], w_up[l], w_down[l])
        if need_ctx:
            xc = xc + g1c * yc
            hc = rmsnorm(xc, norm_ffn[l]) * (1.0 + sc2c) + sh2c
            xc = xc + g2c * expert_choice_ffn(hc, w_router[l], w_gate[l], w_up[l], w_down[l])
    return rmsnorm(x, norm_final)
```

```cpp
#include <hip/hip_runtime.h>
#include <cstdio>
#include <cstdint>
__device__ __forceinline__ int tid_opaque() { int t = (int)threadIdx.x; asm volatile("" : "+v"(t)); return t; }
#define MEGA 1
namespace pg8 {
#define PG8_LAS __attribute__((address_space(3)))
typedef unsigned short bf16_t;
typedef short bf16x8 __attribute__((ext_vector_type(8)));
typedef float f32x4 __attribute__((ext_vector_type(4)));
typedef unsigned u32x4 __attribute__((ext_vector_type(4)));
constexpr int BM = 256, BK = 64, HALF = 128, HTB = HALF * BK * 2  , STAGE_BYTES = 8 * HTB, NXCD = 8, WGM = 8;

__host__ __device__ __forceinline__ int lds_byte(int r, int c) { const int st = (r >> 4) * 2 + (c >> 5), rr = r & 15, cc = c & 31, ob = rr * 64 + cc * 2; return st * 1024 + (ob ^ (((ob >> 9) & 1) << 5)); }
__host__ __device__ __forceinline__ void stage_rc(int b, int& R, int& C) { const int st = b / 1024, sb = b % 1024, swz = sb ^ (((sb >> 9) & 1) << 5); R = (st >> 1) * 16 + swz / 64; C = (st & 1) * 32 + (swz % 64) / 2; }
__host__ __device__ __forceinline__ int perm32(int rho) { const int n = rho >> 4, i = rho & 15; return 8 * (i >> 2) + 4 * n + (i & 3); }

struct Unit { int pm, pn, pb; };
struct Gemm { const bf16_t* A; const bf16_t* Bt; int M, N, K; const PG8_LAS int* ridx; };

struct StaticOrder {
    int nM, nN, nwg, G, c;
    __host__ __device__ void init(int M, int N, int G_, int c_) { nM = M / BM; nN = N / BM; nwg = nM * nN; G = G_; c = c_; }
    __host__ __device__ bool next(int i, Unit& u) const {
        const long L = (long)i * G + c; if (L >= nwg) return false;
        int wgid = (int)L; { const int q = nwg / NXCD, r = nwg % NXCD, xcd = wgid % NXCD, off = wgid / NXCD; wgid = (xcd < r ? xcd * (q + 1) : r * (q + 1) + (xcd - r) * q) + off; }
        const int nig = WGM * nN, gid = wgid / nig, fm = gid * WGM, gsz = (nM - fm) < WGM ? (nM - fm) : WGM;
        u.pm = fm + ((wgid % nig) % gsz); u.pn = (wgid % nig) / gsz; u.pb = u.pn; return true;
    }
    __device__ __forceinline__ void a_ready(const Unit&) const {}
    __device__ __forceinline__ void done(const Unit&) const {}
};

__device__ __forceinline__ unsigned cvt_pk_bf16(float lo, float hi) { unsigned r; asm volatile("v_cvt_pk_bf16_f32 %0, %1, %2" : "=v"(r) : "v"(lo), "v"(hi)); return r; }
typedef float f32x2 __attribute__((ext_vector_type(2)));
__device__ __forceinline__ f32x2 gelu_pk(f32x2 v) {
    const f32x2 av = __builtin_elementwise_abs(v), d = av * 0.2316418882f + 1.0f;
    f32x2 t; t.x = __builtin_amdgcn_rcpf(d.x); t.y = __builtin_amdgcn_rcpf(d.y);
    f32x2 q = t * 0.5307027145f + (-0.7265760135f); q = q * t + 0.7107068705f; q = q * t + (-0.142248368f); q = q * t + 0.127414796f; q = q * t;
    const f32x2 s = (v * v) * (-0.72134752044f);
    f32x2 e; e.x = __builtin_amdgcn_exp2f(s.x); e.y = __builtin_amdgcn_exp2f(s.y);
    const f32x2 m = v * (q * e), r = v - m;
    f32x2 o; o.x = v.x < 0.f ? m.x : r.x; o.y = v.y < 0.f ? m.y : r.y; return o;
}

template <int ACT  > struct EpiBf16 {
    static constexpr bool PERM = true, AFTER_DRAIN = false; static_assert(ACT == 0 || ACT == 1, "EpiBf16: ACT is 0 (none) or 1 (gelu_pk)");
    bf16_t* O; int ldc; const float* bias; int split_cols; size_t split_stride; float scale0;
    __device__ __forceinline__ void operator()(const f32x4 (&acc)[2][2][4][2], const Unit& u, int wr, int wc, int fr, int fq) const {
        const int row0 = u.pm * BM + wr * 64 + fr; int colt = u.pn * BM; bf16_t* base = O;
        float sc = 1.f; if (split_cols) { const int t = colt / split_cols; base += (size_t)t * split_stride; colt -= t * split_cols; if (t == 0) sc = scale0; }
        const int col0 = colt + wc * 32 + 8 * fq, bcol0 = u.pn * BM + wc * 32 + 8 * fq;
        f32x4 bv[2][2];
#pragma unroll
        for (int bj = 0; bj < 2; ++bj)
#pragma unroll
            for (int n = 0; n < 2; ++n) bv[bj][n] = bias ? *(const f32x4*)(bias + bcol0 + bj * HALF + 4 * n) : (f32x4){0.f, 0.f, 0.f, 0.f};
#pragma unroll
        for (int ai = 0; ai < 2; ++ai)
#pragma unroll
            for (int m = 0; m < 4; ++m) { bf16_t* rowp = base + (size_t)(row0 + ai * HALF + m * 16) * ldc + col0;
#pragma unroll
                for (int bj = 0; bj < 2; ++bj) { f32x4 v0 = acc[ai][bj][m][0] + bv[bj][0], v1 = acc[ai][bj][m][1] + bv[bj][1];
                    if (ACT == 1) { f32x2 a = gelu_pk((f32x2){v0[0], v0[1]}), b = gelu_pk((f32x2){v0[2], v0[3]}), c = gelu_pk((f32x2){v1[0], v1[1]}), d = gelu_pk((f32x2){v1[2], v1[3]});
                        v0 = (f32x4){a.x, a.y, b.x, b.y}; v1 = (f32x4){c.x, c.y, d.x, d.y}; }
                    v0 = v0 * sc; v1 = v1 * sc; u32x4 w; w.x = cvt_pk_bf16(v0[0], v0[1]); w.y = cvt_pk_bf16(v0[2], v0[3]); w.z = cvt_pk_bf16(v1[0], v1[1]); w.w = cvt_pk_bf16(v1[2], v1[3]);
                    *(u32x4*)(rowp + bj * HALF) = w; } }
    }
};

template <class Epi, class Sched, bool ALIGN_EPI = false, bool SP2 = false, bool GATHER = false>
__device__ __forceinline__ void gemm_phase(PG8_LAS unsigned char* lds, const Gemm g, const Sched& S, const Epi& E) {
    const int tid = tid_opaque(), wid = __builtin_amdgcn_readfirstlane(tid >> 6), lane = tid & 63, wr = wid >> 2, wc = wid & 3, fr = lane & 15, fq = lane >> 4;
    const int K = g.K, nt = K / BK;
    unsigned voffA[2], voffB[2];
#pragma unroll
    for (int i = 0; i < 2; ++i) { int R, C; stage_rc(tid * 16 + i * 8192, R, C); const int Rb = Epi::PERM ? ((R & ~31) + perm32(R & 31)) : R;
        voffA[i] = (unsigned)(R * K + C) * 2u; voffB[i] = (unsigned)(Rb * K + C) * 2u; }
    unsigned cvA[2][2], nvA[2][2];
#define PG8_AOFFS(dst, unit, ord) do { _Pragma("unroll") for (int _h = 0; _h < 2; ++_h) _Pragma("unroll") for (int _i = 0; _i < 2; ++_i) { int R_, C_; stage_rc(tid * 16 + _i * 8192, R_, C_); \
        if constexpr (GATHER) dst[_h][_i] = (unsigned)(g.ridx[(ord) * BM + _h * HALF + R_] * K + C_) * 2u; else dst[_h][_i] = voffA[_i] + (unsigned)(_h * HALF * K * 2); } } while (0)
    const size_t kstep = (size_t)(BK * 2);
    const size_t hstep = (size_t)HALF * K * 2;
    const size_t tstep = 2 * hstep;
    const unsigned ldsw = (unsigned)wid * 1024u;
    const int aoff = lds_byte(wr * 64 + fr, fq * 8), boff = lds_byte(wc * 32 + fr, fq * 8);
#define PG8_SA(b, h) (((b) * 2 + (h)) * HTB)
#define PG8_SB(b, h) ((4 + (b) * 2 + (h)) * HTB)
#define PG8_STAGE(bufoff, gbase, voff) do { _Pragma("unroll") for (int _i = 0; _i < 2; ++_i) \
        __builtin_amdgcn_global_load_lds((const unsigned*)((const char*)(gbase) + (voff)[_i]), (PG8_LAS unsigned*)(lds + (bufoff) + ldsw + _i * 8192), 16, 0, 0); } while (0)
#define PG8_LDA(dst, b, h) do { _Pragma("unroll") for (int m = 0; m < 4; ++m) _Pragma("unroll") for (int k = 0; k < 2; ++k) dst[m][k] = *(const PG8_LAS bf16x8*)(lds + PG8_SA(b, h) + aoff + m * 2048 + k * 1024); } while (0)
#define PG8_LDB(dst, b, h) do { _Pragma("unroll") for (int n = 0; n < 2; ++n) _Pragma("unroll") for (int k = 0; k < 2; ++k) dst[n][k] = *(const PG8_LAS bf16x8*)(lds + PG8_SB(b, h) + boff + n * 2048 + k * 1024); } while (0)
#define PG8_MMA(ai, bj, At, Bt) do { __builtin_amdgcn_s_setprio(1); _Pragma("unroll") for (int m = 0; m < 4; ++m) _Pragma("unroll") for (int n = 0; n < 2; ++n) _Pragma("unroll") for (int k = 0; k < 2; ++k) \
        acc[ai][bj][m][n] = __builtin_amdgcn_mfma_f32_16x16x32_bf16(Bt[n][k], At[m][k], acc[ai][bj][m][n], 0, 0, 0); __builtin_amdgcn_s_setprio(0); } while (0)
#define PG8_WAIT_V(n) asm volatile("s_waitcnt vmcnt(" #n ")" ::: "memory")
#define PG8_WAIT_L(n) asm volatile("s_waitcnt lgkmcnt(" #n ")" ::: "memory")
#define PG8_BAR __builtin_amdgcn_s_barrier()
#define PG8_SCHED __builtin_amdgcn_sched_barrier(0)
    Unit cur, nxt; int ui = 0;
    if (!S.next(0, cur)) return;
    f32x4 acc[2][2][4][2];
#pragma unroll
    for (int a = 0; a < 2; ++a)
#pragma unroll
        for (int b = 0; b < 2; ++b)
#pragma unroll
            for (int m = 0; m < 4; ++m)
#pragma unroll
                for (int n = 0; n < 2; ++n) acc[a][b][m][n] = (f32x4){0.f, 0.f, 0.f, 0.f};
    bf16x8 At[4][2], B0[2][2], B1[2][2];
    const char* cA = (const char*)g.A + (GATHER ? (size_t)0 : (size_t)cur.pm * tstep); const char* cB = (const char*)g.Bt + (size_t)cur.pb * tstep;
    S.a_ready(cur);
    PG8_AOFFS(cvA, cur, 0);
    if constexpr (SP2) {
        PG8_STAGE(PG8_SB(0, 0), cB, voffB); PG8_STAGE(PG8_SB(0, 1), cB + hstep, voffB); PG8_STAGE(PG8_SA(0, 0), cA, cvA[0]); PG8_STAGE(PG8_SA(0, 1), cA, cvA[1]);
        if (wr == 1) PG8_BAR;
        PG8_WAIT_V(2); PG8_BAR;
        PG8_STAGE(PG8_SB(1, 0), cB + kstep, voffB); PG8_STAGE(PG8_SA(1, 0), cA + kstep, cvA[0]); PG8_STAGE(PG8_SB(1, 1), cB + hstep + kstep, voffB);
        PG8_WAIT_V(6); PG8_BAR;
    } else { static_assert(SP2, "only the SP2 loop is kept in this file"); }
    for (;;) {
        const bool has_next = S.next(ui + 1, nxt);
        const char* nA = (has_next && !GATHER) ? (const char*)g.A + (size_t)nxt.pm * tstep : cA;
        if constexpr (GATHER) { if (has_next) PG8_AOFFS(nvA, nxt, ui + 1); else { _Pragma("unroll") for (int _h = 0; _h < 2; ++_h) _Pragma("unroll") for (int _i = 0; _i < 2; ++_i) nvA[_h][_i] = cvA[_h][_i]; } }
        const char* nB = has_next ? (const char*)g.Bt + (size_t)nxt.pb * tstep : cB;
        for (int t = 0; t < nt; t += 2) {
            const bool last = (t == nt - 2);
            const char* a1 = cA + (size_t)(t + 1) * kstep;
            const char* a2 = last ? nA : cA + (size_t)(t + 2) * kstep; const char* b2 = last ? nB : cB + (size_t)(t + 2) * kstep;
            const char* a3 = a2 + kstep; const char* b3 = b2 + kstep;
            unsigned xA0[2], xA1[2];
#pragma unroll
            for (int _i = 0; _i < 2; ++_i) { xA0[_i] = (GATHER && last) ? nvA[0][_i] : cvA[0][_i]; xA1[_i] = (GATHER && last) ? nvA[1][_i] : cvA[1][_i]; }
            if (last && has_next) S.a_ready(nxt);
            if constexpr (SP2) {
            PG8_LDB(B0, 0, 0); PG8_LDB(B1, 0, 1); PG8_SCHED; PG8_LDA(At, 0, 0); PG8_STAGE(PG8_SA(1, 1), a1, cvA[1]);
            PG8_WAIT_V(8); PG8_WAIT_L(0); PG8_BAR; PG8_MMA(0, 0, At, B0); PG8_MMA(0, 1, At, B1); PG8_BAR; PG8_SCHED;
            PG8_LDA(At, 0, 1); PG8_STAGE(PG8_SB(0, 0), b2, voffB); PG8_STAGE(PG8_SB(0, 1), b2 + hstep, voffB); PG8_STAGE(PG8_SA(0, 0), a2, xA0);
            PG8_WAIT_V(8); PG8_WAIT_L(0); PG8_BAR; PG8_MMA(1, 0, At, B0); PG8_MMA(1, 1, At, B1); PG8_BAR; PG8_SCHED;
            PG8_LDB(B0, 1, 0); PG8_LDB(B1, 1, 1); PG8_SCHED; PG8_LDA(At, 1, 0); PG8_STAGE(PG8_SA(0, 1), a2, xA1);
            PG8_WAIT_V(8); PG8_WAIT_L(0); PG8_BAR; PG8_MMA(0, 0, At, B0); PG8_MMA(0, 1, At, B1); PG8_BAR; PG8_SCHED;
            PG8_LDA(At, 1, 1); PG8_STAGE(PG8_SB(1, 0), b3, voffB); PG8_STAGE(PG8_SB(1, 1), b3 + hstep, voffB); PG8_STAGE(PG8_SA(1, 0), a3, xA0);
            PG8_WAIT_V(8); PG8_WAIT_L(0); PG8_BAR; PG8_MMA(1, 0, At, B0); PG8_MMA(1, 1, At, B1); PG8_BAR; PG8_SCHED;
            }
        }
        if constexpr (ALIGN_EPI) { if (wr == 0) PG8_BAR; }
        if constexpr (!Epi::AFTER_DRAIN) { E(acc, cur, wr, wc, fr, fq); S.done(cur); }
        if (!has_next) break;
#pragma unroll
        for (int a = 0; a < 2; ++a)
#pragma unroll
            for (int b = 0; b < 2; ++b)
#pragma unroll
                for (int m = 0; m < 4; ++m)
#pragma unroll
                    for (int n = 0; n < 2; ++n) acc[a][b][m][n] = (f32x4){0.f, 0.f, 0.f, 0.f};
        cur = nxt; cA = nA; cB = nB; ++ui;
        if constexpr (GATHER) { _Pragma("unroll") for (int _h = 0; _h < 2; ++_h) _Pragma("unroll") for (int _i = 0; _i < 2; ++_i) cvA[_h][_i] = nvA[_h][_i]; }
        if constexpr (ALIGN_EPI) { if (wr == 1) PG8_BAR; }
    }
    PG8_WAIT_V(0);
    if constexpr (!ALIGN_EPI) { if (wr == 0) PG8_BAR; }
    PG8_BAR;
    if constexpr (Epi::AFTER_DRAIN) { E.fused(acc, cur, wr, wc, fr, fq, lds, wid, lane); S.done(cur); }
#undef PG8_SA
#undef PG8_SB
#undef PG8_STAGE
#undef PG8_LDA
#undef PG8_LDB
#undef PG8_MMA
#undef PG8_WAIT_V
#undef PG8_WAIT_L
#undef PG8_BAR
#undef PG8_SCHED
#undef PG8_AOFFS
}
}
#define LAS __attribute__((address_space(3)))
#define XB_TMO      128
#define XB_XCNT(j)  (256  + 64 * (j))
#define XB_XSUB(j)  (1280 + 64 * (j))
#define XB_XGEN(j)  (2304 + 64 * (j))
#define XB_TOP      3328
#define XB_TOPGEN   3392
#define XCD_BAR_WORDS 3456
#define XB_SPIN_CAP (1u << 18)

__device__ __forceinline__ unsigned xb_ld(unsigned* p)              { return __hip_atomic_load(p, __ATOMIC_RELAXED, __HIP_MEMORY_SCOPE_AGENT); }
__device__ __forceinline__ unsigned xb_add(unsigned* p, unsigned v) { return __hip_atomic_fetch_add(p, v, __ATOMIC_RELAXED, __HIP_MEMORY_SCOPE_AGENT); }
__device__ __forceinline__ unsigned xb_xcc_id() { return (unsigned)__builtin_amdgcn_s_getreg((3 << 11) | 20) & 0xFu; }
#define XB_SPIN(cond, bar) do { unsigned _sp = 0; while (cond) { __builtin_amdgcn_s_sleep(1); \
    if ((++_sp & 255u) == 0u) { if (xb_ld(&(bar)[XB_TMO])) break; if (_sp > XB_SPIN_CAP) { atomicAdd(&(bar)[XB_TMO], 1u); break; } } } } while (0)

struct XcdBarrier {
    unsigned* bar; unsigned x;
    volatile LAS unsigned* st;
};

__device__ __forceinline__ XcdBarrier xcd_barrier_post(unsigned* bar, volatile LAS unsigned* st) {
    XcdBarrier b; b.bar = bar; b.x = xb_xcc_id(); b.st = st;
    if (threadIdx.x == 0) (void)xb_add(&bar[XB_XCNT(b.x)], 1u);
    return b;
}
__device__ __forceinline__ void xcd_barrier_complete(unsigned* bar, unsigned x, unsigned& nloc, unsigned& nx) {
    const unsigned G = gridDim.x * gridDim.y * gridDim.z;
    unsigned sum, cnt, mine, sp = 0u;
    for (;;) {
        sum = 0u; cnt = 0u; mine = 0u;
#pragma unroll
        for (unsigned j = 0; j < 16; ++j) { const unsigned c = xb_ld(&bar[XB_XCNT(j)]); sum += c; cnt += (c > 0u) ? 1u : 0u; mine = (j == x) ? c : mine; }
        if (sum == G) break;
        __builtin_amdgcn_s_sleep(1);
        if ((++sp & 255u) == 0u) { if (xb_ld(&bar[XB_TMO])) break; if (sp > XB_SPIN_CAP) { atomicAdd(&bar[XB_TMO], 1u); break; } }
    }
    nloc = mine > 0u ? mine : 1u; nx = cnt > 0u ? cnt : 1u;
}

__device__ __forceinline__ void xcd_barrier(const XcdBarrier& b) {
    asm volatile("s_waitcnt vmcnt(0)" ::: "memory");
    __syncthreads();
    if (threadIdx.x == 0) {
        unsigned* bar = b.bar;
        __builtin_amdgcn_s_waitcnt(0);
        unsigned nloc = b.st[0], nx = b.st[1];
        if (nloc == 0u) { xcd_barrier_complete(bar, b.x, nloc, nx); b.st[0] = nloc; b.st[1] = nx; }
        const unsigned old = xb_add(&bar[XB_XSUB(b.x)], 1u);
        const unsigned gen = old / nloc;
        if (old + 1u == (gen + 1u) * nloc) {
            __builtin_amdgcn_fence(__ATOMIC_RELEASE, "agent");
            asm volatile("s_waitcnt vmcnt(0)" ::: "memory");
            const unsigned og = xb_add(&bar[XB_TOP], 1u);
            const unsigned tg = og / nx;
            if (og + 1u == (tg + 1u) * nx) xb_add(&bar[XB_TOPGEN], 1u);
            else XB_SPIN(xb_ld(&bar[XB_TOPGEN]) == tg, bar);
            __builtin_amdgcn_fence(__ATOMIC_ACQUIRE, "agent");
            xb_add(&bar[XB_XGEN(b.x)], 1u);
            asm volatile("s_waitcnt vmcnt(0)" ::: "memory");
        } else {
            XB_SPIN(xb_ld(&bar[XB_XGEN(b.x)]) == gen, bar);
            __builtin_amdgcn_fence(__ATOMIC_ACQUIRE, "agent");
            asm volatile("s_waitcnt vmcnt(0)" ::: "memory");
        }
    }
    __syncthreads();
}
#undef LAS
__constant__ float ROPE_COS[1024] = { 1.000000000e+00f, 1.000000000e+00f, 1.000000000e+00f, 1.000000000e+00f, 1.000000000e+00f, 1.000000000e+00f, 1.000000000e+00f, 1.000000000e+00f, 1.000000000e+00f, 1.000000000e+00f, 1.000000000e+00f, 1.000000000e+00f, 1.000000000e+00f, 1.000000000e+00f, 1.000000000e+00f, 1.000000000e+00f, 5.403022766e-01f, 8.460091352e-01f, 9.504152536e-01f, 9.842302203e-01f, 9.950041771e-01f, 9.984192848e-01f, 9.995000362e-01f, 9.998418689e-01f, 9.999499917e-01f, 9.999842048e-01f, 9.999949932e-01f, 9.999983907e-01f, 9.999995232e-01f, 9.999998212e-01f, 9.999999404e-01f, 1.000000000e+00f, -4.161468446e-01f, 4.314628243e-01f, 8.065783978e-01f, 9.374182820e-01f, 9.800665975e-01f, 9.936820865e-01f, 9.980006814e-01f, 9.993675947e-01f, 9.998000264e-01f, 9.999367595e-01f, 9.999799728e-01f, 9.999936819e-01f, 9.999979734e-01f, 9.999993443e-01f, 9.999998212e-01f, 9.999999404e-01f, -9.899924994e-01f, -1.159661636e-01f, 5.827536583e-01f, 8.610406518e-01f, 9.553365111e-01f, 9.858034849e-01f, 9.955033660e-01f, 9.985772967e-01f, 9.995500445e-01f, 9.998577237e-01f, 9.999549985e-01f, 9.999857545e-01f, 9.999955297e-01f, 9.999985695e-01f, 9.999995232e-01f, 9.999998808e-01f, -6.536436081e-01f, -6.276797056e-01f, 3.011374772e-01f, 7.575061917e-01f, 9.210609794e-01f, 9.748082757e-01f, 9.920106530e-01f, 9.974712729e-01f, 9.992001057e-01f, 9.997470379e-01f, 9.999200106e-01f, 9.999747276e-01f, 9.999920130e-01f, 9.999974966e-01f, 9.999992251e-01f, 9.999997616e-01f, 2.836622000e-01f, -9.460792542e-01f, -1.034233812e-02f, 6.300802827e-01f, 8.775825500e-01f, 9.607312679e-01f, 9.875259995e-01f, 9.960497618e-01f, 9.987502694e-01f, 9.996047616e-01f, 9.998750091e-01f, 9.999604821e-01f, 9.999874830e-01f, 9.999960661e-01f, 9.999987483e-01f, 9.999995828e-01f, 9.601702690e-01f, -9.731037021e-01f, -3.207964003e-01f, 4.827820361e-01f, 8.253356218e-01f, 9.436169863e-01f, 9.820539355e-01f, 9.943132997e-01f, 9.982005358e-01f, 9.994308352e-01f, 9.998199940e-01f, 9.999430776e-01f, 9.999819994e-01f, 9.999943376e-01f, 9.999982119e-01f, 9.999994040e-01f, 7.539022565e-01f, -7.004297972e-01f, -5.994374752e-01f, 3.202570081e-01f, 7.648422122e-01f, 9.235194325e-01f, 9.755998850e-01f, 9.922624230e-01f, 9.975510240e-01f, 9.992253184e-01f, 9.997550249e-01f, 9.999225140e-01f, 9.999755025e-01f, 9.999922514e-01f, 9.999975562e-01f, 9.999992251e-01f, -1.455000341e-01f, -2.120364457e-01f, -8.186324239e-01f, 1.476312131e-01f, 6.967067122e-01f, 9.005023241e-01f, 9.681702852e-01f, 9.898977876e-01f, 9.968017340e-01f, 9.989882708e-01f, 9.996800423e-01f, 9.998987913e-01f, 9.999679923e-01f, 9.999898672e-01f, 9.999967813e-01f, 9.999989867e-01f, -9.111302495e-01f, 3.416602612e-01f, -9.566441774e-01f, -2.965079620e-02f, 6.216099262e-01f, 8.746382594e-01f, 9.597726464e-01f, 9.872201085e-01f, 9.959527254e-01f, 9.987195730e-01f, 9.995950460e-01f, 9.998719096e-01f, 9.999595284e-01f, 9.999871850e-01f, 9.999959469e-01f, 9.999987483e-01f, -8.390715122e-01f, 7.901318669e-01f, -9.997860789e-01f, -2.059976310e-01f, 5.403022766e-01f, 8.460091352e-01f, 9.504153132e-01f, 9.842302203e-01f, 9.950041771e-01f, 9.984192848e-01f, 9.995000362e-01f, 9.998418689e-01f, 9.999499917e-01f, 9.999842048e-01f, 9.999949932e-01f, 9.999983907e-01f, 4.425697960e-03f, 9.952573776e-01f, -9.437797666e-01f, -3.758473992e-01f, 4.535960853e-01f, 8.147053123e-01f, 9.401075840e-01f, 9.809291363e-01f, 9.939560890e-01f, 9.980874062e-01f, 9.993950725e-01f, 9.998086691e-01f, 9.999395013e-01f, 9.999808669e-01f, 9.999939203e-01f, 9.999980927e-01f, 8.438539505e-01f, 8.938615918e-01f, -7.941793799e-01f, -5.338430405e-01f, 3.623577058e-01f, 7.808259130e-01f, 9.288598895e-01f, 9.773178697e-01f, 9.928086400e-01f, 9.977239966e-01f, 9.992800951e-01f, 9.997723103e-01f, 9.999279976e-01f, 9.999772310e-01f, 9.999927878e-01f, 9.999977350e-01f, 9.074468017e-01f, 5.171728730e-01f, -5.658205152e-01f, -6.750016809e-01f, 2.674987614e-01f, 7.444779873e-01f, 9.166833758e-01f, 9.733975530e-01f, 9.915618896e-01f, 9.973290563e-01f, 9.991551042e-01f, 9.997327924e-01f, 9.999154806e-01f, 9.999732971e-01f, 9.999915361e-01f, 9.999973178e-01f, 1.367372125e-01f, -1.879615150e-02f, -2.813494802e-01f, -7.948709130e-01f, 1.699671596e-01f, 7.057763934e-01f, 9.035902619e-01f, 9.691694379e-01f, 9.902160168e-01f, 9.969025850e-01f, 9.990201592e-01f, 9.996901155e-01f, 9.999020100e-01f, 9.999690056e-01f, 9.999902248e-01f, 9.999969006e-01f, -7.596879005e-01f, -5.489754677e-01f, 3.102235124e-02f, -8.896704316e-01f, 7.073719800e-02f, 6.648434997e-01f, 8.895936012e-01f, 9.646348357e-01f, 9.887710810e-01f, 9.964445233e-01f, 9.988752007e-01f, 9.996442795e-01f, 9.998875260e-01f, 9.999644160e-01f, 9.999887347e-01f, 9.999964237e-01f, -9.576594830e-01f, -9.100810885e-01f, 3.403181732e-01f, -9.564100504e-01f, -2.919954620e-02f, 6.218088269e-01f, 8.747074604e-01f, 9.597951770e-01f, 9.872272611e-01f, 9.959549904e-01f, 9.987202883e-01f, 9.995952845e-01f, 9.998720288e-01f, 9.999595284e-01f, 9.999871850e-01f, 9.999959469e-01f, -2.751633525e-01f, -9.908979535e-01f, 6.158648133e-01f, -9.929850101e-01f, -1.288445443e-01f, 5.768082738e-01f, 8.589466810e-01f, 9.546520114e-01f, 9.855847955e-01f, 9.954339862e-01f, 9.985553622e-01f, 9.995430708e-01f, 9.998555183e-01f, 9.999542832e-01f, 9.999855757e-01f, 9.999954104e-01f, 6.603167057e-01f, -7.665365338e-01f, 8.303361535e-01f, -9.982416630e-01f, -2.272021621e-01f, 5.299841762e-01f, 8.423270583e-01f, 9.492070079e-01f, 9.838436842e-01f, 9.948815107e-01f, 9.983804226e-01f, 9.994877577e-01f, 9.998379946e-01f, 9.999487996e-01f, 9.999837875e-01f, 9.999948740e-01f, 9.887046218e-01f, -3.060953915e-01f, 9.624637961e-01f, -9.720142484e-01f, -3.232895434e-01f, 4.814845920e-01f, 8.248651624e-01f, 9.434618354e-01f, 9.820042253e-01f, 9.942975044e-01f, 9.981955290e-01f, 9.994292855e-01f, 9.998195171e-01f, 9.999428988e-01f, 9.999819398e-01f, 9.999942780e-01f, 4.080820680e-01f, 2.486167252e-01f, 9.991443753e-01f, -9.151299596e-01f, -4.161468446e-01f, 4.314628243e-01f, 8.065784574e-01f, 9.374182820e-01f, 9.800665975e-01f, 9.936820865e-01f, 9.980006814e-01f, 9.993675947e-01f, 9.998000264e-01f, 9.999367595e-01f, 9.999799728e-01f, 9.999936819e-01f, -5.477292538e-01f, 7.267602682e-01f, 9.367404580e-01f, -8.293829560e-01f, -5.048462152e-01f, 3.800770044e-01f, 7.874851823e-01f, 9.310783744e-01f, 9.780309200e-01f, 9.930352569e-01f, 9.977958202e-01f, 9.993028045e-01f, 9.997795224e-01f, 9.999302626e-01f, 9.999779463e-01f, 9.999930263e-01f, -9.999608397e-01f, 9.810745716e-01f, 7.814403772e-01f, -7.174774408e-01f, -5.885011554e-01f, 3.274895847e-01f, 7.676045895e-01f, 9.244439602e-01f, 9.758974314e-01f, 9.923570156e-01f, 9.975810051e-01f, 9.992348552e-01f, 9.997580051e-01f, 9.999234676e-01f, 9.999758005e-01f, 9.999923706e-01f, -5.328330398e-01f, 9.332357645e-01f, 5.486452579e-01f, -5.829432607e-01f, -6.662759781e-01f, 2.738668323e-01f, 7.469564080e-01f, 9.175173044e-01f, 9.736663699e-01f, 9.916474223e-01f, 9.973561764e-01f, 9.991636872e-01f, 9.997355342e-01f, 9.999163747e-01f, 9.999735355e-01f, 9.999916553e-01f, 4.241790175e-01f, 5.979771614e-01f, 2.614416778e-01f, -4.300232828e-01f, -7.373937964e-01f, 2.193782777e-01f, 7.255613208e-01f, 9.103004336e-01f, 9.713379741e-01f, 9.909064770e-01f, 9.971213937e-01f, 9.990894198e-01f, 9.997119904e-01f, 9.999089241e-01f, 9.999712110e-01f, 9.999908805e-01f, 9.912028313e-01f, 7.855226099e-02f, -5.168933049e-02f, -2.635405958e-01f, -8.011435866e-01f, 1.641961634e-01f, 7.034407258e-01f, 9.027957320e-01f, 9.689124227e-01f, 9.901341200e-01f, 9.968766570e-01f, 9.990119338e-01f, 9.996874928e-01f, 9.999011755e-01f, 9.999687672e-01f, 9.999901056e-01f, 6.469193101e-01f, -4.650644958e-01f, -3.596943319e-01f, -8.874550462e-02f, -8.568888307e-01f, 1.084949449e-01f, 6.806167960e-01f, 8.950055838e-01f, 9.663899541e-01f, 9.893305302e-01f, 9.966219068e-01f, 9.989313483e-01f, 9.996620417e-01f, 9.998931289e-01f, 9.999662042e-01f, 9.999893308e-01f, -2.921388149e-01f, -8.654506207e-01f, -6.320286393e-01f, 8.884811401e-02f, -9.040721655e-01f, 5.245061591e-02f, 6.571123004e-01f, 8.869323730e-01f, 9.637709260e-01f, 9.884956479e-01f, 9.963572025e-01f, 9.988475442e-01f, 9.996355176e-01f, 9.998847246e-01f, 9.999635220e-01f, 9.999884963e-01f, -9.626058936e-01f, -9.992933869e-01f, -8.416849375e-01f, 2.636395097e-01f, -9.422222972e-01f, -3.759419080e-03f, 6.329506636e-01f, 8.785787225e-01f, 9.610554576e-01f, 9.876294732e-01f, 9.960825443e-01f, 9.987606406e-01f, 9.996080399e-01f, 9.998760223e-01f, 9.999607801e-01f, 9.999876022e-01f, -7.480575442e-01f, -8.253716230e-01f, -9.678714871e-01f, 4.301158488e-01f, -9.709581733e-01f, -5.995756760e-02f, 6.081562042e-01f, 8.699471951e-01f, 9.582439065e-01f, 9.867320657e-01f, 9.957979321e-01f, 9.986705780e-01f, 9.995795488e-01f, 9.998670220e-01f, 9.999579787e-01f, 9.999867082e-01f, 1.542514563e-01f, -3.972518742e-01f, -9.980752468e-01f, 5.830269456e-01f, -9.899924994e-01f, -1.159661636e-01f, 5.827536583e-01f, 8.610406518e-01f, 9.553365111e-01f, 9.858034849e-01f, 9.955033660e-01f, 9.985772967e-01f, 9.995500445e-01f, 9.998577237e-01f, 9.999549985e-01f, 9.999857545e-01f, 9.147423506e-01f, 1.532154828e-01f, -9.293003082e-01f, 7.175492048e-01f, -9.991351366e-01f, -1.716081351e-01f, 5.567683578e-01f, 8.518617749e-01f, 9.523335695e-01f, 9.848436713e-01f, 9.951988459e-01f, 9.984809160e-01f, 9.995195270e-01f, 9.998480678e-01f, 9.999519587e-01f, 9.999848008e-01f, 8.342233896e-01f, 6.564951539e-01f, -7.683671117e-01f, 8.294403553e-01f, -9.982947707e-01f, -2.267075777e-01f, 5.302263498e-01f, 8.424135447e-01f, 9.492354393e-01f, 9.838528037e-01f, 9.948843718e-01f, 9.983813763e-01f, 9.994880557e-01f, 9.998381138e-01f, 9.999487996e-01f, 9.999837875e-01f, -1.327674743e-02f, 9.575860500e-01f, -5.312352777e-01f, 9.151713848e-01f, -9.874798059e-01f, -2.810903192e-01f, 5.031541586e-01f, 8.326989412e-01f, 9.460423589e-01f, 9.828307629e-01f, 9.945599437e-01f, 9.982786179e-01f, 9.994555712e-01f, 9.998278022e-01f, 9.999455214e-01f, 9.999827743e-01f, -8.485702872e-01f, 9.637575150e-01f, -2.414211184e-01f, 9.720383286e-01f, -9.667981863e-01f, -3.345843852e-01f, 4.755789042e-01f, 8.227210045e-01f, 9.427546859e-01f, 9.817776680e-01f, 9.942255616e-01f, 9.981727600e-01f, 9.994220734e-01f, 9.998172522e-01f, 9.999421835e-01f, 9.999817014e-01f, -9.036921859e-01f, 6.731102467e-01f, 7.233466953e-02f, 9.982477427e-01f, -9.364566803e-01f, -3.870206773e-01f, 4.475280643e-01f, 8.124829531e-01f, 9.393727183e-01f, 9.806935191e-01f, 9.938812256e-01f, 9.980637431e-01f, 9.993875623e-01f, 9.998063445e-01f, 9.999387264e-01f, 9.999806285e-01f, -1.279636919e-01f, 1.751565337e-01f, 3.789161742e-01f, 9.929728508e-01f, -8.967583776e-01f, -4.382335544e-01f, 4.190297425e-01f, 8.019878864e-01f, 9.358968139e-01f, 9.795783162e-01f, 9.935269952e-01f, 9.979515672e-01f, 9.993520975e-01f, 9.997950792e-01f, 9.999352098e-01f, 9.999794960e-01f, 7.654140592e-01f, -3.767423034e-01f, 6.479216814e-01f, 9.563800097e-01f, -8.481000066e-01f, -4.880608618e-01f, 3.901124299e-01f, 7.912392616e-01f, 9.323273301e-01f, 9.784321785e-01f, 9.931628108e-01f, 9.978361726e-01f, 9.993155599e-01f, 9.997835755e-01f, 9.999315739e-01f, 9.999783635e-01f, 9.550736547e-01f, -8.126112223e-01f, 8.526731133e-01f, 8.896234632e-01f, -7.909677625e-01f, -5.363451838e-01f, 3.608050346e-01f, 7.802404165e-01f, 9.286646247e-01f, 9.772551060e-01f, 9.927886724e-01f, 9.977176785e-01f, 9.992780685e-01f, 9.997717142e-01f, 9.999278188e-01f, 9.999771714e-01f, 2.666429281e-01f, -9.982103705e-01f, 9.728653431e-01f, 7.948083878e-01f, -7.259322405e-01f, -5.829339027e-01f, 3.311368525e-01f, 7.689949274e-01f, 9.249090552e-01f, 9.760470986e-01f, 9.924046397e-01f, 9.975960255e-01f, 9.992396235e-01f, 9.997594953e-01f, 9.999239445e-01f, 9.999759793e-01f, -6.669380665e-01f, -8.763794303e-01f, 9.965789914e-01f, 6.749256253e-01f, -6.536436081e-01f, -6.276797056e-01f, 3.011375964e-01f, 7.575061917e-01f, 9.210609794e-01f, 9.748082757e-01f, 9.920106530e-01f, 9.974712729e-01f, 9.992001057e-01f, 9.997470379e-01f, 9.999200106e-01f, 9.999747276e-01f, -9.873392582e-01f, -4.846394062e-01f, 9.214623570e-01f, 5.337560773e-01f, -5.748240352e-01f, -6.704410911e-01f, 2.708370686e-01f, 7.457779050e-01f, 9.171208143e-01f, 9.735385776e-01f, 9.916067719e-01f, 9.973433018e-01f, 9.991596341e-01f, 9.997342229e-01f, 9.999159575e-01f, 9.999734163e-01f, -3.999853134e-01f, 5.636094138e-02f, 7.549653649e-01f, 3.757521510e-01f, -4.902605712e-01f, -7.110829353e-01f, 2.402658761e-01f, 7.338138223e-01f, 9.130889177e-01f, 9.722381234e-01f, 9.911929369e-01f, 9.972121716e-01f, 9.991181493e-01f, 9.997211099e-01f, 9.999117851e-01f, 9.999721050e-01f, 5.551133156e-01f, 5.800031424e-01f, 5.135984421e-01f, 2.058971673e-01f, -4.007990062e-01f, -7.494767308e-01f, 2.094544172e-01f, 7.216176391e-01f, 9.089657664e-01f, 9.709069133e-01f, 9.907692075e-01f, 9.970778823e-01f, 9.990756512e-01f, 9.997076392e-01f, 9.999075532e-01f, 9.999707937e-01f, 9.998432994e-01f, 9.250146747e-01f, 2.212981731e-01f, 2.954781987e-02f, -3.073327839e-01f, -7.855011225e-01f, 1.784335226e-01f, 7.091933489e-01f, 9.047516584e-01f, 9.695450068e-01f, 9.903355837e-01f, 9.969404936e-01f, 9.990321398e-01f, 9.996939301e-01f, 9.999032021e-01f, 9.999693632e-01f, 5.253219604e-01f, 9.851381779e-01f, -9.294810891e-02f, -1.477329880e-01f, -2.107958049e-01f, -8.190422058e-01f, 1.472342163e-01f, 6.965447664e-01f, 9.004471302e-01f, 9.681524038e-01f, 9.898920655e-01f, 9.967998862e-01f, 9.989876747e-01f, 9.996798635e-01f, 9.998987317e-01f, 9.999679923e-01f, -4.321779311e-01f, 7.418580055e-01f, -3.979767561e-01f, -3.203543723e-01f, -1.121526212e-01f, -8.499938846e-01f, 1.158876941e-01f, 6.836758852e-01f, 8.960524797e-01f, 9.667292237e-01f, 9.894386530e-01f, 9.966561794e-01f, 9.989421964e-01f, 9.996654391e-01f, 9.998942018e-01f, 9.999665618e-01f, -9.923354983e-01f, 2.700984478e-01f, -6.635382771e-01f, -4.828719497e-01f, -1.238837745e-02f, -8.782584071e-01f, 8.442528546e-02f, 6.705908775e-01f, 8.915683031e-01f, 9.652754664e-01f, 9.889753461e-01f, 9.965093136e-01f, 9.988957047e-01f, 9.996507764e-01f, 9.998895526e-01f, 9.999650717e-01f, -6.401443481e-01f, -2.848466039e-01f, -8.632965088e-01f, -6.301599741e-01f, 8.749917150e-02f, -9.037463665e-01f, 5.287845805e-02f, 6.572937369e-01f, 8.869948983e-01f, 9.637911916e-01f, 9.885020852e-01f, 9.963592887e-01f, 9.988481998e-01f, 9.996357560e-01f, 9.998847842e-01f, 9.999635816e-01f, 3.005925417e-01f, -7.520639896e-01f, -9.774427414e-01f, -7.575730681e-01f, 1.865124702e-01f, -9.263771176e-01f, 2.127875760e-02f, 6.437888145e-01f, 8.823328614e-01f, 9.622764587e-01f, 9.880189896e-01f, 9.962061048e-01f, 9.987997413e-01f, 9.996203780e-01f, 9.998799562e-01f, 9.999620318e-01f, 9.649659991e-01f, -9.876590967e-01f, -9.946564436e-01f, -8.610926867e-01f, 2.836622000e-01f, -9.460792542e-01f, -1.034221891e-02f, 6.300802827e-01f, 8.775825500e-01f, 9.607312679e-01f, 9.875259995e-01f, 9.960497618e-01f, 9.987502694e-01f, 9.996047616e-01f, 9.998750091e-01f, 9.999604821e-01f, 7.421541810e-01f, -9.190735221e-01f, -9.132301211e-01f, -9.374542236e-01f, 3.779776692e-01f, -9.627903700e-01f, -4.195285589e-02f, 6.161724925e-01f, 8.727445006e-01f, 9.591556787e-01f, 9.870231748e-01f, 9.958902597e-01f, 9.986997843e-01f, 9.995887876e-01f, 9.998699427e-01f, 9.999588728e-01f, -1.629907787e-01f, -5.674300194e-01f, -7.412399650e-01f, -9.842484593e-01f, 4.685169160e-01f, -9.764577150e-01f, -7.352153957e-02f, 6.020699143e-01f, 8.678191900e-01f, 9.575498104e-01f, 9.865104556e-01f, 9.957276583e-01f, 9.986482859e-01f, 9.995725155e-01f, 9.998648167e-01f, 9.999572635e-01f, -9.182828069e-01f, -4.102819040e-02f, -4.957418144e-01f, -1.000000000e+00f, 5.543745160e-01f, -9.870380163e-01f, -1.050167084e-01f, 5.877769589e-01f, 8.628070951e-01f, 9.559136033e-01f, 9.859878421e-01f, 9.955618382e-01f, 9.985958338e-01f, 9.995558858e-01f, 9.998595715e-01f, 9.999555945e-01f, -8.293098211e-01f, 4.980095923e-01f, -2.010796219e-01f, -9.842120409e-01f, 6.346929669e-01f, -9.944978952e-01f, -1.364068687e-01f, 5.732980371e-01f, 8.577086926e-01f, 9.542471766e-01f, 9.854553938e-01f, 9.953929186e-01f, 9.985423684e-01f, 9.995389581e-01f, 9.998542070e-01f, 9.999538660e-01f, 2.212675661e-02f, 8.836693168e-01f, 1.135217771e-01f, -9.373825192e-01f, 7.086697817e-01f, -9.988136292e-01f, -1.676606387e-01f, 5.586379170e-01f, 8.525245190e-01f, 9.525505900e-01f, 9.849131107e-01f, 9.952208400e-01f, 9.984878898e-01f, 9.995217323e-01f, 9.998487830e-01f, 9.999521971e-01f, 8.532201052e-01f, 9.971746206e-01f, 4.168670774e-01f, -8.609884381e-01f, 7.755658031e-01f, -9.999717474e-01f, -1.987468749e-01f, 5.438010693e-01f, 8.472551107e-01f, 9.508239031e-01f, 9.843609333e-01f, 9.950456619e-01f, 9.984323978e-01f, 9.995042086e-01f, 9.998431802e-01f, 9.999504089e-01f, 8.998668194e-01f, 8.035690784e-01f, 6.788702011e-01f, -7.574391961e-01f, 8.347129226e-01f, -9.979684949e-01f, -2.296342701e-01f, 5.287923217e-01f, 8.419010043e-01f, 9.490671158e-01f, 9.837989211e-01f, 9.948672652e-01f, 9.983759522e-01f, 9.994863272e-01f, 9.998375773e-01f, 9.999486208e-01f, 1.191801354e-01f, 3.624766767e-01f, 8.735505342e-01f, -6.300007105e-01f, 8.855196238e-01f, -9.928101897e-01f, -2.602920532e-01f, 5.136163235e-01f, 8.364626765e-01f, 9.472803473e-01f, 9.832270741e-01f, 9.946857691e-01f, 9.983184934e-01f, 9.994681478e-01f, 9.998317957e-01f, 9.999468327e-01f, -7.710801959e-01f, -1.902491003e-01f, 9.816020727e-01f, -4.826923311e-01f, 9.274784923e-01f, -9.845131636e-01f, -2.906895578e-01f, 4.982779026e-01f, 8.309407234e-01f, 9.454635978e-01f, 9.826454520e-01f, 9.945011139e-01f, 9.982600212e-01f, 9.994496703e-01f, 9.998259544e-01f, 9.999449849e-01f, -9.524129629e-01f, -6.843819022e-01f, 9.923083186e-01f, -3.201591671e-01f, 9.601702690e-01f, -9.731037021e-01f, -3.207964003e-01f, 4.827820361e-01f, 8.253356218e-01f, 9.436169863e-01f, 9.820539355e-01f, 9.943132997e-01f, 9.982005358e-01f, 9.994308352e-01f, 9.998199940e-01f, 9.999430776e-01f, -2.581016421e-01f, -9.677396417e-01f, 9.046075940e-01f, -1.475291997e-01f, 9.832684398e-01f, -9.586178064e-01f, -3.505824506e-01f, 4.671334028e-01f, 8.196480274e-01f, 9.417404532e-01f, 9.814526439e-01f, 9.941223264e-01f, 9.981400967e-01f, 9.994117022e-01f, 9.998139739e-01f, 9.999411702e-01f, 6.735071540e-01f, -9.530500174e-01f, 7.271980643e-01f, 2.975377068e-02f, 9.965420961e-01f, -9.411013126e-01f, -3.800179660e-01f, 4.513370395e-01f, 8.138784766e-01f, 9.398342371e-01f, 9.808415174e-01f, 9.939282537e-01f, 9.980786443e-01f, 9.993922710e-01f, 9.998078346e-01f, 9.999392033e-01f, 9.858965874e-01f, -6.448370218e-01f, 4.776714444e-01f, 2.060983330e-01f, 9.998586178e-01f, -9.206095338e-01f, -4.090735018e-01f, 4.353979528e-01f, 8.080275059e-01f, 9.378982186e-01f, 9.802205563e-01f, 9.937310219e-01f, 9.980161786e-01f, 9.993724823e-01f, 9.998015761e-01f, 9.999372363e-01f };
__constant__ float ROPE_SIN[1024] = { 0.000000000e+00f, 0.000000000e+00f, 0.000000000e+00f, 0.000000000e+00f, 0.000000000e+00f, 0.000000000e+00f, 0.000000000e+00f, 0.000000000e+00f, 0.000000000e+00f, 0.000000000e+00f, 0.000000000e+00f, 0.000000000e+00f, 0.000000000e+00f, 0.000000000e+00f, 0.000000000e+00f, 0.000000000e+00f, 8.414709568e-01f, 5.331684351e-01f, 3.109835982e-01f, 1.768921912e-01f, 9.983342141e-02f, 5.620449781e-02f, 3.161750361e-02f, 1.778185740e-02f, 9.999833070e-03f, 5.623383448e-03f, 3.162272274e-03f, 1.778278500e-03f, 9.999999311e-04f, 5.623412435e-04f, 3.162277571e-04f, 1.778279402e-04f, 9.092974067e-01f, 9.021307230e-01f, 5.911270976e-01f, 3.482052684e-01f, 1.986693293e-01f, 1.122313142e-01f, 6.320339441e-02f, 3.555808961e-02f, 1.999866590e-02f, 1.124658901e-02f, 6.324512884e-03f, 3.556551412e-03f, 1.999998698e-03f, 1.124682371e-03f, 6.324554561e-04f, 3.556558804e-04f, 1.411200017e-01f, 9.932531714e-01f, 8.126488924e-01f, 5.085361004e-01f, 2.955202162e-01f, 1.679033041e-01f, 9.472608566e-02f, 5.332308263e-02f, 2.999549918e-02f, 1.686943881e-02f, 9.486690164e-03f, 5.334813148e-03f, 2.999995602e-03f, 1.687023090e-03f, 9.486831259e-04f, 5.334838061e-04f, -7.568024993e-01f, 7.784717083e-01f, 9.535807371e-01f, 6.528279781e-01f, 3.894183338e-01f, 2.230444849e-01f, 1.261540651e-01f, 7.107120752e-02f, 3.998933360e-02f, 2.249175683e-02f, 1.264877338e-02f, 7.113057654e-03f, 3.999989480e-03f, 2.249363344e-03f, 1.264910679e-03f, 7.113117026e-04f, -9.589242935e-01f, 3.239352703e-01f, 9.999465346e-01f, 7.765299678e-01f, 4.794255495e-01f, 2.774805427e-01f, 1.574558765e-01f, 8.879686147e-02f, 4.997916520e-02f, 2.811336145e-02f, 1.581072807e-02f, 8.891279809e-03f, 4.999979399e-03f, 2.811702900e-03f, 1.581138116e-03f, 8.891395992e-04f, -2.794154882e-01f, -2.303675115e-01f, 9.471482038e-01f, 8.757405281e-01f, 5.646424890e-01f, 3.310393095e-01f, 1.886002719e-01f, 1.064944416e-01f, 5.996400490e-02f, 3.373407945e-02f, 1.897252724e-02f, 1.066947449e-02f, 5.999964196e-03f, 3.374041524e-03f, 1.897365320e-03f, 1.066967379e-03f, 6.569865942e-01f, -7.137212753e-01f, 8.004215956e-01f, 9.473307133e-01f, 6.442176700e-01f, 3.835515678e-01f, 2.195560932e-01f, 1.241583377e-01f, 6.994284689e-02f, 3.935372457e-02f, 2.213413455e-02f, 1.244763471e-02f, 6.999942940e-03f, 3.936378751e-03f, 2.213592408e-03f, 1.244795276e-03f, 9.893582463e-01f, -9.772617817e-01f, 5.743177533e-01f, 9.890424609e-01f, 7.173560858e-01f, 4.348512292e-01f, 2.502923310e-01f, 1.417829692e-01f, 7.991468906e-02f, 4.497213289e-02f, 2.529552206e-02f, 1.422575582e-02f, 7.999914698e-03f, 4.498715047e-03f, 2.529819263e-03f, 1.422623056e-03f, 4.121184945e-01f, -9.398235083e-01f, 2.912592292e-01f, 9.995602965e-01f, 7.833269238e-01f, 4.847761393e-01f, 2.807783186e-01f, 1.593627781e-01f, 8.987854421e-02f, 5.058911815e-02f, 2.845665626e-02f, 1.600383036e-02f, 8.999879472e-03f, 5.061050411e-03f, 2.846045885e-03f, 1.600450720e-03f, -5.440211296e-01f, -6.129369140e-01f, -2.068356983e-02f, 9.785524607e-01f, 8.414709568e-01f, 5.331684351e-01f, 3.109835684e-01f, 1.768921912e-01f, 9.983341396e-02f, 5.620449781e-02f, 3.161750361e-02f, 1.778185740e-02f, 9.999834001e-03f, 5.623383448e-03f, 3.162272274e-03f, 1.778278500e-03f, -9.999902248e-01f, -9.727645665e-02f, -3.305749595e-01f, 9.266815782e-01f, 8.912073970e-01f, 5.798751712e-01f, 3.408778608e-01f, 1.943656504e-01f, 1.097782999e-01f, 6.181810424e-02f, 3.477803990e-02f, 1.955982670e-02f, 1.099977922e-02f, 6.185714621e-03f, 3.478498431e-03f, 1.956106164e-03f, -5.365729332e-01f, 4.483429790e-01f, -6.076834202e-01f, 8.455836177e-01f, 9.320390821e-01f, 6.247486472e-01f, 3.704313040e-01f, 2.117776722e-01f, 1.197122037e-01f, 6.742975861e-02f, 3.793822229e-02f, 2.133773454e-02f, 1.199971233e-02f, 6.748044398e-03f, 3.794723889e-03f, 2.133933594e-03f, 4.201670289e-01f, 8.558809757e-01f, -8.245284557e-01f, 7.378162146e-01f, 9.635581970e-01f, 6.676470041e-01f, 3.996143043e-01f, 2.291227132e-01f, 1.296341419e-01f, 7.303927839e-02f, 4.109803215e-02f, 2.311557345e-02f, 1.299963426e-02f, 7.310371846e-03f, 4.110949114e-03f, 2.311761025e-03f, 9.906073809e-01f, 9.998233318e-01f, -9.596053958e-01f, 6.067785621e-01f, 9.854497313e-01f, 7.084347010e-01f, 4.283977747e-01f, 2.463953048e-01f, 1.395431161e-01f, 7.864648104e-02f, 4.425742477e-02f, 2.489333972e-02f, 1.399954315e-02f, 7.872696966e-03f, 4.427174106e-03f, 2.489588689e-03f, 6.502878666e-01f, 8.358384371e-01f, -9.995186925e-01f, 4.566032588e-01f, 9.974949956e-01f, 7.469826341e-01f, 4.567528665e-01f, 2.635899782e-01f, 1.494381279e-01f, 8.425120264e-02f, 4.741638154e-02f, 2.667102963e-02f, 1.499943808e-02f, 8.435020223e-03f, 4.743398633e-03f, 2.667415887e-03f, -2.879033089e-01f, 4.144302309e-01f, -9.403103590e-01f, 2.920270860e-01f, 9.995735884e-01f, 7.831690907e-01f, 4.846512377e-01f, 2.807013094e-01f, 1.593182087e-01f, 8.985326439e-02f, 5.057485774e-02f, 2.844863199e-02f, 1.599931903e-02f, 8.997339755e-03f, 5.059622694e-03f, 2.845243318e-03f, -9.613974690e-01f, -1.346151382e-01f, -7.878518701e-01f, 1.182405204e-01f, 9.916648269e-01f, 8.168795705e-01f, 5.120649934e-01f, 2.977238595e-01f, 1.691823453e-01f, 9.545248002e-02f, 5.373282731e-02f, 3.022614494e-02f, 1.699918136e-02f, 9.559656493e-03f, 5.375845823e-03f, 3.023070283e-03f, -7.509872317e-01f, -6.422007084e-01f, -5.572628975e-01f, -5.927551910e-02f, 9.738476276e-01f, 8.480075598e-01f, 5.389667153e-01f, 3.146522641e-01f, 1.790295690e-01f, 1.010486856e-01f, 5.689026415e-02f, 3.200356290e-02f, 1.799902879e-02f, 1.012197044e-02f, 5.692068953e-03f, 3.200897481e-03f, 1.498772055e-01f, -9.520008564e-01f, -2.714101076e-01f, -2.349217981e-01f, 9.463000894e-01f, 8.764545321e-01f, 5.653295517e-01f, 3.314811885e-01f, 1.888588965e-01f, 1.066416800e-01f, 6.004713103e-02f, 3.378088027e-02f, 1.899885759e-02f, 1.068428159e-02f, 6.008291151e-03f, 3.378724447e-03f, 9.129452705e-01f, -9.686019421e-01f, 4.135828838e-02f, -4.031589925e-01f, 9.092974067e-01f, 9.021307230e-01f, 5.911270380e-01f, 3.482052684e-01f, 1.986693144e-01f, 1.122313142e-01f, 6.320339441e-02f, 3.555808961e-02f, 1.999866776e-02f, 1.124658901e-02f, 6.324512884e-03f, 3.556551412e-03f, 8.366556168e-01f, -6.868911982e-01f, 3.500247598e-01f, -5.586805344e-01f, 8.632093072e-01f, 9.249548316e-01f, 6.163335443e-01f, 3.648192585e-01f, 2.084598988e-01f, 1.178173944e-01f, 6.635902822e-02f, 3.733518720e-02f, 2.099845745e-02f, 1.180889271e-02f, 6.640734151e-03f, 3.734378144e-03f, -8.851309307e-03f, -1.936302334e-01f, 6.239799261e-01f, -6.965817213e-01f, 8.084963560e-01f, 9.448547959e-01f, 6.409237385e-01f, 3.813178837e-01f, 2.182296216e-01f, 1.233997419e-01f, 6.951400638e-02f, 3.911216930e-02f, 2.199822664e-02f, 1.237119269e-02f, 6.956954487e-03f, 3.912204877e-03f, -8.462204337e-01f, 3.592645228e-01f, 8.360552788e-01f, -8.125128746e-01f, 7.457052469e-01f, 9.617676139e-01f, 6.648730636e-01f, 3.976959288e-01f, 2.279775143e-01f, 1.289781928e-01f, 7.266827673e-02f, 4.088902473e-02f, 2.299797349e-02f, 1.293348987e-02f, 7.273174357e-03f, 4.090031609e-03f, -9.055783749e-01f, 8.015131354e-01f, 9.652192593e-01f, -9.028177857e-01f, 6.754631400e-01f, 9.756398797e-01f, 6.881574988e-01f, 4.139482081e-01f, 2.377026230e-01f, 1.345525682e-01f, 7.582182437e-02f, 4.266574979e-02f, 2.399769612e-02f, 1.349578146e-02f, 7.589393295e-03f, 4.267857410e-03f, -1.323517561e-01f, 9.969099760e-01f, 9.986631870e-01f, -9.646483064e-01f, 5.984721184e-01f, 9.864277244e-01f, 7.107539177e-01f, 4.300695956e-01f, 2.474039644e-01f, 1.401226968e-01f, 7.897461206e-02f, 4.444234073e-02f, 2.499739639e-02f, 1.405806933e-02f, 7.905611768e-03f, 4.445684142e-03f, 7.625584602e-01f, 8.852767944e-01f, 9.330701828e-01f, -9.960543513e-01f, 5.155012608e-01f, 9.940969944e-01f, 7.326396108e-01f, 4.460549951e-01f, 2.570805550e-01f, 1.456883848e-01f, 8.212661743e-02f, 4.621879384e-02f, 2.599707060e-02f, 1.462035347e-02f, 8.221829310e-03f, 4.623509943e-03f, 9.563759565e-01f, 5.009942055e-01f, 7.749450207e-01f, -9.960451722e-01f, 4.273798466e-01f, 9.986234903e-01f, 7.537927032e-01f, 4.618993104e-01f, 2.667314112e-01f, 1.512494683e-01f, 8.527779579e-02f, 4.799510166e-02f, 2.699672058e-02f, 1.518263202e-02f, 8.538045920e-03f, 4.801335745e-03f, 2.709057927e-01f, -3.758566082e-02f, 5.399689674e-01f, -9.646213055e-01f, 3.349882066e-01f, 9.999929070e-01f, 7.741920948e-01f, 4.775975943e-01f, 2.763556540e-01f, 1.568057537e-01f, 8.842811733e-02f, 4.977125302e-02f, 2.799634263e-02f, 1.574490592e-02f, 8.854261599e-03f, 4.979162011e-03f, -6.636338830e-01f, -5.645897985e-01f, 2.514453232e-01f, -9.027736783e-01f, 2.392492294e-01f, 9.982009530e-01f, 7.938174009e-01f, 4.931448400e-01f, 2.859522104e-01f, 1.623570919e-01f, 9.157756716e-02f, 5.154724792e-02f, 2.899593674e-02f, 1.630717516e-02f, 9.170476347e-03f, 5.156987347e-03f, -9.880316257e-01f, -9.177096486e-01f, -6.201484054e-02f, -8.124528527e-01f, 1.411200017e-01f, 9.932531714e-01f, 8.126488924e-01f, 5.085361004e-01f, 2.955201864e-01f, 1.679033041e-01f, 9.472609311e-02f, 5.332308263e-02f, 2.999550104e-02f, 1.686943881e-02f, 9.486690164e-03f, 5.334813148e-03f, -4.040376544e-01f, -9.881927967e-01f, -3.693250120e-01f, -6.965078115e-01f, 4.158052057e-02f, 9.851652980e-01f, 8.306677938e-01f, 5.237666368e-01f, 3.050586283e-01f, 1.734442115e-01f, 9.787366539e-02f, 5.509874597e-02f, 3.099503554e-02f, 1.743169688e-02f, 9.802903049e-03f, 5.512638018e-03f, 5.514267087e-01f, -7.543302178e-01f, -6.400094032e-01f, -5.585952997e-01f, -5.837419257e-02f, 9.739628434e-01f, 8.478561044e-01f, 5.388315320e-01f, 3.145665526e-01f, 1.789796203e-01f, 1.010202691e-01f, 5.687423423e-02f, 3.199454024e-02f, 1.799395122e-02f, 1.011911593e-02f, 5.690463353e-03f, 9.999118447e-01f, -2.881473899e-01f, -8.472243547e-01f, -4.030649364e-01f, -1.577456445e-01f, 9.596813321e-01f, 8.641966581e-01f, 5.537260175e-01f, 3.240430057e-01f, 1.845093668e-01f, 1.041658595e-01f, 5.864954367e-02f, 3.299400955e-02f, 1.855619811e-02f, 1.043532696e-02f, 5.868288688e-03f, 5.290827155e-01f, 2.667797208e-01f, -9.704204202e-01f, -2.348221242e-01f, -2.555412054e-01f, 9.423658252e-01f, 8.796730638e-01f, 5.684453845e-01f, 3.334870934e-01f, 1.900332868e-01f, 1.073104069e-01f, 6.042466685e-02f, 3.399345279e-02f, 1.911843941e-02f, 1.075153705e-02f, 6.046113092e-03f, -4.281826615e-01f, 7.395421267e-01f, -9.973804355e-01f, -5.917267874e-02f, -3.507832289e-01f, 9.220710397e-01f, 8.942698836e-01f, 5.829849839e-01f, 3.428978026e-01f, 1.955512017e-01f, 1.104538813e-01f, 6.219960377e-02f, 3.499285504e-02f, 1.968067512e-02f, 1.106774528e-02f, 6.223937962e-03f, -9.917788506e-01f, 9.845405817e-01f, -9.254310131e-01f, 1.183425859e-01f, -4.425205588e-01f, 8.988611698e-01f, 9.079725146e-01f, 5.973402858e-01f, 3.522742093e-01f, 2.010629177e-01f, 1.135962531e-01f, 6.397433579e-02f, 3.599222749e-02f, 2.024290524e-02f, 1.138395350e-02f, 6.401761901e-03f, -6.435381174e-01f, 9.263181090e-01f, -7.617069483e-01f, 2.921253741e-01f, -5.298361778e-01f, 8.728095889e-01f, 9.207672477e-01f, 6.115067005e-01f, 3.616154492e-01f, 2.065682709e-01f, 1.167374924e-01f, 6.574887782e-02f, 3.699155897e-02f, 2.080512606e-02f, 1.170015987e-02f, 6.579586305e-03f, 2.963685691e-01f, 5.828061700e-01f, -5.224447846e-01f, 4.566946924e-01f, -6.118578315e-01f, 8.439987302e-01f, 9.326412678e-01f, 6.254796982e-01f, 3.709204793e-01f, 2.120671123e-01f, 1.198775545e-01f, 6.752320379e-02f, 3.799085692e-02f, 2.136734314e-02f, 1.201636530e-02f, 6.757410709e-03f, 9.637953639e-01f, 5.980031565e-02f, -2.313720137e-01f, 6.068604589e-01f, -6.877662539e-01f, 8.125196099e-01f, 9.435827136e-01f, 6.392549276e-01f, 3.801884055e-01f, 2.175592482e-01f, 1.230164245e-01f, 6.929731369e-02f, 3.899011388e-02f, 2.192955278e-02f, 1.233256981e-02f, 6.935234182e-03f, 7.451131344e-01f, -4.816212952e-01f, 8.264580369e-02f, 7.378857136e-01f, -7.568024993e-01f, 7.784717083e-01f, 9.535806775e-01f, 6.528279781e-01f, 3.894183338e-01f, 2.230444849e-01f, 1.261540651e-01f, 7.107120752e-02f, 3.998933733e-02f, 2.249175683e-02f, 1.264877338e-02f, 7.113057654e-03f, -1.586226672e-01f, -8.747140169e-01f, 3.884676993e-01f, 8.456384540e-01f, -8.182770610e-01f, 7.419627905e-01f, 9.626252055e-01f, 6.661946774e-01f, 3.986093104e-01f, 2.285226882e-01f, 1.292904317e-01f, 7.284487784e-02f, 4.098851606e-02f, 2.305394970e-02f, 1.296497509e-02f, 7.290880661e-03f, -9.165215492e-01f, -9.984104633e-01f, 6.557646990e-01f, 9.267202020e-01f, -8.715758920e-01f, 7.031081319e-01f, 9.707071185e-01f, 6.793506742e-01f, 4.077604413e-01f, 2.339936644e-01f, 1.324255317e-01f, 7.461831719e-02f, 4.198765755e-02f, 2.361613885e-02f, 1.328117587e-02f, 7.468704134e-03f, -8.317747712e-01f, -8.146142364e-01f, 8.580306768e-01f, 9.785736203e-01f, -9.161660075e-01f, 6.620306373e-01f, 9.778184295e-01f, 6.922917962e-01f, 4.168707728e-01f, 2.394572198e-01f, 1.355592906e-01f, 7.639151812e-02f, 4.298675060e-02f, 2.417832054e-02f, 1.359737478e-02f, 7.646527141e-03f, 1.770192571e-02f, -3.799313903e-01f, 9.752061963e-01f, 9.995633960e-01f, -9.516021013e-01f, 6.188601851e-01f, 9.839519858e-01f, 7.050140500e-01f, 4.259394705e-01f, 2.449132055e-01f, 1.386916935e-01f, 7.816448808e-02f, 4.398580641e-02f, 2.474049293e-02f, 1.391357277e-02f, 7.824349217e-03f, 8.509035110e-01f, 1.717635691e-01f, 9.956709743e-01f, 9.890272617e-01f, -9.775301218e-01f, 5.737332702e-01f, 9.891016483e-01f, 7.175133228e-01f, 4.349655211e-01f, 2.503614724e-01f, 1.418227106e-01f, 7.993719727e-02f, 4.498481750e-02f, 2.530265786e-02f, 1.422976889e-02f, 8.002171293e-03f, 9.017883539e-01f, 6.705570221e-01f, 9.173954725e-01f, 9.472977519e-01f, -9.936909676e-01f, 5.267925262e-01f, 9.932623506e-01f, 7.297857404e-01f, 4.439480901e-01f, 2.558017969e-01f, 1.449523121e-01f, 8.170966059e-02f, 4.598378390e-02f, 2.586481534e-02f, 1.454596408e-02f, 8.179994300e-03f, 1.235731244e-01f, 9.628326893e-01f, 7.481423616e-01f, 8.756909966e-01f, -9.999232888e-01f, 4.781863391e-01f, 9.964298010e-01f, 7.418274283e-01f, 4.528862834e-01f, 2.612340748e-01f, 1.480804533e-01f, 8.348185569e-02f, 4.698270187e-02f, 2.642696351e-02f, 1.486215740e-02f, 8.357816376e-03f, -7.682546377e-01f, 9.585731030e-01f, 5.046970844e-01f, 7.764653563e-01f, -9.961646199e-01f, 4.280683994e-01f, 9.986009598e-01f, 7.536345124e-01f, 4.617791772e-01f, 2.666580379e-01f, 1.512071192e-01f, 8.525379747e-02f, 4.798157141e-02f, 2.698910423e-02f, 1.517834887e-02f, 8.535637520e-03f, -9.537526369e-01f, 6.590901017e-01f, 2.112006545e-01f, 6.527503729e-01f, -9.824525714e-01f, 3.765971363e-01f, 9.997735620e-01f, 7.652031779e-01f, 4.706258774e-01f, 2.720735669e-01f, 1.543322802e-01f, 8.702547103e-02f, 4.898039624e-02f, 2.755123749e-02f, 1.549453940e-02f, 8.713459596e-03f, -2.623748481e-01f, 1.566190720e-01f, -1.032404602e-01f, 5.084479451e-01f, -9.589242935e-01f, 3.239352703e-01f, 9.999465346e-01f, 7.765299678e-01f, 4.794255495e-01f, 2.774805427e-01f, 1.574558914e-01f, 8.879686147e-02f, 4.997916892e-02f, 2.811335959e-02f, 1.581072807e-02f, 8.891279809e-03f, 6.702291965e-01f, -3.940860629e-01f, -4.074441493e-01f, 3.481085002e-01f, -9.258147478e-01f, 2.702493370e-01f, 9.991195798e-01f, 7.876111865e-01f, 4.881772399e-01f, 2.828786969e-01f, 1.605779380e-01f, 9.056797624e-02f, 5.097789690e-02f, 2.867547423e-02f, 1.612691768e-02f, 9.069100954e-03f, 9.866275787e-01f, -8.234215975e-01f, -6.712401509e-01f, 1.767906845e-01f, -8.834545016e-01f, 2.157090008e-01f, 9.972936511e-01f, 7.984433770e-01f, 4.968801141e-01f, 2.882679403e-01f, 1.636983752e-01f, 9.233880043e-02f, 5.197656900e-02f, 2.923758142e-02f, 1.644310169e-02f, 9.246920235e-03f, 3.959251642e-01f, -9.991579652e-01f, -8.684699535e-01f, -1.030206768e-04f, -8.322673440e-01f, 1.604867280e-01f, 9.944704771e-01f, 8.090230227e-01f, 5.055333376e-01f, 2.936480343e-01f, 1.668171734e-01f, 9.410934150e-02f, 5.297519267e-02f, 2.979967557e-02f, 1.675928757e-02f, 9.424741380e-03f, -5.587890744e-01f, -8.671715260e-01f, -9.795749187e-01f, -1.769934744e-01f, -7.727644444e-01f, 1.047568321e-01f, 9.906529188e-01f, 8.193469048e-01f, 5.141359568e-01f, 2.990188897e-01f, 1.699342877e-01f, 9.587957710e-02f, 5.397376046e-02f, 3.036176413e-02f, 1.707546785e-02f, 9.602561593e-03f, -9.997551441e-01f, -4.681116641e-01f, -9.935355186e-01f, -3.483016491e-01f, -7.055402994e-01f, 4.869600013e-02f, 9.858447909e-01f, 8.294116855e-01f, 5.226872563e-01f, 3.043802381e-01f, 1.730497181e-01f, 9.764950722e-02f, 5.497227982e-02f, 3.092384152e-02f, 1.739165001e-02f, 9.780380875e-03f, -5.215510130e-01f, 7.511820644e-02f, -9.089674354e-01f, -5.086245537e-01f, -6.312667131e-01f, -7.518785074e-03f, 9.800508618e-01f, 8.392141461e-01f, 5.311862230e-01f, 3.097319603e-01f, 1.761634201e-01f, 9.941913933e-02f, 5.597073585e-02f, 3.148590773e-02f, 1.770782843e-02f, 9.958200157e-03f, 4.361647666e-01f, 5.952115059e-01f, -7.342582941e-01f, -6.529057026e-01f, -5.506852865e-01f, -6.370979548e-02f, 9.732769728e-01f, 8.487512469e-01f, 5.396320224e-01f, 3.150739372e-01f, 1.792753637e-01f, 1.011884511e-01f, 5.696914345e-02f, 3.204796836e-02f, 1.802400686e-02f, 1.013601944e-02f, 9.928726554e-01f, 9.319928288e-01f, -4.867334962e-01f, -7.765945792e-01f, -4.646020234e-01f, -1.196993962e-01f, 9.655299187e-01f, 8.580200076e-01f, 5.480239391e-01f, 3.204059005e-01f, 1.823855042e-01f, 1.029574350e-01f, 5.796748772e-02f, 3.261001408e-02f, 1.834018156e-02f, 1.031383779e-02f, 6.367380023e-01f, 9.817358255e-01f, -1.909380108e-01f, -8.757900000e-01f, -3.738765717e-01f, -1.753105819e-01f, 9.568174481e-01f, 8.670173883e-01f, 5.563610196e-01f, 3.257277906e-01f, 1.854938269e-01f, 1.047261059e-01f, 5.896577984e-02f, 3.317204863e-02f, 1.865635626e-02f, 1.049165614e-02f, -3.048106134e-01f, 7.291237116e-01f, 1.237909496e-01f, -9.473637342e-01f, -2.794154882e-01f, -2.303675115e-01f, 9.471482038e-01f, 8.757405281e-01f, 5.646424294e-01f, 3.310393095e-01f, 1.886002868e-01f, 1.064944416e-01f, 5.996400863e-02f, 3.373407945e-02f, 1.897252724e-02f, 1.066947449e-02f, -9.661177993e-01f, 2.519522607e-01f, 4.262454212e-01f, -9.890577197e-01f, -1.821625978e-01f, -2.846961617e-01f, 9.365318418e-01f, 8.841868639e-01f, 5.728674531e-01f, 3.363404274e-01f, 1.917048544e-01f, 1.082624346e-01f, 6.096218154e-02f, 3.429609165e-02f, 1.928869821e-02f, 1.084729191e-02f, -7.391806841e-01f, -3.028128743e-01f, 6.864276528e-01f, -9.995572567e-01f, -8.308912069e-02f, -3.381247520e-01f, 9.249790907e-01f, 8.923535347e-01f, 5.810351372e-01f, 3.416308761e-01f, 1.948075294e-01f, 1.100300923e-01f, 6.196028739e-02f, 3.485809639e-02f, 1.960486546e-02f, 1.102510840e-02f, 1.673557013e-01f, -7.643200755e-01f, 8.785385489e-01f, -9.785313010e-01f, 1.681409031e-02f, -3.904843926e-01f, 9.125014544e-01f, 9.002380967e-01f, 5.891447663e-01f, 3.469105363e-01f, 1.979082376e-01f, 1.117973924e-01f, 6.295833737e-02f, 3.542009369e-02f, 1.992103085e-02f, 1.120292582e-02f };

#define LAS __attribute__((address_space(3)))
typedef unsigned short bf16;
typedef float f32x4 __attribute__((ext_vector_type(4)));
typedef float f32x2 __attribute__((ext_vector_type(2)));
typedef float f32x16 __attribute__((ext_vector_type(16)));
typedef short bf16x8 __attribute__((ext_vector_type(8)));
typedef short s16x4 __attribute__((ext_vector_type(4)));
typedef unsigned u32x4 __attribute__((ext_vector_type(4)));
typedef unsigned u32x2 __attribute__((ext_vector_type(2)));

constexpr int DM = 2048, NB = 8, SEQ = 2048, CTX = 256, DEPTH = 2;
constexpr int NLAT = NB * SEQ, NCTX = NB * CTX, NROW = NLAT + NCTX;
constexpr int INC = 5888, NEXP = 16, EFF = 1024, ADAW = 6 * DM;
constexpr int ZC_RQ = 0, ZC_RK = 512, ZC_RV = 1024, ZC_RG = 1536, ZC_CB = 2048, ZC_CC = 2560, ZC_CH = 3072, ZC_SQ = 3584, ZC_SK = 4096, ZC_SV = 4224, ZC_NQ = 4352, ZC_NK = 4864, ZC_NV = 5376;
constexpr int YC_RET = 0, YC_CONV = 512, YC_SWA = 1024, YC_NA = 1536;
constexpr float LOG2E = 1.4426950408889634f;
constexpr float RMS_EPS = 1e-6f;
constexpr int NWAVES = 8, NTHR = 512;

constexpr size_t MiB = (size_t)1 << 20;
constexpr size_t WS_CTL = 0, CTL_ZERO_BYTES = 1 * MiB;
constexpr size_t WS_ADA = 1 * MiB;
constexpr size_t WS_AFF = 2 * MiB;
constexpr size_t WS_SEL = 4 * MiB;
constexpr size_t WS_IDX = 6 * MiB;
constexpr size_t WS_GATEV = 6 * MiB + 256 * 1024;
constexpr size_t WS_WIN = 8 * MiB;
constexpr size_t WS_WOUT = 54 * MiB;
constexpr size_t WS_WGU = 70 * MiB;
constexpr size_t WS_WD = 326 * MiB;
constexpr size_t WS_XC = 454 * MiB;
constexpr size_t WS_HB = 470 * MiB;
constexpr size_t WS_Z = 542 * MiB;
constexpr size_t WS_ACT = 749 * MiB;
constexpr size_t WS_SST = 821 * MiB;
constexpr size_t WS_SIN = 857 * MiB;
constexpr size_t WS_XB = 876 * MiB;
constexpr size_t WS_END = 948 * MiB;
constexpr int CW_BAR = 4096;

constexpr int LDS_BYTES = 147456;
constexpr int MISC_OFF = 131072 + 320;
constexpr int ROPE_LDS = 131072 + 8192;

struct Params {
    const float* x; const float* c; const float* ctx; const float* c_ctx; const float* w_ada; const float* b_ada; const float* norm_mix; const float* norm_ffn;
    const float* w_in; const float* w_out; const float* dec_f; const float* dec_b; const float* conv_w; const float* sink; const float* rpb; const float* w_router;
    const float* w_gate; const float* w_up; const float* w_down; const float* norm_final;
    float* out; unsigned char* ws;
};

__device__ __forceinline__ float bf2f(unsigned v) { return __uint_as_float(v << 16); }
__device__ __forceinline__ unsigned f2bf(float f) { unsigned u = __float_as_uint(f); return (u + 0x7fffu + ((u >> 16) & 1u)) >> 16; }
__device__ __forceinline__ unsigned pk2(float lo, float hi) { unsigned r; asm volatile("v_cvt_pk_bf16_f32 %0, %1, %2" : "=v"(r) : "v"(lo), "v"(hi)); return r; }
__device__ __forceinline__ float ex2(float x) { return __builtin_amdgcn_exp2f(x); }
__device__ __forceinline__ float wave_sum(float v) {
#pragma unroll
    for (int o = 1; o < 64; o <<= 1) v += __shfl_xor(v, o);
    return v;
}
__device__ __forceinline__ float half_sum32(float v) {
#pragma unroll
    for (int o = 1; o < 32; o <<= 1) v += __shfl_xor(v, o);
    return v;
}
__device__ __forceinline__ float silu_f(float x) { return x / (1.f + __expf(-x)); }
__device__ __forceinline__ int crow(int r, int hi) { return (r & 3) + 8 * (r >> 2) + 4 * hi; }
#define MFMA32(a, b, c) __builtin_amdgcn_mfma_f32_32x32x16_bf16((a), (b), (c), 0, 0, 0)
#define LDS_WAIT() asm volatile("s_waitcnt lgkmcnt(0)" ::: "memory")
typedef short v4i16_t __attribute__((ext_vector_type(4)));
__device__ __forceinline__ s16x4 trrd(LAS const unsigned char* p) { return __builtin_bit_cast(s16x4, __builtin_amdgcn_ds_read_tr16_b64_v4i16((LAS v4i16_t*)p)); }
__device__ __forceinline__ bf16x8 cat8(s16x4 lo, s16x4 hi) { return (bf16x8){lo[0], lo[1], lo[2], lo[3], hi[0], hi[1], hi[2], hi[3]}; }
__device__ __forceinline__ u32x4 scale8(u32x4 v, float s) {
    u32x4 r;
#pragma unroll
    for (int i = 0; i < 4; ++i) r[i] = pk2(bf2f(v[i] & 0xffffu) * s, __uint_as_float(v[i] & 0xffff0000u) * s);
    return r;
}

__device__ __forceinline__ float* ws_ada(const Params& p) { return (float*)(p.ws + WS_ADA); }
__device__ __forceinline__ bf16* ws_z(const Params& p) { return (bf16*)(p.ws + WS_Z); }
__device__ __forceinline__ bf16* ws_hb(const Params& p) { return (bf16*)(p.ws + WS_HB); }
constexpr int KVH_ROWS = SEQ + CTX;
__device__ __forceinline__ bf16* ws_kvh(const Params& p) { return (bf16*)(p.ws + WS_ACT); }
__device__ __forceinline__ size_t kvh_off(int kind, int b, int h) { return (size_t)((kind * NB + b) * 8 + h) * KVH_ROWS * 64; }
__device__ __forceinline__ bf16* ws_xb(const Params& p) { return (bf16*)(p.ws + WS_XB); }

namespace pg8 {
struct GroupedOrder {
    StaticOrder S; int tpe;
    __device__ void init(int tpe_, int G_, int c_) { tpe = tpe_; S.init(16 * tpe_ * BM, 8 * BM, G_, c_); }
    __device__ bool next(int i, Unit& u) const { if (!S.next(i, u)) return false; u.pb = (u.pm / tpe) * 8 + u.pn; return true; }
    __device__ __forceinline__ void a_ready(const Unit&) const {}
    __device__ __forceinline__ void done(const Unit&) const {}
};
struct SkipOrder {
    StaticOrder S; int G, c;
    __device__ void init(int G_, int c_) { S.init(16384, 5888, G_, c_); G = G_; c = c_; }
    __device__ bool next(int i, Unit& u) const {
        if (S.next(i, u)) return true;
        const int j = i * G + c - 64 * 23; if (j < 0 || j >= 72) return false;
        const int t = j >> 3; u.pm = 64 + (j & 7); u.pn = t < 4 ? 2 + t : (t == 4 ? 16 : 14 + t); u.pb = u.pn; return true;
    }
    __device__ __forceinline__ void a_ready(const Unit&) const {}
    __device__ __forceinline__ void done(const Unit&) const {}
};
template <bool BASE_F32> struct EpiResGate {
    static constexpr bool PERM = true, AFTER_DRAIN = false;
    const float* base_lat; const float* base_ctx; bf16_t* xb; const float* ada; int goff;
    __device__ __forceinline__ void operator()(const f32x4 (&acc)[2][2][4][2], const Unit& u, int wr, int wc, int fr, int fq) const {
        const bool isctx = u.pm >= 64;
        const int grow = isctx ? 8 : (u.pm >> 3);
        const float* g = ada + grow * 12288 + goff;
        const float* basef = isctx ? base_ctx - (size_t)64 * BM * 2048 : base_lat;
        const int row0 = u.pm * BM + wr * 64 + fr, col0 = u.pn * BM + wc * 32 + 8 * fq;
        f32x4 gv[2][2];
#pragma unroll
        for (int bj = 0; bj < 2; ++bj)
#pragma unroll
            for (int n = 0; n < 2; ++n) gv[bj][n] = *(const f32x4*)(g + col0 + bj * HALF + 4 * n);
#pragma unroll
        for (int ai = 0; ai < 2; ++ai)
#pragma unroll
            for (int m = 0; m < 4; ++m) { const size_t off = (size_t)(row0 + ai * HALF + m * 16) * 2048 + col0;
#pragma unroll
                for (int bj = 0; bj < 2; ++bj) { f32x4 b0, b1;
                    if constexpr (BASE_F32) { b0 = *(const f32x4*)(basef + off + bj * HALF); b1 = *(const f32x4*)(basef + off + bj * HALF + 4); }
                    else { const u32x4 w = *(const u32x4*)(xb + off + bj * HALF);
                        b0 = (f32x4){__uint_as_float(w.x << 16), __uint_as_float(w.x & 0xffff0000u), __uint_as_float(w.y << 16), __uint_as_float(w.y & 0xffff0000u)};
                        b1 = (f32x4){__uint_as_float(w.z << 16), __uint_as_float(w.z & 0xffff0000u), __uint_as_float(w.w << 16), __uint_as_float(w.w & 0xffff0000u)}; }
                    const f32x4 v0 = b0 + gv[bj][0] * acc[ai][bj][m][0], v1 = b1 + gv[bj][1] * acc[ai][bj][m][1];
                    u32x4 o; o.x = cvt_pk_bf16(v0[0], v0[1]); o.y = cvt_pk_bf16(v0[2], v0[3]); o.z = cvt_pk_bf16(v1[0], v1[1]); o.w = cvt_pk_bf16(v1[2], v1[3]);
                    *(u32x4*)(xb + off + bj * HALF) = o; }
                asm volatile("" ::: "memory"); }
    }
};
struct EpiSiluMul {
    static constexpr bool PERM = true, AFTER_DRAIN = false;
    bf16_t* O;
    __device__ __forceinline__ void operator()(const f32x4 (&acc)[2][2][4][2], const Unit& u, int wr, int wc, int fr, int fq) const {
        const int row0 = u.pm * BM + wr * 64 + fr, col0 = u.pn * HALF + wc * 32 + 8 * fq;
#pragma unroll
        for (int ai = 0; ai < 2; ++ai)
#pragma unroll
            for (int m = 0; m < 4; ++m) { bf16_t* rowp = O + (size_t)(row0 + ai * HALF + m * 16) * 1024 + col0;
                float v[8];
#pragma unroll
                for (int n = 0; n < 2; ++n)
#pragma unroll
                    for (int j = 0; j < 4; ++j) { const float gg = acc[ai][0][m][n][j], uu = acc[ai][1][m][n][j]; v[n * 4 + j] = gg * __builtin_amdgcn_rcpf(1.f + __builtin_amdgcn_exp2f(-gg * 1.4426950408889634f)) * uu; }
                u32x4 w; w.x = cvt_pk_bf16(v[0], v[1]); w.y = cvt_pk_bf16(v[2], v[3]); w.z = cvt_pk_bf16(v[4], v[5]); w.w = cvt_pk_bf16(v[6], v[7]);
                *(u32x4*)rowp = w; }
    }
};
struct EpiDown {
    static constexpr bool PERM = true, AFTER_DRAIN = false;
    bf16_t* O; const float* gatev;
    __device__ __forceinline__ void operator()(const f32x4 (&acc)[2][2][4][2], const Unit& u, int wr, int wc, int fr, int fq) const {
        const int row0 = u.pm * BM + wr * 64 + fr, col0 = u.pn * BM + wc * 32 + 8 * fq;
        float sg[2][4];
#pragma unroll
        for (int ai = 0; ai < 2; ++ai)
#pragma unroll
            for (int m = 0; m < 4; ++m) sg[ai][m] = gatev[row0 + ai * HALF + m * 16];
#pragma unroll
        for (int ai = 0; ai < 2; ++ai)
#pragma unroll
            for (int m = 0; m < 4; ++m) { const int row = row0 + ai * HALF + m * 16; const float s = sg[ai][m]; bf16_t* rowp = O + (size_t)row * 2048 + col0;
#pragma unroll
                for (int bj = 0; bj < 2; ++bj) { const f32x4 v0 = acc[ai][bj][m][0] * s, v1 = acc[ai][bj][m][1] * s;
                    u32x4 w; w.x = cvt_pk_bf16(v0[0], v0[1]); w.y = cvt_pk_bf16(v0[2], v0[3]); w.z = cvt_pk_bf16(v1[0], v1[1]); w.w = cvt_pk_bf16(v1[2], v1[3]);
                    *(u32x4*)(rowp + bj * HALF) = w; } }
    }
};
struct EpiZRope {
    static constexpr bool PERM = true, AFTER_DRAIN = false;
    bf16_t* O; LAS const float* rcos; LAS const float* rsin; bf16_t* KV;
    __device__ __forceinline__ void operator()(const f32x4 (&acc)[2][2][4][2], const Unit& u, int wr, int wc, int fr, int fq) const {
        const int row0 = u.pm * BM + wr * 64 + fr, tile = u.pn;
        const bool rtile = (tile < 4) || (tile >= 14 && tile <= 16);
        if (tile >= 19) {
            const int b = (u.pm < 64) ? (u.pm >> 3) : (u.pm - 64), rloc0 = ((u.pm < 64) ? (u.pm & 7) * 256 : 2048) + wr * 64 + fr;
#pragma unroll
            for (int bj = 0; bj < 2; ++bj) { const int c = (tile - 19) * BM + wc * 32 + 8 * fq + bj * HALF;
                bf16_t* hp = KV + ((size_t)(((c >> 9) * 8 + b) * 8 + ((c >> 6) & 7)) * 2304 + rloc0) * 64 + (c & 63);
#pragma unroll
                for (int ai = 0; ai < 2; ++ai)
#pragma unroll
                    for (int m = 0; m < 4; ++m) { const f32x4 v0 = acc[ai][bj][m][0], v1 = acc[ai][bj][m][1];
                        u32x4 w; w.x = cvt_pk_bf16(v0[0], v0[1]); w.y = cvt_pk_bf16(v0[2], v0[3]); w.z = cvt_pk_bf16(v1[0], v1[1]); w.w = cvt_pk_bf16(v1[2], v1[3]);
                        *(u32x4*)(hp + (ai * HALF + m * 16) * 64) = w; } }
            return;
        }
        if (!rtile) {
            const int col0 = tile * BM + wc * 32 + 8 * fq;
#pragma unroll
            for (int ai = 0; ai < 2; ++ai)
#pragma unroll
                for (int m = 0; m < 4; ++m) { bf16_t* rowp = O + (size_t)(row0 + ai * HALF + m * 16) * 5888 + col0;
#pragma unroll
                    for (int bj = 0; bj < 2; ++bj) { const f32x4 v0 = acc[ai][bj][m][0], v1 = acc[ai][bj][m][1];
                        u32x4 w; w.x = cvt_pk_bf16(v0[0], v0[1]); w.y = cvt_pk_bf16(v0[2], v0[3]); w.z = cvt_pk_bf16(v1[0], v1[1]); w.w = cvt_pk_bf16(v1[2], v1[3]);
                        *(u32x4*)(rowp + bj * HALF) = w; } }
            return;
        }
        const bool pass = (tile == 16) && (wc >= 2);
        const int c1 = pass ? 4224 + (wc - 2) * 32 : tile * BM + wc * 64, c2 = pass ? c1 + 64 : c1 + 32;
        const bool rope = !pass && (u.pm < 64);
#pragma unroll
        for (int ai = 0; ai < 2; ++ai)
#pragma unroll
            for (int m = 0; m < 4; ++m) { const int row = row0 + ai * HALF + m * 16; bf16_t* rowp = O + (size_t)row * 5888 + 8 * fq;
                f32x4 a0 = acc[ai][0][m][0], a1 = acc[ai][0][m][1], b0 = acc[ai][1][m][0], b1 = acc[ai][1][m][1];
                if (rope) { const int t = row & 2047, pos = (fq < 2) ? (t >> 6) : (t & 63), ti = pos * 16 + 8 * (fq & 1);
                    const f32x4 cs0 = *(LAS const f32x4*)(rcos + ti), cs1 = *(LAS const f32x4*)(rcos + ti + 4), sn0 = *(LAS const f32x4*)(rsin + ti), sn1 = *(LAS const f32x4*)(rsin + ti + 4);
                    const f32x4 x0 = a0 * cs0 - b0 * sn0, x1 = a1 * cs1 - b1 * sn1, y0 = a0 * sn0 + b0 * cs0, y1 = a1 * sn1 + b1 * cs1;
                    a0 = x0; a1 = x1; b0 = y0; b1 = y1; }
                u32x4 w; w.x = cvt_pk_bf16(a0[0], a0[1]); w.y = cvt_pk_bf16(a0[2], a0[3]); w.z = cvt_pk_bf16(a1[0], a1[1]); w.w = cvt_pk_bf16(a1[2], a1[3]);
                *(u32x4*)(rowp + c1) = w;
                w.x = cvt_pk_bf16(b0[0], b0[1]); w.y = cvt_pk_bf16(b0[2], b0[3]); w.z = cvt_pk_bf16(b1[0], b1[1]); w.w = cvt_pk_bf16(b1[2], b1[3]);
                *(u32x4*)(rowp + c2) = w; }
    }
};
}

__device__ __forceinline__ void transpose_item(const float* W, int N, bf16* WT, int K, int k0, int n0, int drow0, LAS float* scr, int lane) {
#pragma unroll 8
    for (int i = 0; i < 32; ++i) { const int kk = 2 * i + (lane >> 5); scr[kk * 33 + (lane & 31)] = W[(size_t)(k0 + kk) * N + n0 + (lane & 31)]; }
    LDS_WAIT();
    const int c = lane & 7;
#pragma unroll
    for (int j = 0; j < 4; ++j) { const int n = (lane >> 3) + 8 * j; const LAS float* s = scr + (8 * c) * 33 + n;
        u32x4 o; o.x = pk2(s[0 * 33], s[1 * 33]); o.y = pk2(s[2 * 33], s[3 * 33]); o.z = pk2(s[4 * 33], s[5 * 33]); o.w = pk2(s[6 * 33], s[7 * 33]);
        *(u32x4*)(WT + (size_t)(drow0 + n) * K + k0 + 8 * c) = o; }
    LDS_WAIT();
}
__device__ __forceinline__ int win_dst_group(int sg) {
    const int tile = sg >> 3, r = sg & 7;
    if (tile < 4 || tile == 14 || tile == 15) return tile * 8 + (r & 1) * 4 + (r >> 1);
    if (tile == 16) return 128 + (r < 4 ? ((r & 1) * 4 + (r >> 1)) : (r < 6 ? r - 2 : r));
    return sg;
}
constexpr int I_IN = 32 * 184, I_OUT = 32 * 64, I_G = 16 * 32 * 32, I_D = 16 * 16 * 64, I_L = I_IN + I_OUT + 2 * I_G + I_D;

__device__ __forceinline__ void convert_item(const Params& p, int l, int r, LAS float* scr, int lane) {
    bf16* WIN = (bf16*)(p.ws + WS_WIN); bf16* WOUT = (bf16*)(p.ws + WS_WOUT); bf16* WGU = (bf16*)(p.ws + WS_WGU); bf16* WD = (bf16*)(p.ws + WS_WD);
    if (r < I_IN) { const int kb = r / 184, nb = r % 184; transpose_item(p.w_in + (size_t)l * 2048 * INC, INC, WIN + (size_t)l * INC * 2048, 2048, 64 * kb, 32 * nb, 32 * win_dst_group(nb), scr, lane); return; } r -= I_IN;
    if (r < I_OUT) { const int kb = r / 64, nb = r % 64; transpose_item(p.w_out + (size_t)l * 2048 * 2048, 2048, WOUT + (size_t)l * 2048 * 2048, 2048, 64 * kb, 32 * nb, 32 * nb, scr, lane); return; } r -= I_OUT;
    if (r < 2 * I_G) { const int isup = r >= I_G; if (isup) r -= I_G; const int e = r >> 10, rr = r & 1023, kb = rr >> 5, nb = rr & 31, n0 = 32 * nb;
        const float* W = (isup ? p.w_up : p.w_gate) + (size_t)(l * 16 + e) * 2048 * 1024;
        transpose_item(W, 1024, WGU + (size_t)(l * 16 + e) * 2048 * 2048, 2048, 64 * kb, n0, (n0 >> 7) * 256 + (n0 & 127) + (isup ? 128 : 0), scr, lane); return; } r -= 2 * I_G;
    { const int e = r >> 10, rr = r & 1023, kb = rr >> 6, nb = rr & 63;
      transpose_item(p.w_down + (size_t)(l * 16 + e) * 1024 * 2048, 2048, WD + (size_t)(l * 16 + e) * 2048 * 1024, 1024, 64 * kb, 32 * nb, 32 * nb, scr, lane); }
}
#ifndef TAIL_P2
#define TAIL_P2 0
#define TAIL_P6 (192 * 128)
#define TAIL_P9 0
#define TAIL_P10 0
#endif
constexpr int TAIL_OFF_P2 = 0, TAIL_OFF_P6 = TAIL_P2, TAIL_OFF_P9 = TAIL_P2 + TAIL_P6, TAIL_OFF_P10 = TAIL_P2 + TAIL_P6 + TAIL_P9, TAIL_ITEMS = TAIL_P2 + TAIL_P6 + TAIL_P9 + TAIL_P10;
static_assert(TAIL_ITEMS <= I_L, "tail items are layer-1 items");
__device__ __forceinline__ void ph_prologue(const Params& p, LAS unsigned char* lds) {
    const int tid = tid_opaque(), lane = tid & 63, wave = __builtin_amdgcn_readfirstlane(tid >> 6);
    const int G = gridDim.x;
    for (int u = blockIdx.x; u < 192; u += G) {
        const int l = u / 96, cg = u % 96;
        LAS float* s_sil = (LAS float*)lds; LAS float* s_red = (LAS float*)(lds + 73728);
        for (int i = tid; i < 9 * 2048; i += NTHR) { const int r = i >> 11, k = i & 2047; const float v = (r < 8) ? p.c[r * 2048 + k] : p.c_ctx[k]; s_sil[i] = silu_f(v); }
        __syncthreads();
        const float* W = p.w_ada + (size_t)l * 2048 * ADAW + cg * 128 + 2 * lane;
        float acc[9][2];
#pragma unroll
        for (int r = 0; r < 9; ++r) { acc[r][0] = 0.f; acc[r][1] = 0.f; }
        const int k0 = wave * 256;
        for (int kk = 0; kk < 256; kk += 8) {
            f32x2 w[8];
#pragma unroll
            for (int j = 0; j < 8; ++j) w[j] = *(const f32x2*)(W + (size_t)(k0 + kk + j) * ADAW);
#pragma unroll
            for (int r = 0; r < 9; ++r) {
                const f32x4 sa = *(LAS const f32x4*)(s_sil + r * 2048 + k0 + kk), sb = *(LAS const f32x4*)(s_sil + r * 2048 + k0 + kk + 4);
#pragma unroll
                for (int j = 0; j < 4; ++j) { acc[r][0] += sa[j] * w[j].x; acc[r][1] += sa[j] * w[j].y; acc[r][0] += sb[j] * w[4 + j].x; acc[r][1] += sb[j] * w[4 + j].y; }
            }
        }
#pragma unroll
        for (int r = 0; r < 9; ++r) { s_red[(wave * 9 + r) * 128 + 2 * lane] = acc[r][0]; s_red[(wave * 9 + r) * 128 + 2 * lane + 1] = acc[r][1]; }
        __syncthreads();
        for (int i = tid; i < 9 * 128; i += NTHR) { const int r = i >> 7, cc = i & 127; float s = p.b_ada[l * ADAW + cg * 128 + cc];
#pragma unroll
            for (int w = 0; w < 8; ++w) s += s_red[(w * 9 + r) * 128 + cc];
            ws_ada(p)[(size_t)(l * 9 + r) * ADAW + cg * 128 + cc] = s; }
        __syncthreads();
    }
    LAS float* scr = (LAS float*)(lds + wave * 8448);
    const int gw = blockIdx.x * NWAVES + wave, NGW = G * NWAVES;
    const int tail = (G == 256) ? TAIL_ITEMS : 0;
    for (int it = gw; it < 2 * I_L - tail; it += NGW) { const int g = it < I_L ? it : it + tail; convert_item(p, g / I_L, g % I_L, scr, lane); }
}
__device__ __forceinline__ void tail_convert(const Params& p, int off, int n, int rank, int nidle, LAS unsigned char* lds) {
    const int tid = tid_opaque(), lane = tid & 63, wave = __builtin_amdgcn_readfirstlane(tid >> 6);
    LAS float* scr = (LAS float*)(lds + wave * 8448);
    for (int it = rank * NWAVES + wave; it < n; it += nidle * NWAVES) convert_item(p, 1, off + it, scr, lane);
}

__device__ __forceinline__ void load_row8(f32x4 (&v)[8], const float* row, int lane) {
#pragma unroll
    for (int j = 0; j < 8; ++j) v[j] = *(const f32x4*)(row + 256 * j + 4 * lane);
}
__device__ __forceinline__ void load_row8_bf16(f32x4 (&v)[8], const bf16* row, int lane) {
#pragma unroll
    for (int j = 0; j < 8; ++j) { const u32x2 w = *(const u32x2*)(row + 256 * j + 4 * lane);
        v[j] = (f32x4){__uint_as_float(w.x << 16), __uint_as_float(w.x & 0xffff0000u), __uint_as_float(w.y << 16), __uint_as_float(w.y & 0xffff0000u)}; }
}
__device__ __forceinline__ float row_rstd(const f32x4 (&v)[8]) {
    float s = 0.f;
#pragma unroll
    for (int j = 0; j < 8; ++j) s += (v[j].x * v[j].x + v[j].y * v[j].y) + (v[j].z * v[j].z + v[j].w * v[j].w);
    return rsqrtf(wave_sum(s) * (1.f / 2048.f) + RMS_EPS);
}
__device__ __forceinline__ void modulate8(f32x4 (&v)[8], float rstd, const float* nw, const float* sc, const float* sh, int lane) {
#pragma unroll
    for (int j = 0; j < 8; ++j) { const int c = 256 * j + 4 * lane; const f32x4 w = *(const f32x4*)(nw + c), s1 = *(const f32x4*)(sc + c), s0 = *(const f32x4*)(sh + c);
        v[j] = v[j] * rstd * w * (1.f + s1) + s0; }
}
__device__ __forceinline__ void store_row8_bf16(const f32x4 (&v)[8], bf16* row, int lane) {
#pragma unroll
    for (int j = 0; j < 8; ++j) { u32x2 w; w.x = pk2(v[j].x, v[j].y); w.y = pk2(v[j].z, v[j].w); *(u32x2*)(row + 256 * j + 4 * lane) = w; }
}
__device__ __forceinline__ void load_coeffs(f32x4 (&wv)[8], f32x4 (&sv)[8], const float* nw, const float* sc, const float* sh, int lane) {
#pragma unroll
    for (int j = 0; j < 8; ++j) { const int c = 256 * j + 4 * lane; wv[j] = *(const f32x4*)(nw + c) * (1.f + *(const f32x4*)(sc + c)); sv[j] = *(const f32x4*)(sh + c); }
}
__device__ __forceinline__ void ph_modnorm0(const Params& p) {
    const int tid_ = tid_opaque(), lane = tid_ & 63, wave = __builtin_amdgcn_readfirstlane(tid_ >> 6);
    const int gw = blockIdx.x * NWAVES + wave, NGW = gridDim.x * NWAVES;
    const int rpw = (NROW + NGW - 1) / NGW, r0 = gw * rpw, r1 = (r0 + rpw < NROW) ? r0 + rpw : NROW;
    int cur = -1; f32x4 wv[8], sv[8], vn[8];
#define XROW0(r) (((r) < NLAT) ? p.x + (size_t)(r) * DM : p.ctx + (size_t)((r) - NLAT) * DM)
    if (r0 < r1) load_row8(vn, XROW0(r0), lane);
    for (int row = r0; row < r1; ++row) {
        f32x4 v[8];
#pragma unroll
        for (int j = 0; j < 8; ++j) v[j] = vn[j];
        if (row + 1 < r1) load_row8(vn, XROW0(row + 1), lane);
        const int arow = (row < NLAT) ? (row >> 11) : 8;
        if (arow != cur) { const float* ad = ws_ada(p) + (size_t)(0 * 9 + arow) * ADAW; load_coeffs(wv, sv, p.norm_mix, ad + 2048, ad, lane); cur = arow; }
        const float rstd = row_rstd(v);
#pragma unroll
        for (int j = 0; j < 8; ++j) v[j] = v[j] * rstd * wv[j] + sv[j];
        store_row8_bf16(v, ws_hb(p) + (size_t)row * DM, lane);
    }
#undef XROW0
}

namespace att {
__device__ __forceinline__ float xh_max(float v) { auto rr = __builtin_amdgcn_permlane32_swap(__float_as_uint(v), __float_as_uint(v), false, false); float a = __uint_as_float(rr[0]), b = __uint_as_float(rr[1]), r; asm("v_max_f32_e32 %0, %1, %2" : "=v"(r) : "v"(a), "v"(b)); return r; }
__device__ __forceinline__ float xh_sum(float v) { auto rr = __builtin_amdgcn_permlane32_swap(__float_as_uint(v), __float_as_uint(v), false, false); return __uint_as_float(rr[0]) + __uint_as_float(rr[1]); }
__device__ __forceinline__ float max3f(float a, float b, float c) { float r; asm("v_max3_f32 %0, %1, %2, %3" : "=v"(r) : "v"(a), "v"(b), "v"(c)); return r; }
constexpr int KB0 = 0, VB0 = 16384, SCR = 32768, RPB = 34816, BYTES = 36864;
struct TileRegs { u32x4 k, v; };
template <int PITCH = INC> __device__ __forceinline__ void tile_load(TileRegs& t, const bf16* kp, const bf16* vp, int tid) {
    const int key = tid >> 3, c = tid & 7;
    t.k = *(const u32x4*)(kp + (size_t)key * PITCH + c * 8);
    t.v = *(const u32x4*)(vp + (size_t)key * PITCH + c * 8);
}
__device__ __forceinline__ void tile_store(const TileRegs& t, LAS unsigned char* kb, LAS unsigned char* vb, int tid) {
    const int key = tid >> 3, c = tid & 7;
    *(LAS u32x4*)(kb + c * 1024 + key * 16) = t.k;
    *(LAS u32x4*)(vb + (c >> 2) * 4096 + (key >> 3) * 512 + (key & 7) * 64 + (c & 3) * 16) = t.v;
}
__device__ __forceinline__ void qk_tile(f32x16& p0, f32x16& p1, LAS const unsigned char* kbuf, const bf16x8 (&qr)[4], int r32, int hi) {
    LAS const unsigned char* kb = kbuf + hi * 1024 + r32 * 16;
    f32x16 z;
#pragma unroll
    for (int i = 0; i < 16; ++i) z[i] = 0.f;
    p0 = z; p1 = z;
#pragma unroll
    for (int d0 = 0; d0 < 4; ++d0) {
        const bf16x8 k0 = *(LAS const bf16x8*)(kb + d0 * 2048), k1 = *(LAS const bf16x8*)(kb + d0 * 2048 + 512);
        p0 = MFMA32(k0, qr[d0], p0); p1 = MFMA32(k1, qr[d0], p1);
    }
}
__device__ __forceinline__ void k_frags(bf16x8 (&kf)[8], LAS const unsigned char* kbuf, int r32, int hi) {
    LAS const unsigned char* kb = kbuf + hi * 1024 + r32 * 16;
#pragma unroll
    for (int d0 = 0; d0 < 4; ++d0) { kf[2 * d0] = *(LAS const bf16x8*)(kb + d0 * 2048); kf[2 * d0 + 1] = *(LAS const bf16x8*)(kb + d0 * 2048 + 512); }
}
__device__ __forceinline__ void qk_frags(f32x16& p0, f32x16& p1, const bf16x8 (&kf)[8], const bf16x8 (&qr)[4]) {
    f32x16 z;
#pragma unroll
    for (int i = 0; i < 16; ++i) z[i] = 0.f;
    p0 = z; p1 = z;
#pragma unroll
    for (int d0 = 0; d0 < 4; ++d0) { p0 = MFMA32(kf[2 * d0], qr[d0], p0); p1 = MFMA32(kf[2 * d0 + 1], qr[d0], p1); }
}
__device__ __forceinline__ void pv_tile(f32x16& o0, f32x16& o1, const f32x16& p0, const f32x16& p1, LAS const unsigned char* vl) {
    u32x4 pk[4];
#pragma unroll
    for (int i = 0; i < 4; ++i) { pk[0][i] = pk2(p0[2 * i], p0[2 * i + 1]); pk[1][i] = pk2(p0[8 + 2 * i], p0[9 + 2 * i]); pk[2][i] = pk2(p1[2 * i], p1[2 * i + 1]); pk[3][i] = pk2(p1[8 + 2 * i], p1[9 + 2 * i]); }
#pragma unroll
    for (int ks = 0; ks < 4; ++ks) {
        const bf16x8 a = __builtin_bit_cast(bf16x8, pk[ks]);
        const bf16x8 v0 = cat8(trrd(vl + ks * 1024), trrd(vl + ks * 1024 + 512));
        const bf16x8 v1 = cat8(trrd(vl + 4096 + ks * 1024), trrd(vl + 4096 + ks * 1024 + 512));
        o0 = MFMA32(v0, a, o0); o1 = MFMA32(v1, a, o1);
    }
}
__device__ __forceinline__ void softmax_pv(f32x16& p0, f32x16& p1, float& m, float& lsum, f32x16& o0, f32x16& o1, LAS float* scr, LAS const unsigned char* vl, int r32, int hi) {
    float mx = max3f(p0[0], p1[0], p0[1]), mx2 = max3f(p1[1], p0[2], p1[2]);
#pragma unroll
    for (int r = 3; r < 15; r += 2) { mx = max3f(mx, p0[r], p1[r]); mx2 = max3f(mx2, p0[r + 1], p1[r + 1]); }
    mx = xh_max(max3f(mx, mx2, max3f(p0[15], p1[15], p0[15])));
    if (__any(mx > m + 8.f)) {
        const float mnew = max3f(m, mx, mx), alpha = ex2(m - mnew);
        m = mnew; lsum *= alpha;
#pragma unroll
        for (int r = 0; r < 16; ++r) { o0[r] *= alpha; o1[r] *= alpha; }
    }
    float rs = 0.f;
#pragma unroll
    for (int r = 0; r < 16; ++r) { p0[r] = ex2(p0[r] - m); p1[r] = ex2(p1[r] - m); rs += p0[r] + p1[r]; }
    lsum += rs;
    pv_tile(o0, o1, p0, p1, vl);
}
__device__ __forceinline__ void qk_win(f32x16& p0, LAS const unsigned char* kwin, const bf16x8 (&qr)[4], int r32, int hi) {
    LAS const unsigned char* kb = kwin + hi * 1024 + r32 * 16;
#pragma unroll
    for (int i = 0; i < 16; ++i) p0[i] = 0.f;
#pragma unroll
    for (int d0 = 0; d0 < 4; ++d0) { const bf16x8 k0 = *(LAS const bf16x8*)(kb + d0 * 2048); p0 = MFMA32(k0, qr[d0], p0); }
}
__device__ __forceinline__ void softmax_pv_win(f32x16& p0, float& m, float& lsum, f32x16& o0, f32x16& o1, LAS const unsigned char* vwin) {
    float mx = max3f(p0[0], p0[1], p0[2]), mx2 = max3f(p0[3], p0[4], p0[5]);
#pragma unroll
    for (int r = 6; r < 14; r += 4) { mx = max3f(mx, p0[r], p0[r + 1]); mx2 = max3f(mx2, p0[r + 2], p0[r + 3]); }
    mx = xh_max(max3f(mx, mx2, max3f(p0[14], p0[15], p0[15])));
    if (__any(mx > m + 8.f)) {
        const float mnew = max3f(m, mx, mx), alpha = ex2(m - mnew);
        m = mnew; lsum *= alpha;
#pragma unroll
        for (int r = 0; r < 16; ++r) { o0[r] *= alpha; o1[r] *= alpha; }
    }
    float rs = 0.f;
#pragma unroll
    for (int r = 0; r < 16; ++r) { p0[r] = ex2(p0[r] - m); rs += p0[r]; }
    lsum += rs;
    u32x4 pk[2];
#pragma unroll
    for (int i = 0; i < 4; ++i) { pk[0][i] = pk2(p0[2 * i], p0[2 * i + 1]); pk[1][i] = pk2(p0[8 + 2 * i], p0[9 + 2 * i]); }
#pragma unroll
    for (int ks = 0; ks < 2; ++ks) {
        const bf16x8 a = __builtin_bit_cast(bf16x8, pk[ks]);
        const bf16x8 v0 = cat8(trrd(vwin + ks * 1024), trrd(vwin + ks * 1024 + 512));
        const bf16x8 v1 = cat8(trrd(vwin + 4096 + ks * 1024), trrd(vwin + 4096 + ks * 1024 + 512));
        o0 = MFMA32(v0, a, o0); o1 = MFMA32(v1, a, o1);
    }
}
__device__ __forceinline__ void finalize_store_lane(const f32x16& o0, const f32x16& o1, float lsum, bf16* orl, int hi);
__device__ __forceinline__ void finalize_store(const f32x16& o0, const f32x16& o1, float lsum, bf16* orow, LAS float* scr, int r32, int hi) {
    finalize_store_lane(o0, o1, lsum, orow + (size_t)r32 * DM, hi);
}
__device__ __forceinline__ void finalize_store_lane(const f32x16& o0, const f32x16& o1, float lsum, bf16* orl, int hi) {
    const float inv = 1.f / xh_sum(lsum);
    bf16* op = orl + 4 * hi;
#pragma unroll
    for (int g = 0; g < 4; ++g) {
        u32x2 w0, w1; w0.x = pk2(o0[4 * g] * inv, o0[4 * g + 1] * inv); w0.y = pk2(o0[4 * g + 2] * inv, o0[4 * g + 3] * inv); w1.x = pk2(o1[4 * g] * inv, o1[4 * g + 1] * inv); w1.y = pk2(o1[4 * g + 2] * inv, o1[4 * g + 3] * inv);
        *(u32x2*)(op + 8 * g) = w0; *(u32x2*)(op + 32 + 8 * g) = w1; }
}

__device__ __forceinline__ void swa_unit(const Params& p, int l, int b, int kvh, int qb, int gp, bool isctx, LAS unsigned char* L) {
    const int tid = tid_opaque(), lane = tid & 63, wave = __builtin_amdgcn_readfirstlane(tid >> 6), r32 = lane & 31, hi = lane >> 5;
    const bf16* Z = ws_z(p); bf16* Y = ws_hb(p);
    const int g = 2 * gp + (wave >> 2), rb = wave & 3, head = kvh * 4 + g;
    const size_t qrow0 = isctx ? (size_t)(NLAT + b * CTX + qb * 128) : (size_t)(b * SEQ + qb * 128);
    bf16x8 qr[4];
    { const bf16* qp = Z + (qrow0 + 32 * rb + r32) * INC + ZC_SQ + head * 64 + hi * 8;
#pragma unroll
      for (int d0 = 0; d0 < 4; ++d0) qr[d0] = *(const bf16x8*)(qp + d0 * 16); }
    float m = p.sink[l * 8 + head] * LOG2E, ls = (hi == 0) ? 1.f : 0.f; f32x16 o0, o1;
#pragma unroll
    for (int i = 0; i < 16; ++i) { o0[i] = 0.f; o1[i] = 0.f; }
    const int t0 = (qb == 0) ? 2 : 0, t1 = (qb == 15) ? 4 : 6;
    const int nwin = isctx ? 0 : (t1 - t0), nt = nwin + 4;
    const bf16* Kc = Z + ZC_SK + kvh * 64; const bf16* Vc = Z + ZC_SV + kvh * 64;
#define SWA_TROW(t) ((t) < nwin ? (size_t)(b * SEQ + 128 * (qb - 1) + 64 * (t0 + (t))) : (size_t)(NLAT + b * CTX + 64 * ((t) - nwin)))
    LAS float* scr = (LAS float*)(L + SCR) + wave * 64;
    const int vlo = ((lane >> 4) & 1) * 32 + (lane & 3) * 8 + (4 * hi + ((lane & 15) >> 2)) * 64;
    constexpr float SC = 0.125f * LOG2E;
    const int qi = 32 * rb + r32;
#define SWA_BODY(t, cur) { \
        const int wi = ((t) < nwin) ? t0 + (t) : -1; \
        const bool act = !(wi == 0 && rb >= 2) && !(wi == 5 && rb < 2); \
        if (act) { \
            f32x16 p0, p1; qk_tile(p0, p1, L + KB0 + (cur) * 8192, qr, r32, hi); \
            if ((wi == 0) || (wi == 1) || (wi == 4) || (wi == 5)) { \
                const int dbase = 64 * wi - 128 - qi; \
                _Pragma("unroll") for (int r = 0; r < 16; ++r) { const int d0 = dbase + crow(r, hi), d1 = d0 + 32; \
                    p0[r] = (d0 >= -128 && d0 <= 128) ? p0[r] * SC : -INFINITY; p1[r] = (d1 >= -128 && d1 <= 128) ? p1[r] * SC : -INFINITY; } \
            } else { \
                _Pragma("unroll") for (int r = 0; r < 16; ++r) { p0[r] *= SC; p1[r] *= SC; } \
            } \
            softmax_pv(p0, p1, m, ls, o0, o1, scr, L + VB0 + (cur) * 8192 + vlo, r32, hi); \
        } }
    TileRegs rA, rB, rC, rD;
    { const size_t r0 = SWA_TROW(0); tile_load(rA, Kc + r0 * INC, Vc + r0 * INC, tid); }
    { const size_t r1 = SWA_TROW(1); tile_load(rB, Kc + r1 * INC, Vc + r1 * INC, tid); }
    { const size_t r2 = SWA_TROW(2); tile_load(rC, Kc + r2 * INC, Vc + r2 * INC, tid); }
    { const size_t r3 = SWA_TROW(3); tile_load(rD, Kc + r3 * INC, Vc + r3 * INC, tid); }
    tile_store(rA, L + KB0, L + VB0, tid);
    __syncthreads();
#define SWA_STEP(tt, RL, RS, cur) { \
          \
        { const int tn = (tt) + 4 < nt ? (tt) + 4 : nt - 1; const size_t rn = SWA_TROW(tn); tile_load(RL, Kc + rn * INC, Vc + rn * INC, tid); } \
        SWA_BODY(tt, cur) \
        tile_store(RS, L + KB0 + ((cur) ^ 1) * 8192, L + VB0 + ((cur) ^ 1) * 8192, tid); \
        __syncthreads(); }
    int t = 0;
    for (; t + 4 <= nt; t += 4) {
        SWA_STEP(t, rA, rB, 0) SWA_STEP(t + 1, rB, rC, 1) SWA_STEP(t + 2, rC, rD, 0) SWA_STEP(t + 3, rD, rA, 1)
    }
    if (t < nt) { SWA_STEP(t, rA, rB, 0) if (t + 1 < nt) { SWA_STEP(t + 1, rB, rC, 1) if (t + 2 < nt) { SWA_STEP(t + 2, rC, rD, 0) } } }
#undef SWA_STEP
#undef SWA_BODY
#undef SWA_TROW
    finalize_store(o0, o1, ls, Y + (qrow0 + 32 * rb) * DM + YC_SWA + head * 64, scr, r32, hi);
}

__device__ __forceinline__ void na_unit(const Params& p, int l, int b, int h, int rg, bool isctx, LAS unsigned char* L, int rep = 0) {
    const int tid = tid_opaque(), lane = tid & 63, wave = __builtin_amdgcn_readfirstlane(tid >> 6), r32 = lane & 31, hi = lane >> 5;
    const bf16* Z = ws_z(p); bf16* Y = ws_hb(p);
    const int ig = wave & 3, gr0 = 4 * rg + 2 * (wave >> 2);
    const int rq = gr0 + (r32 >> 4), qcol = 16 * ig + (r32 & 15);
    const size_t qrow = isctx ? (size_t)(NLAT + b * CTX + 32 * wave + r32) : (size_t)(b * SEQ + rq * 64 + qcol);
    bf16x8 qr[4];
    { const bf16* qp = Z + qrow * INC + ZC_NQ + h * 64 + hi * 8;
#pragma unroll
      for (int d0 = 0; d0 < 4; ++d0) qr[d0] = *(const bf16x8*)(qp + d0 * 16); }
    LAS float* rpbl = (LAS float*)(L + RPB);
    if (tid < 465) rpbl[tid] = p.rpb[(size_t)(l * 8 + h) * 465 + tid] * LOG2E;
    float m = -1e30f, ls = 0.f; f32x16 o0, o1;
#pragma unroll
    for (int i = 0; i < 16; ++i) { o0[i] = 0.f; o1[i] = 0.f; }
    int R0 = 4 * rg - 4; R0 = R0 < 0 ? 0 : (R0 > 24 ? 24 : R0);
    int R1 = 4 * rg - 1; R1 = (R1 < 0 ? 0 : (R1 > 24 ? 24 : R1)) + 8;
    const int nband = isctx ? 0 : (R1 - R0), nt = nband + 4;
    int w0 = gr0 - 4; w0 = w0 < 0 ? 0 : (w0 > 24 ? 24 : w0);
    int w1 = gr0 - 3; w1 = (w1 < 0 ? 0 : (w1 > 24 ? 24 : w1)) + 8;
    int rs = rq - 4; rs = rs < 0 ? 0 : (rs > 24 ? 24 : rs);
    int cs = qcol - 8; cs = cs < 0 ? 0 : (cs > 48 ? 48 : cs);
    int key0 = 16 * ig - 8; key0 = key0 < 0 ? 0 : (key0 > 32 ? 32 : key0);
    const bf16* Kc = ws_kvh(p) + kvh_off(0, b, h); const bf16* Vc = ws_kvh(p) + kvh_off(1, b, h);
#define NA_TROW(t) ((t) < nband ? (size_t)(64 * (R0 + (t))) : (size_t)(SEQ + 64 * ((t) - nband)))
    LAS float* scr = (LAS float*)(L + SCR) + wave * 64;
    const int vlo = ((lane >> 4) & 1) * 32 + (lane & 3) * 8 + (4 * hi + ((lane & 15) >> 2)) * 64;
    constexpr float SC = 0.125f * LOG2E;
#define NA_BODY(t, cur) { \
        const int kr = ((t) < nband) ? R0 + (t) : -1; \
        if (kr < 0) { \
            f32x16 p0, p1; qk_tile(p0, p1, L + KB0 + (cur) * 8192, qr, r32, hi); \
            _Pragma("unroll") for (int r = 0; r < 16; ++r) { p0[r] *= SC; p1[r] *= SC; } \
            softmax_pv(p0, p1, m, ls, o0, o1, scr, L + VB0 + (cur) * 8192 + vlo, r32, hi); \
        } else if (kr >= w0 && kr < w1) { \
            f32x16 p0; qk_win(p0, L + KB0 + (cur) * 8192 + key0 * 16, qr, r32, hi); \
            const bool rowok = (kr >= rs) && (kr < rs + 8);                           \
            int dr = kr - rq + 7; dr = dr < 0 ? 0 : (dr > 14 ? 14 : dr); \
            LAS const float* tb = rpbl + dr * 31 + (15 - qcol);                       \
              \
            float bb[16]; \
            _Pragma("unroll") for (int r = 0; r < 16; ++r) { const int k = key0 + crow(r, hi); int kc = k < cs ? cs : k; kc = kc > cs + 15 ? cs + 15 : kc; bb[r] = tb[kc]; } \
            _Pragma("unroll") for (int r = 0; r < 16; ++r) asm volatile("" : "+v"(bb[r])); \
            _Pragma("unroll") for (int r = 0; r < 16; ++r) { const int k = key0 + crow(r, hi); const bool v = rowok && (k >= cs) && (k < cs + 16); p0[r] = v ? p0[r] * SC + bb[r] : -INFINITY; } \
            softmax_pv_win(p0, m, ls, o0, o1, L + VB0 + (cur) * 8192 + vlo + (key0 >> 3) * 512); \
        } }
    TileRegs rA, rB, rC, rD;
    { const size_t r0 = NA_TROW(0); tile_load<64>(rA, Kc + r0 * 64, Vc + r0 * 64, tid); }
    { const size_t r1 = NA_TROW(1); tile_load<64>(rB, Kc + r1 * 64, Vc + r1 * 64, tid); }
    { const size_t r2 = NA_TROW(2); tile_load<64>(rC, Kc + r2 * 64, Vc + r2 * 64, tid); }
    { const size_t r3 = NA_TROW(3); tile_load<64>(rD, Kc + r3 * 64, Vc + r3 * 64, tid); }
    tile_store(rA, L + KB0, L + VB0, tid);
    __syncthreads();
#define NA_STEP(tt, RL, RS, cur) { \
          \
        { const int tn = (tt) + 4 < nt ? (tt) + 4 : nt - 1; const size_t rn = NA_TROW(tn); tile_load<64>(RL, Kc + rn * 64, Vc + rn * 64, tid); } \
        NA_BODY(tt, cur) \
        tile_store(RS, L + KB0 + ((cur) ^ 1) * 8192, L + VB0 + ((cur) ^ 1) * 8192, tid); \
        __syncthreads(); }
    int t = 0;
    for (; t + 4 <= nt; t += 4) {
        NA_STEP(t, rA, rB, 0) NA_STEP(t + 1, rB, rC, 1) NA_STEP(t + 2, rC, rD, 0) NA_STEP(t + 3, rD, rA, 1)
    }
    if (t < nt) { NA_STEP(t, rA, rB, 0) if (t + 1 < nt) { NA_STEP(t + 1, rB, rC, 1) if (t + 2 < nt) { NA_STEP(t + 2, rC, rD, 0) } } }
#undef NA_STEP
#undef NA_BODY
#undef NA_TROW
    finalize_store_lane(o0, o1, ls, Y + qrow * DM + YC_NA + h * 64, hi);
}
}

__device__ __forceinline__ size_t ret_row(int b, int c, int j) { return c < 2 ? (size_t)(NLAT + b * CTX + 128 * c + j) : (size_t)(b * SEQ + 128 * (c - 2) + j); }
__device__ __forceinline__ float log2_sigmoid(float x) { return -log1pf(__expf(-x)) * LOG2E; }
__device__ __forceinline__ int tr_addr(int tile, int key, int cch) { return tile * 8192 + (cch >> 2) * 4096 + (key >> 3) * 512 + (key & 7) * 64 + (cch & 3) * 16; }

__device__ __forceinline__ void r1_unit(const Params& p, int l, int b, int h, int c, LAS unsigned char* L) {
    const int tid = tid_opaque(), lane = tid & 63, wave = __builtin_amdgcn_readfirstlane(tid >> 6), r32 = lane & 31, hi = lane >> 5;
    const bf16* Z = ws_z(p);
    const float lgf = log2_sigmoid(p.dec_f[l * 8 + h]), lgb = log2_sigmoid(p.dec_b[l * 8 + h]);
    LAS unsigned char* KT = L; LAS unsigned char* VF = L + 16384; LAS unsigned char* VBk = L + 32768;
#pragma unroll
    for (int i = 0; i < 2; ++i) { const int q = tid + 512 * i, tok = q >> 3, cch = q & 7;
        const bf16* rp = Z + ret_row(b, c, tok) * INC + h * 64 + cch * 8;
        const u32x4 kv = *(const u32x4*)(rp + ZC_RK), vv = *(const u32x4*)(rp + ZC_RV);
        const int a = tr_addr(tok >> 6, tok & 63, cch);
        *(LAS u32x4*)(KT + a) = kv;
        *(LAS u32x4*)(VF + a) = scale8(vv, ex2(lgf * (float)(127 - tok)));
        *(LAS u32x4*)(VBk + a) = scale8(vv, ex2(lgb * (float)tok)); }
    __syncthreads();
    const int dir = wave >> 2, dvb = (wave >> 1) & 1, dkb = wave & 1;
    const int vlo = ((lane >> 4) & 1) * 32 + (lane & 3) * 8 + (4 * hi + ((lane & 15) >> 2)) * 64;
    LAS const unsigned char* Ab = (dir ? VBk : VF) + dvb * 4096 + vlo; LAS const unsigned char* Bb = KT + dkb * 4096 + vlo;
    f32x16 acc;
#pragma unroll
    for (int i = 0; i < 16; ++i) acc[i] = 0.f;
#pragma unroll
    for (int ks = 0; ks < 8; ++ks) { const int off = (ks >> 2) * 8192 + (ks & 3) * 1024;
        const bf16x8 a = cat8(trrd(Ab + off), trrd(Ab + off + 512)), bb = cat8(trrd(Bb + off), trrd(Bb + off + 512));
        acc = MFMA32(a, bb, acc); }
    float* St = (float*)(p.ws + WS_SST) + ((size_t)((b * 8 + h) * 18 + c) * 2 + dir) * 4096;
#pragma unroll
    for (int r = 0; r < 16; ++r) St[(32 * dvb + crow(r, hi)) * 64 + 32 * dkb + r32] = acc[r];
    __syncthreads();
}

__device__ __forceinline__ void ph_ret_scan(const Params& p, int l) {
    const int tid = tid_opaque();
    const int task = blockIdx.x * 256 + tid;
    if (tid < 256) for (int tk = task; tk < 65536; tk += gridDim.x * 256) {
        const int cd = tk & 7, dv = (tk >> 3) & 63, dir = (tk >> 9) & 1, bh = tk >> 10, h = bh & 7;
        const float lg = log2_sigmoid((dir ? p.dec_b : p.dec_f)[l * 8 + h]), cdec = ex2(lg * 128.f);
        const float* Sb = (const float*)(p.ws + WS_SST) + (size_t)(bh * 18) * 2 * 4096 + dir * 4096 + dv * 64 + cd * 8;
        unsigned char* Ob = p.ws + WS_SIN + (size_t)(bh * 18) * 2 * 8192 + dir * 8192 + cd * 1024 + dv * 16;
        f32x4 a0 = {0.f, 0.f, 0.f, 0.f}, a1 = a0;
#pragma unroll
        for (int g = 0; g < 3; ++g) {
            f32x4 s0[6], s1[6];
#pragma unroll
            for (int k = 0; k < 6; ++k) { const int st = 6 * g + k, c = dir ? (st == 0 ? 1 : (st == 1 ? 0 : 19 - st)) : st; const float* sp = Sb + (size_t)c * 2 * 4096; s0[k] = *(const f32x4*)sp; s1[k] = *(const f32x4*)(sp + 4); }
#pragma unroll
            for (int k = 0; k < 6; ++k) { const int st = 6 * g + k, c = dir ? (st == 0 ? 1 : (st == 1 ? 0 : 19 - st)) : st;
                u32x4 w; w.x = pk2(a0.x, a0.y); w.y = pk2(a0.z, a0.w); w.z = pk2(a1.x, a1.y); w.w = pk2(a1.z, a1.w);
                *(u32x4*)(Ob + (size_t)c * 2 * 8192) = w;
                a0 = a0 * cdec + s0[k]; a1 = a1 * cdec + s1[k]; }
        }
    }
}

__device__ __forceinline__ void r3_pair(const Params& p, int l, int b, int h, int cp, LAS unsigned char* L) {
    const int tid = tid_opaque(), lane = tid & 63, wave = __builtin_amdgcn_readfirstlane(tid >> 6), r32 = lane & 31, hi = lane >> 5;
    const int half = wave >> 2, wq = wave & 3, c = 2 * cp + half, th = tid & 255;
    const bf16* Z = ws_z(p); bf16* Y = ws_hb(p);
    const float lgf = log2_sigmoid(p.dec_f[l * 8 + h]), lgb = log2_sigmoid(p.dec_b[l * 8 + h]);
    LAS unsigned char* Lh = L + half * 49152;
    LAS unsigned char* KT = Lh; LAS unsigned char* VT = Lh + 16384; LAS unsigned char* SF = Lh + 32768; LAS unsigned char* SBk = Lh + 40960;
#pragma unroll
    for (int i = 0; i < 4; ++i) { const int q = th + 256 * i, tok = q >> 3, cch = q & 7;
        const bf16* rp = Z + ret_row(b, c, tok) * INC + h * 64 + cch * 8;
        const u32x4 kv = *(const u32x4*)(rp + ZC_RK), vv = *(const u32x4*)(rp + ZC_RV);
        *(LAS u32x4*)(KT + (tok >> 6) * 8192 + cch * 1024 + (tok & 63) * 16) = kv;
        *(LAS u32x4*)(VT + tr_addr(tok >> 6, tok & 63, cch)) = vv; }
    const int qi = 32 * wq + r32;
    bf16x8 qr[4]; u32x2 gva[4], gvb[4];
    { const bf16* qp = Z + ret_row(b, c, qi) * INC + ZC_RQ + h * 64 + hi * 8;
#pragma unroll
      for (int d0 = 0; d0 < 4; ++d0) qr[d0] = *(const bf16x8*)(qp + d0 * 16);
      const bf16* gp0 = Z + ret_row(b, c, qi) * INC + ZC_RG + h * 64 + 4 * hi;
#pragma unroll
      for (int g = 0; g < 4; ++g) { gva[g] = *(const u32x2*)(gp0 + 8 * g); gvb[g] = *(const u32x2*)(gp0 + 32 + 8 * g); } }
    { const unsigned char* src = p.ws + WS_SIN + (size_t)(((b * 8 + h) * 18 + c) * 2) * 8192;
#pragma unroll
      for (int i = 0; i < 4; ++i) { const int q = th + 256 * i; *(LAS u32x4*)(SF + q * 16) = *(const u32x4*)(src + q * 16); } }
    __syncthreads();
    f32x16 o0, o1;
#pragma unroll
    for (int i = 0; i < 16; ++i) { o0[i] = 0.f; o1[i] = 0.f; }
    const int vlo = ((lane >> 4) & 1) * 32 + (lane & 3) * 8 + (4 * hi + ((lane & 15) >> 2)) * 64;
#pragma unroll
    for (int t = 0; t < 2; ++t) {
        f32x16 p0, p1; att::qk_tile(p0, p1, KT + t * 8192, qr, r32, hi);
#pragma unroll
        for (int r = 0; r < 16; ++r) { const int d0 = qi - (64 * t + crow(r, hi)), d1 = d0 - 32;
            p0[r] *= (d0 >= 0) ? ex2(lgf * (float)d0) : ex2(lgb * (float)(-d0));
            p1[r] *= (d1 >= 0) ? ex2(lgf * (float)d1) : ex2(lgb * (float)(-d1)); }
        att::pv_tile(o0, o1, p0, p1, VT + t * 8192 + vlo);
    }
    { const float xf = ex2(lgf * (float)(qi + 1)), xb = ex2(lgb * (float)(128 - qi));
#pragma unroll
      for (int s = 0; s < 4; ++s) {
          const bf16x8 af = __builtin_bit_cast(bf16x8, scale8(__builtin_bit_cast(u32x4, qr[s]), xf)), ab = __builtin_bit_cast(bf16x8, scale8(__builtin_bit_cast(u32x4, qr[s]), xb));
          LAS const unsigned char* sf = SF + (2 * s + hi) * 1024 + r32 * 16; LAS const unsigned char* sb = SBk + (2 * s + hi) * 1024 + r32 * 16;
          o0 = MFMA32(*(LAS const bf16x8*)sf, af, o0); o1 = MFMA32(*(LAS const bf16x8*)(sf + 512), af, o1);
          o0 = MFMA32(*(LAS const bf16x8*)sb, ab, o0); o1 = MFMA32(*(LAS const bf16x8*)(sb + 512), ab, o1); } }
    { float s1 = 0.f;
#pragma unroll
      for (int r = 0; r < 16; ++r) { o0[r] *= 0.125f; o1[r] *= 0.125f; s1 += o0[r] + o1[r]; }
      const float mean = att::xh_sum(s1) * (1.f / 64.f); float s2 = 0.f;
#pragma unroll
      for (int r = 0; r < 16; ++r) { o0[r] -= mean; o1[r] -= mean; s2 += o0[r] * o0[r] + o1[r] * o1[r]; }
      const float rstd = rsqrtf(att::xh_sum(s2) * (1.f / 64.f) + 1e-6f);
      const size_t row = ret_row(b, c, qi);
      bf16* yp = Y + row * DM + YC_RET + h * 64 + 4 * hi;
#pragma unroll
      for (int g = 0; g < 4; ++g) {
          const u32x2 ga = gva[g], gb = gvb[g]; u32x2 w0, w1;
          w0.x = pk2(silu_f(bf2f(ga.x & 0xffffu)) * o0[4 * g] * rstd, silu_f(__uint_as_float(ga.x & 0xffff0000u)) * o0[4 * g + 1] * rstd);
          w0.y = pk2(silu_f(bf2f(ga.y & 0xffffu)) * o0[4 * g + 2] * rstd, silu_f(__uint_as_float(ga.y & 0xffff0000u)) * o0[4 * g + 3] * rstd);
          w1.x = pk2(silu_f(bf2f(gb.x & 0xffffu)) * o1[4 * g] * rstd, silu_f(__uint_as_float(gb.x & 0xffff0000u)) * o1[4 * g + 1] * rstd);
          w1.y = pk2(silu_f(bf2f(gb.y & 0xffffu)) * o1[4 * g + 2] * rstd, silu_f(__uint_as_float(gb.y & 0xffff0000u)) * o1[4 * g + 3] * rstd);
          *(u32x2*)(yp + 8 * g) = w0; *(u32x2*)(yp + 32 + 8 * g) = w1; } }
    __syncthreads();
}

__device__ __forceinline__ void rope_task(const Params& p, int row, int task) {
    bf16* Z = ws_z(p);
    const int hq = task >> 2, i = task & 3, t = row & 2047;
    const int base = hq < 8 ? ZC_RQ + 64 * hq : (hq < 16 ? ZC_RK + 64 * (hq - 8) : (hq < 24 ? ZC_SQ + 64 * (hq - 16) : ZC_SK + 64 * (hq - 24)));
    const int pos = (i < 2) ? (t >> 6) : (t & 63), f0 = 8 * (i & 1);
    bf16* p1 = Z + (size_t)row * INC + base + 8 * i; bf16* p2 = p1 + 32;
    const u32x4 a = *(const u32x4*)p1, bq = *(const u32x4*)p2; u32x4 oa, ob;
#pragma unroll
    for (int k = 0; k < 4; ++k) {
        const float c0 = ROPE_COS[pos * 16 + f0 + 2 * k], s0 = ROPE_SIN[pos * 16 + f0 + 2 * k], c1 = ROPE_COS[pos * 16 + f0 + 2 * k + 1], s1 = ROPE_SIN[pos * 16 + f0 + 2 * k + 1];
        const float x1l = bf2f(a[k] & 0xffffu), x1h = __uint_as_float(a[k] & 0xffff0000u), x2l = bf2f(bq[k] & 0xffffu), x2h = __uint_as_float(bq[k] & 0xffff0000u);
        oa[k] = pk2(x1l * c0 - x2l * s0, x1h * c1 - x2h * s1); ob[k] = pk2(x1l * s0 + x2l * c0, x1h * s1 + x2h * c1); }
    *(u32x4*)p1 = oa; *(u32x4*)p2 = ob;
}
__device__ __forceinline__ void conv_task(const Params& p, int l, int row, int ch8) {
    const bf16* Z = ws_z(p); bf16* Y = ws_hb(p);
    const int t = (row < NLAT) ? (row & 2047) : ((row - NLAT) & 255), tl = (row < NLAT) ? 2047 : 255;
    const float* w = p.conv_w + (size_t)l * 3 * 512 + ch8 * 8;
    const bf16* zr = Z + (size_t)row * INC + ch8 * 8;
    float acc[8];
#pragma unroll
    for (int k = 0; k < 8; ++k) acc[k] = 0.f;
#pragma unroll
    for (int dt = -1; dt <= 1; ++dt) {
        if ((dt < 0 && t == 0) || (dt > 0 && t == tl)) continue;
        const bf16* zz = zr + (long)dt * INC;
        const u32x4 cc = *(const u32x4*)(zz + ZC_CC), hh = *(const u32x4*)(zz + ZC_CH);
        const f32x4 w0 = *(const f32x4*)(w + (dt + 1) * 512), w1 = *(const f32x4*)(w + (dt + 1) * 512 + 4);
#pragma unroll
        for (int k = 0; k < 4; ++k) { const float wl = (k < 2) ? w0[2 * k] : w1[2 * k - 4], wh = (k < 2) ? w0[2 * k + 1] : w1[2 * k - 3];
            acc[2 * k] += wl * bf2f(cc[k] & 0xffffu) * bf2f(hh[k] & 0xffffu); acc[2 * k + 1] += wh * __uint_as_float(cc[k] & 0xffff0000u) * __uint_as_float(hh[k] & 0xffff0000u); }
    }
    const u32x4 bb = *(const u32x4*)(zr + ZC_CB); u32x4 o;
#pragma unroll
    for (int k = 0; k < 4; ++k) o[k] = pk2(acc[2 * k] * bf2f(bb[k] & 0xffffu), acc[2 * k + 1] * __uint_as_float(bb[k] & 0xffff0000u));
    *(u32x4*)(Y + (size_t)row * DM + YC_CONV + ch8 * 8) = o;
}

__device__ __forceinline__ void ph_norm_router(const Params& p, int l, LAS unsigned char* lds) {
    const int tid = tid_opaque(), lane = tid & 63, wave = __builtin_amdgcn_readfirstlane(tid >> 6);
    constexpr int WPITCH = 4112;
    const float* wr = p.w_router + (size_t)l * 2048 * 16;
    { f32x4 t[16];
#pragma unroll
      for (int k = 0; k < 16; ++k) { const int n = tid + NTHR * k; t[k] = *(const f32x4*)(wr + (n >> 2) * 16 + (n & 3) * 4); }
#pragma unroll
      for (int k = 0; k < 16; ++k) { const int n = tid + NTHR * k, kk = n >> 2, q = n & 3;
#pragma unroll
          for (int i = 0; i < 4; ++i) *(LAS bf16*)(lds + (4 * q + i) * WPITCH + kk * 2) = (bf16)f2bf(t[k][i]); } }
    const int gw = blockIdx.x * NWAVES + wave, NGW = gridDim.x * NWAVES;
    const int nrows = (l == 0) ? NROW : NLAT;
    float* aff = (float*)(p.ws + WS_AFF);
    const int rpw = (nrows + NGW - 1) / NGW, r0 = gw * rpw, r1 = (r0 + rpw < nrows) ? r0 + rpw : nrows;
    { int cur = -1; f32x4 wv[8], sv[8], vn[8];
      if (r0 < r1) load_row8_bf16(vn, ws_xb(p) + (size_t)r0 * DM, lane);
      for (int row = r0; row < r1; ++row) {
          f32x4 v[8];
#pragma unroll
          for (int j = 0; j < 8; ++j) v[j] = vn[j];
          if (row + 1 < r1) load_row8_bf16(vn, ws_xb(p) + (size_t)(row + 1) * DM, lane);
          const int arow = (row < NLAT) ? (row >> 11) : 8;
          if (arow != cur) { const float* ad = ws_ada(p) + (size_t)(l * 9 + arow) * ADAW; load_coeffs(wv, sv, p.norm_ffn + l * DM, ad + 4 * 2048, ad + 3 * 2048, lane); cur = arow; }
          const float rstd = row_rstd(v);
#pragma unroll
          for (int j = 0; j < 8; ++j) v[j] = v[j] * rstd * wv[j] + sv[j];
          store_row8_bf16(v, ws_hb(p) + (size_t)row * DM, lane);
      } }
    asm volatile("s_waitcnt vmcnt(0)" ::: "memory");
    __syncthreads();
    if (tid < 64) { __builtin_amdgcn_fence(__ATOMIC_ACQUIRE, "agent"); asm volatile("s_waitcnt vmcnt(0)" ::: "memory"); }
    __syncthreads();
    const int R = rpw * NWAVES, R0 = blockIdx.x * R, R1 = (R0 + R < nrows) ? R0 + R : nrows;
    if (R0 + 16 * wave < R1) {
        const int fr = lane & 15, kg = lane >> 4;
        int arow_ = R0 + 16 * wave + fr; if (arow_ > R1 - 1) arow_ = R1 - 1;
        const bf16* ap = ws_hb(p) + (size_t)arow_ * DM + 8 * kg;
        LAS const unsigned char* bp = lds + fr * WPITCH + 16 * kg;
        f32x4 acc = {0.f, 0.f, 0.f, 0.f};
        for (int s0 = 0; s0 < 64; s0 += 8) {
            bf16x8 af[8];
#pragma unroll
            for (int s = 0; s < 8; ++s) af[s] = *(const bf16x8*)(ap + 32 * (s0 + s));
#pragma unroll
            for (int s = 0; s < 8; ++s) acc = __builtin_amdgcn_mfma_f32_16x16x32_bf16(af[s], *(LAS const bf16x8*)(bp + 64 * (s0 + s)), acc, 0, 0, 0);
        }
#pragma unroll
        for (int r = 0; r < 4; ++r) {
            float mx = acc[r];
#pragma unroll
            for (int o = 1; o < 16; o <<= 1) mx = fmaxf(mx, __shfl_xor(mx, o));
            const float ex = __expf(acc[r] - mx); float sum = ex;
#pragma unroll
            for (int o = 1; o < 16; o <<= 1) sum += __shfl_xor(sum, o);
            const int row = R0 + 16 * wave + 4 * kg + r;
            if (row < R1) aff[(size_t)row * 16 + fr] = ex / sum;
        }
    }
}

__device__ __forceinline__ int moe_mpe(int l) { return l == 0 ? 2304 : 2048; }
constexpr int CW_SCF = 8192;
constexpr int CW_TKF = 3072;
constexpr int RIDX_OFF = 131072 + 1024;
__device__ __forceinline__ void ph_topk(const Params& p, int l, LAS unsigned char* lds) {
    const int tid = tid_opaque(), lane = tid & 63, wave = __builtin_amdgcn_readfirstlane(tid >> 6);
    const int nprob = (l == 0) ? 256 : 128, MPE = moe_mpe(l);
    const float* aff = (const float*)(p.ws + WS_AFF); int* sel = (int*)(p.ws + WS_SEL); int* idx = (int*)(p.ws + WS_IDX); float* gatev = (float*)(p.ws + WS_GATEV);
    LAS int* lcnt = (LAS int*)lds;
    for (int prob = blockIdx.x; prob < nprob; prob += gridDim.x) {
        const bool isctx = prob >= 128; const int q = prob & 127, b = q >> 4, e = q & 15;
        const int T = isctx ? CTX : SEQ, cap = isctx ? 32 : 256, row0 = isctx ? NLAT + b * CTX : b * SEQ, slot0 = e * MPE + (isctx ? 2048 + b * 32 : b * 256);
        if (tid < 48) lcnt[tid] = 0;
        unsigned u[4];
#pragma unroll
        for (int k = 0; k < 4; ++k) { const int t = 256 * wave + 64 * k + lane; u[k] = (t < T) ? __float_as_uint(aff[(size_t)(row0 + t) * 16 + e]) : 0u; }
        __syncthreads();
        unsigned tau = 0u;
        for (int bit = 29; bit >= 0; --bit) {
            const unsigned cand = tau | (1u << bit); int cnt = 0;
#pragma unroll
            for (int k = 0; k < 4; ++k) cnt += __popcll(__ballot(u[k] >= cand));
            if (lane == 0 && cnt) __hip_atomic_fetch_add(&lcnt[bit], cnt, __ATOMIC_RELAXED, __HIP_MEMORY_SCOPE_WORKGROUP);
            __syncthreads();
            if (lcnt[bit] >= cap) tau = cand;
        }
        int ngt = 0, neq = 0;
#pragma unroll
        for (int k = 0; k < 4; ++k) { const int t = 256 * wave + 64 * k + lane; ngt += __popcll(__ballot(u[k] > tau)); neq += __popcll(__ballot((t < T) && u[k] == tau)); }
        if (lane == 0) { lcnt[32 + wave] = ngt; lcnt[40 + wave] = neq; }
        __syncthreads();
        int tgt = 0, eqb = 0;
#pragma unroll
        for (int w = 0; w < 8; ++w) { tgt += lcnt[32 + w]; }
        const int need_eq = cap - tgt;
        int base = 0;
#pragma unroll
        for (int w = 0; w < 8; ++w) if (w < wave) { const int ne = lcnt[40 + w]; int tk = need_eq - eqb; tk = tk < 0 ? 0 : (tk > ne ? ne : tk); base += lcnt[32 + w] + tk; eqb += ne; }
        const unsigned long long lt = (1ull << lane) - 1ull;
        int eqc = eqb;
#pragma unroll
        for (int k = 0; k < 4; ++k) { const int t = 256 * wave + 64 * k + lane; const bool valid = t < T;
            const bool gt = u[k] > tau, eq = valid && (u[k] == tau);
            const unsigned long long em = __ballot(eq);
            const bool take = gt || (eq && (eqc + __popcll(em & lt) < need_eq));
            const unsigned long long sm = __ballot(take);
            const int slot = base + __popcll(sm & lt);
            if (valid) { if (take) { idx[slot0 + slot] = row0 + t; gatev[slot0 + slot] = __uint_as_float(u[k]); }
                         sel[(size_t)(row0 + t) * 16 + e] = take ? slot : -1; }
            base += __popcll(sm); eqc += __popcll(em); }
        asm volatile("s_waitcnt vmcnt(0)" ::: "memory");
        __syncthreads();
        if (tid == 0) { __builtin_amdgcn_fence(__ATOMIC_RELEASE, "agent"); asm volatile("s_waitcnt vmcnt(0)" ::: "memory");
            __hip_atomic_store((unsigned*)(p.ws + WS_CTL) + CW_TKF + l * 256 + prob, 1u, __ATOMIC_RELAXED, __HIP_MEMORY_SCOPE_AGENT); }
    }
}
template <class Sched> __device__ __forceinline__ void topk_wait(const Params& p, int l, const Sched& S, int tpe, int tid) {
    if (tid < 64) {
        const int i = tid >> 3, sub = tid & 7; pg8::Unit u; int flag = -1;
        if (i < 6 && S.next(i, u)) { const int e = u.pm / tpe, j = u.pm % tpe; if (j < 8) { if (sub == 0) flag = j * 16 + e; } else flag = 128 + sub * 16 + e; }
        if (flag >= 0) { const unsigned* f = (const unsigned*)(p.ws + WS_CTL) + CW_TKF + l * 256 + flag; unsigned sp = 0;
            while (__hip_atomic_load(f, __ATOMIC_RELAXED, __HIP_MEMORY_SCOPE_AGENT) == 0u && ++sp < (1u << 20)) __builtin_amdgcn_s_sleep(2); }
        __builtin_amdgcn_fence(__ATOMIC_ACQUIRE, "agent"); asm volatile("s_waitcnt vmcnt(0)" ::: "memory");
    }
    __syncthreads();
}


__device__ __forceinline__ void ph_combine(const Params& p, int l) {
    const int tid_ = tid_opaque(), lane = tid_ & 63, wave = __builtin_amdgcn_readfirstlane(tid_ >> 6);
    const int gw = blockIdx.x * NWAVES + wave, NGW = gridDim.x * NWAVES;
    const int nrows = (l == 0) ? NROW : NLAT, MPE = moe_mpe(l);
    const int* sel = (const int*)(p.ws + WS_SEL); const bf16* YE = ws_z(p);
    const int rpw = (nrows + NGW - 1) / NGW, r0 = gw * rpw, r1 = (r0 + rpw < nrows) ? r0 + rpw : nrows;
    int cur = -1; f32x4 g2[8], vn[8]; int seln = -1;
    f32x4 wfin[8];
    if (l != 0) {
#pragma unroll
        for (int j = 0; j < 8; ++j) wfin[j] = *(const f32x4*)(p.norm_final + 256 * j + 4 * lane); }
    if (r0 < r1) { load_row8_bf16(vn, ws_xb(p) + (size_t)r0 * DM, lane); seln = (lane < 16) ? sel[(size_t)r0 * 16 + lane] : -1; }
    for (int row = r0; row < r1; ++row) {
        f32x4 v[8];
#pragma unroll
        for (int j = 0; j < 8; ++j) v[j] = vn[j];
        const int selv = seln;
        if (row + 1 < r1) { load_row8_bf16(vn, ws_xb(p) + (size_t)(row + 1) * DM, lane); seln = (lane < 16) ? sel[(size_t)(row + 1) * 16 + lane] : -1; }
        const bool isctx = row >= NLAT;
        const int arow = isctx ? 8 : (row >> 11);
        const int sbase = isctx ? 2048 + ((row - NLAT) >> 8) * 32 : (row >> 11) * 256;
        if (arow != cur) { const float* ad = ws_ada(p) + (size_t)(l * 9 + arow) * ADAW;
#pragma unroll
            for (int j = 0; j < 8; ++j) g2[j] = *(const f32x4*)(ad + 5 * 2048 + 256 * j + 4 * lane);
            cur = arow; }
        f32x4 acc[8];
#pragma unroll
        for (int j = 0; j < 8; ++j) acc[j] = (f32x4){0.f, 0.f, 0.f, 0.f};
        unsigned long long mask = __ballot(selv >= 0);
        while (mask) {
            const int e0 = __builtin_ctzll(mask); mask &= mask - 1;
            const bool two = mask != 0ull; const int e1 = two ? __builtin_ctzll(mask) : e0; if (two) mask &= mask - 1;
            const int s0 = __builtin_amdgcn_readlane(selv, e0), s1 = __builtin_amdgcn_readlane(selv, e1);
            const bf16* y0 = YE + (size_t)(e0 * MPE + sbase + s0) * DM + 4 * lane; const bf16* y1 = YE + (size_t)(e1 * MPE + sbase + s1) * DM + 4 * lane;
            u32x2 a[8], bq[8];
#pragma unroll
            for (int j = 0; j < 8; ++j) a[j] = *(const u32x2*)(y0 + 256 * j);
            if (two) {
#pragma unroll
                for (int j = 0; j < 8; ++j) bq[j] = *(const u32x2*)(y1 + 256 * j); }
#pragma unroll
            for (int j = 0; j < 8; ++j) { acc[j].x += bf2f(a[j].x & 0xffffu); acc[j].y += __uint_as_float(a[j].x & 0xffff0000u); acc[j].z += bf2f(a[j].y & 0xffffu); acc[j].w += __uint_as_float(a[j].y & 0xffff0000u); }
            if (two) {
#pragma unroll
                for (int j = 0; j < 8; ++j) { acc[j].x += bf2f(bq[j].x & 0xffffu); acc[j].y += __uint_as_float(bq[j].x & 0xffff0000u); acc[j].z += bf2f(bq[j].y & 0xffffu); acc[j].w += __uint_as_float(bq[j].y & 0xffff0000u); } }
        }
#pragma unroll
        for (int j = 0; j < 8; ++j) v[j] = v[j] + g2[j] * acc[j];
        const float rstd = row_rstd(v);
        if (l == 0) {
            store_row8_bf16(v, ws_xb(p) + (size_t)row * DM, lane);
            const float* ad1 = ws_ada(p) + (size_t)(1 * 9 + arow) * ADAW;
            modulate8(v, rstd, p.norm_mix + 1 * DM, ad1 + 2048, ad1, lane);
            store_row8_bf16(v, ws_hb(p) + (size_t)row * DM, lane);
        } else {
#pragma unroll
            for (int j = 0; j < 8; ++j) *(f32x4*)(p.out + (size_t)row * DM + 256 * j + 4 * lane) = v[j] * rstd * wfin[j];
        }
    }
}

constexpr int N_PHASES = 12;
template <int PH> __device__ __forceinline__ void run_phase(const Params& p, int l, LAS unsigned char* lds, int rep) {
    const int G = gridDim.x, bid = blockIdx.x, tid = tid_opaque();
    const bool need_ctx = (l == 0);
    const int vb = (G % 8 == 0) ? (bid & 7) * (G >> 3) + (bid >> 3) : bid;
    if constexpr (PH == 0) ph_prologue(p, lds);
    if constexpr (PH == 1) ph_modnorm0(p);
    if constexpr (PH == 2) {
        pg8::Gemm g{ws_hb(p), (const bf16*)(p.ws + WS_WIN) + (size_t)l * INC * 2048, NROW, INC, DM};
        { LAS float* rl = (LAS float*)(lds + ROPE_LDS);
          for (int i = tid; i < 1024; i += NTHR) { rl[i] = ROPE_COS[i]; rl[1024 + i] = ROPE_SIN[i]; } }
        __syncthreads();
        pg8::EpiZRope E{ws_z(p), (LAS const float*)(lds + ROPE_LDS), (LAS const float*)(lds + ROPE_LDS) + 1024, ws_kvh(p)};
        if (l == DEPTH - 1) { pg8::SkipOrder S; S.init(G, bid);
            pg8::gemm_phase<pg8::EpiZRope, pg8::SkipOrder, true, true>(lds, g, S, E); }
        else { pg8::StaticOrder S; S.init(NROW, INC, G, bid);
            pg8::gemm_phase<pg8::EpiZRope, pg8::StaticOrder, true, true>(lds, g, S, E); }
        if (l == 0 && !rep && G == 256 && bid >= 120 && TAIL_P2 > 0) tail_convert(p, TAIL_OFF_P2, TAIL_P2, bid - 120, G - 120, lds);
    }
    if constexpr (PH == 3) {
        const int nu = 512 + (need_ctx ? 64 : 0);
        if (rep != 3) for (int u = vb; u < nu; u += G) {
            if (u < 576) { const bool ic = u >= 512; const int q = u - 512; att::na_unit(p, l, ic ? q >> 3 : u >> 6, ic ? q & 7 : (u >> 3) & 7, ic ? 0 : u & 7, ic, lds, rep); }
        }
        const int gt = bid * NTHR + tid, NT = G * NTHR;
        const int crows = need_ctx ? NROW : NLAT;
        if (rep != 2 && rep < 4) for (int i = gt; i < crows * 64; i += NT) conv_task(p, l, i >> 6, i & 63);
    }
    if constexpr (PH == 4) {
        const int nsu = 512 + (need_ctx ? 64 : 0);
        if (rep != 3) for (int u = (vb + 128) % G; u < nsu; u += G) { const bool ic = u >= 512; const int q = u - 512;
            att::swa_unit(p, l, ic ? q >> 3 : u >> 6, ic ? (q >> 2) & 1 : (u >> 5) & 1, ic ? (q >> 1) & 1 : (u >> 1) & 15, ic ? q & 1 : u & 1, ic, lds); }
        __syncthreads();
        if (rep != 2) for (int u = bid; u < 1152; u += G) { const int bh = u / 18, c = u % 18; r1_unit(p, l, bh >> 3, bh & 7, c, lds); }
    }
    if constexpr (PH == 5) {
        const int c0 = need_ctx ? 0 : 1, npair = 9 - c0;
        unsigned* sflag = (unsigned*)(p.ws + WS_CTL) + CW_SCF + l * 1024;
        if (!rep) { ph_ret_scan(p, l);
            asm volatile("s_waitcnt vmcnt(0)" ::: "memory"); __syncthreads();
            if (tid == 0) { __builtin_amdgcn_fence(__ATOMIC_RELEASE, "agent"); asm volatile("s_waitcnt vmcnt(0)" ::: "memory"); __hip_atomic_store(sflag + bid, 1u, __ATOMIC_RELAXED, __HIP_MEMORY_SCOPE_AGENT); } }
        for (int u = bid; u < 64 * npair; u += G) { const int bh = u / npair, cp = c0 + u % npair;
            if (!rep) {
                if (tid < 64) { const int nf = (G == 256) ? 4 : G, f0 = (G == 256) ? 4 * bh : 0;
                    for (int f = tid; f < nf; f += 64) { unsigned sp = 0; while (__hip_atomic_load(sflag + f0 + f, __ATOMIC_RELAXED, __HIP_MEMORY_SCOPE_AGENT) == 0u && ++sp < (1u << 20)) __builtin_amdgcn_s_sleep(2); }
                    __builtin_amdgcn_fence(__ATOMIC_ACQUIRE, "agent"); asm volatile("s_waitcnt vmcnt(0)" ::: "memory"); }
                __syncthreads(); }
            r3_pair(p, l, bh >> 3, bh & 7, cp, lds); }
    }
    if constexpr (PH == 6) { if (!(rep && l == 1)) {
        const int M = need_ctx ? NROW : NLAT;
        pg8::Gemm g{ws_hb(p), (const bf16*)(p.ws + WS_WOUT) + (size_t)l * 2048 * 2048, M, DM, DM}; pg8::StaticOrder S; S.init(M, DM, G, bid);
        if (l == 0) { pg8::EpiResGate<true> E{p.x, p.ctx, ws_xb(p), ws_ada(p) + (size_t)l * 9 * ADAW, 2 * 2048};
            pg8::gemm_phase<pg8::EpiResGate<true>, pg8::StaticOrder, true, true>(lds, g, S, E);
            if (!rep && G == 256 && bid >= 64 && TAIL_P6 > 0) tail_convert(p, TAIL_OFF_P6, TAIL_P6, bid - 64, G - 64, lds); }
        else { pg8::EpiResGate<false> E{nullptr, nullptr, ws_xb(p), ws_ada(p) + (size_t)l * 9 * ADAW, 2 * 2048};
            pg8::gemm_phase<pg8::EpiResGate<false>, pg8::StaticOrder, true, true>(lds, g, S, E); }
    } }
    if constexpr (PH == 7) ph_norm_router(p, l, lds);
    if constexpr (PH == 9) {
        const int tpe = need_ctx ? 9 : 8;
        pg8::GroupedOrder S; S.init(tpe, G, bid);
        if (!rep) { ph_topk(p, l, lds); topk_wait(p, l, S, tpe, tid); }
        { LAS int* rl = (LAS int*)(lds + RIDX_OFF); const int* idx = (const int*)(p.ws + WS_IDX); pg8::Unit u;
          for (int i = 0; S.next(i, u); ++i) if (tid < 256) rl[i * 256 + tid] = idx[u.pm * 256 + tid];
          __syncthreads(); }
        pg8::Gemm g{ws_hb(p), (const bf16*)(p.ws + WS_WGU) + (size_t)l * 16 * 2048 * 2048, 16 * tpe * 256, 2048, DM, (const LAS int*)(lds + RIDX_OFF)};
        pg8::EpiSiluMul E{(bf16*)(p.ws + WS_ACT)};
        pg8::gemm_phase<pg8::EpiSiluMul, pg8::GroupedOrder, true, true, true>(lds, g, S, E);
        if (l == 0 && !rep && G == 256 && bid >= 128 && TAIL_P9 > 0) tail_convert(p, TAIL_OFF_P9, TAIL_P9, bid - 128, G - 128, lds);
    }
    if constexpr (PH == 10) {
        const int tpe = need_ctx ? 9 : 8;
        pg8::Gemm g{(const bf16*)(p.ws + WS_ACT), (const bf16*)(p.ws + WS_WD) + (size_t)l * 16 * 2048 * 1024, 16 * tpe * 256, 2048, EFF}; pg8::GroupedOrder S; S.init(tpe, G, bid);
        pg8::EpiDown E{ws_z(p), (const float*)(p.ws + WS_GATEV)};
        pg8::gemm_phase<pg8::EpiDown, pg8::GroupedOrder, true, true>(lds, g, S, E);
        if (l == 0 && !rep && G == 256 && bid >= 128 && TAIL_P10 > 0) tail_convert(p, TAIL_OFF_P10, TAIL_P10, bid - 128, G - 128, lds);
    }
    if constexpr (PH == 11) { if (!rep) ph_combine(p, l); }
}

#ifndef MEGA
#define MEGA 1
#endif
template <int PH> __global__ void __launch_bounds__(NTHR, 2) k_phase(Params p, int l) {
    extern __shared__ __attribute__((aligned(16))) unsigned char lds_raw[];
    run_phase<PH>(p, l, (LAS unsigned char*)lds_raw, 0);
}

#if MEGA
__global__ void __launch_bounds__(NTHR, 2) k_mega(Params p) {
    extern __shared__ __attribute__((aligned(16))) unsigned char lds_raw[];
    LAS unsigned char* lds = (LAS unsigned char*)lds_raw;
    volatile LAS unsigned* MISC = (volatile LAS unsigned*)(lds + MISC_OFF);
    if (threadIdx.x < 32) MISC[threadIdx.x] = 0u;
    __syncthreads();
    XcdBarrier bar = xcd_barrier_post((unsigned*)(p.ws + WS_CTL) + CW_BAR, MISC + 8);
#ifndef REPEAT_MASK
#define REPEAT_MASK 0
#endif
#ifndef REPEAT_SUB
#define REPEAT_SUB 1
#endif
#define RP(k, l) do { run_phase<k>(p, l, lds, 0); xcd_barrier(bar); if ((REPEAT_MASK >> k) & 1) { run_phase<k>(p, l, lds, REPEAT_SUB); xcd_barrier(bar); } } while (0)
    RP(0, 0); RP(1, 0);
#ifdef EXTRA_BARRIERS
    for (int i_ = 0; i_ < EXTRA_BARRIERS; ++i_) xcd_barrier(bar);
#endif
#define LAYER_PHASES(l) RP(2, l); run_phase<3>(p, l, lds, 0); __syncthreads(); if ((REPEAT_MASK >> 3) & 1) { run_phase<3>(p, l, lds, REPEAT_SUB); __syncthreads(); } RP(4, l); RP(5, l); RP(6, l); RP(7, l); RP(9, l); RP(10, l);
    LAYER_PHASES(0) RP(11, 0);
    LAYER_PHASES(1) run_phase<11>(p, 1, lds, 0);
#undef RP
#undef LAYER_PHASES
}
#endif

template <int PH> static void launch_phase(const Params& p, int l, int grid, hipStream_t stream) {
    static bool attr_set = false;
    if (!attr_set) { (void)hipFuncSetAttribute((const void*)k_phase<PH>, hipFuncAttributeMaxDynamicSharedMemorySize, LDS_BYTES); attr_set = true; }
    hipLaunchKernelGGL(k_phase<PH>, dim3(grid), dim3(NTHR), LDS_BYTES, stream, p, l);
}

extern "C" void kernel_launch(void* const* d_in, const int* in_sizes, int n_in, void* d_out, int out_size, void* d_ws, size_t ws_size, hipStream_t stream) {
    static int grid = 0;
    if (grid == 0) {
        if (n_in != 20 || in_sizes[0] != NLAT * DM || out_size != NLAT * DM || ws_size < WS_END) {
            fprintf(stderr, "kernel_launch: unexpected problem shape (n_in %d, in0 %d, out %d, ws %zu; need ws >= %zu); nothing launched\n", n_in, n_in > 0 ? in_sizes[0] : -1, out_size, ws_size, (size_t)WS_END);
            grid = -1; return; }
        int dev = 0, cus = 0;
        if (hipGetDevice(&dev) != hipSuccess || hipDeviceGetAttribute(&cus, hipDeviceAttributeMultiprocessorCount, dev) != hipSuccess) { grid = -1; return; }
#if MEGA
        if (hipFuncSetAttribute((const void*)k_mega, hipFuncAttributeMaxDynamicSharedMemorySize, LDS_BYTES) != hipSuccess) { fprintf(stderr, "kernel_launch: hipFuncSetAttribute failed\n"); grid = -1; return; }
        int per_cu = 0;
        if (hipOccupancyMaxActiveBlocksPerMultiprocessor(&per_cu, (const void*)k_mega, NTHR, LDS_BYTES) != hipSuccess || per_cu < 1) { fprintf(stderr, "kernel_launch: occupancy query reports %d blocks per CU\n", per_cu); }
        (void)hipGetLastError();
#endif
        grid = cus;
    }
    if (grid < 0) return;
    Params p{};
    p.x = (const float*)d_in[0]; p.c = (const float*)d_in[1]; p.ctx = (const float*)d_in[2]; p.c_ctx = (const float*)d_in[3]; p.w_ada = (const float*)d_in[4]; p.b_ada = (const float*)d_in[5];
    p.norm_mix = (const float*)d_in[6]; p.norm_ffn = (const float*)d_in[7]; p.w_in = (const float*)d_in[8]; p.w_out = (const float*)d_in[9]; p.dec_f = (const float*)d_in[10]; p.dec_b = (const float*)d_in[11];
    p.conv_w = (const float*)d_in[12]; p.sink = (const float*)d_in[13]; p.rpb = (const float*)d_in[14]; p.w_router = (const float*)d_in[15]; p.w_gate = (const float*)d_in[16]; p.w_up = (const float*)d_in[17];
    p.w_down = (const float*)d_in[18]; p.norm_final = (const float*)d_in[19]; p.out = (float*)d_out; p.ws = (unsigned char*)d_ws;
    if (hipMemsetAsync((char*)d_ws + WS_CTL, 0, CTL_ZERO_BYTES, stream) != hipSuccess) { fprintf(stderr, "kernel_launch: memset failed\n"); return; }
#if MEGA
    hipLaunchKernelGGL(k_mega, dim3(grid), dim3(NTHR), LDS_BYTES, stream, p);
#else
    launch_phase<0>(p, 0, grid, stream); launch_phase<1>(p, 0, grid, stream);
    for (int l = 0; l < DEPTH; ++l) {
        launch_phase<2>(p, l, grid, stream); launch_phase<3>(p, l, grid, stream); launch_phase<4>(p, l, grid, stream); launch_phase<5>(p, l, grid, stream); launch_phase<6>(p, l, grid, stream);
        launch_phase<7>(p, l, grid, stream); launch_phase<9>(p, l, grid, stream); launch_phase<10>(p, l, grid, stream); launch_phase<11>(p, l, grid, stream);
    }
#endif
}
```

```cpp
#include <hip/hip_runtime.h>
#include <cstdio>
#include <cstdint>
__device__ __forceinline__ int tid_opaque() { int t = (int)threadIdx.x; asm volatile("" : "+v"(t)); return t; }
#define MEGA 1
namespace pg8 {
#define PG8_LAS __attribute__((address_space(3)))
typedef unsigned short bf16_t;
typedef short bf16x8 __attribute__((ext_vector_type(8)));
typedef float f32x4 __attribute__((ext_vector_type(4)));
typedef unsigned u32x4 __attribute__((ext_vector_type(4)));
constexpr int BM = 256, BK = 64, HALF = 128, HTB = HALF * BK * 2  , STAGE_BYTES = 8 * HTB, NXCD = 8, WGM = 8;

__host__ __device__ __forceinline__ int lds_byte(int r, int c) { const int st = (r >> 4) * 2 + (c >> 5), rr = r & 15, cc = c & 31, ob = rr * 64 + cc * 2; return st * 1024 + (ob ^ (((ob >> 9) & 1) << 5)); }
__host__ __device__ __forceinline__ void stage_rc(int b, int& R, int& C) { const int st = b / 1024, sb = b % 1024, swz = sb ^ (((sb >> 9) & 1) << 5); R = (st >> 1) * 16 + swz / 64; C = (st & 1) * 32 + (swz % 64) / 2; }
__host__ __device__ __forceinline__ int perm32(int rho) { const int n = rho >> 4, i = rho & 15; return 8 * (i >> 2) + 4 * n + (i & 3); }

struct Unit { int pm, pn, pb, q; };
struct Gemm { const bf16_t* A; const bf16_t* Bt; int M, N, K; const PG8_LAS int* ridx; };

struct StaticOrder {
    int nM, nN, nwg, G, c;
    __host__ __device__ void init(int M, int N, int G_, int c_) { nM = M / BM; nN = N / BM; nwg = nM * nN; G = G_; c = c_; }
    __host__ __device__ bool next(int i, Unit& u) const {
        const long L = (long)i * G + c; if (L >= nwg) return false;
        int wgid = (int)L; { const int q = nwg / NXCD, r = nwg % NXCD, xcd = wgid % NXCD, off = wgid / NXCD; wgid = (xcd < r ? xcd * (q + 1) : r * (q + 1) + (xcd - r) * q) + off; }
        const int nig = WGM * nN, gid = wgid / nig, fm = gid * WGM, gsz = (nM - fm) < WGM ? (nM - fm) : WGM;
        u.pm = fm + ((wgid % nig) % gsz); u.pn = (wgid % nig) / gsz; u.pb = u.pn; return true;
    }
    __device__ __forceinline__ void a_ready(const Unit&) const {}
    __device__ __forceinline__ void done(const Unit&) const {}
};

__device__ __forceinline__ unsigned cvt_pk_bf16(float lo, float hi) { unsigned r; asm volatile("v_cvt_pk_bf16_f32 %0, %1, %2" : "=v"(r) : "v"(lo), "v"(hi)); return r; }
typedef float f32x2 __attribute__((ext_vector_type(2)));
__device__ __forceinline__ f32x2 gelu_pk(f32x2 v) {
    const f32x2 av = __builtin_elementwise_abs(v), d = av * 0.2316418882f + 1.0f;
    f32x2 t; t.x = __builtin_amdgcn_rcpf(d.x); t.y = __builtin_amdgcn_rcpf(d.y);
    f32x2 q = t * 0.5307027145f + (-0.7265760135f); q = q * t + 0.7107068705f; q = q * t + (-0.142248368f); q = q * t + 0.127414796f; q = q * t;
    const f32x2 s = (v * v) * (-0.72134752044f);
    f32x2 e; e.x = __builtin_amdgcn_exp2f(s.x); e.y = __builtin_amdgcn_exp2f(s.y);
    const f32x2 m = v * (q * e), r = v - m;
    f32x2 o; o.x = v.x < 0.f ? m.x : r.x; o.y = v.y < 0.f ? m.y : r.y; return o;
}

template <int ACT  > struct EpiBf16 {
    static constexpr bool PERM = true, AFTER_DRAIN = false; static_assert(ACT == 0 || ACT == 1, "EpiBf16: ACT is 0 (none) or 1 (gelu_pk)");
    bf16_t* O; int ldc; const float* bias; int split_cols; size_t split_stride; float scale0;
    __device__ __forceinline__ void operator()(const f32x4 (&acc)[2][2][4][2], const Unit& u, int wr, int wc, int fr, int fq) const {
        const int row0 = u.pm * BM + wr * 64 + fr; int colt = u.pn * BM; bf16_t* base = O;
        float sc = 1.f; if (split_cols) { const int t = colt / split_cols; base += (size_t)t * split_stride; colt -= t * split_cols; if (t == 0) sc = scale0; }
        const int col0 = colt + wc * 32 + 8 * fq, bcol0 = u.pn * BM + wc * 32 + 8 * fq;
        f32x4 bv[2][2];
#pragma unroll
        for (int bj = 0; bj < 2; ++bj)
#pragma unroll
            for (int n = 0; n < 2; ++n) bv[bj][n] = bias ? *(const f32x4*)(bias + bcol0 + bj * HALF + 4 * n) : (f32x4){0.f, 0.f, 0.f, 0.f};
#pragma unroll
        for (int ai = 0; ai < 2; ++ai)
#pragma unroll
            for (int m = 0; m < 4; ++m) { bf16_t* rowp = base + (size_t)(row0 + ai * HALF + m * 16) * ldc + col0;
#pragma unroll
                for (int bj = 0; bj < 2; ++bj) { f32x4 v0 = acc[ai][bj][m][0] + bv[bj][0], v1 = acc[ai][bj][m][1] + bv[bj][1];
                    if (ACT == 1) { f32x2 a = gelu_pk((f32x2){v0[0], v0[1]}), b = gelu_pk((f32x2){v0[2], v0[3]}), c = gelu_pk((f32x2){v1[0], v1[1]}), d = gelu_pk((f32x2){v1[2], v1[3]});
                        v0 = (f32x4){a.x, a.y, b.x, b.y}; v1 = (f32x4){c.x, c.y, d.x, d.y}; }
                    v0 = v0 * sc; v1 = v1 * sc; u32x4 w; w.x = cvt_pk_bf16(v0[0], v0[1]); w.y = cvt_pk_bf16(v0[2], v0[3]); w.z = cvt_pk_bf16(v1[0], v1[1]); w.w = cvt_pk_bf16(v1[2], v1[3]);
                    *(u32x4*)(rowp + bj * HALF) = w; } }
    }
};

template <class Epi, class Sched, bool ALIGN_EPI = false, bool SP2 = false, bool GATHER = false, bool QUAD = false>
__device__ __forceinline__ void gemm_phase(PG8_LAS unsigned char* lds, const Gemm g, const Sched& S, const Epi& E) {
    const int tid = tid_opaque(), wid = __builtin_amdgcn_readfirstlane(tid >> 6), lane = tid & 63, wr = wid >> 2, wc = wid & 3, fr = lane & 15, fq = lane >> 4;
    const int K = g.K, nt = K / BK;
    unsigned voffA[2], voffB[2];
#pragma unroll
    for (int i = 0; i < 2; ++i) { int R, C; stage_rc(tid * 16 + i * 8192, R, C); const int Rb = Epi::PERM ? ((R & ~31) + perm32(R & 31)) : R;
        voffA[i] = (unsigned)(R * K + C) * 2u; voffB[i] = (unsigned)(Rb * K + C) * 2u; }
    unsigned cvA[2][2], nvA[2][2];
#define PG8_AOFFS(dst, unit, ord) do { _Pragma("unroll") for (int _h = 0; _h < 2; ++_h) _Pragma("unroll") for (int _i = 0; _i < 2; ++_i) { int R_, C_; stage_rc(tid * 16 + _i * 8192, R_, C_); \
        if constexpr (GATHER) dst[_h][_i] = (unsigned)(g.ridx[(ord) * BM + _h * HALF + R_] * K + C_) * 2u; else dst[_h][_i] = voffA[_i] + (unsigned)(_h * HALF * K * 2); } } while (0)
    const size_t kstep = (size_t)(BK * 2);
    const size_t hstep = (size_t)HALF * K * 2;
    const size_t tstep = 2 * hstep;
    const unsigned ldsw = (unsigned)wid * 1024u;
    const int aoff = lds_byte(wr * 64 + fr, fq * 8), boff = lds_byte(wc * 32 + fr, fq * 8);
#define PG8_SA(b, h) (((b) * 2 + (h)) * HTB)
#define PG8_SB(b, h) ((4 + (b) * 2 + (h)) * HTB)
#define PG8_STAGE(bufoff, gbase, voff) do { _Pragma("unroll") for (int _i = 0; _i < 2; ++_i) \
        __builtin_amdgcn_global_load_lds((const unsigned*)((const char*)(gbase) + (voff)[_i]), (PG8_LAS unsigned*)(lds + (bufoff) + ldsw + _i * 8192), 16, 0, 0); } while (0)
#define PG8_LDA(dst, b, h) do { _Pragma("unroll") for (int m = 0; m < 4; ++m) _Pragma("unroll") for (int k = 0; k < 2; ++k) dst[m][k] = *(const PG8_LAS bf16x8*)(lds + PG8_SA(b, h) + aoff + m * 2048 + k * 1024); } while (0)
#define PG8_LDB(dst, b, h) do { _Pragma("unroll") for (int n = 0; n < 2; ++n) _Pragma("unroll") for (int k = 0; k < 2; ++k) dst[n][k] = *(const PG8_LAS bf16x8*)(lds + PG8_SB(b, h) + boff + n * 2048 + k * 1024); } while (0)
#define PG8_MMA(ai, bj, At, Bt) do { __builtin_amdgcn_s_setprio(1); _Pragma("unroll") for (int m = 0; m < 4; ++m) _Pragma("unroll") for (int n = 0; n < 2; ++n) _Pragma("unroll") for (int k = 0; k < 2; ++k) \
        acc[QUAD ? 0 : (ai)][QUAD ? 0 : (bj)][m][n] = __builtin_amdgcn_mfma_f32_16x16x32_bf16(Bt[n][k], At[m][k], acc[QUAD ? 0 : (ai)][QUAD ? 0 : (bj)][m][n], 0, 0, 0); __builtin_amdgcn_s_setprio(0); } while (0)
#define PG8_QMMA(ai, bj, At, Bt) do { if (!QUAD || cur.q == 2 * (ai) + (bj)) PG8_MMA(ai, bj, At, Bt); } while (0)
#define PG8_WAIT_V(n) asm volatile("s_waitcnt vmcnt(" #n ")" ::: "memory")
#define PG8_WAIT_L(n) asm volatile("s_waitcnt lgkmcnt(" #n ")" ::: "memory")
#define PG8_BAR __builtin_amdgcn_s_barrier()
#define PG8_SCHED __builtin_amdgcn_sched_barrier(0)
    Unit cur, nxt; int ui = 0;
    if (!S.next(0, cur)) return;
    constexpr int NQ = QUAD ? 1 : 2;
    f32x4 acc[NQ][NQ][4][2];
#pragma unroll
    for (int a = 0; a < NQ; ++a)
#pragma unroll
        for (int b = 0; b < NQ; ++b)
#pragma unroll
            for (int m = 0; m < 4; ++m)
#pragma unroll
                for (int n = 0; n < 2; ++n) acc[a][b][m][n] = (f32x4){0.f, 0.f, 0.f, 0.f};
    bf16x8 At[4][2], B0[2][2], B1[2][2];
    const char* cA = (const char*)g.A + (GATHER ? (size_t)0 : (size_t)cur.pm * tstep); const char* cB = (const char*)g.Bt + (size_t)cur.pb * tstep;
    S.a_ready(cur);
    PG8_AOFFS(cvA, cur, 0);
    if constexpr (SP2) {
        PG8_STAGE(PG8_SB(0, 0), cB, voffB); PG8_STAGE(PG8_SB(0, 1), cB + hstep, voffB); PG8_STAGE(PG8_SA(0, 0), cA, cvA[0]); PG8_STAGE(PG8_SA(0, 1), cA, cvA[1]);
        if (wr == 1) PG8_BAR;
        PG8_WAIT_V(2); PG8_BAR;
        PG8_STAGE(PG8_SB(1, 0), cB + kstep, voffB); PG8_STAGE(PG8_SA(1, 0), cA + kstep, cvA[0]); PG8_STAGE(PG8_SB(1, 1), cB + hstep + kstep, voffB);
        PG8_WAIT_V(6); PG8_BAR;
    } else { static_assert(SP2, "only the SP2 loop is kept in this file"); }
    for (;;) {
        const bool has_next = S.next(ui + 1, nxt);
        const char* nA = (has_next && !GATHER) ? (const char*)g.A + (size_t)nxt.pm * tstep : cA;
        if constexpr (GATHER) { if (has_next) PG8_AOFFS(nvA, nxt, ui + 1); else { _Pragma("unroll") for (int _h = 0; _h < 2; ++_h) _Pragma("unroll") for (int _i = 0; _i < 2; ++_i) nvA[_h][_i] = cvA[_h][_i]; } }
        const char* nB = has_next ? (const char*)g.Bt + (size_t)nxt.pb * tstep : cB;
        for (int t = 0; t < nt; t += 2) {
            const bool last = (t == nt - 2);
            const char* a1 = cA + (size_t)(t + 1) * kstep;
            const char* a2 = last ? nA : cA + (size_t)(t + 2) * kstep; const char* b2 = last ? nB : cB + (size_t)(t + 2) * kstep;
            const char* a3 = a2 + kstep; const char* b3 = b2 + kstep;
            unsigned xA0[2], xA1[2];
#pragma unroll
            for (int _i = 0; _i < 2; ++_i) { xA0[_i] = (GATHER && last) ? nvA[0][_i] : cvA[0][_i]; xA1[_i] = (GATHER && last) ? nvA[1][_i] : cvA[1][_i]; }
            if (last && has_next) S.a_ready(nxt);
            if constexpr (SP2) {
            PG8_LDB(B0, 0, 0); PG8_LDB(B1, 0, 1); PG8_SCHED; PG8_LDA(At, 0, 0); PG8_STAGE(PG8_SA(1, 1), a1, cvA[1]);
            PG8_WAIT_V(8); PG8_WAIT_L(0); PG8_BAR; PG8_QMMA(0, 0, At, B0); PG8_QMMA(0, 1, At, B1); PG8_BAR; PG8_SCHED;
            PG8_LDA(At, 0, 1); PG8_STAGE(PG8_SB(0, 0), b2, voffB); PG8_STAGE(PG8_SB(0, 1), b2 + hstep, voffB); PG8_STAGE(PG8_SA(0, 0), a2, xA0);
            PG8_WAIT_V(8); PG8_WAIT_L(0); PG8_BAR; PG8_QMMA(1, 0, At, B0); PG8_QMMA(1, 1, At, B1); PG8_BAR; PG8_SCHED;
            PG8_LDB(B0, 1, 0); PG8_LDB(B1, 1, 1); PG8_SCHED; PG8_LDA(At, 1, 0); PG8_STAGE(PG8_SA(0, 1), a2, xA1);
            PG8_WAIT_V(8); PG8_WAIT_L(0); PG8_BAR; PG8_QMMA(0, 0, At, B0); PG8_QMMA(0, 1, At, B1); PG8_BAR; PG8_SCHED;
            PG8_LDA(At, 1, 1); PG8_STAGE(PG8_SB(1, 0), b3, voffB); PG8_STAGE(PG8_SB(1, 1), b3 + hstep, voffB); PG8_STAGE(PG8_SA(1, 0), a3, xA0);
            PG8_WAIT_V(8); PG8_WAIT_L(0); PG8_BAR; PG8_QMMA(1, 0, At, B0); PG8_QMMA(1, 1, At, B1); PG8_BAR; PG8_SCHED;
            }
        }
        if constexpr (ALIGN_EPI) { if (wr == 0) PG8_BAR; }
        if constexpr (QUAD) { E.quad(acc[0][0], cur, wr, wc, fr, fq); S.done(cur); }
        else if constexpr (!Epi::AFTER_DRAIN) { E(acc, cur, wr, wc, fr, fq); S.done(cur); }
        if (!has_next) break;
#pragma unroll
        for (int a = 0; a < NQ; ++a)
#pragma unroll
            for (int b = 0; b < NQ; ++b)
#pragma unroll
                for (int m = 0; m < 4; ++m)
#pragma unroll
                    for (int n = 0; n < 2; ++n) acc[a][b][m][n] = (f32x4){0.f, 0.f, 0.f, 0.f};
        cur = nxt; cA = nA; cB = nB; ++ui;
        if constexpr (GATHER) { _Pragma("unroll") for (int _h = 0; _h < 2; ++_h) _Pragma("unroll") for (int _i = 0; _i < 2; ++_i) cvA[_h][_i] = nvA[_h][_i]; }
        if constexpr (ALIGN_EPI) { if (wr == 1) PG8_BAR; }
    }
    PG8_WAIT_V(0);
    if constexpr (!ALIGN_EPI) { if (wr == 0) PG8_BAR; }
    PG8_BAR;
    if constexpr (!QUAD && Epi::AFTER_DRAIN) { E.fused(acc, cur, wr, wc, fr, fq, lds, wid, lane); S.done(cur); }
#undef PG8_SA
#undef PG8_SB
#undef PG8_STAGE
#undef PG8_LDA
#undef PG8_LDB
#undef PG8_MMA
#undef PG8_QMMA
#undef PG8_WAIT_V
#undef PG8_WAIT_L
#undef PG8_BAR
#undef PG8_SCHED
#undef PG8_AOFFS
}
}
#define LAS __attribute__((address_space(3)))
#define XB_TMO      128
#define XB_XCNT(j)  (256  + 64 * (j))
#define XB_XSUB(j)  (1280 + 64 * (j))
#define XB_XGEN(j)  (2304 + 64 * (j))
#define XB_TOP      3328
#define XB_TOPGEN   3392
#define XCD_BAR_WORDS 3456
#define XB_SPIN_CAP (1u << 18)

__device__ __forceinline__ unsigned xb_ld(unsigned* p)              { return __hip_atomic_load(p, __ATOMIC_RELAXED, __HIP_MEMORY_SCOPE_AGENT); }
__device__ __forceinline__ unsigned xb_add(unsigned* p, unsigned v) { return __hip_atomic_fetch_add(p, v, __ATOMIC_RELAXED, __HIP_MEMORY_SCOPE_AGENT); }
__device__ __forceinline__ unsigned xb_xcc_id() { return (unsigned)__builtin_amdgcn_s_getreg((3 << 11) | 20) & 0xFu; }
#define XB_SPIN(cond, bar) do { unsigned _sp = 0; while (cond) { __builtin_amdgcn_s_sleep(1); \
    if ((++_sp & 255u) == 0u) { if (xb_ld(&(bar)[XB_TMO])) break; if (_sp > XB_SPIN_CAP) { atomicAdd(&(bar)[XB_TMO], 1u); break; } } } } while (0)

struct XcdBarrier {
    unsigned* bar; unsigned x;
    volatile LAS unsigned* st;
};

__device__ __forceinline__ XcdBarrier xcd_barrier_post(unsigned* bar, volatile LAS unsigned* st) {
    XcdBarrier b; b.bar = bar; b.x = xb_xcc_id(); b.st = st;
    if (threadIdx.x == 0) (void)xb_add(&bar[XB_XCNT(b.x)], 1u);
    return b;
}
__device__ __forceinline__ void xcd_barrier_complete(unsigned* bar, unsigned x, unsigned& nloc, unsigned& nx) {
    const unsigned G = gridDim.x * gridDim.y * gridDim.z;
    unsigned sum, cnt, mine, sp = 0u;
    for (;;) {
        sum = 0u; cnt = 0u; mine = 0u;
#pragma unroll
        for (unsigned j = 0; j < 16; ++j) { const unsigned c = xb_ld(&bar[XB_XCNT(j)]); sum += c; cnt += (c > 0u) ? 1u : 0u; mine = (j == x) ? c : mine; }
        if (sum == G) break;
        __builtin_amdgcn_s_sleep(1);
        if ((++sp & 255u) == 0u) { if (xb_ld(&bar[XB_TMO])) break; if (sp > XB_SPIN_CAP) { atomicAdd(&bar[XB_TMO], 1u); break; } }
    }
    nloc = mine > 0u ? mine : 1u; nx = cnt > 0u ? cnt : 1u;
}

__device__ __forceinline__ void xcd_barrier(const XcdBarrier& b) {
    asm volatile("s_waitcnt vmcnt(0)" ::: "memory");
    __syncthreads();
    if (threadIdx.x == 0) {
        unsigned* bar = b.bar;
        __builtin_amdgcn_s_waitcnt(0);
        unsigned nloc = b.st[0], nx = b.st[1];
        if (nloc == 0u) { xcd_barrier_complete(bar, b.x, nloc, nx); b.st[0] = nloc; b.st[1] = nx; }
        const unsigned old = xb_add(&bar[XB_XSUB(b.x)], 1u);
        const unsigned gen = old / nloc;
        if (old + 1u == (gen + 1u) * nloc) {
            __builtin_amdgcn_fence(__ATOMIC_RELEASE, "agent");
            asm volatile("s_waitcnt vmcnt(0)" ::: "memory");
            const unsigned og = xb_add(&bar[XB_TOP], 1u);
            const unsigned tg = og / nx;
            if (og + 1u == (tg + 1u) * nx) xb_add(&bar[XB_TOPGEN], 1u);
            else XB_SPIN(xb_ld(&bar[XB_TOPGEN]) == tg, bar);
            __builtin_amdgcn_fence(__ATOMIC_ACQUIRE, "agent");
            xb_add(&bar[XB_XGEN(b.x)], 1u);
            asm volatile("s_waitcnt vmcnt(0)" ::: "memory");
        } else {
            XB_SPIN(xb_ld(&bar[XB_XGEN(b.x)]) == gen, bar);
            __builtin_amdgcn_fence(__ATOMIC_ACQUIRE, "agent");
            asm volatile("s_waitcnt vmcnt(0)" ::: "memory");
        }
    }
    __syncthreads();
}
#undef LAS
__constant__ float ROPE_COS[1024] = { 1.000000000e+00f, 1.000000000e+00f, 1.000000000e+00f, 1.000000000e+00f, 1.000000000e+00f, 1.000000000e+00f, 1.000000000e+00f, 1.000000000e+00f, 1.000000000e+00f, 1.000000000e+00f, 1.000000000e+00f, 1.000000000e+00f, 1.000000000e+00f, 1.000000000e+00f, 1.000000000e+00f, 1.000000000e+00f, 5.403022766e-01f, 8.460091352e-01f, 9.504152536e-01f, 9.842302203e-01f, 9.950041771e-01f, 9.984192848e-01f, 9.995000362e-01f, 9.998418689e-01f, 9.999499917e-01f, 9.999842048e-01f, 9.999949932e-01f, 9.999983907e-01f, 9.999995232e-01f, 9.999998212e-01f, 9.999999404e-01f, 1.000000000e+00f, -4.161468446e-01f, 4.314628243e-01f, 8.065783978e-01f, 9.374182820e-01f, 9.800665975e-01f, 9.936820865e-01f, 9.980006814e-01f, 9.993675947e-01f, 9.998000264e-01f, 9.999367595e-01f, 9.999799728e-01f, 9.999936819e-01f, 9.999979734e-01f, 9.999993443e-01f, 9.999998212e-01f, 9.999999404e-01f, -9.899924994e-01f, -1.159661636e-01f, 5.827536583e-01f, 8.610406518e-01f, 9.553365111e-01f, 9.858034849e-01f, 9.955033660e-01f, 9.985772967e-01f, 9.995500445e-01f, 9.998577237e-01f, 9.999549985e-01f, 9.999857545e-01f, 9.999955297e-01f, 9.999985695e-01f, 9.999995232e-01f, 9.999998808e-01f, -6.536436081e-01f, -6.276797056e-01f, 3.011374772e-01f, 7.575061917e-01f, 9.210609794e-01f, 9.748082757e-01f, 9.920106530e-01f, 9.974712729e-01f, 9.992001057e-01f, 9.997470379e-01f, 9.999200106e-01f, 9.999747276e-01f, 9.999920130e-01f, 9.999974966e-01f, 9.999992251e-01f, 9.999997616e-01f, 2.836622000e-01f, -9.460792542e-01f, -1.034233812e-02f, 6.300802827e-01f, 8.775825500e-01f, 9.607312679e-01f, 9.875259995e-01f, 9.960497618e-01f, 9.987502694e-01f, 9.996047616e-01f, 9.998750091e-01f, 9.999604821e-01f, 9.999874830e-01f, 9.999960661e-01f, 9.999987483e-01f, 9.999995828e-01f, 9.601702690e-01f, -9.731037021e-01f, -3.207964003e-01f, 4.827820361e-01f, 8.253356218e-01f, 9.436169863e-01f, 9.820539355e-01f, 9.943132997e-01f, 9.982005358e-01f, 9.994308352e-01f, 9.998199940e-01f, 9.999430776e-01f, 9.999819994e-01f, 9.999943376e-01f, 9.999982119e-01f, 9.999994040e-01f, 7.539022565e-01f, -7.004297972e-01f, -5.994374752e-01f, 3.202570081e-01f, 7.648422122e-01f, 9.235194325e-01f, 9.755998850e-01f, 9.922624230e-01f, 9.975510240e-01f, 9.992253184e-01f, 9.997550249e-01f, 9.999225140e-01f, 9.999755025e-01f, 9.999922514e-01f, 9.999975562e-01f, 9.999992251e-01f, -1.455000341e-01f, -2.120364457e-01f, -8.186324239e-01f, 1.476312131e-01f, 6.967067122e-01f, 9.005023241e-01f, 9.681702852e-01f, 9.898977876e-01f, 9.968017340e-01f, 9.989882708e-01f, 9.996800423e-01f, 9.998987913e-01f, 9.999679923e-01f, 9.999898672e-01f, 9.999967813e-01f, 9.999989867e-01f, -9.111302495e-01f, 3.416602612e-01f, -9.566441774e-01f, -2.965079620e-02f, 6.216099262e-01f, 8.746382594e-01f, 9.597726464e-01f, 9.872201085e-01f, 9.959527254e-01f, 9.987195730e-01f, 9.995950460e-01f, 9.998719096e-01f, 9.999595284e-01f, 9.999871850e-01f, 9.999959469e-01f, 9.999987483e-01f, -8.390715122e-01f, 7.901318669e-01f, -9.997860789e-01f, -2.059976310e-01f, 5.403022766e-01f, 8.460091352e-01f, 9.504153132e-01f, 9.842302203e-01f, 9.950041771e-01f, 9.984192848e-01f, 9.995000362e-01f, 9.998418689e-01f, 9.999499917e-01f, 9.999842048e-01f, 9.999949932e-01f, 9.999983907e-01f, 4.425697960e-03f, 9.952573776e-01f, -9.437797666e-01f, -3.758473992e-01f, 4.535960853e-01f, 8.147053123e-01f, 9.401075840e-01f, 9.809291363e-01f, 9.939560890e-01f, 9.980874062e-01f, 9.993950725e-01f, 9.998086691e-01f, 9.999395013e-01f, 9.999808669e-01f, 9.999939203e-01f, 9.999980927e-01f, 8.438539505e-01f, 8.938615918e-01f, -7.941793799e-01f, -5.338430405e-01f, 3.623577058e-01f, 7.808259130e-01f, 9.288598895e-01f, 9.773178697e-01f, 9.928086400e-01f, 9.977239966e-01f, 9.992800951e-01f, 9.997723103e-01f, 9.999279976e-01f, 9.999772310e-01f, 9.999927878e-01f, 9.999977350e-01f, 9.074468017e-01f, 5.171728730e-01f, -5.658205152e-01f, -6.750016809e-01f, 2.674987614e-01f, 7.444779873e-01f, 9.166833758e-01f, 9.733975530e-01f, 9.915618896e-01f, 9.973290563e-01f, 9.991551042e-01f, 9.997327924e-01f, 9.999154806e-01f, 9.999732971e-01f, 9.999915361e-01f, 9.999973178e-01f, 1.367372125e-01f, -1.879615150e-02f, -2.813494802e-01f, -7.948709130e-01f, 1.699671596e-01f, 7.057763934e-01f, 9.035902619e-01f, 9.691694379e-01f, 9.902160168e-01f, 9.969025850e-01f, 9.990201592e-01f, 9.996901155e-01f, 9.999020100e-01f, 9.999690056e-01f, 9.999902248e-01f, 9.999969006e-01f, -7.596879005e-01f, -5.489754677e-01f, 3.102235124e-02f, -8.896704316e-01f, 7.073719800e-02f, 6.648434997e-01f, 8.895936012e-01f, 9.646348357e-01f, 9.887710810e-01f, 9.964445233e-01f, 9.988752007e-01f, 9.996442795e-01f, 9.998875260e-01f, 9.999644160e-01f, 9.999887347e-01f, 9.999964237e-01f, -9.576594830e-01f, -9.100810885e-01f, 3.403181732e-01f, -9.564100504e-01f, -2.919954620e-02f, 6.218088269e-01f, 8.747074604e-01f, 9.597951770e-01f, 9.872272611e-01f, 9.959549904e-01f, 9.987202883e-01f, 9.995952845e-01f, 9.998720288e-01f, 9.999595284e-01f, 9.999871850e-01f, 9.999959469e-01f, -2.751633525e-01f, -9.908979535e-01f, 6.158648133e-01f, -9.929850101e-01f, -1.288445443e-01f, 5.768082738e-01f, 8.589466810e-01f, 9.546520114e-01f, 9.855847955e-01f, 9.954339862e-01f, 9.985553622e-01f, 9.995430708e-01f, 9.998555183e-01f, 9.999542832e-01f, 9.999855757e-01f, 9.999954104e-01f, 6.603167057e-01f, -7.665365338e-01f, 8.303361535e-01f, -9.982416630e-01f, -2.272021621e-01f, 5.299841762e-01f, 8.423270583e-01f, 9.492070079e-01f, 9.838436842e-01f, 9.948815107e-01f, 9.983804226e-01f, 9.994877577e-01f, 9.998379946e-01f, 9.999487996e-01f, 9.999837875e-01f, 9.999948740e-01f, 9.887046218e-01f, -3.060953915e-01f, 9.624637961e-01f, -9.720142484e-01f, -3.232895434e-01f, 4.814845920e-01f, 8.248651624e-01f, 9.434618354e-01f, 9.820042253e-01f, 9.942975044e-01f, 9.981955290e-01f, 9.994292855e-01f, 9.998195171e-01f, 9.999428988e-01f, 9.999819398e-01f, 9.999942780e-01f, 4.080820680e-01f, 2.486167252e-01f, 9.991443753e-01f, -9.151299596e-01f, -4.161468446e-01f, 4.314628243e-01f, 8.065784574e-01f, 9.374182820e-01f, 9.800665975e-01f, 9.936820865e-01f, 9.980006814e-01f, 9.993675947e-01f, 9.998000264e-01f, 9.999367595e-01f, 9.999799728e-01f, 9.999936819e-01f, -5.477292538e-01f, 7.267602682e-01f, 9.367404580e-01f, -8.293829560e-01f, -5.048462152e-01f, 3.800770044e-01f, 7.874851823e-01f, 9.310783744e-01f, 9.780309200e-01f, 9.930352569e-01f, 9.977958202e-01f, 9.993028045e-01f, 9.997795224e-01f, 9.999302626e-01f, 9.999779463e-01f, 9.999930263e-01f, -9.999608397e-01f, 9.810745716e-01f, 7.814403772e-01f, -7.174774408e-01f, -5.885011554e-01f, 3.274895847e-01f, 7.676045895e-01f, 9.244439602e-01f, 9.758974314e-01f, 9.923570156e-01f, 9.975810051e-01f, 9.992348552e-01f, 9.997580051e-01f, 9.999234676e-01f, 9.999758005e-01f, 9.999923706e-01f, -5.328330398e-01f, 9.332357645e-01f, 5.486452579e-01f, -5.829432607e-01f, -6.662759781e-01f, 2.738668323e-01f, 7.469564080e-01f, 9.175173044e-01f, 9.736663699e-01f, 9.916474223e-01f, 9.973561764e-01f, 9.991636872e-01f, 9.997355342e-01f, 9.999163747e-01f, 9.999735355e-01f, 9.999916553e-01f, 4.241790175e-01f, 5.979771614e-01f, 2.614416778e-01f, -4.300232828e-01f, -7.373937964e-01f, 2.193782777e-01f, 7.255613208e-01f, 9.103004336e-01f, 9.713379741e-01f, 9.909064770e-01f, 9.971213937e-01f, 9.990894198e-01f, 9.997119904e-01f, 9.999089241e-01f, 9.999712110e-01f, 9.999908805e-01f, 9.912028313e-01f, 7.855226099e-02f, -5.168933049e-02f, -2.635405958e-01f, -8.011435866e-01f, 1.641961634e-01f, 7.034407258e-01f, 9.027957320e-01f, 9.689124227e-01f, 9.901341200e-01f, 9.968766570e-01f, 9.990119338e-01f, 9.996874928e-01f, 9.999011755e-01f, 9.999687672e-01f, 9.999901056e-01f, 6.469193101e-01f, -4.650644958e-01f, -3.596943319e-01f, -8.874550462e-02f, -8.568888307e-01f, 1.084949449e-01f, 6.806167960e-01f, 8.950055838e-01f, 9.663899541e-01f, 9.893305302e-01f, 9.966219068e-01f, 9.989313483e-01f, 9.996620417e-01f, 9.998931289e-01f, 9.999662042e-01f, 9.999893308e-01f, -2.921388149e-01f, -8.654506207e-01f, -6.320286393e-01f, 8.884811401e-02f, -9.040721655e-01f, 5.245061591e-02f, 6.571123004e-01f, 8.869323730e-01f, 9.637709260e-01f, 9.884956479e-01f, 9.963572025e-01f, 9.988475442e-01f, 9.996355176e-01f, 9.998847246e-01f, 9.999635220e-01f, 9.999884963e-01f, -9.626058936e-01f, -9.992933869e-01f, -8.416849375e-01f, 2.636395097e-01f, -9.422222972e-01f, -3.759419080e-03f, 6.329506636e-01f, 8.785787225e-01f, 9.610554576e-01f, 9.876294732e-01f, 9.960825443e-01f, 9.987606406e-01f, 9.996080399e-01f, 9.998760223e-01f, 9.999607801e-01f, 9.999876022e-01f, -7.480575442e-01f, -8.253716230e-01f, -9.678714871e-01f, 4.301158488e-01f, -9.709581733e-01f, -5.995756760e-02f, 6.081562042e-01f, 8.699471951e-01f, 9.582439065e-01f, 9.867320657e-01f, 9.957979321e-01f, 9.986705780e-01f, 9.995795488e-01f, 9.998670220e-01f, 9.999579787e-01f, 9.999867082e-01f, 1.542514563e-01f, -3.972518742e-01f, -9.980752468e-01f, 5.830269456e-01f, -9.899924994e-01f, -1.159661636e-01f, 5.827536583e-01f, 8.610406518e-01f, 9.553365111e-01f, 9.858034849e-01f, 9.955033660e-01f, 9.985772967e-01f, 9.995500445e-01f, 9.998577237e-01f, 9.999549985e-01f, 9.999857545e-01f, 9.147423506e-01f, 1.532154828e-01f, -9.293003082e-01f, 7.175492048e-01f, -9.991351366e-01f, -1.716081351e-01f, 5.567683578e-01f, 8.518617749e-01f, 9.523335695e-01f, 9.848436713e-01f, 9.951988459e-01f, 9.984809160e-01f, 9.995195270e-01f, 9.998480678e-01f, 9.999519587e-01f, 9.999848008e-01f, 8.342233896e-01f, 6.564951539e-01f, -7.683671117e-01f, 8.294403553e-01f, -9.982947707e-01f, -2.267075777e-01f, 5.302263498e-01f, 8.424135447e-01f, 9.492354393e-01f, 9.838528037e-01f, 9.948843718e-01f, 9.983813763e-01f, 9.994880557e-01f, 9.998381138e-01f, 9.999487996e-01f, 9.999837875e-01f, -1.327674743e-02f, 9.575860500e-01f, -5.312352777e-01f, 9.151713848e-01f, -9.874798059e-01f, -2.810903192e-01f, 5.031541586e-01f, 8.326989412e-01f, 9.460423589e-01f, 9.828307629e-01f, 9.945599437e-01f, 9.982786179e-01f, 9.994555712e-01f, 9.998278022e-01f, 9.999455214e-01f, 9.999827743e-01f, -8.485702872e-01f, 9.637575150e-01f, -2.414211184e-01f, 9.720383286e-01f, -9.667981863e-01f, -3.345843852e-01f, 4.755789042e-01f, 8.227210045e-01f, 9.427546859e-01f, 9.817776680e-01f, 9.942255616e-01f, 9.981727600e-01f, 9.994220734e-01f, 9.998172522e-01f, 9.999421835e-01f, 9.999817014e-01f, -9.036921859e-01f, 6.731102467e-01f, 7.233466953e-02f, 9.982477427e-01f, -9.364566803e-01f, -3.870206773e-01f, 4.475280643e-01f, 8.124829531e-01f, 9.393727183e-01f, 9.806935191e-01f, 9.938812256e-01f, 9.980637431e-01f, 9.993875623e-01f, 9.998063445e-01f, 9.999387264e-01f, 9.999806285e-01f, -1.279636919e-01f, 1.751565337e-01f, 3.789161742e-01f, 9.929728508e-01f, -8.967583776e-01f, -4.382335544e-01f, 4.190297425e-01f, 8.019878864e-01f, 9.358968139e-01f, 9.795783162e-01f, 9.935269952e-01f, 9.979515672e-01f, 9.993520975e-01f, 9.997950792e-01f, 9.999352098e-01f, 9.999794960e-01f, 7.654140592e-01f, -3.767423034e-01f, 6.479216814e-01f, 9.563800097e-01f, -8.481000066e-01f, -4.880608618e-01f, 3.901124299e-01f, 7.912392616e-01f, 9.323273301e-01f, 9.784321785e-01f, 9.931628108e-01f, 9.978361726e-01f, 9.993155599e-01f, 9.997835755e-01f, 9.999315739e-01f, 9.999783635e-01f, 9.550736547e-01f, -8.126112223e-01f, 8.526731133e-01f, 8.896234632e-01f, -7.909677625e-01f, -5.363451838e-01f, 3.608050346e-01f, 7.802404165e-01f, 9.286646247e-01f, 9.772551060e-01f, 9.927886724e-01f, 9.977176785e-01f, 9.992780685e-01f, 9.997717142e-01f, 9.999278188e-01f, 9.999771714e-01f, 2.666429281e-01f, -9.982103705e-01f, 9.728653431e-01f, 7.948083878e-01f, -7.259322405e-01f, -5.829339027e-01f, 3.311368525e-01f, 7.689949274e-01f, 9.249090552e-01f, 9.760470986e-01f, 9.924046397e-01f, 9.975960255e-01f, 9.992396235e-01f, 9.997594953e-01f, 9.999239445e-01f, 9.999759793e-01f, -6.669380665e-01f, -8.763794303e-01f, 9.965789914e-01f, 6.749256253e-01f, -6.536436081e-01f, -6.276797056e-01f, 3.011375964e-01f, 7.575061917e-01f, 9.210609794e-01f, 9.748082757e-01f, 9.920106530e-01f, 9.974712729e-01f, 9.992001057e-01f, 9.997470379e-01f, 9.999200106e-01f, 9.999747276e-01f, -9.873392582e-01f, -4.846394062e-01f, 9.214623570e-01f, 5.337560773e-01f, -5.748240352e-01f, -6.704410911e-01f, 2.708370686e-01f, 7.457779050e-01f, 9.171208143e-01f, 9.735385776e-01f, 9.916067719e-01f, 9.973433018e-01f, 9.991596341e-01f, 9.997342229e-01f, 9.999159575e-01f, 9.999734163e-01f, -3.999853134e-01f, 5.636094138e-02f, 7.549653649e-01f, 3.757521510e-01f, -4.902605712e-01f, -7.110829353e-01f, 2.402658761e-01f, 7.338138223e-01f, 9.130889177e-01f, 9.722381234e-01f, 9.911929369e-01f, 9.972121716e-01f, 9.991181493e-01f, 9.997211099e-01f, 9.999117851e-01f, 9.999721050e-01f, 5.551133156e-01f, 5.800031424e-01f, 5.135984421e-01f, 2.058971673e-01f, -4.007990062e-01f, -7.494767308e-01f, 2.094544172e-01f, 7.216176391e-01f, 9.089657664e-01f, 9.709069133e-01f, 9.907692075e-01f, 9.970778823e-01f, 9.990756512e-01f, 9.997076392e-01f, 9.999075532e-01f, 9.999707937e-01f, 9.998432994e-01f, 9.250146747e-01f, 2.212981731e-01f, 2.954781987e-02f, -3.073327839e-01f, -7.855011225e-01f, 1.784335226e-01f, 7.091933489e-01f, 9.047516584e-01f, 9.695450068e-01f, 9.903355837e-01f, 9.969404936e-01f, 9.990321398e-01f, 9.996939301e-01f, 9.999032021e-01f, 9.999693632e-01f, 5.253219604e-01f, 9.851381779e-01f, -9.294810891e-02f, -1.477329880e-01f, -2.107958049e-01f, -8.190422058e-01f, 1.472342163e-01f, 6.965447664e-01f, 9.004471302e-01f, 9.681524038e-01f, 9.898920655e-01f, 9.967998862e-01f, 9.989876747e-01f, 9.996798635e-01f, 9.998987317e-01f, 9.999679923e-01f, -4.321779311e-01f, 7.418580055e-01f, -3.979767561e-01f, -3.203543723e-01f, -1.121526212e-01f, -8.499938846e-01f, 1.158876941e-01f, 6.836758852e-01f, 8.960524797e-01f, 9.667292237e-01f, 9.894386530e-01f, 9.966561794e-01f, 9.989421964e-01f, 9.996654391e-01f, 9.998942018e-01f, 9.999665618e-01f, -9.923354983e-01f, 2.700984478e-01f, -6.635382771e-01f, -4.828719497e-01f, -1.238837745e-02f, -8.782584071e-01f, 8.442528546e-02f, 6.705908775e-01f, 8.915683031e-01f, 9.652754664e-01f, 9.889753461e-01f, 9.965093136e-01f, 9.988957047e-01f, 9.996507764e-01f, 9.998895526e-01f, 9.999650717e-01f, -6.401443481e-01f, -2.848466039e-01f, -8.632965088e-01f, -6.301599741e-01f, 8.749917150e-02f, -9.037463665e-01f, 5.287845805e-02f, 6.572937369e-01f, 8.869948983e-01f, 9.637911916e-01f, 9.885020852e-01f, 9.963592887e-01f, 9.988481998e-01f, 9.996357560e-01f, 9.998847842e-01f, 9.999635816e-01f, 3.005925417e-01f, -7.520639896e-01f, -9.774427414e-01f, -7.575730681e-01f, 1.865124702e-01f, -9.263771176e-01f, 2.127875760e-02f, 6.437888145e-01f, 8.823328614e-01f, 9.622764587e-01f, 9.880189896e-01f, 9.962061048e-01f, 9.987997413e-01f, 9.996203780e-01f, 9.998799562e-01f, 9.999620318e-01f, 9.649659991e-01f, -9.876590967e-01f, -9.946564436e-01f, -8.610926867e-01f, 2.836622000e-01f, -9.460792542e-01f, -1.034221891e-02f, 6.300802827e-01f, 8.775825500e-01f, 9.607312679e-01f, 9.875259995e-01f, 9.960497618e-01f, 9.987502694e-01f, 9.996047616e-01f, 9.998750091e-01f, 9.999604821e-01f, 7.421541810e-01f, -9.190735221e-01f, -9.132301211e-01f, -9.374542236e-01f, 3.779776692e-01f, -9.627903700e-01f, -4.195285589e-02f, 6.161724925e-01f, 8.727445006e-01f, 9.591556787e-01f, 9.870231748e-01f, 9.958902597e-01f, 9.986997843e-01f, 9.995887876e-01f, 9.998699427e-01f, 9.999588728e-01f, -1.629907787e-01f, -5.674300194e-01f, -7.412399650e-01f, -9.842484593e-01f, 4.685169160e-01f, -9.764577150e-01f, -7.352153957e-02f, 6.020699143e-01f, 8.678191900e-01f, 9.575498104e-01f, 9.865104556e-01f, 9.957276583e-01f, 9.986482859e-01f, 9.995725155e-01f, 9.998648167e-01f, 9.999572635e-01f, -9.182828069e-01f, -4.102819040e-02f, -4.957418144e-01f, -1.000000000e+00f, 5.543745160e-01f, -9.870380163e-01f, -1.050167084e-01f, 5.877769589e-01f, 8.628070951e-01f, 9.559136033e-01f, 9.859878421e-01f, 9.955618382e-01f, 9.985958338e-01f, 9.995558858e-01f, 9.998595715e-01f, 9.999555945e-01f, -8.293098211e-01f, 4.980095923e-01f, -2.010796219e-01f, -9.842120409e-01f, 6.346929669e-01f, -9.944978952e-01f, -1.364068687e-01f, 5.732980371e-01f, 8.577086926e-01f, 9.542471766e-01f, 9.854553938e-01f, 9.953929186e-01f, 9.985423684e-01f, 9.995389581e-01f, 9.998542070e-01f, 9.999538660e-01f, 2.212675661e-02f, 8.836693168e-01f, 1.135217771e-01f, -9.373825192e-01f, 7.086697817e-01f, -9.988136292e-01f, -1.676606387e-01f, 5.586379170e-01f, 8.525245190e-01f, 9.525505900e-01f, 9.849131107e-01f, 9.952208400e-01f, 9.984878898e-01f, 9.995217323e-01f, 9.998487830e-01f, 9.999521971e-01f, 8.532201052e-01f, 9.971746206e-01f, 4.168670774e-01f, -8.609884381e-01f, 7.755658031e-01f, -9.999717474e-01f, -1.987468749e-01f, 5.438010693e-01f, 8.472551107e-01f, 9.508239031e-01f, 9.843609333e-01f, 9.950456619e-01f, 9.984323978e-01f, 9.995042086e-01f, 9.998431802e-01f, 9.999504089e-01f, 8.998668194e-01f, 8.035690784e-01f, 6.788702011e-01f, -7.574391961e-01f, 8.347129226e-01f, -9.979684949e-01f, -2.296342701e-01f, 5.287923217e-01f, 8.419010043e-01f, 9.490671158e-01f, 9.837989211e-01f, 9.948672652e-01f, 9.983759522e-01f, 9.994863272e-01f, 9.998375773e-01f, 9.999486208e-01f, 1.191801354e-01f, 3.624766767e-01f, 8.735505342e-01f, -6.300007105e-01f, 8.855196238e-01f, -9.928101897e-01f, -2.602920532e-01f, 5.136163235e-01f, 8.364626765e-01f, 9.472803473e-01f, 9.832270741e-01f, 9.946857691e-01f, 9.983184934e-01f, 9.994681478e-01f, 9.998317957e-01f, 9.999468327e-01f, -7.710801959e-01f, -1.902491003e-01f, 9.816020727e-01f, -4.826923311e-01f, 9.274784923e-01f, -9.845131636e-01f, -2.906895578e-01f, 4.982779026e-01f, 8.309407234e-01f, 9.454635978e-01f, 9.826454520e-01f, 9.945011139e-01f, 9.982600212e-01f, 9.994496703e-01f, 9.998259544e-01f, 9.999449849e-01f, -9.524129629e-01f, -6.843819022e-01f, 9.923083186e-01f, -3.201591671e-01f, 9.601702690e-01f, -9.731037021e-01f, -3.207964003e-01f, 4.827820361e-01f, 8.253356218e-01f, 9.436169863e-01f, 9.820539355e-01f, 9.943132997e-01f, 9.982005358e-01f, 9.994308352e-01f, 9.998199940e-01f, 9.999430776e-01f, -2.581016421e-01f, -9.677396417e-01f, 9.046075940e-01f, -1.475291997e-01f, 9.832684398e-01f, -9.586178064e-01f, -3.505824506e-01f, 4.671334028e-01f, 8.196480274e-01f, 9.417404532e-01f, 9.814526439e-01f, 9.941223264e-01f, 9.981400967e-01f, 9.994117022e-01f, 9.998139739e-01f, 9.999411702e-01f, 6.735071540e-01f, -9.530500174e-01f, 7.271980643e-01f, 2.975377068e-02f, 9.965420961e-01f, -9.411013126e-01f, -3.800179660e-01f, 4.513370395e-01f, 8.138784766e-01f, 9.398342371e-01f, 9.808415174e-01f, 9.939282537e-01f, 9.980786443e-01f, 9.993922710e-01f, 9.998078346e-01f, 9.999392033e-01f, 9.858965874e-01f, -6.448370218e-01f, 4.776714444e-01f, 2.060983330e-01f, 9.998586178e-01f, -9.206095338e-01f, -4.090735018e-01f, 4.353979528e-01f, 8.080275059e-01f, 9.378982186e-01f, 9.802205563e-01f, 9.937310219e-01f, 9.980161786e-01f, 9.993724823e-01f, 9.998015761e-01f, 9.999372363e-01f };
__constant__ float ROPE_SIN[1024] = { 0.000000000e+00f, 0.000000000e+00f, 0.000000000e+00f, 0.000000000e+00f, 0.000000000e+00f, 0.000000000e+00f, 0.000000000e+00f, 0.000000000e+00f, 0.000000000e+00f, 0.000000000e+00f, 0.000000000e+00f, 0.000000000e+00f, 0.000000000e+00f, 0.000000000e+00f, 0.000000000e+00f, 0.000000000e+00f, 8.414709568e-01f, 5.331684351e-01f, 3.109835982e-01f, 1.768921912e-01f, 9.983342141e-02f, 5.620449781e-02f, 3.161750361e-02f, 1.778185740e-02f, 9.999833070e-03f, 5.623383448e-03f, 3.162272274e-03f, 1.778278500e-03f, 9.999999311e-04f, 5.623412435e-04f, 3.162277571e-04f, 1.778279402e-04f, 9.092974067e-01f, 9.021307230e-01f, 5.911270976e-01f, 3.482052684e-01f, 1.986693293e-01f, 1.122313142e-01f, 6.320339441e-02f, 3.555808961e-02f, 1.999866590e-02f, 1.124658901e-02f, 6.324512884e-03f, 3.556551412e-03f, 1.999998698e-03f, 1.124682371e-03f, 6.324554561e-04f, 3.556558804e-04f, 1.411200017e-01f, 9.932531714e-01f, 8.126488924e-01f, 5.085361004e-01f, 2.955202162e-01f, 1.679033041e-01f, 9.472608566e-02f, 5.332308263e-02f, 2.999549918e-02f, 1.686943881e-02f, 9.486690164e-03f, 5.334813148e-03f, 2.999995602e-03f, 1.687023090e-03f, 9.486831259e-04f, 5.334838061e-04f, -7.568024993e-01f, 7.784717083e-01f, 9.535807371e-01f, 6.528279781e-01f, 3.894183338e-01f, 2.230444849e-01f, 1.261540651e-01f, 7.107120752e-02f, 3.998933360e-02f, 2.249175683e-02f, 1.264877338e-02f, 7.113057654e-03f, 3.999989480e-03f, 2.249363344e-03f, 1.264910679e-03f, 7.113117026e-04f, -9.589242935e-01f, 3.239352703e-01f, 9.999465346e-01f, 7.765299678e-01f, 4.794255495e-01f, 2.774805427e-01f, 1.574558765e-01f, 8.879686147e-02f, 4.997916520e-02f, 2.811336145e-02f, 1.581072807e-02f, 8.891279809e-03f, 4.999979399e-03f, 2.811702900e-03f, 1.581138116e-03f, 8.891395992e-04f, -2.794154882e-01f, -2.303675115e-01f, 9.471482038e-01f, 8.757405281e-01f, 5.646424890e-01f, 3.310393095e-01f, 1.886002719e-01f, 1.064944416e-01f, 5.996400490e-02f, 3.373407945e-02f, 1.897252724e-02f, 1.066947449e-02f, 5.999964196e-03f, 3.374041524e-03f, 1.897365320e-03f, 1.066967379e-03f, 6.569865942e-01f, -7.137212753e-01f, 8.004215956e-01f, 9.473307133e-01f, 6.442176700e-01f, 3.835515678e-01f, 2.195560932e-01f, 1.241583377e-01f, 6.994284689e-02f, 3.935372457e-02f, 2.213413455e-02f, 1.244763471e-02f, 6.999942940e-03f, 3.936378751e-03f, 2.213592408e-03f, 1.244795276e-03f, 9.893582463e-01f, -9.772617817e-01f, 5.743177533e-01f, 9.890424609e-01f, 7.173560858e-01f, 4.348512292e-01f, 2.502923310e-01f, 1.417829692e-01f, 7.991468906e-02f, 4.497213289e-02f, 2.529552206e-02f, 1.422575582e-02f, 7.999914698e-03f, 4.498715047e-03f, 2.529819263e-03f, 1.422623056e-03f, 4.121184945e-01f, -9.398235083e-01f, 2.912592292e-01f, 9.995602965e-01f, 7.833269238e-01f, 4.847761393e-01f, 2.807783186e-01f, 1.593627781e-01f, 8.987854421e-02f, 5.058911815e-02f, 2.845665626e-02f, 1.600383036e-02f, 8.999879472e-03f, 5.061050411e-03f, 2.846045885e-03f, 1.600450720e-03f, -5.440211296e-01f, -6.129369140e-01f, -2.068356983e-02f, 9.785524607e-01f, 8.414709568e-01f, 5.331684351e-01f, 3.109835684e-01f, 1.768921912e-01f, 9.983341396e-02f, 5.620449781e-02f, 3.161750361e-02f, 1.778185740e-02f, 9.999834001e-03f, 5.623383448e-03f, 3.162272274e-03f, 1.778278500e-03f, -9.999902248e-01f, -9.727645665e-02f, -3.305749595e-01f, 9.266815782e-01f, 8.912073970e-01f, 5.798751712e-01f, 3.408778608e-01f, 1.943656504e-01f, 1.097782999e-01f, 6.181810424e-02f, 3.477803990e-02f, 1.955982670e-02f, 1.099977922e-02f, 6.185714621e-03f, 3.478498431e-03f, 1.956106164e-03f, -5.365729332e-01f, 4.483429790e-01f, -6.076834202e-01f, 8.455836177e-01f, 9.320390821e-01f, 6.247486472e-01f, 3.704313040e-01f, 2.117776722e-01f, 1.197122037e-01f, 6.742975861e-02f, 3.793822229e-02f, 2.133773454e-02f, 1.199971233e-02f, 6.748044398e-03f, 3.794723889e-03f, 2.133933594e-03f, 4.201670289e-01f, 8.558809757e-01f, -8.245284557e-01f, 7.378162146e-01f, 9.635581970e-01f, 6.676470041e-01f, 3.996143043e-01f, 2.291227132e-01f, 1.296341419e-01f, 7.303927839e-02f, 4.109803215e-02f, 2.311557345e-02f, 1.299963426e-02f, 7.310371846e-03f, 4.110949114e-03f, 2.311761025e-03f, 9.906073809e-01f, 9.998233318e-01f, -9.596053958e-01f, 6.067785621e-01f, 9.854497313e-01f, 7.084347010e-01f, 4.283977747e-01f, 2.463953048e-01f, 1.395431161e-01f, 7.864648104e-02f, 4.425742477e-02f, 2.489333972e-02f, 1.399954315e-02f, 7.872696966e-03f, 4.427174106e-03f, 2.489588689e-03f, 6.502878666e-01f, 8.358384371e-01f, -9.995186925e-01f, 4.566032588e-01f, 9.974949956e-01f, 7.469826341e-01f, 4.567528665e-01f, 2.635899782e-01f, 1.494381279e-01f, 8.425120264e-02f, 4.741638154e-02f, 2.667102963e-02f, 1.499943808e-02f, 8.435020223e-03f, 4.743398633e-03f, 2.667415887e-03f, -2.879033089e-01f, 4.144302309e-01f, -9.403103590e-01f, 2.920270860e-01f, 9.995735884e-01f, 7.831690907e-01f, 4.846512377e-01f, 2.807013094e-01f, 1.593182087e-01f, 8.985326439e-02f, 5.057485774e-02f, 2.844863199e-02f, 1.599931903e-02f, 8.997339755e-03f, 5.059622694e-03f, 2.845243318e-03f, -9.613974690e-01f, -1.346151382e-01f, -7.878518701e-01f, 1.182405204e-01f, 9.916648269e-01f, 8.168795705e-01f, 5.120649934e-01f, 2.977238595e-01f, 1.691823453e-01f, 9.545248002e-02f, 5.373282731e-02f, 3.022614494e-02f, 1.699918136e-02f, 9.559656493e-03f, 5.375845823e-03f, 3.023070283e-03f, -7.509872317e-01f, -6.422007084e-01f, -5.572628975e-01f, -5.927551910e-02f, 9.738476276e-01f, 8.480075598e-01f, 5.389667153e-01f, 3.146522641e-01f, 1.790295690e-01f, 1.010486856e-01f, 5.689026415e-02f, 3.200356290e-02f, 1.799902879e-02f, 1.012197044e-02f, 5.692068953e-03f, 3.200897481e-03f, 1.498772055e-01f, -9.520008564e-01f, -2.714101076e-01f, -2.349217981e-01f, 9.463000894e-01f, 8.764545321e-01f, 5.653295517e-01f, 3.314811885e-01f, 1.888588965e-01f, 1.066416800e-01f, 6.004713103e-02f, 3.378088027e-02f, 1.899885759e-02f, 1.068428159e-02f, 6.008291151e-03f, 3.378724447e-03f, 9.129452705e-01f, -9.686019421e-01f, 4.135828838e-02f, -4.031589925e-01f, 9.092974067e-01f, 9.021307230e-01f, 5.911270380e-01f, 3.482052684e-01f, 1.986693144e-01f, 1.122313142e-01f, 6.320339441e-02f, 3.555808961e-02f, 1.999866776e-02f, 1.124658901e-02f, 6.324512884e-03f, 3.556551412e-03f, 8.366556168e-01f, -6.868911982e-01f, 3.500247598e-01f, -5.586805344e-01f, 8.632093072e-01f, 9.249548316e-01f, 6.163335443e-01f, 3.648192585e-01f, 2.084598988e-01f, 1.178173944e-01f, 6.635902822e-02f, 3.733518720e-02f, 2.099845745e-02f, 1.180889271e-02f, 6.640734151e-03f, 3.734378144e-03f, -8.851309307e-03f, -1.936302334e-01f, 6.239799261e-01f, -6.965817213e-01f, 8.084963560e-01f, 9.448547959e-01f, 6.409237385e-01f, 3.813178837e-01f, 2.182296216e-01f, 1.233997419e-01f, 6.951400638e-02f, 3.911216930e-02f, 2.199822664e-02f, 1.237119269e-02f, 6.956954487e-03f, 3.912204877e-03f, -8.462204337e-01f, 3.592645228e-01f, 8.360552788e-01f, -8.125128746e-01f, 7.457052469e-01f, 9.617676139e-01f, 6.648730636e-01f, 3.976959288e-01f, 2.279775143e-01f, 1.289781928e-01f, 7.266827673e-02f, 4.088902473e-02f, 2.299797349e-02f, 1.293348987e-02f, 7.273174357e-03f, 4.090031609e-03f, -9.055783749e-01f, 8.015131354e-01f, 9.652192593e-01f, -9.028177857e-01f, 6.754631400e-01f, 9.756398797e-01f, 6.881574988e-01f, 4.139482081e-01f, 2.377026230e-01f, 1.345525682e-01f, 7.582182437e-02f, 4.266574979e-02f, 2.399769612e-02f, 1.349578146e-02f, 7.589393295e-03f, 4.267857410e-03f, -1.323517561e-01f, 9.969099760e-01f, 9.986631870e-01f, -9.646483064e-01f, 5.984721184e-01f, 9.864277244e-01f, 7.107539177e-01f, 4.300695956e-01f, 2.474039644e-01f, 1.401226968e-01f, 7.897461206e-02f, 4.444234073e-02f, 2.499739639e-02f, 1.405806933e-02f, 7.905611768e-03f, 4.445684142e-03f, 7.625584602e-01f, 8.852767944e-01f, 9.330701828e-01f, -9.960543513e-01f, 5.155012608e-01f, 9.940969944e-01f, 7.326396108e-01f, 4.460549951e-01f, 2.570805550e-01f, 1.456883848e-01f, 8.212661743e-02f, 4.621879384e-02f, 2.599707060e-02f, 1.462035347e-02f, 8.221829310e-03f, 4.623509943e-03f, 9.563759565e-01f, 5.009942055e-01f, 7.749450207e-01f, -9.960451722e-01f, 4.273798466e-01f, 9.986234903e-01f, 7.537927032e-01f, 4.618993104e-01f, 2.667314112e-01f, 1.512494683e-01f, 8.527779579e-02f, 4.799510166e-02f, 2.699672058e-02f, 1.518263202e-02f, 8.538045920e-03f, 4.801335745e-03f, 2.709057927e-01f, -3.758566082e-02f, 5.399689674e-01f, -9.646213055e-01f, 3.349882066e-01f, 9.999929070e-01f, 7.741920948e-01f, 4.775975943e-01f, 2.763556540e-01f, 1.568057537e-01f, 8.842811733e-02f, 4.977125302e-02f, 2.799634263e-02f, 1.574490592e-02f, 8.854261599e-03f, 4.979162011e-03f, -6.636338830e-01f, -5.645897985e-01f, 2.514453232e-01f, -9.027736783e-01f, 2.392492294e-01f, 9.982009530e-01f, 7.938174009e-01f, 4.931448400e-01f, 2.859522104e-01f, 1.623570919e-01f, 9.157756716e-02f, 5.154724792e-02f, 2.899593674e-02f, 1.630717516e-02f, 9.170476347e-03f, 5.156987347e-03f, -9.880316257e-01f, -9.177096486e-01f, -6.201484054e-02f, -8.124528527e-01f, 1.411200017e-01f, 9.932531714e-01f, 8.126488924e-01f, 5.085361004e-01f, 2.955201864e-01f, 1.679033041e-01f, 9.472609311e-02f, 5.332308263e-02f, 2.999550104e-02f, 1.686943881e-02f, 9.486690164e-03f, 5.334813148e-03f, -4.040376544e-01f, -9.881927967e-01f, -3.693250120e-01f, -6.965078115e-01f, 4.158052057e-02f, 9.851652980e-01f, 8.306677938e-01f, 5.237666368e-01f, 3.050586283e-01f, 1.734442115e-01f, 9.787366539e-02f, 5.509874597e-02f, 3.099503554e-02f, 1.743169688e-02f, 9.802903049e-03f, 5.512638018e-03f, 5.514267087e-01f, -7.543302178e-01f, -6.400094032e-01f, -5.585952997e-01f, -5.837419257e-02f, 9.739628434e-01f, 8.478561044e-01f, 5.388315320e-01f, 3.145665526e-01f, 1.789796203e-01f, 1.010202691e-01f, 5.687423423e-02f, 3.199454024e-02f, 1.799395122e-02f, 1.011911593e-02f, 5.690463353e-03f, 9.999118447e-01f, -2.881473899e-01f, -8.472243547e-01f, -4.030649364e-01f, -1.577456445e-01f, 9.596813321e-01f, 8.641966581e-01f, 5.537260175e-01f, 3.240430057e-01f, 1.845093668e-01f, 1.041658595e-01f, 5.864954367e-02f, 3.299400955e-02f, 1.855619811e-02f, 1.043532696e-02f, 5.868288688e-03f, 5.290827155e-01f, 2.667797208e-01f, -9.704204202e-01f, -2.348221242e-01f, -2.555412054e-01f, 9.423658252e-01f, 8.796730638e-01f, 5.684453845e-01f, 3.334870934e-01f, 1.900332868e-01f, 1.073104069e-01f, 6.042466685e-02f, 3.399345279e-02f, 1.911843941e-02f, 1.075153705e-02f, 6.046113092e-03f, -4.281826615e-01f, 7.395421267e-01f, -9.973804355e-01f, -5.917267874e-02f, -3.507832289e-01f, 9.220710397e-01f, 8.942698836e-01f, 5.829849839e-01f, 3.428978026e-01f, 1.955512017e-01f, 1.104538813e-01f, 6.219960377e-02f, 3.499285504e-02f, 1.968067512e-02f, 1.106774528e-02f, 6.223937962e-03f, -9.917788506e-01f, 9.845405817e-01f, -9.254310131e-01f, 1.183425859e-01f, -4.425205588e-01f, 8.988611698e-01f, 9.079725146e-01f, 5.973402858e-01f, 3.522742093e-01f, 2.010629177e-01f, 1.135962531e-01f, 6.397433579e-02f, 3.599222749e-02f, 2.024290524e-02f, 1.138395350e-02f, 6.401761901e-03f, -6.435381174e-01f, 9.263181090e-01f, -7.617069483e-01f, 2.921253741e-01f, -5.298361778e-01f, 8.728095889e-01f, 9.207672477e-01f, 6.115067005e-01f, 3.616154492e-01f, 2.065682709e-01f, 1.167374924e-01f, 6.574887782e-02f, 3.699155897e-02f, 2.080512606e-02f, 1.170015987e-02f, 6.579586305e-03f, 2.963685691e-01f, 5.828061700e-01f, -5.224447846e-01f, 4.566946924e-01f, -6.118578315e-01f, 8.439987302e-01f, 9.326412678e-01f, 6.254796982e-01f, 3.709204793e-01f, 2.120671123e-01f, 1.198775545e-01f, 6.752320379e-02f, 3.799085692e-02f, 2.136734314e-02f, 1.201636530e-02f, 6.757410709e-03f, 9.637953639e-01f, 5.980031565e-02f, -2.313720137e-01f, 6.068604589e-01f, -6.877662539e-01f, 8.125196099e-01f, 9.435827136e-01f, 6.392549276e-01f, 3.801884055e-01f, 2.175592482e-01f, 1.230164245e-01f, 6.929731369e-02f, 3.899011388e-02f, 2.192955278e-02f, 1.233256981e-02f, 6.935234182e-03f, 7.451131344e-01f, -4.816212952e-01f, 8.264580369e-02f, 7.378857136e-01f, -7.568024993e-01f, 7.784717083e-01f, 9.535806775e-01f, 6.528279781e-01f, 3.894183338e-01f, 2.230444849e-01f, 1.261540651e-01f, 7.107120752e-02f, 3.998933733e-02f, 2.249175683e-02f, 1.264877338e-02f, 7.113057654e-03f, -1.586226672e-01f, -8.747140169e-01f, 3.884676993e-01f, 8.456384540e-01f, -8.182770610e-01f, 7.419627905e-01f, 9.626252055e-01f, 6.661946774e-01f, 3.986093104e-01f, 2.285226882e-01f, 1.292904317e-01f, 7.284487784e-02f, 4.098851606e-02f, 2.305394970e-02f, 1.296497509e-02f, 7.290880661e-03f, -9.165215492e-01f, -9.984104633e-01f, 6.557646990e-01f, 9.267202020e-01f, -8.715758920e-01f, 7.031081319e-01f, 9.707071185e-01f, 6.793506742e-01f, 4.077604413e-01f, 2.339936644e-01f, 1.324255317e-01f, 7.461831719e-02f, 4.198765755e-02f, 2.361613885e-02f, 1.328117587e-02f, 7.468704134e-03f, -8.317747712e-01f, -8.146142364e-01f, 8.580306768e-01f, 9.785736203e-01f, -9.161660075e-01f, 6.620306373e-01f, 9.778184295e-01f, 6.922917962e-01f, 4.168707728e-01f, 2.394572198e-01f, 1.355592906e-01f, 7.639151812e-02f, 4.298675060e-02f, 2.417832054e-02f, 1.359737478e-02f, 7.646527141e-03f, 1.770192571e-02f, -3.799313903e-01f, 9.752061963e-01f, 9.995633960e-01f, -9.516021013e-01f, 6.188601851e-01f, 9.839519858e-01f, 7.050140500e-01f, 4.259394705e-01f, 2.449132055e-01f, 1.386916935e-01f, 7.816448808e-02f, 4.398580641e-02f, 2.474049293e-02f, 1.391357277e-02f, 7.824349217e-03f, 8.509035110e-01f, 1.717635691e-01f, 9.956709743e-01f, 9.890272617e-01f, -9.775301218e-01f, 5.737332702e-01f, 9.891016483e-01f, 7.175133228e-01f, 4.349655211e-01f, 2.503614724e-01f, 1.418227106e-01f, 7.993719727e-02f, 4.498481750e-02f, 2.530265786e-02f, 1.422976889e-02f, 8.002171293e-03f, 9.017883539e-01f, 6.705570221e-01f, 9.173954725e-01f, 9.472977519e-01f, -9.936909676e-01f, 5.267925262e-01f, 9.932623506e-01f, 7.297857404e-01f, 4.439480901e-01f, 2.558017969e-01f, 1.449523121e-01f, 8.170966059e-02f, 4.598378390e-02f, 2.586481534e-02f, 1.454596408e-02f, 8.179994300e-03f, 1.235731244e-01f, 9.628326893e-01f, 7.481423616e-01f, 8.756909966e-01f, -9.999232888e-01f, 4.781863391e-01f, 9.964298010e-01f, 7.418274283e-01f, 4.528862834e-01f, 2.612340748e-01f, 1.480804533e-01f, 8.348185569e-02f, 4.698270187e-02f, 2.642696351e-02f, 1.486215740e-02f, 8.357816376e-03f, -7.682546377e-01f, 9.585731030e-01f, 5.046970844e-01f, 7.764653563e-01f, -9.961646199e-01f, 4.280683994e-01f, 9.986009598e-01f, 7.536345124e-01f, 4.617791772e-01f, 2.666580379e-01f, 1.512071192e-01f, 8.525379747e-02f, 4.798157141e-02f, 2.698910423e-02f, 1.517834887e-02f, 8.535637520e-03f, -9.537526369e-01f, 6.590901017e-01f, 2.112006545e-01f, 6.527503729e-01f, -9.824525714e-01f, 3.765971363e-01f, 9.997735620e-01f, 7.652031779e-01f, 4.706258774e-01f, 2.720735669e-01f, 1.543322802e-01f, 8.702547103e-02f, 4.898039624e-02f, 2.755123749e-02f, 1.549453940e-02f, 8.713459596e-03f, -2.623748481e-01f, 1.566190720e-01f, -1.032404602e-01f, 5.084479451e-01f, -9.589242935e-01f, 3.239352703e-01f, 9.999465346e-01f, 7.765299678e-01f, 4.794255495e-01f, 2.774805427e-01f, 1.574558914e-01f, 8.879686147e-02f, 4.997916892e-02f, 2.811335959e-02f, 1.581072807e-02f, 8.891279809e-03f, 6.702291965e-01f, -3.940860629e-01f, -4.074441493e-01f, 3.481085002e-01f, -9.258147478e-01f, 2.702493370e-01f, 9.991195798e-01f, 7.876111865e-01f, 4.881772399e-01f, 2.828786969e-01f, 1.605779380e-01f, 9.056797624e-02f, 5.097789690e-02f, 2.867547423e-02f, 1.612691768e-02f, 9.069100954e-03f, 9.866275787e-01f, -8.234215975e-01f, -6.712401509e-01f, 1.767906845e-01f, -8.834545016e-01f, 2.157090008e-01f, 9.972936511e-01f, 7.984433770e-01f, 4.968801141e-01f, 2.882679403e-01f, 1.636983752e-01f, 9.233880043e-02f, 5.197656900e-02f, 2.923758142e-02f, 1.644310169e-02f, 9.246920235e-03f, 3.959251642e-01f, -9.991579652e-01f, -8.684699535e-01f, -1.030206768e-04f, -8.322673440e-01f, 1.604867280e-01f, 9.944704771e-01f, 8.090230227e-01f, 5.055333376e-01f, 2.936480343e-01f, 1.668171734e-01f, 9.410934150e-02f, 5.297519267e-02f, 2.979967557e-02f, 1.675928757e-02f, 9.424741380e-03f, -5.587890744e-01f, -8.671715260e-01f, -9.795749187e-01f, -1.769934744e-01f, -7.727644444e-01f, 1.047568321e-01f, 9.906529188e-01f, 8.193469048e-01f, 5.141359568e-01f, 2.990188897e-01f, 1.699342877e-01f, 9.587957710e-02f, 5.397376046e-02f, 3.036176413e-02f, 1.707546785e-02f, 9.602561593e-03f, -9.997551441e-01f, -4.681116641e-01f, -9.935355186e-01f, -3.483016491e-01f, -7.055402994e-01f, 4.869600013e-02f, 9.858447909e-01f, 8.294116855e-01f, 5.226872563e-01f, 3.043802381e-01f, 1.730497181e-01f, 9.764950722e-02f, 5.497227982e-02f, 3.092384152e-02f, 1.739165001e-02f, 9.780380875e-03f, -5.215510130e-01f, 7.511820644e-02f, -9.089674354e-01f, -5.086245537e-01f, -6.312667131e-01f, -7.518785074e-03f, 9.800508618e-01f, 8.392141461e-01f, 5.311862230e-01f, 3.097319603e-01f, 1.761634201e-01f, 9.941913933e-02f, 5.597073585e-02f, 3.148590773e-02f, 1.770782843e-02f, 9.958200157e-03f, 4.361647666e-01f, 5.952115059e-01f, -7.342582941e-01f, -6.529057026e-01f, -5.506852865e-01f, -6.370979548e-02f, 9.732769728e-01f, 8.487512469e-01f, 5.396320224e-01f, 3.150739372e-01f, 1.792753637e-01f, 1.011884511e-01f, 5.696914345e-02f, 3.204796836e-02f, 1.802400686e-02f, 1.013601944e-02f, 9.928726554e-01f, 9.319928288e-01f, -4.867334962e-01f, -7.765945792e-01f, -4.646020234e-01f, -1.196993962e-01f, 9.655299187e-01f, 8.580200076e-01f, 5.480239391e-01f, 3.204059005e-01f, 1.823855042e-01f, 1.029574350e-01f, 5.796748772e-02f, 3.261001408e-02f, 1.834018156e-02f, 1.031383779e-02f, 6.367380023e-01f, 9.817358255e-01f, -1.909380108e-01f, -8.757900000e-01f, -3.738765717e-01f, -1.753105819e-01f, 9.568174481e-01f, 8.670173883e-01f, 5.563610196e-01f, 3.257277906e-01f, 1.854938269e-01f, 1.047261059e-01f, 5.896577984e-02f, 3.317204863e-02f, 1.865635626e-02f, 1.049165614e-02f, -3.048106134e-01f, 7.291237116e-01f, 1.237909496e-01f, -9.473637342e-01f, -2.794154882e-01f, -2.303675115e-01f, 9.471482038e-01f, 8.757405281e-01f, 5.646424294e-01f, 3.310393095e-01f, 1.886002868e-01f, 1.064944416e-01f, 5.996400863e-02f, 3.373407945e-02f, 1.897252724e-02f, 1.066947449e-02f, -9.661177993e-01f, 2.519522607e-01f, 4.262454212e-01f, -9.890577197e-01f, -1.821625978e-01f, -2.846961617e-01f, 9.365318418e-01f, 8.841868639e-01f, 5.728674531e-01f, 3.363404274e-01f, 1.917048544e-01f, 1.082624346e-01f, 6.096218154e-02f, 3.429609165e-02f, 1.928869821e-02f, 1.084729191e-02f, -7.391806841e-01f, -3.028128743e-01f, 6.864276528e-01f, -9.995572567e-01f, -8.308912069e-02f, -3.381247520e-01f, 9.249790907e-01f, 8.923535347e-01f, 5.810351372e-01f, 3.416308761e-01f, 1.948075294e-01f, 1.100300923e-01f, 6.196028739e-02f, 3.485809639e-02f, 1.960486546e-02f, 1.102510840e-02f, 1.673557013e-01f, -7.643200755e-01f, 8.785385489e-01f, -9.785313010e-01f, 1.681409031e-02f, -3.904843926e-01f, 9.125014544e-01f, 9.002380967e-01f, 5.891447663e-01f, 3.469105363e-01f, 1.979082376e-01f, 1.117973924e-01f, 6.295833737e-02f, 3.542009369e-02f, 1.992103085e-02f, 1.120292582e-02f };

#define LAS __attribute__((address_space(3)))
typedef unsigned short bf16;
typedef float f32x4 __attribute__((ext_vector_type(4)));
typedef float f32x2 __attribute__((ext_vector_type(2)));
typedef float f32x16 __attribute__((ext_vector_type(16)));
typedef short bf16x8 __attribute__((ext_vector_type(8)));
typedef short s16x4 __attribute__((ext_vector_type(4)));
typedef unsigned u32x4 __attribute__((ext_vector_type(4)));
typedef unsigned u32x2 __attribute__((ext_vector_type(2)));

constexpr int DM = 2048, NB = 8, SEQ = 2048, CTX = 256, DEPTH = 2;
constexpr int NLAT = NB * SEQ, NCTX = NB * CTX, NROW = NLAT + NCTX;
constexpr int INC = 5888, NEXP = 16, EFF = 1024, ADAW = 6 * DM;
constexpr int ZC_RQ = 0, ZC_RK = 512, ZC_RV = 1024, ZC_RG = 1536, ZC_CB = 2048, ZC_CC = 2560, ZC_CH = 3072, ZC_SQ = 3584, ZC_SK = 4096, ZC_SV = 4224, ZC_NQ = 4352, ZC_NK = 4864, ZC_NV = 5376;
constexpr int YC_RET = 0, YC_CONV = 512, YC_SWA = 1024, YC_NA = 1536;
constexpr float LOG2E = 1.4426950408889634f;
constexpr float RMS_EPS = 1e-6f;
constexpr int NWAVES = 8, NTHR = 512;

constexpr size_t MiB = (size_t)1 << 20;
constexpr size_t WS_CTL = 0, CTL_ZERO_BYTES = 1 * MiB;
constexpr size_t WS_ADA = 1 * MiB;
constexpr size_t WS_AFF = 2 * MiB;
constexpr size_t WS_SEL = 4 * MiB;
constexpr size_t WS_IDX = 6 * MiB;
constexpr size_t WS_GATEV = 6 * MiB + 256 * 1024;
constexpr size_t WS_WIN = 8 * MiB;
constexpr size_t WS_WOUT = 54 * MiB;
constexpr size_t WS_WGU = 70 * MiB;
constexpr size_t WS_WD = 326 * MiB;
constexpr size_t WS_XC = 454 * MiB;
constexpr size_t WS_HB = 470 * MiB;
constexpr size_t WS_Z = 542 * MiB;
constexpr size_t WS_ACT = 749 * MiB;
constexpr size_t WS_SST = 821 * MiB;
constexpr size_t WS_SIN = 857 * MiB;
constexpr size_t WS_XB = 876 * MiB;
constexpr size_t WS_END = 948 * MiB;
constexpr int CW_BAR = 4096;

constexpr int LDS_BYTES = 147456;
constexpr int MISC_OFF = 131072 + 320;
constexpr int ROPE_LDS = 131072 + 8192;

struct Params {
    const float* x; const float* c; const float* ctx; const float* c_ctx; const float* w_ada; const float* b_ada; const float* norm_mix; const float* norm_ffn;
    const float* w_in; const float* w_out; const float* dec_f; const float* dec_b; const float* conv_w; const float* sink; const float* rpb; const float* w_router;
    const float* w_gate; const float* w_up; const float* w_down; const float* norm_final;
    float* out; unsigned char* ws;
};

__device__ __forceinline__ float bf2f(unsigned v) { return __uint_as_float(v << 16); }
__device__ __forceinline__ unsigned f2bf(float f) { unsigned u = __float_as_uint(f); return (u + 0x7fffu + ((u >> 16) & 1u)) >> 16; }
__device__ __forceinline__ unsigned pk2(float lo, float hi) { unsigned r; asm volatile("v_cvt_pk_bf16_f32 %0, %1, %2" : "=v"(r) : "v"(lo), "v"(hi)); return r; }
__device__ __forceinline__ float ex2(float x) { return __builtin_amdgcn_exp2f(x); }
__device__ __forceinline__ float wave_sum(float v) {
#pragma unroll
    for (int o = 1; o < 64; o <<= 1) v += __shfl_xor(v, o);
    return v;
}
__device__ __forceinline__ float half_sum32(float v) {
#pragma unroll
    for (int o = 1; o < 32; o <<= 1) v += __shfl_xor(v, o);
    return v;
}
__device__ __forceinline__ float silu_f(float x) { return x / (1.f + __expf(-x)); }
__device__ __forceinline__ int crow(int r, int hi) { return (r & 3) + 8 * (r >> 2) + 4 * hi; }
#define MFMA32(a, b, c) __builtin_amdgcn_mfma_f32_32x32x16_bf16((a), (b), (c), 0, 0, 0)
#define LDS_WAIT() asm volatile("s_waitcnt lgkmcnt(0)" ::: "memory")
typedef short v4i16_t __attribute__((ext_vector_type(4)));
__device__ __forceinline__ s16x4 trrd(LAS const unsigned char* p) { return __builtin_bit_cast(s16x4, __builtin_amdgcn_ds_read_tr16_b64_v4i16((LAS v4i16_t*)p)); }
__device__ __forceinline__ bf16x8 cat8(s16x4 lo, s16x4 hi) { return (bf16x8){lo[0], lo[1], lo[2], lo[3], hi[0], hi[1], hi[2], hi[3]}; }
__device__ __forceinline__ u32x4 scale8(u32x4 v, float s) {
    u32x4 r;
#pragma unroll
    for (int i = 0; i < 4; ++i) r[i] = pk2(bf2f(v[i] & 0xffffu) * s, __uint_as_float(v[i] & 0xffff0000u) * s);
    return r;
}

__device__ __forceinline__ float* ws_ada(const Params& p) { return (float*)(p.ws + WS_ADA); }
__device__ __forceinline__ bf16* ws_z(const Params& p) { return (bf16*)(p.ws + WS_Z); }
__device__ __forceinline__ bf16* ws_hb(const Params& p) { return (bf16*)(p.ws + WS_HB); }
constexpr int KVH_ROWS = SEQ + CTX;
__device__ __forceinline__ bf16* ws_kvh(const Params& p) { return (bf16*)(p.ws + WS_ACT); }
__device__ __forceinline__ size_t kvh_off(int kind, int b, int h) { return (size_t)((kind * NB + b) * 8 + h) * KVH_ROWS * 64; }
__device__ __forceinline__ bf16* ws_xb(const Params& p) { return (bf16*)(p.ws + WS_XB); }

namespace pg8 {
struct GroupedOrder {
    StaticOrder S; int tpe;
    __device__ void init(int tpe_, int G_, int c_) { tpe = tpe_; S.init(16 * tpe_ * BM, 8 * BM, G_, c_); }
    __device__ bool next(int i, Unit& u) const { if (!S.next(i, u)) return false; u.pb = (u.pm / tpe) * 8 + u.pn; return true; }
    __device__ __forceinline__ void a_ready(const Unit&) const {}
    __device__ __forceinline__ void done(const Unit&) const {}
};
struct SkipOrder {
    StaticOrder S; int G, c;
    __device__ void init(int G_, int c_) { S.init(16384, 5888, G_, c_); G = G_; c = c_; }
    __device__ bool next(int i, Unit& u) const {
        if (S.next(i, u)) return true;
        const int j = i * G + c - 64 * 23; if (j < 0 || j >= 64) return false;
        const int t = j >> 3; u.pm = 64 + (j & 7); u.pn = t < 4 ? 2 + t : (t == 4 ? 16 : 14 + t); u.pb = u.pn; return true;
    }
    __device__ __forceinline__ void a_ready(const Unit&) const {}
    __device__ __forceinline__ void done(const Unit&) const {}
};
struct QuadOrder {
    int G, c;
    __device__ void init(int G_, int c_) { G = G_; c = c_; }
    __device__ bool next(int i, Unit& u) const {
        const int x = i * G + c; if (x >= 32) return false;
        u.pm = 64 + (x >> 2); u.pn = 22; u.pb = 22; u.q = x & 3; return true;
    }
    __device__ __forceinline__ void a_ready(const Unit&) const {}
    __device__ __forceinline__ void done(const Unit&) const {}
};
template <bool BASE_F32> struct EpiResGate {
    static constexpr bool PERM = true, AFTER_DRAIN = false;
    const float* base_lat; const float* base_ctx; bf16_t* xb; const float* ada; int goff;
    __device__ __forceinline__ void operator()(const f32x4 (&acc)[2][2][4][2], const Unit& u, int wr, int wc, int fr, int fq) const {
        const bool isctx = u.pm >= 64;
        const int grow = isctx ? 8 : (u.pm >> 3);
        const float* g = ada + grow * 12288 + goff;
        const float* basef = isctx ? base_ctx - (size_t)64 * BM * 2048 : base_lat;
        const int row0 = u.pm * BM + wr * 64 + fr, col0 = u.pn * BM + wc * 32 + 8 * fq;
        f32x4 gv[2][2];
#pragma unroll
        for (int bj = 0; bj < 2; ++bj)
#pragma unroll
            for (int n = 0; n < 2; ++n) gv[bj][n] = *(const f32x4*)(g + col0 + bj * HALF + 4 * n);
#pragma unroll
        for (int ai = 0; ai < 2; ++ai)
#pragma unroll
            for (int m = 0; m < 4; ++m) { const size_t off = (size_t)(row0 + ai * HALF + m * 16) * 2048 + col0;
#pragma unroll
                for (int bj = 0; bj < 2; ++bj) { f32x4 b0, b1;
                    if constexpr (BASE_F32) { b0 = *(const f32x4*)(basef + off + bj * HALF); b1 = *(const f32x4*)(basef + off + bj * HALF + 4); }
                    else { const u32x4 w = *(const u32x4*)(xb + off + bj * HALF);
                        b0 = (f32x4){__uint_as_float(w.x << 16), __uint_as_float(w.x & 0xffff0000u), __uint_as_float(w.y << 16), __uint_as_float(w.y & 0xffff0000u)};
                        b1 = (f32x4){__uint_as_float(w.z << 16), __uint_as_float(w.z & 0xffff0000u), __uint_as_float(w.w << 16), __uint_as_float(w.w & 0xffff0000u)}; }
                    const f32x4 v0 = b0 + gv[bj][0] * acc[ai][bj][m][0], v1 = b1 + gv[bj][1] * acc[ai][bj][m][1];
                    u32x4 o; o.x = cvt_pk_bf16(v0[0], v0[1]); o.y = cvt_pk_bf16(v0[2], v0[3]); o.z = cvt_pk_bf16(v1[0], v1[1]); o.w = cvt_pk_bf16(v1[2], v1[3]);
                    *(u32x4*)(xb + off + bj * HALF) = o; }
                asm volatile("" ::: "memory"); }
    }
};
struct EpiSiluMul {
    static constexpr bool PERM = true, AFTER_DRAIN = false;
    bf16_t* O;
    __device__ __forceinline__ void operator()(const f32x4 (&acc)[2][2][4][2], const Unit& u, int wr, int wc, int fr, int fq) const {
        const int row0 = u.pm * BM + wr * 64 + fr, col0 = u.pn * HALF + wc * 32 + 8 * fq;
#pragma unroll
        for (int ai = 0; ai < 2; ++ai)
#pragma unroll
            for (int m = 0; m < 4; ++m) { bf16_t* rowp = O + (size_t)(row0 + ai * HALF + m * 16) * 1024 + col0;
                float v[8];
#pragma unroll
                for (int n = 0; n < 2; ++n)
#pragma unroll
                    for (int j = 0; j < 4; ++j) { const float gg = acc[ai][0][m][n][j], uu = acc[ai][1][m][n][j]; v[n * 4 + j] = gg * __builtin_amdgcn_rcpf(1.f + __builtin_amdgcn_exp2f(-gg * 1.4426950408889634f)) * uu; }
                u32x4 w; w.x = cvt_pk_bf16(v[0], v[1]); w.y = cvt_pk_bf16(v[2], v[3]); w.z = cvt_pk_bf16(v[4], v[5]); w.w = cvt_pk_bf16(v[6], v[7]);
                *(u32x4*)rowp = w; }
    }
};
struct EpiDown {
    static constexpr bool PERM = true, AFTER_DRAIN = false;
    bf16_t* O; const float* gatev;
    __device__ __forceinline__ void operator()(const f32x4 (&acc)[2][2][4][2], const Unit& u, int wr, int wc, int fr, int fq) const {
        const int row0 = u.pm * BM + wr * 64 + fr, col0 = u.pn * BM + wc * 32 + 8 * fq;
        float sg[2][4];
#pragma unroll
        for (int ai = 0; ai < 2; ++ai)
#pragma unroll
            for (int m = 0; m < 4; ++m) sg[ai][m] = gatev[row0 + ai * HALF + m * 16];
#pragma unroll
        for (int ai = 0; ai < 2; ++ai)
#pragma unroll
            for (int m = 0; m < 4; ++m) { const int row = row0 + ai * HALF + m * 16; const float s = sg[ai][m]; bf16_t* rowp = O + (size_t)row * 2048 + col0;
#pragma unroll
                for (int bj = 0; bj < 2; ++bj) { const f32x4 v0 = acc[ai][bj][m][0] * s, v1 = acc[ai][bj][m][1] * s;
                    u32x4 w; w.x = cvt_pk_bf16(v0[0], v0[1]); w.y = cvt_pk_bf16(v0[2], v0[3]); w.z = cvt_pk_bf16(v1[0], v1[1]); w.w = cvt_pk_bf16(v1[2], v1[3]);
                    *(u32x4*)(rowp + bj * HALF) = w; } }
    }
};
struct EpiZRope {
    static constexpr bool PERM = true, AFTER_DRAIN = false;
    bf16_t* O; LAS const float* rcos; LAS const float* rsin; bf16_t* KV;
    __device__ __forceinline__ void quad(const f32x4 (&a)[4][2], const Unit& u, int wr, int wc, int fr, int fq) const {
        const int ai = u.q >> 1, bj = u.q & 1, tile = u.pn;
        const int b = (u.pm < 64) ? (u.pm >> 3) : (u.pm - 64), rloc0 = ((u.pm < 64) ? (u.pm & 7) * 256 : 2048) + wr * 64 + fr + ai * HALF;
        const int c = (tile - 19) * BM + wc * 32 + 8 * fq + bj * HALF;
        bf16_t* hp = KV + ((size_t)(((c >> 9) * 8 + b) * 8 + ((c >> 6) & 7)) * 2304 + rloc0) * 64 + (c & 63);
#pragma unroll
        for (int m = 0; m < 4; ++m) { const f32x4 v0 = a[m][0], v1 = a[m][1];
            u32x4 w; w.x = cvt_pk_bf16(v0[0], v0[1]); w.y = cvt_pk_bf16(v0[2], v0[3]); w.z = cvt_pk_bf16(v1[0], v1[1]); w.w = cvt_pk_bf16(v1[2], v1[3]);
            *(u32x4*)(hp + (m * 16) * 64) = w; }
    }
    __device__ __forceinline__ void operator()(const f32x4 (&acc)[2][2][4][2], const Unit& u, int wr, int wc, int fr, int fq) const {
        const int row0 = u.pm * BM + wr * 64 + fr, tile = u.pn;
        const bool rtile = (tile < 4) || (tile >= 14 && tile <= 16);
        if (tile >= 19) {
            const int b = (u.pm < 64) ? (u.pm >> 3) : (u.pm - 64), rloc0 = ((u.pm < 64) ? (u.pm & 7) * 256 : 2048) + wr * 64 + fr;
#pragma unroll
            for (int bj = 0; bj < 2; ++bj) { const int c = (tile - 19) * BM + wc * 32 + 8 * fq + bj * HALF;
                bf16_t* hp = KV + ((size_t)(((c >> 9) * 8 + b) * 8 + ((c >> 6) & 7)) * 2304 + rloc0) * 64 + (c & 63);
#pragma unroll
                for (int ai = 0; ai < 2; ++ai) {
#pragma unroll
                    for (int m = 0; m < 4; ++m) { const f32x4 v0 = acc[ai][bj][m][0], v1 = acc[ai][bj][m][1];
                        u32x4 w; w.x = cvt_pk_bf16(v0[0], v0[1]); w.y = cvt_pk_bf16(v0[2], v0[3]); w.z = cvt_pk_bf16(v1[0], v1[1]); w.w = cvt_pk_bf16(v1[2], v1[3]);
                        *(u32x4*)(hp + (ai * HALF + m * 16) * 64) = w; } } }
            return;
        }
        if (!rtile) {
            const int col0 = tile * BM + wc * 32 + 8 * fq;
#pragma unroll
            for (int ai = 0; ai < 2; ++ai)
#pragma unroll
                for (int m = 0; m < 4; ++m) { bf16_t* rowp = O + (size_t)(row0 + ai * HALF + m * 16) * 5888 + col0;
#pragma unroll
                    for (int bj = 0; bj < 2; ++bj) { const f32x4 v0 = acc[ai][bj][m][0], v1 = acc[ai][bj][m][1];
                        u32x4 w; w.x = cvt_pk_bf16(v0[0], v0[1]); w.y = cvt_pk_bf16(v0[2], v0[3]); w.z = cvt_pk_bf16(v1[0], v1[1]); w.w = cvt_pk_bf16(v1[2], v1[3]);
                        *(u32x4*)(rowp + bj * HALF) = w; } }
            return;
        }
        const bool pass = (tile == 16) && (wc >= 2);
        const int c1 = pass ? 4224 + (wc - 2) * 32 : tile * BM + wc * 64, c2 = pass ? c1 + 64 : c1 + 32;
        const bool rope = !pass && (u.pm < 64);
#pragma unroll
        for (int ai = 0; ai < 2; ++ai)
#pragma unroll
            for (int m = 0; m < 4; ++m) { const int row = row0 + ai * HALF + m * 16; bf16_t* rowp = O + (size_t)row * 5888 + 8 * fq;
                f32x4 a0 = acc[ai][0][m][0], a1 = acc[ai][0][m][1], b0 = acc[ai][1][m][0], b1 = acc[ai][1][m][1];
                if (rope) { const int t = row & 2047, pos = (fq < 2) ? (t >> 6) : (t & 63), ti = pos * 16 + 8 * (fq & 1);
                    const f32x4 cs0 = *(LAS const f32x4*)(rcos + ti), cs1 = *(LAS const f32x4*)(rcos + ti + 4), sn0 = *(LAS const f32x4*)(rsin + ti), sn1 = *(LAS const f32x4*)(rsin + ti + 4);
                    const f32x4 x0 = a0 * cs0 - b0 * sn0, x1 = a1 * cs1 - b1 * sn1, y0 = a0 * sn0 + b0 * cs0, y1 = a1 * sn1 + b1 * cs1;
                    a0 = x0; a1 = x1; b0 = y0; b1 = y1; }
                u32x4 w; w.x = cvt_pk_bf16(a0[0], a0[1]); w.y = cvt_pk_bf16(a0[2], a0[3]); w.z = cvt_pk_bf16(a1[0], a1[1]); w.w = cvt_pk_bf16(a1[2], a1[3]);
                *(u32x4*)(rowp + c1) = w;
                w.x = cvt_pk_bf16(b0[0], b0[1]); w.y = cvt_pk_bf16(b0[2], b0[3]); w.z = cvt_pk_bf16(b1[0], b1[1]); w.w = cvt_pk_bf16(b1[2], b1[3]);
                *(u32x4*)(rowp + c2) = w; }
    }
};
}

__device__ __forceinline__ void transpose_item(const float* W, int N, bf16* WT, int K, int k0, int n0, int drow0, LAS float* scr, int lane) {
#pragma unroll 8
    for (int i = 0; i < 32; ++i) { const int kk = 2 * i + (lane >> 5); scr[kk * 33 + (lane & 31)] = W[(size_t)(k0 + kk) * N + n0 + (lane & 31)]; }
    LDS_WAIT();
    const int c = lane & 7;
#pragma unroll
    for (int j = 0; j < 4; ++j) { const int n = (lane >> 3) + 8 * j; const LAS float* s = scr + (8 * c) * 33 + n;
        u32x4 o; o.x = pk2(s[0 * 33], s[1 * 33]); o.y = pk2(s[2 * 33], s[3 * 33]); o.z = pk2(s[4 * 33], s[5 * 33]); o.w = pk2(s[6 * 33], s[7 * 33]);
        *(u32x4*)(WT + (size_t)(drow0 + n) * K + k0 + 8 * c) = o; }
    LDS_WAIT();
}
__device__ __forceinline__ int win_dst_group(int sg) {
    const int tile = sg >> 3, r = sg & 7;
    if (tile < 4 || tile == 14 || tile == 15) return tile * 8 + (r & 1) * 4 + (r >> 1);
    if (tile == 16) return 128 + (r < 4 ? ((r & 1) * 4 + (r >> 1)) : (r < 6 ? r - 2 : r));
    return sg;
}
constexpr int I_IN = 32 * 184, I_OUT = 32 * 64, I_G = 16 * 32 * 32, I_D = 16 * 16 * 64, I_L = I_IN + I_OUT + 2 * I_G + I_D;

__device__ __forceinline__ void convert_item(const Params& p, int l, int r, LAS float* scr, int lane) {
    bf16* WIN = (bf16*)(p.ws + WS_WIN); bf16* WOUT = (bf16*)(p.ws + WS_WOUT); bf16* WGU = (bf16*)(p.ws + WS_WGU); bf16* WD = (bf16*)(p.ws + WS_WD);
    if (r < I_IN) { const int kb = r / 184, nb = r % 184; transpose_item(p.w_in + (size_t)l * 2048 * INC, INC, WIN + (size_t)l * INC * 2048, 2048, 64 * kb, 32 * nb, 32 * win_dst_group(nb), scr, lane); return; } r -= I_IN;
    if (r < I_OUT) { const int kb = r / 64, nb = r % 64; transpose_item(p.w_out + (size_t)l * 2048 * 2048, 2048, WOUT + (size_t)l * 2048 * 2048, 2048, 64 * kb, 32 * nb, 32 * nb, scr, lane); return; } r -= I_OUT;
    if (r < 2 * I_G) { const int isup = r >= I_G; if (isup) r -= I_G; const int e = r >> 10, rr = r & 1023, kb = rr >> 5, nb = rr & 31, n0 = 32 * nb;
        const float* W = (isup ? p.w_up : p.w_gate) + (size_t)(l * 16 + e) * 2048 * 1024;
        transpose_item(W, 1024, WGU + (size_t)(l * 16 + e) * 2048 * 2048, 2048, 64 * kb, n0, (n0 >> 7) * 256 + (n0 & 127) + (isup ? 128 : 0), scr, lane); return; } r -= 2 * I_G;
    { const int e = r >> 10, rr = r & 1023, kb = rr >> 6, nb = rr & 63;
      transpose_item(p.w_down + (size_t)(l * 16 + e) * 1024 * 2048, 2048, WD + (size_t)(l * 16 + e) * 2048 * 1024, 1024, 64 * kb, 32 * nb, 32 * nb, scr, lane); }
}
#ifndef TAIL_P2
#define TAIL_P2 0
#define TAIL_P6 (192 * 128)
#define TAIL_P9 0
#define TAIL_P10 0
#endif
constexpr int TAIL_OFF_P2 = 0, TAIL_OFF_P6 = TAIL_P2, TAIL_OFF_P9 = TAIL_P2 + TAIL_P6, TAIL_OFF_P10 = TAIL_P2 + TAIL_P6 + TAIL_P9, TAIL_ITEMS = TAIL_P2 + TAIL_P6 + TAIL_P9 + TAIL_P10;
static_assert(TAIL_ITEMS <= I_L, "tail items are layer-1 items");
__device__ __forceinline__ void ph_prologue(const Params& p, LAS unsigned char* lds) {
    const int tid = tid_opaque(), lane = tid & 63, wave = __builtin_amdgcn_readfirstlane(tid >> 6);
    const int G = gridDim.x;
    for (int u = blockIdx.x; u < 192; u += G) {
        const int l = u / 96, cg = u % 96;
        LAS float* s_sil = (LAS float*)lds; LAS float* s_red = (LAS float*)(lds + 73728);
        for (int i = tid; i < 9 * 2048; i += NTHR) { const int r = i >> 11, k = i & 2047; const float v = (r < 8) ? p.c[r * 2048 + k] : p.c_ctx[k]; s_sil[i] = silu_f(v); }
        __syncthreads();
        const float* W = p.w_ada + (size_t)l * 2048 * ADAW + cg * 128 + 2 * lane;
        float acc[9][2];
#pragma unroll
        for (int r = 0; r < 9; ++r) { acc[r][0] = 0.f; acc[r][1] = 0.f; }
        const int k0 = wave * 256;
        for (int kk = 0; kk < 256; kk += 8) {
            f32x2 w[8];
#pragma unroll
            for (int j = 0; j < 8; ++j) w[j] = *(const f32x2*)(W + (size_t)(k0 + kk + j) * ADAW);
#pragma unroll
            for (int r = 0; r < 9; ++r) {
                const f32x4 sa = *(LAS const f32x4*)(s_sil + r * 2048 + k0 + kk), sb = *(LAS const f32x4*)(s_sil + r * 2048 + k0 + kk + 4);
#pragma unroll
                for (int j = 0; j < 4; ++j) { acc[r][0] += sa[j] * w[j].x; acc[r][1] += sa[j] * w[j].y; acc[r][0] += sb[j] * w[4 + j].x; acc[r][1] += sb[j] * w[4 + j].y; }
            }
        }
#pragma unroll
        for (int r = 0; r < 9; ++r) { s_red[(wave * 9 + r) * 128 + 2 * lane] = acc[r][0]; s_red[(wave * 9 + r) * 128 + 2 * lane + 1] = acc[r][1]; }
        __syncthreads();
        for (int i = tid; i < 9 * 128; i += NTHR) { const int r = i >> 7, cc = i & 127; float s = p.b_ada[l * ADAW + cg * 128 + cc];
#pragma unroll
            for (int w = 0; w < 8; ++w) s += s_red[(w * 9 + r) * 128 + cc];
            ws_ada(p)[(size_t)(l * 9 + r) * ADAW + cg * 128 + cc] = s; }
        __syncthreads();
    }
    LAS float* scr = (LAS float*)(lds + wave * 8448);
    const int gw = blockIdx.x * NWAVES + wave, NGW = G * NWAVES;
    const int tail = (G == 256) ? TAIL_ITEMS : 0;
    for (int it = gw; it < 2 * I_L - tail; it += NGW) { const int g = it < I_L ? it : it + tail; convert_item(p, g / I_L, g % I_L, scr, lane); }
}
__device__ __forceinline__ void tail_convert(const Params& p, int off, int n, int rank, int nidle, LAS unsigned char* lds) {
    const int tid = tid_opaque(), lane = tid & 63, wave = __builtin_amdgcn_readfirstlane(tid >> 6);
    LAS float* scr = (LAS float*)(lds + wave * 8448);
    for (int it = rank * NWAVES + wave; it < n; it += nidle * NWAVES) convert_item(p, 1, off + it, scr, lane);
}

__device__ __forceinline__ void load_row8(f32x4 (&v)[8], const float* row, int lane) {
#pragma unroll
    for (int j = 0; j < 8; ++j) v[j] = *(const f32x4*)(row + 256 * j + 4 * lane);
}
__device__ __forceinline__ void load_row8_bf16(f32x4 (&v)[8], const bf16* row, int lane) {
#pragma unroll
    for (int j = 0; j < 8; ++j) { const u32x2 w = *(const u32x2*)(row + 256 * j + 4 * lane);
        v[j] = (f32x4){__uint_as_float(w.x << 16), __uint_as_float(w.x & 0xffff0000u), __uint_as_float(w.y << 16), __uint_as_float(w.y & 0xffff0000u)}; }
}
__device__ __forceinline__ float row_rstd(const f32x4 (&v)[8]) {
    float s = 0.f;
#pragma unroll
    for (int j = 0; j < 8; ++j) s += (v[j].x * v[j].x + v[j].y * v[j].y) + (v[j].z * v[j].z + v[j].w * v[j].w);
    return rsqrtf(wave_sum(s) * (1.f / 2048.f) + RMS_EPS);
}
__device__ __forceinline__ void modulate8(f32x4 (&v)[8], float rstd, const float* nw, const float* sc, const float* sh, int lane) {
#pragma unroll
    for (int j = 0; j < 8; ++j) { const int c = 256 * j + 4 * lane; const f32x4 w = *(const f32x4*)(nw + c), s1 = *(const f32x4*)(sc + c), s0 = *(const f32x4*)(sh + c);
        v[j] = v[j] * rstd * w * (1.f + s1) + s0; }
}
__device__ __forceinline__ void store_row8_bf16(const f32x4 (&v)[8], bf16* row, int lane) {
#pragma unroll
    for (int j = 0; j < 8; ++j) { u32x2 w; w.x = pk2(v[j].x, v[j].y); w.y = pk2(v[j].z, v[j].w); *(u32x2*)(row + 256 * j + 4 * lane) = w; }
}
__device__ __forceinline__ void load_coeffs(f32x4 (&wv)[8], f32x4 (&sv)[8], const float* nw, const float* sc, const float* sh, int lane) {
#pragma unroll
    for (int j = 0; j < 8; ++j) { const int c = 256 * j + 4 * lane; wv[j] = *(const f32x4*)(nw + c) * (1.f + *(const f32x4*)(sc + c)); sv[j] = *(const f32x4*)(sh + c); }
}
__device__ __forceinline__ void ph_modnorm0(const Params& p) {
    const int tid_ = tid_opaque(), lane = tid_ & 63, wave = __builtin_amdgcn_readfirstlane(tid_ >> 6);
    const int gw = blockIdx.x * NWAVES + wave, NGW = gridDim.x * NWAVES;
    const int rpw = (NROW + NGW - 1) / NGW, r0 = gw * rpw, r1 = (r0 + rpw < NROW) ? r0 + rpw : NROW;
    int cur = -1; f32x4 wv[8], sv[8], vn[8];
#define XROW0(r) (((r) < NLAT) ? p.x + (size_t)(r) * DM : p.ctx + (size_t)((r) - NLAT) * DM)
    if (r0 < r1) load_row8(vn, XROW0(r0), lane);
    for (int row = r0; row < r1; ++row) {
        f32x4 v[8];
#pragma unroll
        for (int j = 0; j < 8; ++j) v[j] = vn[j];
        if (row + 1 < r1) load_row8(vn, XROW0(row + 1), lane);
        const int arow = (row < NLAT) ? (row >> 11) : 8;
        if (arow != cur) { const float* ad = ws_ada(p) + (size_t)(0 * 9 + arow) * ADAW; load_coeffs(wv, sv, p.norm_mix, ad + 2048, ad, lane); cur = arow; }
        const float rstd = row_rstd(v);
#pragma unroll
        for (int j = 0; j < 8; ++j) v[j] = v[j] * rstd * wv[j] + sv[j];
        store_row8_bf16(v, ws_hb(p) + (size_t)row * DM, lane);
    }
#undef XROW0
}

namespace att {
__device__ __forceinline__ float xh_max(float v) { auto rr = __builtin_amdgcn_permlane32_swap(__float_as_uint(v), __float_as_uint(v), false, false); float a = __uint_as_float(rr[0]), b = __uint_as_float(rr[1]), r; asm("v_max_f32_e32 %0, %1, %2" : "=v"(r) : "v"(a), "v"(b)); return r; }
__device__ __forceinline__ float xh_sum(float v) { auto rr = __builtin_amdgcn_permlane32_swap(__float_as_uint(v), __float_as_uint(v), false, false); return __uint_as_float(rr[0]) + __uint_as_float(rr[1]); }
__device__ __forceinline__ float max3f(float a, float b, float c) { float r; asm("v_max3_f32 %0, %1, %2, %3" : "=v"(r) : "v"(a), "v"(b), "v"(c)); return r; }
constexpr int KB0 = 0, VB0 = 16384, SCR = 32768, RPB = 34816, BYTES = 36864;
struct TileRegs { u32x4 k, v; };
template <int PITCH = INC> __device__ __forceinline__ void tile_load(TileRegs& t, const bf16* kp, const bf16* vp, int tid) {
    const int key = tid >> 3, c = tid & 7;
    t.k = *(const u32x4*)(kp + (size_t)key * PITCH + c * 8);
    t.v = *(const u32x4*)(vp + (size_t)key * PITCH + c * 8);
}
__device__ __forceinline__ void tile_store(const TileRegs& t, LAS unsigned char* kb, LAS unsigned char* vb, int tid) {
    const int key = tid >> 3, c = tid & 7;
    *(LAS u32x4*)(kb + c * 1024 + key * 16) = t.k;
    *(LAS u32x4*)(vb + (c >> 2) * 4096 + (key >> 3) * 512 + (key & 7) * 64 + (c & 3) * 16) = t.v;
}
__device__ __forceinline__ void qk_tile(f32x16& p0, f32x16& p1, LAS const unsigned char* kbuf, const bf16x8 (&qr)[4], int r32, int hi) {
    LAS const unsigned char* kb = kbuf + hi * 1024 + r32 * 16;
    f32x16 z;
#pragma unroll
    for (int i = 0; i < 16; ++i) z[i] = 0.f;
    p0 = z; p1 = z;
#pragma unroll
    for (int d0 = 0; d0 < 4; ++d0) {
        const bf16x8 k0 = *(LAS const bf16x8*)(kb + d0 * 2048), k1 = *(LAS const bf16x8*)(kb + d0 * 2048 + 512);
        p0 = MFMA32(k0, qr[d0], p0); p1 = MFMA32(k1, qr[d0], p1);
    }
}
__device__ __forceinline__ void k_frags(bf16x8 (&kf)[8], LAS const unsigned char* kbuf, int r32, int hi) {
    LAS const unsigned char* kb = kbuf + hi * 1024 + r32 * 16;
#pragma unroll
    for (int d0 = 0; d0 < 4; ++d0) { kf[2 * d0] = *(LAS const bf16x8*)(kb + d0 * 2048); kf[2 * d0 + 1] = *(LAS const bf16x8*)(kb + d0 * 2048 + 512); }
}
__device__ __forceinline__ void qk_frags(f32x16& p0, f32x16& p1, const bf16x8 (&kf)[8], const bf16x8 (&qr)[4]) {
    f32x16 z;
#pragma unroll
    for (int i = 0; i < 16; ++i) z[i] = 0.f;
    p0 = z; p1 = z;
#pragma unroll
    for (int d0 = 0; d0 < 4; ++d0) { p0 = MFMA32(kf[2 * d0], qr[d0], p0); p1 = MFMA32(kf[2 * d0 + 1], qr[d0], p1); }
}
__device__ __forceinline__ void pv_tile(f32x16& o0, f32x16& o1, const f32x16& p0, const f32x16& p1, LAS const unsigned char* vl) {
    u32x4 pk[4];
#pragma unroll
    for (int i = 0; i < 4; ++i) { pk[0][i] = pk2(p0[2 * i], p0[2 * i + 1]); pk[1][i] = pk2(p0[8 + 2 * i], p0[9 + 2 * i]); pk[2][i] = pk2(p1[2 * i], p1[2 * i + 1]); pk[3][i] = pk2(p1[8 + 2 * i], p1[9 + 2 * i]); }
#pragma unroll
    for (int ks = 0; ks < 4; ++ks) {
        const bf16x8 a = __builtin_bit_cast(bf16x8, pk[ks]);
        const bf16x8 v0 = cat8(trrd(vl + ks * 1024), trrd(vl + ks * 1024 + 512));
        const bf16x8 v1 = cat8(trrd(vl + 4096 + ks * 1024), trrd(vl + 4096 + ks * 1024 + 512));
        o0 = MFMA32(v0, a, o0); o1 = MFMA32(v1, a, o1);
    }
}
__device__ __forceinline__ void softmax_pv(f32x16& p0, f32x16& p1, float& m, float& lsum, f32x16& o0, f32x16& o1, LAS float* scr, LAS const unsigned char* vl, int r32, int hi) {
    float mx = max3f(p0[0], p1[0], p0[1]), mx2 = max3f(p1[1], p0[2], p1[2]);
#pragma unroll
    for (int r = 3; r < 15; r += 2) { mx = max3f(mx, p0[r], p1[r]); mx2 = max3f(mx2, p0[r + 1], p1[r + 1]); }
    mx = xh_max(max3f(mx, mx2, max3f(p0[15], p1[15], p0[15])));
    if (__any(mx > m + 8.f)) {
        const float mnew = max3f(m, mx, mx), alpha = ex2(m - mnew);
        m = mnew; lsum *= alpha;
#pragma unroll
        for (int r = 0; r < 16; ++r) { o0[r] *= alpha; o1[r] *= alpha; }
    }
    float rs = 0.f;
#pragma unroll
    for (int r = 0; r < 16; ++r) { p0[r] = ex2(p0[r] - m); p1[r] = ex2(p1[r] - m); rs += p0[r] + p1[r]; }
    lsum += rs;
    pv_tile(o0, o1, p0, p1, vl);
}
__device__ __forceinline__ void qk_win(f32x16& p0, LAS const unsigned char* kwin, const bf16x8 (&qr)[4], int r32, int hi) {
    LAS const unsigned char* kb = kwin + hi * 1024 + r32 * 16;
#pragma unroll
    for (int i = 0; i < 16; ++i) p0[i] = 0.f;
#pragma unroll
    for (int d0 = 0; d0 < 4; ++d0) { const bf16x8 k0 = *(LAS const bf16x8*)(kb + d0 * 2048); p0 = MFMA32(k0, qr[d0], p0); }
}
__device__ __forceinline__ void softmax_pv_win(f32x16& p0, float& m, float& lsum, f32x16& o0, f32x16& o1, LAS const unsigned char* vwin) {
    float mx = max3f(p0[0], p0[1], p0[2]), mx2 = max3f(p0[3], p0[4], p0[5]);
#pragma unroll
    for (int r = 6; r < 14; r += 4) { mx = max3f(mx, p0[r], p0[r + 1]); mx2 = max3f(mx2, p0[r + 2], p0[r + 3]); }
    mx = xh_max(max3f(mx, mx2, max3f(p0[14], p0[15], p0[15])));
    if (__any(mx > m + 8.f)) {
        const float mnew = max3f(m, mx, mx), alpha = ex2(m - mnew);
        m = mnew; lsum *= alpha;
#pragma unroll
        for (int r = 0; r < 16; ++r) { o0[r] *= alpha; o1[r] *= alpha; }
    }
    float rs = 0.f;
#pragma unroll
    for (int r = 0; r < 16; ++r) { p0[r] = ex2(p0[r] - m); rs += p0[r]; }
    lsum += rs;
    u32x4 pk[2];
#pragma unroll
    for (int i = 0; i < 4; ++i) { pk[0][i] = pk2(p0[2 * i], p0[2 * i + 1]); pk[1][i] = pk2(p0[8 + 2 * i], p0[9 + 2 * i]); }
#pragma unroll
    for (int ks = 0; ks < 2; ++ks) {
        const bf16x8 a = __builtin_bit_cast(bf16x8, pk[ks]);
        const bf16x8 v0 = cat8(trrd(vwin + ks * 1024), trrd(vwin + ks * 1024 + 512));
        const bf16x8 v1 = cat8(trrd(vwin + 4096 + ks * 1024), trrd(vwin + 4096 + ks * 1024 + 512));
        o0 = MFMA32(v0, a, o0); o1 = MFMA32(v1, a, o1);
    }
}
__device__ __forceinline__ void finalize_store_lane(const f32x16& o0, const f32x16& o1, float lsum, bf16* orl, int hi);
__device__ __forceinline__ void finalize_store(const f32x16& o0, const f32x16& o1, float lsum, bf16* orow, LAS float* scr, int r32, int hi) {
    finalize_store_lane(o0, o1, lsum, orow + (size_t)r32 * DM, hi);
}
__device__ __forceinline__ void finalize_store_lane(const f32x16& o0, const f32x16& o1, float lsum, bf16* orl, int hi) {
    const float inv = 1.f / xh_sum(lsum);
    bf16* op = orl + 4 * hi;
#pragma unroll
    for (int g = 0; g < 4; ++g) {
        u32x2 w0, w1; w0.x = pk2(o0[4 * g] * inv, o0[4 * g + 1] * inv); w0.y = pk2(o0[4 * g + 2] * inv, o0[4 * g + 3] * inv); w1.x = pk2(o1[4 * g] * inv, o1[4 * g + 1] * inv); w1.y = pk2(o1[4 * g + 2] * inv, o1[4 * g + 3] * inv);
        *(u32x2*)(op + 8 * g) = w0; *(u32x2*)(op + 32 + 8 * g) = w1; }
}

__device__ __forceinline__ void swa_unit(const Params& p, int l, int b, int kvh, int qb, int gp, bool isctx, LAS unsigned char* L) {
    const int tid = tid_opaque(), lane = tid & 63, wave = __builtin_amdgcn_readfirstlane(tid >> 6), r32 = lane & 31, hi = lane >> 5;
    const bf16* Z = ws_z(p); bf16* Y = ws_hb(p);
    const int g = 2 * gp + (wave >> 2), rb = wave & 3, head = kvh * 4 + g;
    const size_t qrow0 = isctx ? (size_t)(NLAT + b * CTX + qb * 128) : (size_t)(b * SEQ + qb * 128);
    bf16x8 qr[4];
    { const bf16* qp = Z + (qrow0 + 32 * rb + r32) * INC + ZC_SQ + head * 64 + hi * 8;
#pragma unroll
      for (int d0 = 0; d0 < 4; ++d0) qr[d0] = *(const bf16x8*)(qp + d0 * 16); }
    float m = p.sink[l * 8 + head] * LOG2E, ls = (hi == 0) ? 1.f : 0.f; f32x16 o0, o1;
#pragma unroll
    for (int i = 0; i < 16; ++i) { o0[i] = 0.f; o1[i] = 0.f; }
    const int t0 = (qb == 0) ? 2 : 0, t1 = (qb == 15) ? 4 : 6;
    const int nwin = isctx ? 0 : (t1 - t0), nt = nwin + 4;
    const bf16* Kc = Z + ZC_SK + kvh * 64; const bf16* Vc = Z + ZC_SV + kvh * 64;
#define SWA_TROW(t) ((t) < nwin ? (size_t)(b * SEQ + 128 * (qb - 1) + 64 * (t0 + (t))) : (size_t)(NLAT + b * CTX + 64 * ((t) - nwin)))
    LAS float* scr = (LAS float*)(L + SCR) + wave * 64;
    const int vlo = ((lane >> 4) & 1) * 32 + (lane & 3) * 8 + (4 * hi + ((lane & 15) >> 2)) * 64;
    constexpr float SC = 0.125f * LOG2E;
    const int qi = 32 * rb + r32;
#define SWA_BODY(t, cur) { \
        const int wi = ((t) < nwin) ? t0 + (t) : -1; \
        const bool act = !(wi == 0 && rb >= 2) && !(wi == 5 && rb < 2); \
        if (act) { \
            f32x16 p0, p1; qk_tile(p0, p1, L + KB0 + (cur) * 8192, qr, r32, hi); \
            if ((wi == 0) || (wi == 1) || (wi == 4) || (wi == 5)) { \
                const int dbase = 64 * wi - 128 - qi; \
                _Pragma("unroll") for (int r = 0; r < 16; ++r) { const int d0 = dbase + crow(r, hi), d1 = d0 + 32; \
                    p0[r] = (d0 >= -128 && d0 <= 128) ? p0[r] * SC : -INFINITY; p1[r] = (d1 >= -128 && d1 <= 128) ? p1[r] * SC : -INFINITY; } \
            } else { \
                _Pragma("unroll") for (int r = 0; r < 16; ++r) { p0[r] *= SC; p1[r] *= SC; } \
            } \
            softmax_pv(p0, p1, m, ls, o0, o1, scr, L + VB0 + (cur) * 8192 + vlo, r32, hi); \
        } }
    TileRegs rA, rB, rC, rD;
    { const size_t r0 = SWA_TROW(0); tile_load(rA, Kc + r0 * INC, Vc + r0 * INC, tid); }
    { const size_t r1 = SWA_TROW(1); tile_load(rB, Kc + r1 * INC, Vc + r1 * INC, tid); }
    { const size_t r2 = SWA_TROW(2); tile_load(rC, Kc + r2 * INC, Vc + r2 * INC, tid); }
    { const size_t r3 = SWA_TROW(3); tile_load(rD, Kc + r3 * INC, Vc + r3 * INC, tid); }
    tile_store(rA, L + KB0, L + VB0, tid);
    __syncthreads();
#define SWA_STEP(tt, RL, RS, cur) { \
          \
        { const int tn = (tt) + 4 < nt ? (tt) + 4 : nt - 1; const size_t rn = SWA_TROW(tn); tile_load(RL, Kc + rn * INC, Vc + rn * INC, tid); } \
        SWA_BODY(tt, cur) \
        tile_store(RS, L + KB0 + ((cur) ^ 1) * 8192, L + VB0 + ((cur) ^ 1) * 8192, tid); \
        __syncthreads(); }
    int t = 0;
    for (; t + 4 <= nt; t += 4) {
        SWA_STEP(t, rA, rB, 0) SWA_STEP(t + 1, rB, rC, 1) SWA_STEP(t + 2, rC, rD, 0) SWA_STEP(t + 3, rD, rA, 1)
    }
    if (t < nt) { SWA_STEP(t, rA, rB, 0) if (t + 1 < nt) { SWA_STEP(t + 1, rB, rC, 1) if (t + 2 < nt) { SWA_STEP(t + 2, rC, rD, 0) } } }
#undef SWA_STEP
#undef SWA_BODY
#undef SWA_TROW
    finalize_store(o0, o1, ls, Y + (qrow0 + 32 * rb) * DM + YC_SWA + head * 64, scr, r32, hi);
}

__device__ __forceinline__ void na_unit(const Params& p, int l, int b, int h, int rg, bool isctx, LAS unsigned char* L, int rep = 0) {
    const int tid = tid_opaque(), lane = tid & 63, wave = __builtin_amdgcn_readfirstlane(tid >> 6), r32 = lane & 31, hi = lane >> 5;
    const bf16* Z = ws_z(p); bf16* Y = ws_hb(p);
    const int ig = wave & 3, gr0 = 4 * rg + 2 * (wave >> 2);
    const int rq = gr0 + (r32 >> 4), qcol = 16 * ig + (r32 & 15);
    const size_t qrow = isctx ? (size_t)(NLAT + b * CTX + 32 * wave + r32) : (size_t)(b * SEQ + rq * 64 + qcol);
    bf16x8 qr[4];
    { const bf16* qp = Z + qrow * INC + ZC_NQ + h * 64 + hi * 8;
#pragma unroll
      for (int d0 = 0; d0 < 4; ++d0) qr[d0] = *(const bf16x8*)(qp + d0 * 16); }
    LAS float* rpbl = (LAS float*)(L + RPB);
    if (tid < 465) rpbl[tid] = p.rpb[(size_t)(l * 8 + h) * 465 + tid] * LOG2E;
    float m = -1e30f, ls = 0.f; f32x16 o0, o1;
#pragma unroll
    for (int i = 0; i < 16; ++i) { o0[i] = 0.f; o1[i] = 0.f; }
    int R0 = 4 * rg - 4; R0 = R0 < 0 ? 0 : (R0 > 24 ? 24 : R0);
    int R1 = 4 * rg - 1; R1 = (R1 < 0 ? 0 : (R1 > 24 ? 24 : R1)) + 8;
    const int nband = isctx ? 0 : (R1 - R0), nt = nband + 4;
    int w0 = gr0 - 4; w0 = w0 < 0 ? 0 : (w0 > 24 ? 24 : w0);
    int w1 = gr0 - 3; w1 = (w1 < 0 ? 0 : (w1 > 24 ? 24 : w1)) + 8;
    int rs = rq - 4; rs = rs < 0 ? 0 : (rs > 24 ? 24 : rs);
    int cs = qcol - 8; cs = cs < 0 ? 0 : (cs > 48 ? 48 : cs);
    int key0 = 16 * ig - 8; key0 = key0 < 0 ? 0 : (key0 > 32 ? 32 : key0);
    const bf16* Kc = ws_kvh(p) + kvh_off(0, b, h); const bf16* Vc = ws_kvh(p) + kvh_off(1, b, h);
#define NA_TROW(t) ((t) < nband ? (size_t)(64 * (R0 + (t))) : (size_t)(SEQ + 64 * ((t) - nband)))
    LAS float* scr = (LAS float*)(L + SCR) + wave * 64;
    const int vlo = ((lane >> 4) & 1) * 32 + (lane & 3) * 8 + (4 * hi + ((lane & 15) >> 2)) * 64;
    constexpr float SC = 0.125f * LOG2E;
#define NA_BODY(t, cur) { \
        const int kr = ((t) < nband) ? R0 + (t) : -1; \
        if (kr < 0) { \
            f32x16 p0, p1; qk_tile(p0, p1, L + KB0 + (cur) * 8192, qr, r32, hi); \
            _Pragma("unroll") for (int r = 0; r < 16; ++r) { p0[r] *= SC; p1[r] *= SC; } \
            softmax_pv(p0, p1, m, ls, o0, o1, scr, L + VB0 + (cur) * 8192 + vlo, r32, hi); \
        } else if (kr >= w0 && kr < w1) { \
            f32x16 p0; qk_win(p0, L + KB0 + (cur) * 8192 + key0 * 16, qr, r32, hi); \
            const bool rowok = (kr >= rs) && (kr < rs + 8);                           \
            int dr = kr - rq + 7; dr = dr < 0 ? 0 : (dr > 14 ? 14 : dr); \
            LAS const float* tb = rpbl + dr * 31 + (15 - qcol);                       \
              \
            float bb[16]; \
            _Pragma("unroll") for (int r = 0; r < 16; ++r) { const int k = key0 + crow(r, hi); int kc = k < cs ? cs : k; kc = kc > cs + 15 ? cs + 15 : kc; bb[r] = tb[kc]; } \
            _Pragma("unroll") for (int r = 0; r < 16; ++r) asm volatile("" : "+v"(bb[r])); \
            _Pragma("unroll") for (int r = 0; r < 16; ++r) { const int k = key0 + crow(r, hi); const bool v = rowok && (k >= cs) && (k < cs + 16); p0[r] = v ? p0[r] * SC + bb[r] : -INFINITY; } \
            softmax_pv_win(p0, m, ls, o0, o1, L + VB0 + (cur) * 8192 + vlo + (key0 >> 3) * 512); \
        } }
    TileRegs rA, rB, rC, rD;
    { const size_t r0 = NA_TROW(0); tile_load<64>(rA, Kc + r0 * 64, Vc + r0 * 64, tid); }
    { const size_t r1 = NA_TROW(1); tile_load<64>(rB, Kc + r1 * 64, Vc + r1 * 64, tid); }
    { const size_t r2 = NA_TROW(2); tile_load<64>(rC, Kc + r2 * 64, Vc + r2 * 64, tid); }
    { const size_t r3 = NA_TROW(3); tile_load<64>(rD, Kc + r3 * 64, Vc + r3 * 64, tid); }
    tile_store(rA, L + KB0, L + VB0, tid);
    __syncthreads();
#define NA_STEP(tt, RL, RS, cur) { \
          \
        { const int tn = (tt) + 4 < nt ? (tt) + 4 : nt - 1; const size_t rn = NA_TROW(tn); tile_load<64>(RL, Kc + rn * 64, Vc + rn * 64, tid); } \
        NA_BODY(tt, cur) \
        tile_store(RS, L + KB0 + ((cur) ^ 1) * 8192, L + VB0 + ((cur) ^ 1) * 8192, tid); \
        __syncthreads(); }
    int t = 0;
    for (; t + 4 <= nt; t += 4) {
        NA_STEP(t, rA, rB, 0) NA_STEP(t + 1, rB, rC, 1) NA_STEP(t + 2, rC, rD, 0) NA_STEP(t + 3, rD, rA, 1)
    }
    if (t < nt) { NA_STEP(t, rA, rB, 0) if (t + 1 < nt) { NA_STEP(t + 1, rB, rC, 1) if (t + 2 < nt) { NA_STEP(t + 2, rC, rD, 0) } } }
#undef NA_STEP
#undef NA_BODY
#undef NA_TROW
    finalize_store_lane(o0, o1, ls, Y + qrow * DM + YC_NA + h * 64, hi);
}
}

__device__ __forceinline__ size_t ret_row(int b, int c, int j) { return c < 2 ? (size_t)(NLAT + b * CTX + 128 * c + j) : (size_t)(b * SEQ + 128 * (c - 2) + j); }
__device__ __forceinline__ float log2_sigmoid(float x) { return -log1pf(__expf(-x)) * LOG2E; }
__device__ __forceinline__ int tr_addr(int tile, int key, int cch) { return tile * 8192 + (cch >> 2) * 4096 + (key >> 3) * 512 + (key & 7) * 64 + (cch & 3) * 16; }

__device__ __forceinline__ void r1_unit(const Params& p, int l, int b, int h, int c, LAS unsigned char* L) {
    const int tid = tid_opaque(), lane = tid & 63, wave = __builtin_amdgcn_readfirstlane(tid >> 6), r32 = lane & 31, hi = lane >> 5;
    const bf16* Z = ws_z(p);
    const float lgf = log2_sigmoid(p.dec_f[l * 8 + h]), lgb = log2_sigmoid(p.dec_b[l * 8 + h]);
    LAS unsigned char* KT = L; LAS unsigned char* VF = L + 16384; LAS unsigned char* VBk = L + 32768;
#pragma unroll
    for (int i = 0; i < 2; ++i) { const int q = tid + 512 * i, tok = q >> 3, cch = q & 7;
        const bf16* rp = Z + ret_row(b, c, tok) * INC + h * 64 + cch * 8;
        const u32x4 kv = *(const u32x4*)(rp + ZC_RK), vv = *(const u32x4*)(rp + ZC_RV);
        const int a = tr_addr(tok >> 6, tok & 63, cch);
        *(LAS u32x4*)(KT + a) = kv;
        *(LAS u32x4*)(VF + a) = scale8(vv, ex2(lgf * (float)(127 - tok)));
        *(LAS u32x4*)(VBk + a) = scale8(vv, ex2(lgb * (float)tok)); }
    __syncthreads();
    const int dir = wave >> 2, dvb = (wave >> 1) & 1, dkb = wave & 1;
    const int vlo = ((lane >> 4) & 1) * 32 + (lane & 3) * 8 + (4 * hi + ((lane & 15) >> 2)) * 64;
    LAS const unsigned char* Ab = (dir ? VBk : VF) + dvb * 4096 + vlo; LAS const unsigned char* Bb = KT + dkb * 4096 + vlo;
    f32x16 acc;
#pragma unroll
    for (int i = 0; i < 16; ++i) acc[i] = 0.f;
#pragma unroll
    for (int ks = 0; ks < 8; ++ks) { const int off = (ks >> 2) * 8192 + (ks & 3) * 1024;
        const bf16x8 a = cat8(trrd(Ab + off), trrd(Ab + off + 512)), bb = cat8(trrd(Bb + off), trrd(Bb + off + 512));
        acc = MFMA32(a, bb, acc); }
    float* St = (float*)(p.ws + WS_SST) + ((size_t)((b * 8 + h) * 18 + c) * 2 + dir) * 4096;
#pragma unroll
    for (int r = 0; r < 16; ++r) St[(32 * dvb + crow(r, hi)) * 64 + 32 * dkb + r32] = acc[r];
    __syncthreads();
}
__device__ __forceinline__ void r1_units(const Params& p, int l, int u0, int G, LAS unsigned char* L) {
    const int tid = tid_opaque(), lane = tid & 63, wave = __builtin_amdgcn_readfirstlane(tid >> 6), r32 = lane & 31, hi = lane >> 5;
    const bf16* Z = ws_z(p);
    LAS unsigned char* KT = L; LAS unsigned char* VF = L + 16384; LAS unsigned char* VBk = L + 32768;
    const int dir = wave >> 2, dvb = (wave >> 1) & 1, dkb = wave & 1;
    const int vlo = ((lane >> 4) & 1) * 32 + (lane & 3) * 8 + (4 * hi + ((lane & 15) >> 2)) * 64;
    LAS const unsigned char* Ab = (dir ? VBk : VF) + dvb * 4096 + vlo; LAS const unsigned char* Bb = KT + dkb * 4096 + vlo;
    if (u0 >= 1152) return;
    u32x4 kv[2], vv[2];
    const float dfall = p.dec_f[l * 8 + (lane & 7)], dball = p.dec_b[l * 8 + (lane & 7)];
#define R1_LOAD(u) { const int bh_ = (u) / 18, c_ = (u) % 18; _Pragma("unroll") for (int i = 0; i < 2; ++i) { const int q = tid + 512 * i, tok = q >> 3, cch = q & 7; \
        const bf16* rp = Z + ret_row(bh_ >> 3, c_, tok) * INC + (bh_ & 7) * 64 + cch * 8; kv[i] = *(const u32x4*)(rp + ZC_RK); vv[i] = *(const u32x4*)(rp + ZC_RV); } }
    R1_LOAD(u0)
    asm volatile("" : "+v"(kv[0]), "+v"(kv[1]), "+v"(vv[0]), "+v"(vv[1]));
    for (int u = u0; u < 1152; u += G) {
        const int bh = u / 18, c = u % 18;
        const int h = bh & 7;
        const float lgf = log2_sigmoid(__uint_as_float(__builtin_amdgcn_readlane(__float_as_uint(dfall), h))), lgb = log2_sigmoid(__uint_as_float(__builtin_amdgcn_readlane(__float_as_uint(dball), h)));
#pragma unroll
        for (int i = 0; i < 2; ++i) { const int q = tid + 512 * i, tok = q >> 3, cch = q & 7;
            const int a = tr_addr(tok >> 6, tok & 63, cch);
            *(LAS u32x4*)(KT + a) = kv[i];
            *(LAS u32x4*)(VF + a) = scale8(vv[i], ex2(lgf * (float)(127 - tok)));
            *(LAS u32x4*)(VBk + a) = scale8(vv[i], ex2(lgb * (float)tok)); }
        __syncthreads();
        { const int un = (u + G < 1152) ? u + G : u; R1_LOAD(un) }
        f32x16 acc;
#pragma unroll
        for (int i = 0; i < 16; ++i) acc[i] = 0.f;
#pragma unroll
        for (int ks = 0; ks < 8; ++ks) { const int off = (ks >> 2) * 8192 + (ks & 3) * 1024;
            const bf16x8 a = cat8(trrd(Ab + off), trrd(Ab + off + 512)), bb = cat8(trrd(Bb + off), trrd(Bb + off + 512));
            acc = MFMA32(a, bb, acc); }
        asm volatile("" : "+v"(kv[0]), "+v"(kv[1]), "+v"(vv[0]), "+v"(vv[1]));
        float* St = (float*)(p.ws + WS_SST) + ((size_t)(bh * 18 + c) * 2 + dir) * 4096;
#pragma unroll
        for (int r = 0; r < 16; ++r) St[(32 * dvb + crow(r, hi)) * 64 + 32 * dkb + r32] = acc[r];
        __syncthreads();
    }
#undef R1_LOAD
}

__device__ __forceinline__ void ph_ret_scan(const Params& p, int l) {
    const int tid = tid_opaque();
    const int task = blockIdx.x * 256 + tid;
    if (tid < 256) for (int tk = task; tk < 65536; tk += gridDim.x * 256) {
        const int cd = tk & 7, dv = (tk >> 3) & 63, dir = (tk >> 9) & 1, bh = tk >> 10, h = bh & 7;
        const float lg = log2_sigmoid((dir ? p.dec_b : p.dec_f)[l * 8 + h]), cdec = ex2(lg * 128.f);
        const float* Sb = (const float*)(p.ws + WS_SST) + (size_t)(bh * 18) * 2 * 4096 + dir * 4096 + dv * 64 + cd * 8;
        unsigned char* Ob = p.ws + WS_SIN + (size_t)(bh * 18) * 2 * 8192 + dir * 8192 + cd * 1024 + dv * 16;
        f32x4 a0 = {0.f, 0.f, 0.f, 0.f}, a1 = a0;
#pragma unroll
        for (int g = 0; g < 3; ++g) {
            f32x4 s0[6], s1[6];
#pragma unroll
            for (int k = 0; k < 6; ++k) { const int st = 6 * g + k, c = dir ? (st == 0 ? 1 : (st == 1 ? 0 : 19 - st)) : st; const float* sp = Sb + (size_t)c * 2 * 4096; s0[k] = *(const f32x4*)sp; s1[k] = *(const f32x4*)(sp + 4); }
#pragma unroll
            for (int k = 0; k < 6; ++k) { const int st = 6 * g + k, c = dir ? (st == 0 ? 1 : (st == 1 ? 0 : 19 - st)) : st;
                u32x4 w; w.x = pk2(a0.x, a0.y); w.y = pk2(a0.z, a0.w); w.z = pk2(a1.x, a1.y); w.w = pk2(a1.z, a1.w);
                *(u32x4*)(Ob + (size_t)c * 2 * 8192) = w;
                a0 = a0 * cdec + s0[k]; a1 = a1 * cdec + s1[k]; }
        }
    }
}

__device__ __forceinline__ void r3_pair(const Params& p, int l, int b, int h, int cp, LAS unsigned char* L) {
    const int tid = tid_opaque(), lane = tid & 63, wave = __builtin_amdgcn_readfirstlane(tid >> 6), r32 = lane & 31, hi = lane >> 5;
    const int half = wave >> 2, wq = wave & 3, c = 2 * cp + half, th = tid & 255;
    const bf16* Z = ws_z(p); bf16* Y = ws_hb(p);
    const float lgf = log2_sigmoid(p.dec_f[l * 8 + h]), lgb = log2_sigmoid(p.dec_b[l * 8 + h]);
    LAS unsigned char* Lh = L + half * 49152;
    LAS unsigned char* KT = Lh; LAS unsigned char* VT = Lh + 16384; LAS unsigned char* SF = Lh + 32768; LAS unsigned char* SBk = Lh + 40960;
#pragma unroll
    for (int i = 0; i < 4; ++i) { const int q = th + 256 * i, tok = q >> 3, cch = q & 7;
        const bf16* rp = Z + ret_row(b, c, tok) * INC + h * 64 + cch * 8;
        const u32x4 kv = *(const u32x4*)(rp + ZC_RK), vv = *(const u32x4*)(rp + ZC_RV);
        *(LAS u32x4*)(KT + (tok >> 6) * 8192 + cch * 1024 + (tok & 63) * 16) = kv;
        *(LAS u32x4*)(VT + tr_addr(tok >> 6, tok & 63, cch)) = vv; }
    const int qi = 32 * wq + r32;
    bf16x8 qr[4]; u32x2 gva[4], gvb[4];
    { const bf16* qp = Z + ret_row(b, c, qi) * INC + ZC_RQ + h * 64 + hi * 8;
#pragma unroll
      for (int d0 = 0; d0 < 4; ++d0) qr[d0] = *(const bf16x8*)(qp + d0 * 16);
      const bf16* gp0 = Z + ret_row(b, c, qi) * INC + ZC_RG + h * 64 + 4 * hi;
#pragma unroll
      for (int g = 0; g < 4; ++g) { gva[g] = *(const u32x2*)(gp0 + 8 * g); gvb[g] = *(const u32x2*)(gp0 + 32 + 8 * g); } }
    { const unsigned char* src = p.ws + WS_SIN + (size_t)(((b * 8 + h) * 18 + c) * 2) * 8192;
#pragma unroll
      for (int i = 0; i < 4; ++i) { const int q = th + 256 * i; *(LAS u32x4*)(SF + q * 16) = *(const u32x4*)(src + q * 16); } }
    __syncthreads();
    f32x16 o0, o1;
#pragma unroll
    for (int i = 0; i < 16; ++i) { o0[i] = 0.f; o1[i] = 0.f; }
    const int vlo = ((lane >> 4) & 1) * 32 + (lane & 3) * 8 + (4 * hi + ((lane & 15) >> 2)) * 64;
#pragma unroll
    for (int t = 0; t < 2; ++t) {
        f32x16 p0, p1; att::qk_tile(p0, p1, KT + t * 8192, qr, r32, hi);
#pragma unroll
        for (int r = 0; r < 16; ++r) { const int d0 = qi - (64 * t + crow(r, hi)), d1 = d0 - 32;
            p0[r] *= (d0 >= 0) ? ex2(lgf * (float)d0) : ex2(lgb * (float)(-d0));
            p1[r] *= (d1 >= 0) ? ex2(lgf * (float)d1) : ex2(lgb * (float)(-d1)); }
        att::pv_tile(o0, o1, p0, p1, VT + t * 8192 + vlo);
    }
    { const float xf = ex2(lgf * (float)(qi + 1)), xb = ex2(lgb * (float)(128 - qi));
#pragma unroll
      for (int s = 0; s < 4; ++s) {
          const bf16x8 af = __builtin_bit_cast(bf16x8, scale8(__builtin_bit_cast(u32x4, qr[s]), xf)), ab = __builtin_bit_cast(bf16x8, scale8(__builtin_bit_cast(u32x4, qr[s]), xb));
          LAS const unsigned char* sf = SF + (2 * s + hi) * 1024 + r32 * 16; LAS const unsigned char* sb = SBk + (2 * s + hi) * 1024 + r32 * 16;
          o0 = MFMA32(*(LAS const bf16x8*)sf, af, o0); o1 = MFMA32(*(LAS const bf16x8*)(sf + 512), af, o1);
          o0 = MFMA32(*(LAS const bf16x8*)sb, ab, o0); o1 = MFMA32(*(LAS const bf16x8*)(sb + 512), ab, o1); } }
    { float s1 = 0.f;
#pragma unroll
      for (int r = 0; r < 16; ++r) { o0[r] *= 0.125f; o1[r] *= 0.125f; s1 += o0[r] + o1[r]; }
      const float mean = att::xh_sum(s1) * (1.f / 64.f); float s2 = 0.f;
#pragma unroll
      for (int r = 0; r < 16; ++r) { o0[r] -= mean; o1[r] -= mean; s2 += o0[r] * o0[r] + o1[r] * o1[r]; }
      const float rstd = rsqrtf(att::xh_sum(s2) * (1.f / 64.f) + 1e-6f);
      const size_t row = ret_row(b, c, qi);
      bf16* yp = Y + row * DM + YC_RET + h * 64 + 4 * hi;
#pragma unroll
      for (int g = 0; g < 4; ++g) {
          const u32x2 ga = gva[g], gb = gvb[g]; u32x2 w0, w1;
          w0.x = pk2(silu_f(bf2f(ga.x & 0xffffu)) * o0[4 * g] * rstd, silu_f(__uint_as_float(ga.x & 0xffff0000u)) * o0[4 * g + 1] * rstd);
          w0.y = pk2(silu_f(bf2f(ga.y & 0xffffu)) * o0[4 * g + 2] * rstd, silu_f(__uint_as_float(ga.y & 0xffff0000u)) * o0[4 * g + 3] * rstd);
          w1.x = pk2(silu_f(bf2f(gb.x & 0xffffu)) * o1[4 * g] * rstd, silu_f(__uint_as_float(gb.x & 0xffff0000u)) * o1[4 * g + 1] * rstd);
          w1.y = pk2(silu_f(bf2f(gb.y & 0xffffu)) * o1[4 * g + 2] * rstd, silu_f(__uint_as_float(gb.y & 0xffff0000u)) * o1[4 * g + 3] * rstd);
          *(u32x2*)(yp + 8 * g) = w0; *(u32x2*)(yp + 32 + 8 * g) = w1; } }
    __syncthreads();
}

__device__ __forceinline__ void rope_task(const Params& p, int row, int task) {
    bf16* Z = ws_z(p);
    const int hq = task >> 2, i = task & 3, t = row & 2047;
    const int base = hq < 8 ? ZC_RQ + 64 * hq : (hq < 16 ? ZC_RK + 64 * (hq - 8) : (hq < 24 ? ZC_SQ + 64 * (hq - 16) : ZC_SK + 64 * (hq - 24)));
    const int pos = (i < 2) ? (t >> 6) : (t & 63), f0 = 8 * (i & 1);
    bf16* p1 = Z + (size_t)row * INC + base + 8 * i; bf16* p2 = p1 + 32;
    const u32x4 a = *(const u32x4*)p1, bq = *(const u32x4*)p2; u32x4 oa, ob;
#pragma unroll
    for (int k = 0; k < 4; ++k) {
        const float c0 = ROPE_COS[pos * 16 + f0 + 2 * k], s0 = ROPE_SIN[pos * 16 + f0 + 2 * k], c1 = ROPE_COS[pos * 16 + f0 + 2 * k + 1], s1 = ROPE_SIN[pos * 16 + f0 + 2 * k + 1];
        const float x1l = bf2f(a[k] & 0xffffu), x1h = __uint_as_float(a[k] & 0xffff0000u), x2l = bf2f(bq[k] & 0xffffu), x2h = __uint_as_float(bq[k] & 0xffff0000u);
        oa[k] = pk2(x1l * c0 - x2l * s0, x1h * c1 - x2h * s1); ob[k] = pk2(x1l * s0 + x2l * c0, x1h * s1 + x2h * c1); }
    *(u32x4*)p1 = oa; *(u32x4*)p2 = ob;
}
__device__ __forceinline__ void conv_task(const Params& p, int l, int row, int ch8) {
    const bf16* Z = ws_z(p); bf16* Y = ws_hb(p);
    const int t = (row < NLAT) ? (row & 2047) : ((row - NLAT) & 255), tl = (row < NLAT) ? 2047 : 255;
    const float* w = p.conv_w + (size_t)l * 3 * 512 + ch8 * 8;
    const bf16* zr = Z + (size_t)row * INC + ch8 * 8;
    float acc[8];
#pragma unroll
    for (int k = 0; k < 8; ++k) acc[k] = 0.f;
#pragma unroll
    for (int dt = -1; dt <= 1; ++dt) {
        if ((dt < 0 && t == 0) || (dt > 0 && t == tl)) continue;
        const bf16* zz = zr + (long)dt * INC;
        const u32x4 cc = *(const u32x4*)(zz + ZC_CC), hh = *(const u32x4*)(zz + ZC_CH);
        const f32x4 w0 = *(const f32x4*)(w + (dt + 1) * 512), w1 = *(const f32x4*)(w + (dt + 1) * 512 + 4);
#pragma unroll
        for (int k = 0; k < 4; ++k) { const float wl = (k < 2) ? w0[2 * k] : w1[2 * k - 4], wh = (k < 2) ? w0[2 * k + 1] : w1[2 * k - 3];
            acc[2 * k] += wl * bf2f(cc[k] & 0xffffu) * bf2f(hh[k] & 0xffffu); acc[2 * k + 1] += wh * __uint_as_float(cc[k] & 0xffff0000u) * __uint_as_float(hh[k] & 0xffff0000u); }
    }
    const u32x4 bb = *(const u32x4*)(zr + ZC_CB); u32x4 o;
#pragma unroll
    for (int k = 0; k < 4; ++k) o[k] = pk2(acc[2 * k] * bf2f(bb[k] & 0xffffu), acc[2 * k + 1] * __uint_as_float(bb[k] & 0xffff0000u));
    *(u32x4*)(Y + (size_t)row * DM + YC_CONV + ch8 * 8) = o;
}

__device__ __forceinline__ void ph_norm_router(const Params& p, int l, LAS unsigned char* lds) {
    const int tid = tid_opaque(), lane = tid & 63, wave = __builtin_amdgcn_readfirstlane(tid >> 6);
    constexpr int WPITCH = 4112;
    const float* wr = p.w_router + (size_t)l * 2048 * 16;
    { f32x4 t[16];
#pragma unroll
      for (int k = 0; k < 16; ++k) { const int n = tid + NTHR * k; t[k] = *(const f32x4*)(wr + (n >> 2) * 16 + (n & 3) * 4); }
#pragma unroll
      for (int k = 0; k < 16; ++k) { const int n = tid + NTHR * k, kk = n >> 2, q = n & 3;
#pragma unroll
          for (int i = 0; i < 4; ++i) *(LAS bf16*)(lds + (4 * q + i) * WPITCH + kk * 2) = (bf16)f2bf(t[k][i]); } }
    const int gw = blockIdx.x * NWAVES + wave, NGW = gridDim.x * NWAVES;
    const int nrows = (l == 0) ? NROW : NLAT;
    float* aff = (float*)(p.ws + WS_AFF);
    const int rpw = (nrows + NGW - 1) / NGW, r0 = gw * rpw, r1 = (r0 + rpw < nrows) ? r0 + rpw : nrows;
    { int cur = -1; f32x4 wv[8], sv[8], vn[8];
      if (r0 < r1) load_row8_bf16(vn, ws_xb(p) + (size_t)r0 * DM, lane);
      for (int row = r0; row < r1; ++row) {
          f32x4 v[8];
#pragma unroll
          for (int j = 0; j < 8; ++j) v[j] = vn[j];
          if (row + 1 < r1) load_row8_bf16(vn, ws_xb(p) + (size_t)(row + 1) * DM, lane);
          const int arow = (row < NLAT) ? (row >> 11) : 8;
          if (arow != cur) { const float* ad = ws_ada(p) + (size_t)(l * 9 + arow) * ADAW; load_coeffs(wv, sv, p.norm_ffn + l * DM, ad + 4 * 2048, ad + 3 * 2048, lane); cur = arow; }
          const float rstd = row_rstd(v);
#pragma unroll
          for (int j = 0; j < 8; ++j) v[j] = v[j] * rstd * wv[j] + sv[j];
          store_row8_bf16(v, ws_hb(p) + (size_t)row * DM, lane);
      } }
    asm volatile("s_waitcnt vmcnt(0)" ::: "memory");
    __syncthreads();
    if (tid < 64) { __builtin_amdgcn_fence(__ATOMIC_ACQUIRE, "agent"); asm volatile("s_waitcnt vmcnt(0)" ::: "memory"); }
    __syncthreads();
    const int R = rpw * NWAVES, R0 = blockIdx.x * R, R1 = (R0 + R < nrows) ? R0 + R : nrows;
    if (R0 + 16 * wave < R1) {
        const int fr = lane & 15, kg = lane >> 4;
        int arow_ = R0 + 16 * wave + fr; if (arow_ > R1 - 1) arow_ = R1 - 1;
        const bf16* ap = ws_hb(p) + (size_t)arow_ * DM + 8 * kg;
        LAS const unsigned char* bp = lds + fr * WPITCH + 16 * kg;
        f32x4 acc = {0.f, 0.f, 0.f, 0.f};
        for (int s0 = 0; s0 < 64; s0 += 8) {
            bf16x8 af[8];
#pragma unroll
            for (int s = 0; s < 8; ++s) af[s] = *(const bf16x8*)(ap + 32 * (s0 + s));
#pragma unroll
            for (int s = 0; s < 8; ++s) acc = __builtin_amdgcn_mfma_f32_16x16x32_bf16(af[s], *(LAS const bf16x8*)(bp + 64 * (s0 + s)), acc, 0, 0, 0);
        }
#pragma unroll
        for (int r = 0; r < 4; ++r) {
            float mx = acc[r];
#pragma unroll
            for (int o = 1; o < 16; o <<= 1) mx = fmaxf(mx, __shfl_xor(mx, o));
            const float ex = __expf(acc[r] - mx); float sum = ex;
#pragma unroll
            for (int o = 1; o < 16; o <<= 1) sum += __shfl_xor(sum, o);
            const int row = R0 + 16 * wave + 4 * kg + r;
            if (row < R1) aff[(size_t)row * 16 + fr] = ex / sum;
        }
    }
}

__device__ __forceinline__ int moe_mpe(int l) { return l == 0 ? 2304 : 2048; }
constexpr int CW_SCF = 8192;
constexpr int CW_TKF = 3072;
constexpr int RIDX_OFF = 131072 + 1024;
__device__ __forceinline__ void ph_topk(const Params& p, int l, LAS unsigned char* lds) {
    const int tid = tid_opaque(), lane = tid & 63, wave = __builtin_amdgcn_readfirstlane(tid >> 6);
    const int nprob = (l == 0) ? 256 : 128, MPE = moe_mpe(l);
    const float* aff = (const float*)(p.ws + WS_AFF); int* sel = (int*)(p.ws + WS_SEL); int* idx = (int*)(p.ws + WS_IDX); float* gatev = (float*)(p.ws + WS_GATEV);
    LAS int* lcnt = (LAS int*)lds;
    for (int prob = blockIdx.x; prob < nprob; prob += gridDim.x) {
        const bool isctx = prob >= 128; const int q = prob & 127, b = q >> 4, e = q & 15;
        const int T = isctx ? CTX : SEQ, cap = isctx ? 32 : 256, row0 = isctx ? NLAT + b * CTX : b * SEQ, slot0 = e * MPE + (isctx ? 2048 + b * 32 : b * 256);
        if (tid < 48) lcnt[tid] = 0;
        unsigned u[4];
#pragma unroll
        for (int k = 0; k < 4; ++k) { const int t = 256 * wave + 64 * k + lane; u[k] = (t < T) ? __float_as_uint(aff[(size_t)(row0 + t) * 16 + e]) : 0u; }
        __syncthreads();
        unsigned tau = 0u;
        for (int bit = 29; bit >= 0; --bit) {
            const unsigned cand = tau | (1u << bit); int cnt = 0;
#pragma unroll
            for (int k = 0; k < 4; ++k) cnt += __popcll(__ballot(u[k] >= cand));
            if (lane == 0 && cnt) __hip_atomic_fetch_add(&lcnt[bit], cnt, __ATOMIC_RELAXED, __HIP_MEMORY_SCOPE_WORKGROUP);
            __syncthreads();
            if (lcnt[bit] >= cap) tau = cand;
        }
        int ngt = 0, neq = 0;
#pragma unroll
        for (int k = 0; k < 4; ++k) { const int t = 256 * wave + 64 * k + lane; ngt += __popcll(__ballot(u[k] > tau)); neq += __popcll(__ballot((t < T) && u[k] == tau)); }
        if (lane == 0) { lcnt[32 + wave] = ngt; lcnt[40 + wave] = neq; }
        __syncthreads();
        int tgt = 0, eqb = 0;
#pragma unroll
        for (int w = 0; w < 8; ++w) { tgt += lcnt[32 + w]; }
        const int need_eq = cap - tgt;
        int base = 0;
#pragma unroll
        for (int w = 0; w < 8; ++w) if (w < wave) { const int ne = lcnt[40 + w]; int tk = need_eq - eqb; tk = tk < 0 ? 0 : (tk > ne ? ne : tk); base += lcnt[32 + w] + tk; eqb += ne; }
        const unsigned long long lt = (1ull << lane) - 1ull;
        int eqc = eqb;
#pragma unroll
        for (int k = 0; k < 4; ++k) { const int t = 256 * wave + 64 * k + lane; const bool valid = t < T;
            const bool gt = u[k] > tau, eq = valid && (u[k] == tau);
            const unsigned long long em = __ballot(eq);
            const bool take = gt || (eq && (eqc + __popcll(em & lt) < need_eq));
            const unsigned long long sm = __ballot(take);
            const int slot = base + __popcll(sm & lt);
            if (valid) { if (take) { idx[slot0 + slot] = row0 + t; gatev[slot0 + slot] = __uint_as_float(u[k]); }
                         sel[(size_t)(row0 + t) * 16 + e] = take ? slot : -1; }
            base += __popcll(sm); eqc += __popcll(em); }
        asm volatile("s_waitcnt vmcnt(0)" ::: "memory");
        __syncthreads();
        if (tid == 0) { __builtin_amdgcn_fence(__ATOMIC_RELEASE, "agent"); asm volatile("s_waitcnt vmcnt(0)" ::: "memory");
            __hip_atomic_store((unsigned*)(p.ws + WS_CTL) + CW_TKF + l * 256 + prob, 1u, __ATOMIC_RELAXED, __HIP_MEMORY_SCOPE_AGENT); }
    }
}
template <class Sched> __device__ __forceinline__ void topk_wait(const Params& p, int l, const Sched& S, int tpe, int tid) {
    if (tid < 64) {
        const int i = tid >> 3, sub = tid & 7; pg8::Unit u; int flag = -1;
        if (i < 6 && S.next(i, u)) { const int e = u.pm / tpe, j = u.pm % tpe; if (j < 8) { if (sub == 0) flag = j * 16 + e; } else flag = 128 + sub * 16 + e; }
        if (flag >= 0) { const unsigned* f = (const unsigned*)(p.ws + WS_CTL) + CW_TKF + l * 256 + flag; unsigned sp = 0;
            while (__hip_atomic_load(f, __ATOMIC_RELAXED, __HIP_MEMORY_SCOPE_AGENT) == 0u && ++sp < (1u << 20)) __builtin_amdgcn_s_sleep(2); }
        __builtin_amdgcn_fence(__ATOMIC_ACQUIRE, "agent"); asm volatile("s_waitcnt vmcnt(0)" ::: "memory");
    }
    __syncthreads();
}


__device__ __forceinline__ void ph_combine(const Params& p, int l) {
    const int tid_ = tid_opaque(), lane = tid_ & 63, wave = __builtin_amdgcn_readfirstlane(tid_ >> 6);
    const int gw = blockIdx.x * NWAVES + wave, NGW = gridDim.x * NWAVES;
    const int nrows = (l == 0) ? NROW : NLAT, MPE = moe_mpe(l);
    const int* sel = (const int*)(p.ws + WS_SEL); const bf16* YE = ws_z(p);
    const int rpw = (nrows + NGW - 1) / NGW, r0 = gw * rpw, r1 = (r0 + rpw < nrows) ? r0 + rpw : nrows;
    int cur = -1; f32x4 g2[8], vn[8]; int seln = -1;
    f32x4 wfin[8];
    if (l != 0) {
#pragma unroll
        for (int j = 0; j < 8; ++j) wfin[j] = *(const f32x4*)(p.norm_final + 256 * j + 4 * lane); }
    if (r0 < r1) { load_row8_bf16(vn, ws_xb(p) + (size_t)r0 * DM, lane); seln = (lane < 16) ? sel[(size_t)r0 * 16 + lane] : -1; }
    for (int row = r0; row < r1; ++row) {
        f32x4 v[8];
#pragma unroll
        for (int j = 0; j < 8; ++j) v[j] = vn[j];
        const int selv = seln;
        if (row + 1 < r1) { load_row8_bf16(vn, ws_xb(p) + (size_t)(row + 1) * DM, lane); seln = (lane < 16) ? sel[(size_t)(row + 1) * 16 + lane] : -1; }
        const bool isctx = row >= NLAT;
        const int arow = isctx ? 8 : (row >> 11);
        const int sbase = isctx ? 2048 + ((row - NLAT) >> 8) * 32 : (row >> 11) * 256;
        if (arow != cur) { const float* ad = ws_ada(p) + (size_t)(l * 9 + arow) * ADAW;
#pragma unroll
            for (int j = 0; j < 8; ++j) g2[j] = *(const f32x4*)(ad + 5 * 2048 + 256 * j + 4 * lane);
            cur = arow; }
        f32x4 acc[8];
#pragma unroll
        for (int j = 0; j < 8; ++j) acc[j] = (f32x4){0.f, 0.f, 0.f, 0.f};
        unsigned long long mask = __ballot(selv >= 0);
        while (mask) {
            const int e0 = __builtin_ctzll(mask); mask &= mask - 1;
            const bool two = mask != 0ull; const int e1 = two ? __builtin_ctzll(mask) : e0; if (two) mask &= mask - 1;
            const int s0 = __builtin_amdgcn_readlane(selv, e0), s1 = __builtin_amdgcn_readlane(selv, e1);
            const bf16* y0 = YE + (size_t)(e0 * MPE + sbase + s0) * DM + 4 * lane; const bf16* y1 = YE + (size_t)(e1 * MPE + sbase + s1) * DM + 4 * lane;
            u32x2 a[8], bq[8];
#pragma unroll
            for (int j = 0; j < 8; ++j) a[j] = *(const u32x2*)(y0 + 256 * j);
            if (two) {
#pragma unroll
                for (int j = 0; j < 8; ++j) bq[j] = *(const u32x2*)(y1 + 256 * j); }
#pragma unroll
            for (int j = 0; j < 8; ++j) { acc[j].x += bf2f(a[j].x & 0xffffu); acc[j].y += __uint_as_float(a[j].x & 0xffff0000u); acc[j].z += bf2f(a[j].y & 0xffffu); acc[j].w += __uint_as_float(a[j].y & 0xffff0000u); }
            if (two) {
#pragma unroll
                for (int j = 0; j < 8; ++j) { acc[j].x += bf2f(bq[j].x & 0xffffu); acc[j].y += __uint_as_float(bq[j].x & 0xffff0000u); acc[j].z += bf2f(bq[j].y & 0xffffu); acc[j].w += __uint_as_float(bq[j].y & 0xffff0000u); } }
        }
#pragma unroll
        for (int j = 0; j < 8; ++j) v[j] = v[j] + g2[j] * acc[j];
        const float rstd = row_rstd(v);
        if (l == 0) {
            store_row8_bf16(v, ws_xb(p) + (size_t)row * DM, lane);
            const float* ad1 = ws_ada(p) + (size_t)(1 * 9 + arow) * ADAW;
            modulate8(v, rstd, p.norm_mix + 1 * DM, ad1 + 2048, ad1, lane);
            store_row8_bf16(v, ws_hb(p) + (size_t)row * DM, lane);
        } else {
#pragma unroll
            for (int j = 0; j < 8; ++j) *(f32x4*)(p.out + (size_t)row * DM + 256 * j + 4 * lane) = v[j] * rstd * wfin[j];
        }
    }
}

constexpr int N_PHASES = 12;
template <int PH> __device__ __forceinline__ void run_phase(const Params& p, int l, LAS unsigned char* lds, int rep) {
    const int G = gridDim.x, bid = blockIdx.x, tid = tid_opaque();
    const bool need_ctx = (l == 0);
    const int vb = (G % 8 == 0) ? (bid & 7) * (G >> 3) + (bid >> 3) : bid;
    if constexpr (PH == 0) ph_prologue(p, lds);
    if constexpr (PH == 1) ph_modnorm0(p);
    if constexpr (PH == 2) {
        pg8::Gemm g{ws_hb(p), (const bf16*)(p.ws + WS_WIN) + (size_t)l * INC * 2048, NROW, INC, DM};
        { LAS float* rl = (LAS float*)(lds + ROPE_LDS);
          for (int i = tid; i < 1024; i += NTHR) { rl[i] = ROPE_COS[i]; rl[1024 + i] = ROPE_SIN[i]; } }
        __syncthreads();
        pg8::EpiZRope E{ws_z(p), (LAS const float*)(lds + ROPE_LDS), (LAS const float*)(lds + ROPE_LDS) + 1024, ws_kvh(p)};
        if (l == DEPTH - 1) { pg8::SkipOrder S; S.init(G, bid);
            pg8::gemm_phase<pg8::EpiZRope, pg8::SkipOrder, true, true>(lds, g, S, E);
            pg8::QuadOrder Q; Q.init(G, bid);
            pg8::gemm_phase<pg8::EpiZRope, pg8::QuadOrder, true, true, false, true>(lds, g, Q, E); }
        else { pg8::StaticOrder S; S.init(NROW, INC, G, bid);
            pg8::gemm_phase<pg8::EpiZRope, pg8::StaticOrder, true, true>(lds, g, S, E); }
        if (l == 0 && !rep && G == 256 && bid >= 120 && TAIL_P2 > 0) tail_convert(p, TAIL_OFF_P2, TAIL_P2, bid - 120, G - 120, lds);
    }
    if constexpr (PH == 3) {
        const int nu = 512 + (need_ctx ? 64 : 0);
        if (rep != 3) for (int u = vb; u < nu; u += G) {
            if (u < 576) { const bool ic = u >= 512; const int q = u - 512; att::na_unit(p, l, ic ? q >> 3 : u >> 6, ic ? q & 7 : (u >> 3) & 7, ic ? 0 : u & 7, ic, lds, rep); }
        }
        const int gt = bid * NTHR + tid, NT = G * NTHR;
        const int crows = need_ctx ? NROW : NLAT;
        if (rep != 2 && rep < 4) for (int i = gt; i < crows * 64; i += NT) conv_task(p, l, i >> 6, i & 63);
    }
    if constexpr (PH == 4) {
        const int nsu = 512 + (need_ctx ? 64 : 0);
        if (rep != 3) for (int u = (vb + 128) % G; u < nsu; u += G) { const bool ic = u >= 512; const int q = u - 512;
            att::swa_unit(p, l, ic ? q >> 3 : u >> 6, ic ? (q >> 2) & 1 : (u >> 5) & 1, ic ? (q >> 1) & 1 : (u >> 1) & 15, ic ? q & 1 : u & 1, ic, lds); }
        __syncthreads();
        if (rep != 2) r1_units(p, l, bid, G, lds);
    }
    if constexpr (PH == 5) {
        const int c0 = need_ctx ? 0 : 1, npair = 9 - c0;
        unsigned* sflag = (unsigned*)(p.ws + WS_CTL) + CW_SCF + l * 1024;
        if (!rep) { ph_ret_scan(p, l);
            asm volatile("s_waitcnt vmcnt(0)" ::: "memory"); __syncthreads();
            if (tid == 0) { __builtin_amdgcn_fence(__ATOMIC_RELEASE, "agent"); asm volatile("s_waitcnt vmcnt(0)" ::: "memory"); __hip_atomic_store(sflag + bid, 1u, __ATOMIC_RELAXED, __HIP_MEMORY_SCOPE_AGENT); } }
        for (int u = bid; u < 64 * npair; u += G) { const int bh = u / npair, cp = c0 + u % npair;
            if (!rep) {
                if (tid < 64) { const int nf = (G == 256) ? 4 : G, f0 = (G == 256) ? 4 * bh : 0;
                    for (int f = tid; f < nf; f += 64) { unsigned sp = 0; while (__hip_atomic_load(sflag + f0 + f, __ATOMIC_RELAXED, __HIP_MEMORY_SCOPE_AGENT) == 0u && ++sp < (1u << 20)) __builtin_amdgcn_s_sleep(2); }
                    __builtin_amdgcn_fence(__ATOMIC_ACQUIRE, "agent"); asm volatile("s_waitcnt vmcnt(0)" ::: "memory"); }
                __syncthreads(); }
            r3_pair(p, l, bh >> 3, bh & 7, cp, lds); }
    }
    if constexpr (PH == 6) { if (!(rep && l == 1)) {
        const int M = need_ctx ? NROW : NLAT;
        pg8::Gemm g{ws_hb(p), (const bf16*)(p.ws + WS_WOUT) + (size_t)l * 2048 * 2048, M, DM, DM}; pg8::StaticOrder S; S.init(M, DM, G, bid);
        if (l == 0) { pg8::EpiResGate<true> E{p.x, p.ctx, ws_xb(p), ws_ada(p) + (size_t)l * 9 * ADAW, 2 * 2048};
            pg8::gemm_phase<pg8::EpiResGate<true>, pg8::StaticOrder, true, true>(lds, g, S, E);
            if (!rep && G == 256 && bid >= 64 && TAIL_P6 > 0) tail_convert(p, TAIL_OFF_P6, TAIL_P6, bid - 64, G - 64, lds); }
        else { pg8::EpiResGate<false> E{nullptr, nullptr, ws_xb(p), ws_ada(p) + (size_t)l * 9 * ADAW, 2 * 2048};
            pg8::gemm_phase<pg8::EpiResGate<false>, pg8::StaticOrder, true, true>(lds, g, S, E); }
    } }
    if constexpr (PH == 7) ph_norm_router(p, l, lds);
    if constexpr (PH == 9) {
        const int tpe = need_ctx ? 9 : 8;
        pg8::GroupedOrder S; S.init(tpe, G, bid);
        if (!rep) { ph_topk(p, l, lds); topk_wait(p, l, S, tpe, tid); }
        { LAS int* rl = (LAS int*)(lds + RIDX_OFF); const int* idx = (const int*)(p.ws + WS_IDX); pg8::Unit u;
          for (int i = 0; S.next(i, u); ++i) if (tid < 256) rl[i * 256 + tid] = idx[u.pm * 256 + tid];
          __syncthreads(); }
        pg8::Gemm g{ws_hb(p), (const bf16*)(p.ws + WS_WGU) + (size_t)l * 16 * 2048 * 2048, 16 * tpe * 256, 2048, DM, (const LAS int*)(lds + RIDX_OFF)};
        pg8::EpiSiluMul E{(bf16*)(p.ws + WS_ACT)};
        pg8::gemm_phase<pg8::EpiSiluMul, pg8::GroupedOrder, true, true, true>(lds, g, S, E);
        if (l == 0 && !rep && G == 256 && bid >= 128 && TAIL_P9 > 0) tail_convert(p, TAIL_OFF_P9, TAIL_P9, bid - 128, G - 128, lds);
    }
    if constexpr (PH == 10) {
        const int tpe = need_ctx ? 9 : 8;
        pg8::Gemm g{(const bf16*)(p.ws + WS_ACT), (const bf16*)(p.ws + WS_WD) + (size_t)l * 16 * 2048 * 1024, 16 * tpe * 256, 2048, EFF}; pg8::GroupedOrder S; S.init(tpe, G, bid);
        pg8::EpiDown E{ws_z(p), (const float*)(p.ws + WS_GATEV)};
        pg8::gemm_phase<pg8::EpiDown, pg8::GroupedOrder, true, true>(lds, g, S, E);
        if (l == 0 && !rep && G == 256 && bid >= 128 && TAIL_P10 > 0) tail_convert(p, TAIL_OFF_P10, TAIL_P10, bid - 128, G - 128, lds);
    }
    if constexpr (PH == 11) { if (!rep) ph_combine(p, l); }
}

#ifndef MEGA
#define MEGA 1
#endif
template <int PH> __global__ void __launch_bounds__(NTHR, 2) k_phase(Params p, int l) {
    extern __shared__ __attribute__((aligned(16))) unsigned char lds_raw[];
    run_phase<PH>(p, l, (LAS unsigned char*)lds_raw, 0);
}

#if MEGA
__global__ void __launch_bounds__(NTHR, 2) k_mega(Params p) {
    extern __shared__ __attribute__((aligned(16))) unsigned char lds_raw[];
    LAS unsigned char* lds = (LAS unsigned char*)lds_raw;
    volatile LAS unsigned* MISC = (volatile LAS unsigned*)(lds + MISC_OFF);
    if (threadIdx.x < 32) MISC[threadIdx.x] = 0u;
    __syncthreads();
    XcdBarrier bar = xcd_barrier_post((unsigned*)(p.ws + WS_CTL) + CW_BAR, MISC + 8);
#ifndef REPEAT_MASK
#define REPEAT_MASK 0
#endif
#ifndef REPEAT_SUB
#define REPEAT_SUB 1
#endif
#define RP(k, l) do { run_phase<k>(p, l, lds, 0); xcd_barrier(bar); if ((REPEAT_MASK >> k) & 1) { run_phase<k>(p, l, lds, REPEAT_SUB); xcd_barrier(bar); } } while (0)
    RP(0, 0); RP(1, 0);
#ifdef EXTRA_BARRIERS
    for (int i_ = 0; i_ < EXTRA_BARRIERS; ++i_) xcd_barrier(bar);
#endif
#define LAYER_PHASES(l) RP(2, l); run_phase<3>(p, l, lds, 0); __syncthreads(); if ((REPEAT_MASK >> 3) & 1) { run_phase<3>(p, l, lds, REPEAT_SUB); __syncthreads(); } RP(4, l); RP(5, l); RP(6, l); RP(7, l); RP(9, l); RP(10, l);
    LAYER_PHASES(0) RP(11, 0);
    LAYER_PHASES(1) run_phase<11>(p, 1, lds, 0);
#undef RP
#undef LAYER_PHASES
}
#endif

template <int PH> static void launch_phase(const Params& p, int l, int grid, hipStream_t stream) {
    static bool attr_set = false;
    if (!attr_set) { (void)hipFuncSetAttribute((const void*)k_phase<PH>, hipFuncAttributeMaxDynamicSharedMemorySize, LDS_BYTES); attr_set = true; }
    hipLaunchKernelGGL(k_phase<PH>, dim3(grid), dim3(NTHR), LDS_BYTES, stream, p, l);
}

extern "C" void kernel_launch(void* const* d_in, const int* in_sizes, int n_in, void* d_out, int out_size, void* d_ws, size_t ws_size, hipStream_t stream) {
    static int grid = 0;
    if (grid == 0) {
        if (n_in != 20 || in_sizes[0] != NLAT * DM || out_size != NLAT * DM || ws_size < WS_END) {
            fprintf(stderr, "kernel_launch: unexpected problem shape (n_in %d, in0 %d, out %d, ws %zu; need ws >= %zu); nothing launched\n", n_in, n_in > 0 ? in_sizes[0] : -1, out_size, ws_size, (size_t)WS_END);
            grid = -1; return; }
        int dev = 0, cus = 0;
        if (hipGetDevice(&dev) != hipSuccess || hipDeviceGetAttribute(&cus, hipDeviceAttributeMultiprocessorCount, dev) != hipSuccess) { grid = -1; return; }
#if MEGA
        if (hipFuncSetAttribute((const void*)k_mega, hipFuncAttributeMaxDynamicSharedMemorySize, LDS_BYTES) != hipSuccess) { fprintf(stderr, "kernel_launch: hipFuncSetAttribute failed\n"); grid = -1; return; }
        int per_cu = 0;
        if (hipOccupancyMaxActiveBlocksPerMultiprocessor(&per_cu, (const void*)k_mega, NTHR, LDS_BYTES) != hipSuccess || per_cu < 1) { fprintf(stderr, "kernel_launch: occupancy query reports %d blocks per CU\n", per_cu); }
        (void)hipGetLastError();
#endif
        grid = cus;
    }
    if (grid < 0) return;
    Params p{};
    p.x = (const float*)d_in[0]; p.c = (const float*)d_in[1]; p.ctx = (const float*)d_in[2]; p.c_ctx = (const float*)d_in[3]; p.w_ada = (const float*)d_in[4]; p.b_ada = (const float*)d_in[5];
    p.norm_mix = (const float*)d_in[6]; p.norm_ffn = (const float*)d_in[7]; p.w_in = (const float*)d_in[8]; p.w_out = (const float*)d_in[9]; p.dec_f = (const float*)d_in[10]; p.dec_b = (const float*)d_in[11];
    p.conv_w = (const float*)d_in[12]; p.sink = (const float*)d_in[13]; p.rpb = (const float*)d_in[14]; p.w_router = (const float*)d_in[15]; p.w_gate = (const float*)d_in[16]; p.w_up = (const float*)d_in[17];
    p.w_down = (const float*)d_in[18]; p.norm_final = (const float*)d_in[19]; p.out = (float*)d_out; p.ws = (unsigned char*)d_ws;
    if (hipMemsetAsync((char*)d_ws + WS_CTL, 0, CTL_ZERO_BYTES, stream) != hipSuccess) { fprintf(stderr, "kernel_launch: memset failed\n"); return; }
#if MEGA
    hipLaunchKernelGGL(k_mega, dim3(grid), dim3(NTHR), LDS_BYTES, stream, p);
#else
    launch_phase<0>(p, 0, grid, stream); launch_phase<1>(p, 0, grid, stream);
    for (int l = 0; l < DEPTH; ++l) {
        launch_phase<2>(p, l, grid, stream); launch_phase<3>(p, l, grid, stream); launch_phase<4>(p, l, grid, stream); launch_phase<5>(p, l, grid, stream); launch_phase<6>(p, l, grid, stream);
        launch_phase<7>(p, l, grid, stream); launch_phase<9>(p, l, grid, stream); launch_phase<10>(p, l, grid, stream); launch_phase<11>(p, l, grid, stream);
    }
#endif
}
```

```cpp
#include <hip/hip_runtime.h>
#include <cstdio>
#include <cstdint>
__device__ __forceinline__ int tid_opaque() { int t = (int)threadIdx.x; asm volatile("" : "+v"(t)); return t; }
#define MEGA 1
namespace pg8 {
#define PG8_LAS __attribute__((address_space(3)))
typedef unsigned short bf16_t;
typedef short bf16x8 __attribute__((ext_vector_type(8)));
typedef float f32x4 __attribute__((ext_vector_type(4)));
typedef unsigned u32x4 __attribute__((ext_vector_type(4)));
constexpr int BM = 256, BK = 64, HALF = 128, HTB = HALF * BK * 2  , STAGE_BYTES = 8 * HTB, NXCD = 8, WGM = 8;

__host__ __device__ __forceinline__ int lds_byte(int r, int c) { const int st = (r >> 4) * 2 + (c >> 5), rr = r & 15, cc = c & 31, ob = rr * 64 + cc * 2; return st * 1024 + (ob ^ (((ob >> 9) & 1) << 5)); }
__host__ __device__ __forceinline__ void stage_rc(int b, int& R, int& C) { const int st = b / 1024, sb = b % 1024, swz = sb ^ (((sb >> 9) & 1) << 5); R = (st >> 1) * 16 + swz / 64; C = (st & 1) * 32 + (swz % 64) / 2; }
__host__ __device__ __forceinline__ int perm32(int rho) { const int n = rho >> 4, i = rho & 15; return 8 * (i >> 2) + 4 * n + (i & 3); }

struct Unit { int pm, pn, pb, q; };
struct Gemm { const bf16_t* A; const bf16_t* Bt; int M, N, K; const PG8_LAS int* ridx; };

struct StaticOrder {
    int nM, nN, nwg, G, c;
    __host__ __device__ void init(int M, int N, int G_, int c_) { nM = M / BM; nN = N / BM; nwg = nM * nN; G = G_; c = c_; }
    __host__ __device__ bool next(int i, Unit& u) const {
        const long L = (long)i * G + c; if (L >= nwg) return false;
        int wgid = (int)L; { const int q = nwg / NXCD, r = nwg % NXCD, xcd = wgid % NXCD, off = wgid / NXCD; wgid = (xcd < r ? xcd * (q + 1) : r * (q + 1) + (xcd - r) * q) + off; }
        const int nig = WGM * nN, gid = wgid / nig, fm = gid * WGM, gsz = (nM - fm) < WGM ? (nM - fm) : WGM;
        u.pm = fm + ((wgid % nig) % gsz); u.pn = (wgid % nig) / gsz; u.pb = u.pn; return true;
    }
    __device__ __forceinline__ void a_ready(const Unit&) const {}
    __device__ __forceinline__ void done(const Unit&) const {}
};

__device__ __forceinline__ unsigned cvt_pk_bf16(float lo, float hi) { unsigned r; asm volatile("v_cvt_pk_bf16_f32 %0, %1, %2" : "=v"(r) : "v"(lo), "v"(hi)); return r; }
typedef float f32x2 __attribute__((ext_vector_type(2)));
__device__ __forceinline__ f32x2 gelu_pk(f32x2 v) {
    const f32x2 av = __builtin_elementwise_abs(v), d = av * 0.2316418882f + 1.0f;
    f32x2 t; t.x = __builtin_amdgcn_rcpf(d.x); t.y = __builtin_amdgcn_rcpf(d.y);
    f32x2 q = t * 0.5307027145f + (-0.7265760135f); q = q * t + 0.7107068705f; q = q * t + (-0.142248368f); q = q * t + 0.127414796f; q = q * t;
    const f32x2 s = (v * v) * (-0.72134752044f);
    f32x2 e; e.x = __builtin_amdgcn_exp2f(s.x); e.y = __builtin_amdgcn_exp2f(s.y);
    const f32x2 m = v * (q * e), r = v - m;
    f32x2 o; o.x = v.x < 0.f ? m.x : r.x; o.y = v.y < 0.f ? m.y : r.y; return o;
}

template <int ACT  > struct EpiBf16 {
    static constexpr bool PERM = true, AFTER_DRAIN = false; static_assert(ACT == 0 || ACT == 1, "EpiBf16: ACT is 0 (none) or 1 (gelu_pk)");
    bf16_t* O; int ldc; const float* bias; int split_cols; size_t split_stride; float scale0;
    __device__ __forceinline__ void operator()(const f32x4 (&acc)[2][2][4][2], const Unit& u, int wr, int wc, int fr, int fq) const {
        const int row0 = u.pm * BM + wr * 64 + fr; int colt = u.pn * BM; bf16_t* base = O;
        float sc = 1.f; if (split_cols) { const int t = colt / split_cols; base += (size_t)t * split_stride; colt -= t * split_cols; if (t == 0) sc = scale0; }
        const int col0 = colt + wc * 32 + 8 * fq, bcol0 = u.pn * BM + wc * 32 + 8 * fq;
        f32x4 bv[2][2];
#pragma unroll
        for (int bj = 0; bj < 2; ++bj)
#pragma unroll
            for (int n = 0; n < 2; ++n) bv[bj][n] = bias ? *(const f32x4*)(bias + bcol0 + bj * HALF + 4 * n) : (f32x4){0.f, 0.f, 0.f, 0.f};
#pragma unroll
        for (int ai = 0; ai < 2; ++ai)
#pragma unroll
            for (int m = 0; m < 4; ++m) { bf16_t* rowp = base + (size_t)(row0 + ai * HALF + m * 16) * ldc + col0;
#pragma unroll
                for (int bj = 0; bj < 2; ++bj) { f32x4 v0 = acc[ai][bj][m][0] + bv[bj][0], v1 = acc[ai][bj][m][1] + bv[bj][1];
                    if (ACT == 1) { f32x2 a = gelu_pk((f32x2){v0[0], v0[1]}), b = gelu_pk((f32x2){v0[2], v0[3]}), c = gelu_pk((f32x2){v1[0], v1[1]}), d = gelu_pk((f32x2){v1[2], v1[3]});
                        v0 = (f32x4){a.x, a.y, b.x, b.y}; v1 = (f32x4){c.x, c.y, d.x, d.y}; }
                    v0 = v0 * sc; v1 = v1 * sc; u32x4 w; w.x = cvt_pk_bf16(v0[0], v0[1]); w.y = cvt_pk_bf16(v0[2], v0[3]); w.z = cvt_pk_bf16(v1[0], v1[1]); w.w = cvt_pk_bf16(v1[2], v1[3]);
                    *(u32x4*)(rowp + bj * HALF) = w; } }
    }
};

template <class Epi, class Sched, bool ALIGN_EPI = false, bool SP2 = false, bool GATHER = false, bool QUAD = false>
__device__ __forceinline__ void gemm_phase(PG8_LAS unsigned char* lds, const Gemm g, const Sched& S, const Epi& E) {
    const int tid = tid_opaque(), wid = __builtin_amdgcn_readfirstlane(tid >> 6), lane = tid & 63, wr = wid >> 2, wc = wid & 3, fr = lane & 15, fq = lane >> 4;
    const int K = g.K, nt = K / BK;
    unsigned voffA[2], voffB[2];
#pragma unroll
    for (int i = 0; i < 2; ++i) { int R, C; stage_rc(tid * 16 + i * 8192, R, C); const int Rb = Epi::PERM ? ((R & ~31) + perm32(R & 31)) : R;
        voffA[i] = (unsigned)(R * K + C) * 2u; voffB[i] = (unsigned)(Rb * K + C) * 2u; }
    unsigned cvA[2][2], nvA[2][2];
#define PG8_AOFFS(dst, unit, ord) do { _Pragma("unroll") for (int _h = 0; _h < 2; ++_h) _Pragma("unroll") for (int _i = 0; _i < 2; ++_i) { int R_, C_; stage_rc(tid * 16 + _i * 8192, R_, C_); \
        if constexpr (GATHER) dst[_h][_i] = (unsigned)(g.ridx[(ord) * BM + _h * HALF + R_] * K + C_) * 2u; else dst[_h][_i] = voffA[_i] + (unsigned)(_h * HALF * K * 2); } } while (0)
    const size_t kstep = (size_t)(BK * 2);
    const size_t hstep = (size_t)HALF * K * 2;
    const size_t tstep = 2 * hstep;
    const unsigned ldsw = (unsigned)wid * 1024u;
    const int aoff = lds_byte(wr * 64 + fr, fq * 8), boff = lds_byte(wc * 32 + fr, fq * 8);
#define PG8_SA(b, h) (((b) * 2 + (h)) * HTB)
#define PG8_SB(b, h) ((4 + (b) * 2 + (h)) * HTB)
#define PG8_STAGE(bufoff, gbase, voff) do { _Pragma("unroll") for (int _i = 0; _i < 2; ++_i) \
        __builtin_amdgcn_global_load_lds((const unsigned*)((const char*)(gbase) + (voff)[_i]), (PG8_LAS unsigned*)(lds + (bufoff) + ldsw + _i * 8192), 16, 0, 0); } while (0)
#define PG8_LDA(dst, b, h) do { _Pragma("unroll") for (int m = 0; m < 4; ++m) _Pragma("unroll") for (int k = 0; k < 2; ++k) dst[m][k] = *(const PG8_LAS bf16x8*)(lds + PG8_SA(b, h) + aoff + m * 2048 + k * 1024); } while (0)
#define PG8_LDB(dst, b, h) do { _Pragma("unroll") for (int n = 0; n < 2; ++n) _Pragma("unroll") for (int k = 0; k < 2; ++k) dst[n][k] = *(const PG8_LAS bf16x8*)(lds + PG8_SB(b, h) + boff + n * 2048 + k * 1024); } while (0)
#define PG8_MMA(ai, bj, At, Bt) do { __builtin_amdgcn_s_setprio(1); _Pragma("unroll") for (int m = 0; m < 4; ++m) _Pragma("unroll") for (int n = 0; n < 2; ++n) _Pragma("unroll") for (int k = 0; k < 2; ++k) \
        acc[QUAD ? 0 : (ai)][QUAD ? 0 : (bj)][m][n] = __builtin_amdgcn_mfma_f32_16x16x32_bf16(Bt[n][k], At[m][k], acc[QUAD ? 0 : (ai)][QUAD ? 0 : (bj)][m][n], 0, 0, 0); __builtin_amdgcn_s_setprio(0); } while (0)
#define PG8_QMMA(ai, bj, At, Bt) do { if (!QUAD || cur.q == 2 * (ai) + (bj)) PG8_MMA(ai, bj, At, Bt); } while (0)
#define PG8_WAIT_V(n) asm volatile("s_waitcnt vmcnt(" #n ")" ::: "memory")
#define PG8_WAIT_L(n) asm volatile("s_waitcnt lgkmcnt(" #n ")" ::: "memory")
#define PG8_BAR __builtin_amdgcn_s_barrier()
#define PG8_SCHED __builtin_amdgcn_sched_barrier(0)
    Unit cur, nxt; int ui = 0;
    if (!S.next(0, cur)) return;
    constexpr int NQ = QUAD ? 1 : 2;
    f32x4 acc[NQ][NQ][4][2];
#pragma unroll
    for (int a = 0; a < NQ; ++a)
#pragma unroll
        for (int b = 0; b < NQ; ++b)
#pragma unroll
            for (int m = 0; m < 4; ++m)
#pragma unroll
                for (int n = 0; n < 2; ++n) acc[a][b][m][n] = (f32x4){0.f, 0.f, 0.f, 0.f};
    bf16x8 At[4][2], B0[2][2], B1[2][2];
    const char* cA = (const char*)g.A + (GATHER ? (size_t)0 : (size_t)cur.pm * tstep); const char* cB = (const char*)g.Bt + (size_t)cur.pb * tstep;
    S.a_ready(cur);
    PG8_AOFFS(cvA, cur, 0);
    if constexpr (SP2) {
        PG8_STAGE(PG8_SB(0, 0), cB, voffB); PG8_STAGE(PG8_SB(0, 1), cB + hstep, voffB); PG8_STAGE(PG8_SA(0, 0), cA, cvA[0]); PG8_STAGE(PG8_SA(0, 1), cA, cvA[1]);
        if (wr == 1) PG8_BAR;
        PG8_WAIT_V(2); PG8_BAR;
        PG8_STAGE(PG8_SB(1, 0), cB + kstep, voffB); PG8_STAGE(PG8_SA(1, 0), cA + kstep, cvA[0]); PG8_STAGE(PG8_SB(1, 1), cB + hstep + kstep, voffB);
        PG8_WAIT_V(6); PG8_BAR;
    } else { static_assert(SP2, "only the SP2 loop is kept in this file"); }
    for (;;) {
        const bool has_next = S.next(ui + 1, nxt);
        const char* nA = (has_next && !GATHER) ? (const char*)g.A + (size_t)nxt.pm * tstep : cA;
        if constexpr (GATHER) { if (has_next) PG8_AOFFS(nvA, nxt, ui + 1); else { _Pragma("unroll") for (int _h = 0; _h < 2; ++_h) _Pragma("unroll") for (int _i = 0; _i < 2; ++_i) nvA[_h][_i] = cvA[_h][_i]; } }
        const char* nB = has_next ? (const char*)g.Bt + (size_t)nxt.pb * tstep : cB;
        for (int t = 0; t < nt; t += 2) {
            const bool last = (t == nt - 2);
            const char* a1 = cA + (size_t)(t + 1) * kstep;
            const char* a2 = last ? nA : cA + (size_t)(t + 2) * kstep; const char* b2 = last ? nB : cB + (size_t)(t + 2) * kstep;
            const char* a3 = a2 + kstep; const char* b3 = b2 + kstep;
            unsigned xA0[2], xA1[2];
#pragma unroll
            for (int _i = 0; _i < 2; ++_i) { xA0[_i] = (GATHER && last) ? nvA[0][_i] : cvA[0][_i]; xA1[_i] = (GATHER && last) ? nvA[1][_i] : cvA[1][_i]; }
            if (last && has_next) S.a_ready(nxt);
            if constexpr (SP2) {
            PG8_LDB(B0, 0, 0); PG8_LDB(B1, 0, 1); PG8_SCHED; PG8_LDA(At, 0, 0); PG8_STAGE(PG8_SA(1, 1), a1, cvA[1]);
            PG8_WAIT_V(8); PG8_WAIT_L(0); PG8_BAR; PG8_QMMA(0, 0, At, B0); PG8_QMMA(0, 1, At, B1); PG8_BAR; PG8_SCHED;
            PG8_LDA(At, 0, 1); PG8_STAGE(PG8_SB(0, 0), b2, voffB); PG8_STAGE(PG8_SB(0, 1), b2 + hstep, voffB); PG8_STAGE(PG8_SA(0, 0), a2, xA0);
            PG8_WAIT_V(8); PG8_WAIT_L(0); PG8_BAR; PG8_QMMA(1, 0, At, B0); PG8_QMMA(1, 1, At, B1); PG8_BAR; PG8_SCHED;
            PG8_LDB(B0, 1, 0); PG8_LDB(B1, 1, 1); PG8_SCHED; PG8_LDA(At, 1, 0); PG8_STAGE(PG8_SA(0, 1), a2, xA1);
            PG8_WAIT_V(8); PG8_WAIT_L(0); PG8_BAR; PG8_QMMA(0, 0, At, B0); PG8_QMMA(0, 1, At, B1); PG8_BAR; PG8_SCHED;
            PG8_LDA(At, 1, 1); PG8_STAGE(PG8_SB(1, 0), b3, voffB); PG8_STAGE(PG8_SB(1, 1), b3 + hstep, voffB); PG8_STAGE(PG8_SA(1, 0), a3, xA0);
            PG8_WAIT_V(8); PG8_WAIT_L(0); PG8_BAR; PG8_QMMA(1, 0, At, B0); PG8_QMMA(1, 1, At, B1); PG8_BAR; PG8_SCHED;
            }
        }
        if constexpr (ALIGN_EPI) { if (wr == 0) PG8_BAR; }
        if constexpr (QUAD) { E.quad(acc[0][0], cur, wr, wc, fr, fq); S.done(cur); }
        else if constexpr (!Epi::AFTER_DRAIN) { E(acc, cur, wr, wc, fr, fq); S.done(cur); }
        if (!has_next) break;
#pragma unroll
        for (int a = 0; a < NQ; ++a)
#pragma unroll
            for (int b = 0; b < NQ; ++b)
#pragma unroll
                for (int m = 0; m < 4; ++m)
#pragma unroll
                    for (int n = 0; n < 2; ++n) acc[a][b][m][n] = (f32x4){0.f, 0.f, 0.f, 0.f};
        cur = nxt; cA = nA; cB = nB; ++ui;
        if constexpr (GATHER) { _Pragma("unroll") for (int _h = 0; _h < 2; ++_h) _Pragma("unroll") for (int _i = 0; _i < 2; ++_i) cvA[_h][_i] = nvA[_h][_i]; }
        if constexpr (ALIGN_EPI) { if (wr == 1) PG8_BAR; }
    }
    PG8_WAIT_V(0);
    if constexpr (!ALIGN_EPI) { if (wr == 0) PG8_BAR; }
    PG8_BAR;
    if constexpr (!QUAD && Epi::AFTER_DRAIN) { E.fused(acc, cur, wr, wc, fr, fq, lds, wid, lane); S.done(cur); }
#undef PG8_SA
#undef PG8_SB
#undef PG8_STAGE
#undef PG8_LDA
#undef PG8_LDB
#undef PG8_MMA
#undef PG8_QMMA
#undef PG8_WAIT_V
#undef PG8_WAIT_L
#undef PG8_BAR
#undef PG8_SCHED
#undef PG8_AOFFS
}
}
#define LAS __attribute__((address_space(3)))
#define XB_TMO      128
#define XB_XCNT(j)  (256  + 64 * (j))
#define XB_XSUB(j)  (1280 + 64 * (j))
#define XB_XGEN(j)  (2304 + 64 * (j))
#define XB_TOP      3328
#define XB_TOPGEN   3392
#define XCD_BAR_WORDS 3456
#define XB_SPIN_CAP (1u << 18)

__device__ __forceinline__ unsigned xb_ld(unsigned* p)              { return __hip_atomic_load(p, __ATOMIC_RELAXED, __HIP_MEMORY_SCOPE_AGENT); }
__device__ __forceinline__ unsigned xb_add(unsigned* p, unsigned v) { return __hip_atomic_fetch_add(p, v, __ATOMIC_RELAXED, __HIP_MEMORY_SCOPE_AGENT); }
__device__ __forceinline__ unsigned xb_xcc_id() { return (unsigned)__builtin_amdgcn_s_getreg((3 << 11) | 20) & 0xFu; }
#define XB_SPIN(cond, bar) do { unsigned _sp = 0; while (cond) { __builtin_amdgcn_s_sleep(1); \
    if ((++_sp & 255u) == 0u) { if (xb_ld(&(bar)[XB_TMO])) break; if (_sp > XB_SPIN_CAP) { atomicAdd(&(bar)[XB_TMO], 1u); break; } } } } while (0)

struct XcdBarrier {
    unsigned* bar; unsigned x;
    volatile LAS unsigned* st;
};

__device__ __forceinline__ XcdBarrier xcd_barrier_post(unsigned* bar, volatile LAS unsigned* st) {
    XcdBarrier b; b.bar = bar; b.x = xb_xcc_id(); b.st = st;
    if (threadIdx.x == 0) (void)xb_add(&bar[XB_XCNT(b.x)], 1u);
    return b;
}
__device__ __forceinline__ void xcd_barrier_complete(unsigned* bar, unsigned x, unsigned& nloc, unsigned& nx) {
    const unsigned G = gridDim.x * gridDim.y * gridDim.z;
    unsigned sum, cnt, mine, sp = 0u;
    for (;;) {
        sum = 0u; cnt = 0u; mine = 0u;
#pragma unroll
        for (unsigned j = 0; j < 16; ++j) { const unsigned c = xb_ld(&bar[XB_XCNT(j)]); sum += c; cnt += (c > 0u) ? 1u : 0u; mine = (j == x) ? c : mine; }
        if (sum == G) break;
        __builtin_amdgcn_s_sleep(1);
        if ((++sp & 255u) == 0u) { if (xb_ld(&bar[XB_TMO])) break; if (sp > XB_SPIN_CAP) { atomicAdd(&bar[XB_TMO], 1u); break; } }
    }
    nloc = mine > 0u ? mine : 1u; nx = cnt > 0u ? cnt : 1u;
}

__device__ __forceinline__ void xcd_barrier(const XcdBarrier& b) {
    asm volatile("s_waitcnt vmcnt(0)" ::: "memory");
    __syncthreads();
    if (threadIdx.x == 0) {
        unsigned* bar = b.bar;
        __builtin_amdgcn_s_waitcnt(0);
        unsigned nloc = b.st[0], nx = b.st[1];
        if (nloc == 0u) { xcd_barrier_complete(bar, b.x, nloc, nx); b.st[0] = nloc; b.st[1] = nx; }
        const unsigned old = xb_add(&bar[XB_XSUB(b.x)], 1u);
        const unsigned gen = old / nloc;
        if (old + 1u == (gen + 1u) * nloc) {
            __builtin_amdgcn_fence(__ATOMIC_RELEASE, "agent");
            asm volatile("s_waitcnt vmcnt(0)" ::: "memory");
            const unsigned og = xb_add(&bar[XB_TOP], 1u);
            const unsigned tg = og / nx;
            if (og + 1u == (tg + 1u) * nx) xb_add(&bar[XB_TOPGEN], 1u);
            else XB_SPIN(xb_ld(&bar[XB_TOPGEN]) == tg, bar);
            __builtin_amdgcn_fence(__ATOMIC_ACQUIRE, "agent");
            xb_add(&bar[XB_XGEN(b.x)], 1u);
            asm volatile("s_waitcnt vmcnt(0)" ::: "memory");
        } else {
            XB_SPIN(xb_ld(&bar[XB_XGEN(b.x)]) == gen, bar);
            __builtin_amdgcn_fence(__ATOMIC_ACQUIRE, "agent");
            asm volatile("s_waitcnt vmcnt(0)" ::: "memory");
        }
    }
    __syncthreads();
}
#undef LAS
__constant__ float ROPE_COS[1024] = { 1.000000000e+00f, 1.000000000e+00f, 1.000000000e+00f, 1.000000000e+00f, 1.000000000e+00f, 1.000000000e+00f, 1.000000000e+00f, 1.000000000e+00f, 1.000000000e+00f, 1.000000000e+00f, 1.000000000e+00f, 1.000000000e+00f, 1.000000000e+00f, 1.000000000e+00f, 1.000000000e+00f, 1.000000000e+00f, 5.403022766e-01f, 8.460091352e-01f, 9.504152536e-01f, 9.842302203e-01f, 9.950041771e-01f, 9.984192848e-01f, 9.995000362e-01f, 9.998418689e-01f, 9.999499917e-01f, 9.999842048e-01f, 9.999949932e-01f, 9.999983907e-01f, 9.999995232e-01f, 9.999998212e-01f, 9.999999404e-01f, 1.000000000e+00f, -4.161468446e-01f, 4.314628243e-01f, 8.065783978e-01f, 9.374182820e-01f, 9.800665975e-01f, 9.936820865e-01f, 9.980006814e-01f, 9.993675947e-01f, 9.998000264e-01f, 9.999367595e-01f, 9.999799728e-01f, 9.999936819e-01f, 9.999979734e-01f, 9.999993443e-01f, 9.999998212e-01f, 9.999999404e-01f, -9.899924994e-01f, -1.159661636e-01f, 5.827536583e-01f, 8.610406518e-01f, 9.553365111e-01f, 9.858034849e-01f, 9.955033660e-01f, 9.985772967e-01f, 9.995500445e-01f, 9.998577237e-01f, 9.999549985e-01f, 9.999857545e-01f, 9.999955297e-01f, 9.999985695e-01f, 9.999995232e-01f, 9.999998808e-01f, -6.536436081e-01f, -6.276797056e-01f, 3.011374772e-01f, 7.575061917e-01f, 9.210609794e-01f, 9.748082757e-01f, 9.920106530e-01f, 9.974712729e-01f, 9.992001057e-01f, 9.997470379e-01f, 9.999200106e-01f, 9.999747276e-01f, 9.999920130e-01f, 9.999974966e-01f, 9.999992251e-01f, 9.999997616e-01f, 2.836622000e-01f, -9.460792542e-01f, -1.034233812e-02f, 6.300802827e-01f, 8.775825500e-01f, 9.607312679e-01f, 9.875259995e-01f, 9.960497618e-01f, 9.987502694e-01f, 9.996047616e-01f, 9.998750091e-01f, 9.999604821e-01f, 9.999874830e-01f, 9.999960661e-01f, 9.999987483e-01f, 9.999995828e-01f, 9.601702690e-01f, -9.731037021e-01f, -3.207964003e-01f, 4.827820361e-01f, 8.253356218e-01f, 9.436169863e-01f, 9.820539355e-01f, 9.943132997e-01f, 9.982005358e-01f, 9.994308352e-01f, 9.998199940e-01f, 9.999430776e-01f, 9.999819994e-01f, 9.999943376e-01f, 9.999982119e-01f, 9.999994040e-01f, 7.539022565e-01f, -7.004297972e-01f, -5.994374752e-01f, 3.202570081e-01f, 7.648422122e-01f, 9.235194325e-01f, 9.755998850e-01f, 9.922624230e-01f, 9.975510240e-01f, 9.992253184e-01f, 9.997550249e-01f, 9.999225140e-01f, 9.999755025e-01f, 9.999922514e-01f, 9.999975562e-01f, 9.999992251e-01f, -1.455000341e-01f, -2.120364457e-01f, -8.186324239e-01f, 1.476312131e-01f, 6.967067122e-01f, 9.005023241e-01f, 9.681702852e-01f, 9.898977876e-01f, 9.968017340e-01f, 9.989882708e-01f, 9.996800423e-01f, 9.998987913e-01f, 9.999679923e-01f, 9.999898672e-01f, 9.999967813e-01f, 9.999989867e-01f, -9.111302495e-01f, 3.416602612e-01f, -9.566441774e-01f, -2.965079620e-02f, 6.216099262e-01f, 8.746382594e-01f, 9.597726464e-01f, 9.872201085e-01f, 9.959527254e-01f, 9.987195730e-01f, 9.995950460e-01f, 9.998719096e-01f, 9.999595284e-01f, 9.999871850e-01f, 9.999959469e-01f, 9.999987483e-01f, -8.390715122e-01f, 7.901318669e-01f, -9.997860789e-01f, -2.059976310e-01f, 5.403022766e-01f, 8.460091352e-01f, 9.504153132e-01f, 9.842302203e-01f, 9.950041771e-01f, 9.984192848e-01f, 9.995000362e-01f, 9.998418689e-01f, 9.999499917e-01f, 9.999842048e-01f, 9.999949932e-01f, 9.999983907e-01f, 4.425697960e-03f, 9.952573776e-01f, -9.437797666e-01f, -3.758473992e-01f, 4.535960853e-01f, 8.147053123e-01f, 9.401075840e-01f, 9.809291363e-01f, 9.939560890e-01f, 9.980874062e-01f, 9.993950725e-01f, 9.998086691e-01f, 9.999395013e-01f, 9.999808669e-01f, 9.999939203e-01f, 9.999980927e-01f, 8.438539505e-01f, 8.938615918e-01f, -7.941793799e-01f, -5.338430405e-01f, 3.623577058e-01f, 7.808259130e-01f, 9.288598895e-01f, 9.773178697e-01f, 9.928086400e-01f, 9.977239966e-01f, 9.992800951e-01f, 9.997723103e-01f, 9.999279976e-01f, 9.999772310e-01f, 9.999927878e-01f, 9.999977350e-01f, 9.074468017e-01f, 5.171728730e-01f, -5.658205152e-01f, -6.750016809e-01f, 2.674987614e-01f, 7.444779873e-01f, 9.166833758e-01f, 9.733975530e-01f, 9.915618896e-01f, 9.973290563e-01f, 9.991551042e-01f, 9.997327924e-01f, 9.999154806e-01f, 9.999732971e-01f, 9.999915361e-01f, 9.999973178e-01f, 1.367372125e-01f, -1.879615150e-02f, -2.813494802e-01f, -7.948709130e-01f, 1.699671596e-01f, 7.057763934e-01f, 9.035902619e-01f, 9.691694379e-01f, 9.902160168e-01f, 9.969025850e-01f, 9.990201592e-01f, 9.996901155e-01f, 9.999020100e-01f, 9.999690056e-01f, 9.999902248e-01f, 9.999969006e-01f, -7.596879005e-01f, -5.489754677e-01f, 3.102235124e-02f, -8.896704316e-01f, 7.073719800e-02f, 6.648434997e-01f, 8.895936012e-01f, 9.646348357e-01f, 9.887710810e-01f, 9.964445233e-01f, 9.988752007e-01f, 9.996442795e-01f, 9.998875260e-01f, 9.999644160e-01f, 9.999887347e-01f, 9.999964237e-01f, -9.576594830e-01f, -9.100810885e-01f, 3.403181732e-01f, -9.564100504e-01f, -2.919954620e-02f, 6.218088269e-01f, 8.747074604e-01f, 9.597951770e-01f, 9.872272611e-01f, 9.959549904e-01f, 9.987202883e-01f, 9.995952845e-01f, 9.998720288e-01f, 9.999595284e-01f, 9.999871850e-01f, 9.999959469e-01f, -2.751633525e-01f, -9.908979535e-01f, 6.158648133e-01f, -9.929850101e-01f, -1.288445443e-01f, 5.768082738e-01f, 8.589466810e-01f, 9.546520114e-01f, 9.855847955e-01f, 9.954339862e-01f, 9.985553622e-01f, 9.995430708e-01f, 9.998555183e-01f, 9.999542832e-01f, 9.999855757e-01f, 9.999954104e-01f, 6.603167057e-01f, -7.665365338e-01f, 8.303361535e-01f, -9.982416630e-01f, -2.272021621e-01f, 5.299841762e-01f, 8.423270583e-01f, 9.492070079e-01f, 9.838436842e-01f, 9.948815107e-01f, 9.983804226e-01f, 9.994877577e-01f, 9.998379946e-01f, 9.999487996e-01f, 9.999837875e-01f, 9.999948740e-01f, 9.887046218e-01f, -3.060953915e-01f, 9.624637961e-01f, -9.720142484e-01f, -3.232895434e-01f, 4.814845920e-01f, 8.248651624e-01f, 9.434618354e-01f, 9.820042253e-01f, 9.942975044e-01f, 9.981955290e-01f, 9.994292855e-01f, 9.998195171e-01f, 9.999428988e-01f, 9.999819398e-01f, 9.999942780e-01f, 4.080820680e-01f, 2.486167252e-01f, 9.991443753e-01f, -9.151299596e-01f, -4.161468446e-01f, 4.314628243e-01f, 8.065784574e-01f, 9.374182820e-01f, 9.800665975e-01f, 9.936820865e-01f, 9.980006814e-01f, 9.993675947e-01f, 9.998000264e-01f, 9.999367595e-01f, 9.999799728e-01f, 9.999936819e-01f, -5.477292538e-01f, 7.267602682e-01f, 9.367404580e-01f, -8.293829560e-01f, -5.048462152e-01f, 3.800770044e-01f, 7.874851823e-01f, 9.310783744e-01f, 9.780309200e-01f, 9.930352569e-01f, 9.977958202e-01f, 9.993028045e-01f, 9.997795224e-01f, 9.999302626e-01f, 9.999779463e-01f, 9.999930263e-01f, -9.999608397e-01f, 9.810745716e-01f, 7.814403772e-01f, -7.174774408e-01f, -5.885011554e-01f, 3.274895847e-01f, 7.676045895e-01f, 9.244439602e-01f, 9.758974314e-01f, 9.923570156e-01f, 9.975810051e-01f, 9.992348552e-01f, 9.997580051e-01f, 9.999234676e-01f, 9.999758005e-01f, 9.999923706e-01f, -5.328330398e-01f, 9.332357645e-01f, 5.486452579e-01f, -5.829432607e-01f, -6.662759781e-01f, 2.738668323e-01f, 7.469564080e-01f, 9.175173044e-01f, 9.736663699e-01f, 9.916474223e-01f, 9.973561764e-01f, 9.991636872e-01f, 9.997355342e-01f, 9.999163747e-01f, 9.999735355e-01f, 9.999916553e-01f, 4.241790175e-01f, 5.979771614e-01f, 2.614416778e-01f, -4.300232828e-01f, -7.373937964e-01f, 2.193782777e-01f, 7.255613208e-01f, 9.103004336e-01f, 9.713379741e-01f, 9.909064770e-01f, 9.971213937e-01f, 9.990894198e-01f, 9.997119904e-01f, 9.999089241e-01f, 9.999712110e-01f, 9.999908805e-01f, 9.912028313e-01f, 7.855226099e-02f, -5.168933049e-02f, -2.635405958e-01f, -8.011435866e-01f, 1.641961634e-01f, 7.034407258e-01f, 9.027957320e-01f, 9.689124227e-01f, 9.901341200e-01f, 9.968766570e-01f, 9.990119338e-01f, 9.996874928e-01f, 9.999011755e-01f, 9.999687672e-01f, 9.999901056e-01f, 6.469193101e-01f, -4.650644958e-01f, -3.596943319e-01f, -8.874550462e-02f, -8.568888307e-01f, 1.084949449e-01f, 6.806167960e-01f, 8.950055838e-01f, 9.663899541e-01f, 9.893305302e-01f, 9.966219068e-01f, 9.989313483e-01f, 9.996620417e-01f, 9.998931289e-01f, 9.999662042e-01f, 9.999893308e-01f, -2.921388149e-01f, -8.654506207e-01f, -6.320286393e-01f, 8.884811401e-02f, -9.040721655e-01f, 5.245061591e-02f, 6.571123004e-01f, 8.869323730e-01f, 9.637709260e-01f, 9.884956479e-01f, 9.963572025e-01f, 9.988475442e-01f, 9.996355176e-01f, 9.998847246e-01f, 9.999635220e-01f, 9.999884963e-01f, -9.626058936e-01f, -9.992933869e-01f, -8.416849375e-01f, 2.636395097e-01f, -9.422222972e-01f, -3.759419080e-03f, 6.329506636e-01f, 8.785787225e-01f, 9.610554576e-01f, 9.876294732e-01f, 9.960825443e-01f, 9.987606406e-01f, 9.996080399e-01f, 9.998760223e-01f, 9.999607801e-01f, 9.999876022e-01f, -7.480575442e-01f, -8.253716230e-01f, -9.678714871e-01f, 4.301158488e-01f, -9.709581733e-01f, -5.995756760e-02f, 6.081562042e-01f, 8.699471951e-01f, 9.582439065e-01f, 9.867320657e-01f, 9.957979321e-01f, 9.986705780e-01f, 9.995795488e-01f, 9.998670220e-01f, 9.999579787e-01f, 9.999867082e-01f, 1.542514563e-01f, -3.972518742e-01f, -9.980752468e-01f, 5.830269456e-01f, -9.899924994e-01f, -1.159661636e-01f, 5.827536583e-01f, 8.610406518e-01f, 9.553365111e-01f, 9.858034849e-01f, 9.955033660e-01f, 9.985772967e-01f, 9.995500445e-01f, 9.998577237e-01f, 9.999549985e-01f, 9.999857545e-01f, 9.147423506e-01f, 1.532154828e-01f, -9.293003082e-01f, 7.175492048e-01f, -9.991351366e-01f, -1.716081351e-01f, 5.567683578e-01f, 8.518617749e-01f, 9.523335695e-01f, 9.848436713e-01f, 9.951988459e-01f, 9.984809160e-01f, 9.995195270e-01f, 9.998480678e-01f, 9.999519587e-01f, 9.999848008e-01f, 8.342233896e-01f, 6.564951539e-01f, -7.683671117e-01f, 8.294403553e-01f, -9.982947707e-01f, -2.267075777e-01f, 5.302263498e-01f, 8.424135447e-01f, 9.492354393e-01f, 9.838528037e-01f, 9.948843718e-01f, 9.983813763e-01f, 9.994880557e-01f, 9.998381138e-01f, 9.999487996e-01f, 9.999837875e-01f, -1.327674743e-02f, 9.575860500e-01f, -5.312352777e-01f, 9.151713848e-01f, -9.874798059e-01f, -2.810903192e-01f, 5.031541586e-01f, 8.326989412e-01f, 9.460423589e-01f, 9.828307629e-01f, 9.945599437e-01f, 9.982786179e-01f, 9.994555712e-01f, 9.998278022e-01f, 9.999455214e-01f, 9.999827743e-01f, -8.485702872e-01f, 9.637575150e-01f, -2.414211184e-01f, 9.720383286e-01f, -9.667981863e-01f, -3.345843852e-01f, 4.755789042e-01f, 8.227210045e-01f, 9.427546859e-01f, 9.817776680e-01f, 9.942255616e-01f, 9.981727600e-01f, 9.994220734e-01f, 9.998172522e-01f, 9.999421835e-01f, 9.999817014e-01f, -9.036921859e-01f, 6.731102467e-01f, 7.233466953e-02f, 9.982477427e-01f, -9.364566803e-01f, -3.870206773e-01f, 4.475280643e-01f, 8.124829531e-01f, 9.393727183e-01f, 9.806935191e-01f, 9.938812256e-01f, 9.980637431e-01f, 9.993875623e-01f, 9.998063445e-01f, 9.999387264e-01f, 9.999806285e-01f, -1.279636919e-01f, 1.751565337e-01f, 3.789161742e-01f, 9.929728508e-01f, -8.967583776e-01f, -4.382335544e-01f, 4.190297425e-01f, 8.019878864e-01f, 9.358968139e-01f, 9.795783162e-01f, 9.935269952e-01f, 9.979515672e-01f, 9.993520975e-01f, 9.997950792e-01f, 9.999352098e-01f, 9.999794960e-01f, 7.654140592e-01f, -3.767423034e-01f, 6.479216814e-01f, 9.563800097e-01f, -8.481000066e-01f, -4.880608618e-01f, 3.901124299e-01f, 7.912392616e-01f, 9.323273301e-01f, 9.784321785e-01f, 9.931628108e-01f, 9.978361726e-01f, 9.993155599e-01f, 9.997835755e-01f, 9.999315739e-01f, 9.999783635e-01f, 9.550736547e-01f, -8.126112223e-01f, 8.526731133e-01f, 8.896234632e-01f, -7.909677625e-01f, -5.363451838e-01f, 3.608050346e-01f, 7.802404165e-01f, 9.286646247e-01f, 9.772551060e-01f, 9.927886724e-01f, 9.977176785e-01f, 9.992780685e-01f, 9.997717142e-01f, 9.999278188e-01f, 9.999771714e-01f, 2.666429281e-01f, -9.982103705e-01f, 9.728653431e-01f, 7.948083878e-01f, -7.259322405e-01f, -5.829339027e-01f, 3.311368525e-01f, 7.689949274e-01f, 9.249090552e-01f, 9.760470986e-01f, 9.924046397e-01f, 9.975960255e-01f, 9.992396235e-01f, 9.997594953e-01f, 9.999239445e-01f, 9.999759793e-01f, -6.669380665e-01f, -8.763794303e-01f, 9.965789914e-01f, 6.749256253e-01f, -6.536436081e-01f, -6.276797056e-01f, 3.011375964e-01f, 7.575061917e-01f, 9.210609794e-01f, 9.748082757e-01f, 9.920106530e-01f, 9.974712729e-01f, 9.992001057e-01f, 9.997470379e-01f, 9.999200106e-01f, 9.999747276e-01f, -9.873392582e-01f, -4.846394062e-01f, 9.214623570e-01f, 5.337560773e-01f, -5.748240352e-01f, -6.704410911e-01f, 2.708370686e-01f, 7.457779050e-01f, 9.171208143e-01f, 9.735385776e-01f, 9.916067719e-01f, 9.973433018e-01f, 9.991596341e-01f, 9.997342229e-01f, 9.999159575e-01f, 9.999734163e-01f, -3.999853134e-01f, 5.636094138e-02f, 7.549653649e-01f, 3.757521510e-01f, -4.902605712e-01f, -7.110829353e-01f, 2.402658761e-01f, 7.338138223e-01f, 9.130889177e-01f, 9.722381234e-01f, 9.911929369e-01f, 9.972121716e-01f, 9.991181493e-01f, 9.997211099e-01f, 9.999117851e-01f, 9.999721050e-01f, 5.551133156e-01f, 5.800031424e-01f, 5.135984421e-01f, 2.058971673e-01f, -4.007990062e-01f, -7.494767308e-01f, 2.094544172e-01f, 7.216176391e-01f, 9.089657664e-01f, 9.709069133e-01f, 9.907692075e-01f, 9.970778823e-01f, 9.990756512e-01f, 9.997076392e-01f, 9.999075532e-01f, 9.999707937e-01f, 9.998432994e-01f, 9.250146747e-01f, 2.212981731e-01f, 2.954781987e-02f, -3.073327839e-01f, -7.855011225e-01f, 1.784335226e-01f, 7.091933489e-01f, 9.047516584e-01f, 9.695450068e-01f, 9.903355837e-01f, 9.969404936e-01f, 9.990321398e-01f, 9.996939301e-01f, 9.999032021e-01f, 9.999693632e-01f, 5.253219604e-01f, 9.851381779e-01f, -9.294810891e-02f, -1.477329880e-01f, -2.107958049e-01f, -8.190422058e-01f, 1.472342163e-01f, 6.965447664e-01f, 9.004471302e-01f, 9.681524038e-01f, 9.898920655e-01f, 9.967998862e-01f, 9.989876747e-01f, 9.996798635e-01f, 9.998987317e-01f, 9.999679923e-01f, -4.321779311e-01f, 7.418580055e-01f, -3.979767561e-01f, -3.203543723e-01f, -1.121526212e-01f, -8.499938846e-01f, 1.158876941e-01f, 6.836758852e-01f, 8.960524797e-01f, 9.667292237e-01f, 9.894386530e-01f, 9.966561794e-01f, 9.989421964e-01f, 9.996654391e-01f, 9.998942018e-01f, 9.999665618e-01f, -9.923354983e-01f, 2.700984478e-01f, -6.635382771e-01f, -4.828719497e-01f, -1.238837745e-02f, -8.782584071e-01f, 8.442528546e-02f, 6.705908775e-01f, 8.915683031e-01f, 9.652754664e-01f, 9.889753461e-01f, 9.965093136e-01f, 9.988957047e-01f, 9.996507764e-01f, 9.998895526e-01f, 9.999650717e-01f, -6.401443481e-01f, -2.848466039e-01f, -8.632965088e-01f, -6.301599741e-01f, 8.749917150e-02f, -9.037463665e-01f, 5.287845805e-02f, 6.572937369e-01f, 8.869948983e-01f, 9.637911916e-01f, 9.885020852e-01f, 9.963592887e-01f, 9.988481998e-01f, 9.996357560e-01f, 9.998847842e-01f, 9.999635816e-01f, 3.005925417e-01f, -7.520639896e-01f, -9.774427414e-01f, -7.575730681e-01f, 1.865124702e-01f, -9.263771176e-01f, 2.127875760e-02f, 6.437888145e-01f, 8.823328614e-01f, 9.622764587e-01f, 9.880189896e-01f, 9.962061048e-01f, 9.987997413e-01f, 9.996203780e-01f, 9.998799562e-01f, 9.999620318e-01f, 9.649659991e-01f, -9.876590967e-01f, -9.946564436e-01f, -8.610926867e-01f, 2.836622000e-01f, -9.460792542e-01f, -1.034221891e-02f, 6.300802827e-01f, 8.775825500e-01f, 9.607312679e-01f, 9.875259995e-01f, 9.960497618e-01f, 9.987502694e-01f, 9.996047616e-01f, 9.998750091e-01f, 9.999604821e-01f, 7.421541810e-01f, -9.190735221e-01f, -9.132301211e-01f, -9.374542236e-01f, 3.779776692e-01f, -9.627903700e-01f, -4.195285589e-02f, 6.161724925e-01f, 8.727445006e-01f, 9.591556787e-01f, 9.870231748e-01f, 9.958902597e-01f, 9.986997843e-01f, 9.995887876e-01f, 9.998699427e-01f, 9.999588728e-01f, -1.629907787e-01f, -5.674300194e-01f, -7.412399650e-01f, -9.842484593e-01f, 4.685169160e-01f, -9.764577150e-01f, -7.352153957e-02f, 6.020699143e-01f, 8.678191900e-01f, 9.575498104e-01f, 9.865104556e-01f, 9.957276583e-01f, 9.986482859e-01f, 9.995725155e-01f, 9.998648167e-01f, 9.999572635e-01f, -9.182828069e-01f, -4.102819040e-02f, -4.957418144e-01f, -1.000000000e+00f, 5.543745160e-01f, -9.870380163e-01f, -1.050167084e-01f, 5.877769589e-01f, 8.628070951e-01f, 9.559136033e-01f, 9.859878421e-01f, 9.955618382e-01f, 9.985958338e-01f, 9.995558858e-01f, 9.998595715e-01f, 9.999555945e-01f, -8.293098211e-01f, 4.980095923e-01f, -2.010796219e-01f, -9.842120409e-01f, 6.346929669e-01f, -9.944978952e-01f, -1.364068687e-01f, 5.732980371e-01f, 8.577086926e-01f, 9.542471766e-01f, 9.854553938e-01f, 9.953929186e-01f, 9.985423684e-01f, 9.995389581e-01f, 9.998542070e-01f, 9.999538660e-01f, 2.212675661e-02f, 8.836693168e-01f, 1.135217771e-01f, -9.373825192e-01f, 7.086697817e-01f, -9.988136292e-01f, -1.676606387e-01f, 5.586379170e-01f, 8.525245190e-01f, 9.525505900e-01f, 9.849131107e-01f, 9.952208400e-01f, 9.984878898e-01f, 9.995217323e-01f, 9.998487830e-01f, 9.999521971e-01f, 8.532201052e-01f, 9.971746206e-01f, 4.168670774e-01f, -8.609884381e-01f, 7.755658031e-01f, -9.999717474e-01f, -1.987468749e-01f, 5.438010693e-01f, 8.472551107e-01f, 9.508239031e-01f, 9.843609333e-01f, 9.950456619e-01f, 9.984323978e-01f, 9.995042086e-01f, 9.998431802e-01f, 9.999504089e-01f, 8.998668194e-01f, 8.035690784e-01f, 6.788702011e-01f, -7.574391961e-01f, 8.347129226e-01f, -9.979684949e-01f, -2.296342701e-01f, 5.287923217e-01f, 8.419010043e-01f, 9.490671158e-01f, 9.837989211e-01f, 9.948672652e-01f, 9.983759522e-01f, 9.994863272e-01f, 9.998375773e-01f, 9.999486208e-01f, 1.191801354e-01f, 3.624766767e-01f, 8.735505342e-01f, -6.300007105e-01f, 8.855196238e-01f, -9.928101897e-01f, -2.602920532e-01f, 5.136163235e-01f, 8.364626765e-01f, 9.472803473e-01f, 9.832270741e-01f, 9.946857691e-01f, 9.983184934e-01f, 9.994681478e-01f, 9.998317957e-01f, 9.999468327e-01f, -7.710801959e-01f, -1.902491003e-01f, 9.816020727e-01f, -4.826923311e-01f, 9.274784923e-01f, -9.845131636e-01f, -2.906895578e-01f, 4.982779026e-01f, 8.309407234e-01f, 9.454635978e-01f, 9.826454520e-01f, 9.945011139e-01f, 9.982600212e-01f, 9.994496703e-01f, 9.998259544e-01f, 9.999449849e-01f, -9.524129629e-01f, -6.843819022e-01f, 9.923083186e-01f, -3.201591671e-01f, 9.601702690e-01f, -9.731037021e-01f, -3.207964003e-01f, 4.827820361e-01f, 8.253356218e-01f, 9.436169863e-01f, 9.820539355e-01f, 9.943132997e-01f, 9.982005358e-01f, 9.994308352e-01f, 9.998199940e-01f, 9.999430776e-01f, -2.581016421e-01f, -9.677396417e-01f, 9.046075940e-01f, -1.475291997e-01f, 9.832684398e-01f, -9.586178064e-01f, -3.505824506e-01f, 4.671334028e-01f, 8.196480274e-01f, 9.417404532e-01f, 9.814526439e-01f, 9.941223264e-01f, 9.981400967e-01f, 9.994117022e-01f, 9.998139739e-01f, 9.999411702e-01f, 6.735071540e-01f, -9.530500174e-01f, 7.271980643e-01f, 2.975377068e-02f, 9.965420961e-01f, -9.411013126e-01f, -3.800179660e-01f, 4.513370395e-01f, 8.138784766e-01f, 9.398342371e-01f, 9.808415174e-01f, 9.939282537e-01f, 9.980786443e-01f, 9.993922710e-01f, 9.998078346e-01f, 9.999392033e-01f, 9.858965874e-01f, -6.448370218e-01f, 4.776714444e-01f, 2.060983330e-01f, 9.998586178e-01f, -9.206095338e-01f, -4.090735018e-01f, 4.353979528e-01f, 8.080275059e-01f, 9.378982186e-01f, 9.802205563e-01f, 9.937310219e-01f, 9.980161786e-01f, 9.993724823e-01f, 9.998015761e-01f, 9.999372363e-01f };
__constant__ float ROPE_SIN[1024] = { 0.000000000e+00f, 0.000000000e+00f, 0.000000000e+00f, 0.000000000e+00f, 0.000000000e+00f, 0.000000000e+00f, 0.000000000e+00f, 0.000000000e+00f, 0.000000000e+00f, 0.000000000e+00f, 0.000000000e+00f, 0.000000000e+00f, 0.000000000e+00f, 0.000000000e+00f, 0.000000000e+00f, 0.000000000e+00f, 8.414709568e-01f, 5.331684351e-01f, 3.109835982e-01f, 1.768921912e-01f, 9.983342141e-02f, 5.620449781e-02f, 3.161750361e-02f, 1.778185740e-02f, 9.999833070e-03f, 5.623383448e-03f, 3.162272274e-03f, 1.778278500e-03f, 9.999999311e-04f, 5.623412435e-04f, 3.162277571e-04f, 1.778279402e-04f, 9.092974067e-01f, 9.021307230e-01f, 5.911270976e-01f, 3.482052684e-01f, 1.986693293e-01f, 1.122313142e-01f, 6.320339441e-02f, 3.555808961e-02f, 1.999866590e-02f, 1.124658901e-02f, 6.324512884e-03f, 3.556551412e-03f, 1.999998698e-03f, 1.124682371e-03f, 6.324554561e-04f, 3.556558804e-04f, 1.411200017e-01f, 9.932531714e-01f, 8.126488924e-01f, 5.085361004e-01f, 2.955202162e-01f, 1.679033041e-01f, 9.472608566e-02f, 5.332308263e-02f, 2.999549918e-02f, 1.686943881e-02f, 9.486690164e-03f, 5.334813148e-03f, 2.999995602e-03f, 1.687023090e-03f, 9.486831259e-04f, 5.334838061e-04f, -7.568024993e-01f, 7.784717083e-01f, 9.535807371e-01f, 6.528279781e-01f, 3.894183338e-01f, 2.230444849e-01f, 1.261540651e-01f, 7.107120752e-02f, 3.998933360e-02f, 2.249175683e-02f, 1.264877338e-02f, 7.113057654e-03f, 3.999989480e-03f, 2.249363344e-03f, 1.264910679e-03f, 7.113117026e-04f, -9.589242935e-01f, 3.239352703e-01f, 9.999465346e-01f, 7.765299678e-01f, 4.794255495e-01f, 2.774805427e-01f, 1.574558765e-01f, 8.879686147e-02f, 4.997916520e-02f, 2.811336145e-02f, 1.581072807e-02f, 8.891279809e-03f, 4.999979399e-03f, 2.811702900e-03f, 1.581138116e-03f, 8.891395992e-04f, -2.794154882e-01f, -2.303675115e-01f, 9.471482038e-01f, 8.757405281e-01f, 5.646424890e-01f, 3.310393095e-01f, 1.886002719e-01f, 1.064944416e-01f, 5.996400490e-02f, 3.373407945e-02f, 1.897252724e-02f, 1.066947449e-02f, 5.999964196e-03f, 3.374041524e-03f, 1.897365320e-03f, 1.066967379e-03f, 6.569865942e-01f, -7.137212753e-01f, 8.004215956e-01f, 9.473307133e-01f, 6.442176700e-01f, 3.835515678e-01f, 2.195560932e-01f, 1.241583377e-01f, 6.994284689e-02f, 3.935372457e-02f, 2.213413455e-02f, 1.244763471e-02f, 6.999942940e-03f, 3.936378751e-03f, 2.213592408e-03f, 1.244795276e-03f, 9.893582463e-01f, -9.772617817e-01f, 5.743177533e-01f, 9.890424609e-01f, 7.173560858e-01f, 4.348512292e-01f, 2.502923310e-01f, 1.417829692e-01f, 7.991468906e-02f, 4.497213289e-02f, 2.529552206e-02f, 1.422575582e-02f, 7.999914698e-03f, 4.498715047e-03f, 2.529819263e-03f, 1.422623056e-03f, 4.121184945e-01f, -9.398235083e-01f, 2.912592292e-01f, 9.995602965e-01f, 7.833269238e-01f, 4.847761393e-01f, 2.807783186e-01f, 1.593627781e-01f, 8.987854421e-02f, 5.058911815e-02f, 2.845665626e-02f, 1.600383036e-02f, 8.999879472e-03f, 5.061050411e-03f, 2.846045885e-03f, 1.600450720e-03f, -5.440211296e-01f, -6.129369140e-01f, -2.068356983e-02f, 9.785524607e-01f, 8.414709568e-01f, 5.331684351e-01f, 3.109835684e-01f, 1.768921912e-01f, 9.983341396e-02f, 5.620449781e-02f, 3.161750361e-02f, 1.778185740e-02f, 9.999834001e-03f, 5.623383448e-03f, 3.162272274e-03f, 1.778278500e-03f, -9.999902248e-01f, -9.727645665e-02f, -3.305749595e-01f, 9.266815782e-01f, 8.912073970e-01f, 5.798751712e-01f, 3.408778608e-01f, 1.943656504e-01f, 1.097782999e-01f, 6.181810424e-02f, 3.477803990e-02f, 1.955982670e-02f, 1.099977922e-02f, 6.185714621e-03f, 3.478498431e-03f, 1.956106164e-03f, -5.365729332e-01f, 4.483429790e-01f, -6.076834202e-01f, 8.455836177e-01f, 9.320390821e-01f, 6.247486472e-01f, 3.704313040e-01f, 2.117776722e-01f, 1.197122037e-01f, 6.742975861e-02f, 3.793822229e-02f, 2.133773454e-02f, 1.199971233e-02f, 6.748044398e-03f, 3.794723889e-03f, 2.133933594e-03f, 4.201670289e-01f, 8.558809757e-01f, -8.245284557e-01f, 7.378162146e-01f, 9.635581970e-01f, 6.676470041e-01f, 3.996143043e-01f, 2.291227132e-01f, 1.296341419e-01f, 7.303927839e-02f, 4.109803215e-02f, 2.311557345e-02f, 1.299963426e-02f, 7.310371846e-03f, 4.110949114e-03f, 2.311761025e-03f, 9.906073809e-01f, 9.998233318e-01f, -9.596053958e-01f, 6.067785621e-01f, 9.854497313e-01f, 7.084347010e-01f, 4.283977747e-01f, 2.463953048e-01f, 1.395431161e-01f, 7.864648104e-02f, 4.425742477e-02f, 2.489333972e-02f, 1.399954315e-02f, 7.872696966e-03f, 4.427174106e-03f, 2.489588689e-03f, 6.502878666e-01f, 8.358384371e-01f, -9.995186925e-01f, 4.566032588e-01f, 9.974949956e-01f, 7.469826341e-01f, 4.567528665e-01f, 2.635899782e-01f, 1.494381279e-01f, 8.425120264e-02f, 4.741638154e-02f, 2.667102963e-02f, 1.499943808e-02f, 8.435020223e-03f, 4.743398633e-03f, 2.667415887e-03f, -2.879033089e-01f, 4.144302309e-01f, -9.403103590e-01f, 2.920270860e-01f, 9.995735884e-01f, 7.831690907e-01f, 4.846512377e-01f, 2.807013094e-01f, 1.593182087e-01f, 8.985326439e-02f, 5.057485774e-02f, 2.844863199e-02f, 1.599931903e-02f, 8.997339755e-03f, 5.059622694e-03f, 2.845243318e-03f, -9.613974690e-01f, -1.346151382e-01f, -7.878518701e-01f, 1.182405204e-01f, 9.916648269e-01f, 8.168795705e-01f, 5.120649934e-01f, 2.977238595e-01f, 1.691823453e-01f, 9.545248002e-02f, 5.373282731e-02f, 3.022614494e-02f, 1.699918136e-02f, 9.559656493e-03f, 5.375845823e-03f, 3.023070283e-03f, -7.509872317e-01f, -6.422007084e-01f, -5.572628975e-01f, -5.927551910e-02f, 9.738476276e-01f, 8.480075598e-01f, 5.389667153e-01f, 3.146522641e-01f, 1.790295690e-01f, 1.010486856e-01f, 5.689026415e-02f, 3.200356290e-02f, 1.799902879e-02f, 1.012197044e-02f, 5.692068953e-03f, 3.200897481e-03f, 1.498772055e-01f, -9.520008564e-01f, -2.714101076e-01f, -2.349217981e-01f, 9.463000894e-01f, 8.764545321e-01f, 5.653295517e-01f, 3.314811885e-01f, 1.888588965e-01f, 1.066416800e-01f, 6.004713103e-02f, 3.378088027e-02f, 1.899885759e-02f, 1.068428159e-02f, 6.008291151e-03f, 3.378724447e-03f, 9.129452705e-01f, -9.686019421e-01f, 4.135828838e-02f, -4.031589925e-01f, 9.092974067e-01f, 9.021307230e-01f, 5.911270380e-01f, 3.482052684e-01f, 1.986693144e-01f, 1.122313142e-01f, 6.320339441e-02f, 3.555808961e-02f, 1.999866776e-02f, 1.124658901e-02f, 6.324512884e-03f, 3.556551412e-03f, 8.366556168e-01f, -6.868911982e-01f, 3.500247598e-01f, -5.586805344e-01f, 8.632093072e-01f, 9.249548316e-01f, 6.163335443e-01f, 3.648192585e-01f, 2.084598988e-01f, 1.178173944e-01f, 6.635902822e-02f, 3.733518720e-02f, 2.099845745e-02f, 1.180889271e-02f, 6.640734151e-03f, 3.734378144e-03f, -8.851309307e-03f, -1.936302334e-01f, 6.239799261e-01f, -6.965817213e-01f, 8.084963560e-01f, 9.448547959e-01f, 6.409237385e-01f, 3.813178837e-01f, 2.182296216e-01f, 1.233997419e-01f, 6.951400638e-02f, 3.911216930e-02f, 2.199822664e-02f, 1.237119269e-02f, 6.956954487e-03f, 3.912204877e-03f, -8.462204337e-01f, 3.592645228e-01f, 8.360552788e-01f, -8.125128746e-01f, 7.457052469e-01f, 9.617676139e-01f, 6.648730636e-01f, 3.976959288e-01f, 2.279775143e-01f, 1.289781928e-01f, 7.266827673e-02f, 4.088902473e-02f, 2.299797349e-02f, 1.293348987e-02f, 7.273174357e-03f, 4.090031609e-03f, -9.055783749e-01f, 8.015131354e-01f, 9.652192593e-01f, -9.028177857e-01f, 6.754631400e-01f, 9.756398797e-01f, 6.881574988e-01f, 4.139482081e-01f, 2.377026230e-01f, 1.345525682e-01f, 7.582182437e-02f, 4.266574979e-02f, 2.399769612e-02f, 1.349578146e-02f, 7.589393295e-03f, 4.267857410e-03f, -1.323517561e-01f, 9.969099760e-01f, 9.986631870e-01f, -9.646483064e-01f, 5.984721184e-01f, 9.864277244e-01f, 7.107539177e-01f, 4.300695956e-01f, 2.474039644e-01f, 1.401226968e-01f, 7.897461206e-02f, 4.444234073e-02f, 2.499739639e-02f, 1.405806933e-02f, 7.905611768e-03f, 4.445684142e-03f, 7.625584602e-01f, 8.852767944e-01f, 9.330701828e-01f, -9.960543513e-01f, 5.155012608e-01f, 9.940969944e-01f, 7.326396108e-01f, 4.460549951e-01f, 2.570805550e-01f, 1.456883848e-01f, 8.212661743e-02f, 4.621879384e-02f, 2.599707060e-02f, 1.462035347e-02f, 8.221829310e-03f, 4.623509943e-03f, 9.563759565e-01f, 5.009942055e-01f, 7.749450207e-01f, -9.960451722e-01f, 4.273798466e-01f, 9.986234903e-01f, 7.537927032e-01f, 4.618993104e-01f, 2.667314112e-01f, 1.512494683e-01f, 8.527779579e-02f, 4.799510166e-02f, 2.699672058e-02f, 1.518263202e-02f, 8.538045920e-03f, 4.801335745e-03f, 2.709057927e-01f, -3.758566082e-02f, 5.399689674e-01f, -9.646213055e-01f, 3.349882066e-01f, 9.999929070e-01f, 7.741920948e-01f, 4.775975943e-01f, 2.763556540e-01f, 1.568057537e-01f, 8.842811733e-02f, 4.977125302e-02f, 2.799634263e-02f, 1.574490592e-02f, 8.854261599e-03f, 4.979162011e-03f, -6.636338830e-01f, -5.645897985e-01f, 2.514453232e-01f, -9.027736783e-01f, 2.392492294e-01f, 9.982009530e-01f, 7.938174009e-01f, 4.931448400e-01f, 2.859522104e-01f, 1.623570919e-01f, 9.157756716e-02f, 5.154724792e-02f, 2.899593674e-02f, 1.630717516e-02f, 9.170476347e-03f, 5.156987347e-03f, -9.880316257e-01f, -9.177096486e-01f, -6.201484054e-02f, -8.124528527e-01f, 1.411200017e-01f, 9.932531714e-01f, 8.126488924e-01f, 5.085361004e-01f, 2.955201864e-01f, 1.679033041e-01f, 9.472609311e-02f, 5.332308263e-02f, 2.999550104e-02f, 1.686943881e-02f, 9.486690164e-03f, 5.334813148e-03f, -4.040376544e-01f, -9.881927967e-01f, -3.693250120e-01f, -6.965078115e-01f, 4.158052057e-02f, 9.851652980e-01f, 8.306677938e-01f, 5.237666368e-01f, 3.050586283e-01f, 1.734442115e-01f, 9.787366539e-02f, 5.509874597e-02f, 3.099503554e-02f, 1.743169688e-02f, 9.802903049e-03f, 5.512638018e-03f, 5.514267087e-01f, -7.543302178e-01f, -6.400094032e-01f, -5.585952997e-01f, -5.837419257e-02f, 9.739628434e-01f, 8.478561044e-01f, 5.388315320e-01f, 3.145665526e-01f, 1.789796203e-01f, 1.010202691e-01f, 5.687423423e-02f, 3.199454024e-02f, 1.799395122e-02f, 1.011911593e-02f, 5.690463353e-03f, 9.999118447e-01f, -2.881473899e-01f, -8.472243547e-01f, -4.030649364e-01f, -1.577456445e-01f, 9.596813321e-01f, 8.641966581e-01f, 5.537260175e-01f, 3.240430057e-01f, 1.845093668e-01f, 1.041658595e-01f, 5.864954367e-02f, 3.299400955e-02f, 1.855619811e-02f, 1.043532696e-02f, 5.868288688e-03f, 5.290827155e-01f, 2.667797208e-01f, -9.704204202e-01f, -2.348221242e-01f, -2.555412054e-01f, 9.423658252e-01f, 8.796730638e-01f, 5.684453845e-01f, 3.334870934e-01f, 1.900332868e-01f, 1.073104069e-01f, 6.042466685e-02f, 3.399345279e-02f, 1.911843941e-02f, 1.075153705e-02f, 6.046113092e-03f, -4.281826615e-01f, 7.395421267e-01f, -9.973804355e-01f, -5.917267874e-02f, -3.507832289e-01f, 9.220710397e-01f, 8.942698836e-01f, 5.829849839e-01f, 3.428978026e-01f, 1.955512017e-01f, 1.104538813e-01f, 6.219960377e-02f, 3.499285504e-02f, 1.968067512e-02f, 1.106774528e-02f, 6.223937962e-03f, -9.917788506e-01f, 9.845405817e-01f, -9.254310131e-01f, 1.183425859e-01f, -4.425205588e-01f, 8.988611698e-01f, 9.079725146e-01f, 5.973402858e-01f, 3.522742093e-01f, 2.010629177e-01f, 1.135962531e-01f, 6.397433579e-02f, 3.599222749e-02f, 2.024290524e-02f, 1.138395350e-02f, 6.401761901e-03f, -6.435381174e-01f, 9.263181090e-01f, -7.617069483e-01f, 2.921253741e-01f, -5.298361778e-01f, 8.728095889e-01f, 9.207672477e-01f, 6.115067005e-01f, 3.616154492e-01f, 2.065682709e-01f, 1.167374924e-01f, 6.574887782e-02f, 3.699155897e-02f, 2.080512606e-02f, 1.170015987e-02f, 6.579586305e-03f, 2.963685691e-01f, 5.828061700e-01f, -5.224447846e-01f, 4.566946924e-01f, -6.118578315e-01f, 8.439987302e-01f, 9.326412678e-01f, 6.254796982e-01f, 3.709204793e-01f, 2.120671123e-01f, 1.198775545e-01f, 6.752320379e-02f, 3.799085692e-02f, 2.136734314e-02f, 1.201636530e-02f, 6.757410709e-03f, 9.637953639e-01f, 5.980031565e-02f, -2.313720137e-01f, 6.068604589e-01f, -6.877662539e-01f, 8.125196099e-01f, 9.435827136e-01f, 6.392549276e-01f, 3.801884055e-01f, 2.175592482e-01f, 1.230164245e-01f, 6.929731369e-02f, 3.899011388e-02f, 2.192955278e-02f, 1.233256981e-02f, 6.935234182e-03f, 7.451131344e-01f, -4.816212952e-01f, 8.264580369e-02f, 7.378857136e-01f, -7.568024993e-01f, 7.784717083e-01f, 9.535806775e-01f, 6.528279781e-01f, 3.894183338e-01f, 2.230444849e-01f, 1.261540651e-01f, 7.107120752e-02f, 3.998933733e-02f, 2.249175683e-02f, 1.264877338e-02f, 7.113057654e-03f, -1.586226672e-01f, -8.747140169e-01f, 3.884676993e-01f, 8.456384540e-01f, -8.182770610e-01f, 7.419627905e-01f, 9.626252055e-01f, 6.661946774e-01f, 3.986093104e-01f, 2.285226882e-01f, 1.292904317e-01f, 7.284487784e-02f, 4.098851606e-02f, 2.305394970e-02f, 1.296497509e-02f, 7.290880661e-03f, -9.165215492e-01f, -9.984104633e-01f, 6.557646990e-01f, 9.267202020e-01f, -8.715758920e-01f, 7.031081319e-01f, 9.707071185e-01f, 6.793506742e-01f, 4.077604413e-01f, 2.339936644e-01f, 1.324255317e-01f, 7.461831719e-02f, 4.198765755e-02f, 2.361613885e-02f, 1.328117587e-02f, 7.468704134e-03f, -8.317747712e-01f, -8.146142364e-01f, 8.580306768e-01f, 9.785736203e-01f, -9.161660075e-01f, 6.620306373e-01f, 9.778184295e-01f, 6.922917962e-01f, 4.168707728e-01f, 2.394572198e-01f, 1.355592906e-01f, 7.639151812e-02f, 4.298675060e-02f, 2.417832054e-02f, 1.359737478e-02f, 7.646527141e-03f, 1.770192571e-02f, -3.799313903e-01f, 9.752061963e-01f, 9.995633960e-01f, -9.516021013e-01f, 6.188601851e-01f, 9.839519858e-01f, 7.050140500e-01f, 4.259394705e-01f, 2.449132055e-01f, 1.386916935e-01f, 7.816448808e-02f, 4.398580641e-02f, 2.474049293e-02f, 1.391357277e-02f, 7.824349217e-03f, 8.509035110e-01f, 1.717635691e-01f, 9.956709743e-01f, 9.890272617e-01f, -9.775301218e-01f, 5.737332702e-01f, 9.891016483e-01f, 7.175133228e-01f, 4.349655211e-01f, 2.503614724e-01f, 1.418227106e-01f, 7.993719727e-02f, 4.498481750e-02f, 2.530265786e-02f, 1.422976889e-02f, 8.002171293e-03f, 9.017883539e-01f, 6.705570221e-01f, 9.173954725e-01f, 9.472977519e-01f, -9.936909676e-01f, 5.267925262e-01f, 9.932623506e-01f, 7.297857404e-01f, 4.439480901e-01f, 2.558017969e-01f, 1.449523121e-01f, 8.170966059e-02f, 4.598378390e-02f, 2.586481534e-02f, 1.454596408e-02f, 8.179994300e-03f, 1.235731244e-01f, 9.628326893e-01f, 7.481423616e-01f, 8.756909966e-01f, -9.999232888e-01f, 4.781863391e-01f, 9.964298010e-01f, 7.418274283e-01f, 4.528862834e-01f, 2.612340748e-01f, 1.480804533e-01f, 8.348185569e-02f, 4.698270187e-02f, 2.642696351e-02f, 1.486215740e-02f, 8.357816376e-03f, -7.682546377e-01f, 9.585731030e-01f, 5.046970844e-01f, 7.764653563e-01f, -9.961646199e-01f, 4.280683994e-01f, 9.986009598e-01f, 7.536345124e-01f, 4.617791772e-01f, 2.666580379e-01f, 1.512071192e-01f, 8.525379747e-02f, 4.798157141e-02f, 2.698910423e-02f, 1.517834887e-02f, 8.535637520e-03f, -9.537526369e-01f, 6.590901017e-01f, 2.112006545e-01f, 6.527503729e-01f, -9.824525714e-01f, 3.765971363e-01f, 9.997735620e-01f, 7.652031779e-01f, 4.706258774e-01f, 2.720735669e-01f, 1.543322802e-01f, 8.702547103e-02f, 4.898039624e-02f, 2.755123749e-02f, 1.549453940e-02f, 8.713459596e-03f, -2.623748481e-01f, 1.566190720e-01f, -1.032404602e-01f, 5.084479451e-01f, -9.589242935e-01f, 3.239352703e-01f, 9.999465346e-01f, 7.765299678e-01f, 4.794255495e-01f, 2.774805427e-01f, 1.574558914e-01f, 8.879686147e-02f, 4.997916892e-02f, 2.811335959e-02f, 1.581072807e-02f, 8.891279809e-03f, 6.702291965e-01f, -3.940860629e-01f, -4.074441493e-01f, 3.481085002e-01f, -9.258147478e-01f, 2.702493370e-01f, 9.991195798e-01f, 7.876111865e-01f, 4.881772399e-01f, 2.828786969e-01f, 1.605779380e-01f, 9.056797624e-02f, 5.097789690e-02f, 2.867547423e-02f, 1.612691768e-02f, 9.069100954e-03f, 9.866275787e-01f, -8.234215975e-01f, -6.712401509e-01f, 1.767906845e-01f, -8.834545016e-01f, 2.157090008e-01f, 9.972936511e-01f, 7.984433770e-01f, 4.968801141e-01f, 2.882679403e-01f, 1.636983752e-01f, 9.233880043e-02f, 5.197656900e-02f, 2.923758142e-02f, 1.644310169e-02f, 9.246920235e-03f, 3.959251642e-01f, -9.991579652e-01f, -8.684699535e-01f, -1.030206768e-04f, -8.322673440e-01f, 1.604867280e-01f, 9.944704771e-01f, 8.090230227e-01f, 5.055333376e-01f, 2.936480343e-01f, 1.668171734e-01f, 9.410934150e-02f, 5.297519267e-02f, 2.979967557e-02f, 1.675928757e-02f, 9.424741380e-03f, -5.587890744e-01f, -8.671715260e-01f, -9.795749187e-01f, -1.769934744e-01f, -7.727644444e-01f, 1.047568321e-01f, 9.906529188e-01f, 8.193469048e-01f, 5.141359568e-01f, 2.990188897e-01f, 1.699342877e-01f, 9.587957710e-02f, 5.397376046e-02f, 3.036176413e-02f, 1.707546785e-02f, 9.602561593e-03f, -9.997551441e-01f, -4.681116641e-01f, -9.935355186e-01f, -3.483016491e-01f, -7.055402994e-01f, 4.869600013e-02f, 9.858447909e-01f, 8.294116855e-01f, 5.226872563e-01f, 3.043802381e-01f, 1.730497181e-01f, 9.764950722e-02f, 5.497227982e-02f, 3.092384152e-02f, 1.739165001e-02f, 9.780380875e-03f, -5.215510130e-01f, 7.511820644e-02f, -9.089674354e-01f, -5.086245537e-01f, -6.312667131e-01f, -7.518785074e-03f, 9.800508618e-01f, 8.392141461e-01f, 5.311862230e-01f, 3.097319603e-01f, 1.761634201e-01f, 9.941913933e-02f, 5.597073585e-02f, 3.148590773e-02f, 1.770782843e-02f, 9.958200157e-03f, 4.361647666e-01f, 5.952115059e-01f, -7.342582941e-01f, -6.529057026e-01f, -5.506852865e-01f, -6.370979548e-02f, 9.732769728e-01f, 8.487512469e-01f, 5.396320224e-01f, 3.150739372e-01f, 1.792753637e-01f, 1.011884511e-01f, 5.696914345e-02f, 3.204796836e-02f, 1.802400686e-02f, 1.013601944e-02f, 9.928726554e-01f, 9.319928288e-01f, -4.867334962e-01f, -7.765945792e-01f, -4.646020234e-01f, -1.196993962e-01f, 9.655299187e-01f, 8.580200076e-01f, 5.480239391e-01f, 3.204059005e-01f, 1.823855042e-01f, 1.029574350e-01f, 5.796748772e-02f, 3.261001408e-02f, 1.834018156e-02f, 1.031383779e-02f, 6.367380023e-01f, 9.817358255e-01f, -1.909380108e-01f, -8.757900000e-01f, -3.738765717e-01f, -1.753105819e-01f, 9.568174481e-01f, 8.670173883e-01f, 5.563610196e-01f, 3.257277906e-01f, 1.854938269e-01f, 1.047261059e-01f, 5.896577984e-02f, 3.317204863e-02f, 1.865635626e-02f, 1.049165614e-02f, -3.048106134e-01f, 7.291237116e-01f, 1.237909496e-01f, -9.473637342e-01f, -2.794154882e-01f, -2.303675115e-01f, 9.471482038e-01f, 8.757405281e-01f, 5.646424294e-01f, 3.310393095e-01f, 1.886002868e-01f, 1.064944416e-01f, 5.996400863e-02f, 3.373407945e-02f, 1.897252724e-02f, 1.066947449e-02f, -9.661177993e-01f, 2.519522607e-01f, 4.262454212e-01f, -9.890577197e-01f, -1.821625978e-01f, -2.846961617e-01f, 9.365318418e-01f, 8.841868639e-01f, 5.728674531e-01f, 3.363404274e-01f, 1.917048544e-01f, 1.082624346e-01f, 6.096218154e-02f, 3.429609165e-02f, 1.928869821e-02f, 1.084729191e-02f, -7.391806841e-01f, -3.028128743e-01f, 6.864276528e-01f, -9.995572567e-01f, -8.308912069e-02f, -3.381247520e-01f, 9.249790907e-01f, 8.923535347e-01f, 5.810351372e-01f, 3.416308761e-01f, 1.948075294e-01f, 1.100300923e-01f, 6.196028739e-02f, 3.485809639e-02f, 1.960486546e-02f, 1.102510840e-02f, 1.673557013e-01f, -7.643200755e-01f, 8.785385489e-01f, -9.785313010e-01f, 1.681409031e-02f, -3.904843926e-01f, 9.125014544e-01f, 9.002380967e-01f, 5.891447663e-01f, 3.469105363e-01f, 1.979082376e-01f, 1.117973924e-01f, 6.295833737e-02f, 3.542009369e-02f, 1.992103085e-02f, 1.120292582e-02f };

#define LAS __attribute__((address_space(3)))
typedef unsigned short bf16;
typedef float f32x4 __attribute__((ext_vector_type(4)));
typedef float f32x2 __attribute__((ext_vector_type(2)));
typedef float f32x16 __attribute__((ext_vector_type(16)));
typedef short bf16x8 __attribute__((ext_vector_type(8)));
typedef short s16x4 __attribute__((ext_vector_type(4)));
typedef unsigned u32x4 __attribute__((ext_vector_type(4)));
typedef unsigned u32x2 __attribute__((ext_vector_type(2)));

constexpr int DM = 2048, NB = 8, SEQ = 2048, CTX = 256, DEPTH = 2;
constexpr int NLAT = NB * SEQ, NCTX = NB * CTX, NROW = NLAT + NCTX;
constexpr int INC = 5888, NEXP = 16, EFF = 1024, ADAW = 6 * DM;
constexpr int ZC_RQ = 0, ZC_RK = 512, ZC_RV = 1024, ZC_RG = 1536, ZC_CB = 2048, ZC_CC = 2560, ZC_CH = 3072, ZC_SQ = 3584, ZC_SK = 4096, ZC_SV = 4224, ZC_NQ = 4352, ZC_NK = 4864, ZC_NV = 5376;
constexpr int YC_RET = 0, YC_CONV = 512, YC_SWA = 1024, YC_NA = 1536;
constexpr float LOG2E = 1.4426950408889634f;
constexpr float RMS_EPS = 1e-6f;
constexpr int NWAVES = 8, NTHR = 512;

constexpr size_t MiB = (size_t)1 << 20;
constexpr size_t WS_CTL = 0, CTL_ZERO_BYTES = 1 * MiB;
constexpr size_t WS_ADA = 1 * MiB;
constexpr size_t WS_AFF = 2 * MiB;
constexpr size_t WS_SEL = 4 * MiB;
constexpr size_t WS_IDX = 6 * MiB;
constexpr size_t WS_GATEV = 6 * MiB + 256 * 1024;
constexpr size_t WS_WIN = 8 * MiB;
constexpr size_t WS_WOUT = 54 * MiB;
constexpr size_t WS_WGU = 70 * MiB;
constexpr size_t WS_WD = 326 * MiB;
constexpr size_t WS_XC = 454 * MiB;
constexpr size_t WS_HB = 470 * MiB;
constexpr size_t WS_Z = 542 * MiB;
constexpr size_t WS_ACT = 749 * MiB;
constexpr size_t WS_SST = 821 * MiB;
constexpr size_t WS_SIN = 857 * MiB;
constexpr size_t WS_XB = 876 * MiB;
constexpr size_t WS_END = 948 * MiB;
constexpr int CW_BAR = 4096;

constexpr int LDS_BYTES = 147456;
constexpr int MISC_OFF = 131072 + 320;
constexpr int ROPE_LDS = 131072 + 8192;

struct Params {
    const float* x; const float* c; const float* ctx; const float* c_ctx; const float* w_ada; const float* b_ada; const float* norm_mix; const float* norm_ffn;
    const float* w_in; const float* w_out; const float* dec_f; const float* dec_b; const float* conv_w; const float* sink; const float* rpb; const float* w_router;
    const float* w_gate; const float* w_up; const float* w_down; const float* norm_final;
    float* out; unsigned char* ws;
};

__device__ __forceinline__ float bf2f(unsigned v) { return __uint_as_float(v << 16); }
__device__ __forceinline__ unsigned f2bf(float f) { unsigned u = __float_as_uint(f); return (u + 0x7fffu + ((u >> 16) & 1u)) >> 16; }
__device__ __forceinline__ unsigned pk2(float lo, float hi) { unsigned r; asm volatile("v_cvt_pk_bf16_f32 %0, %1, %2" : "=v"(r) : "v"(lo), "v"(hi)); return r; }
__device__ __forceinline__ float ex2(float x) { return __builtin_amdgcn_exp2f(x); }
__device__ __forceinline__ float wave_sum(float v) {
#pragma unroll
    for (int o = 1; o < 64; o <<= 1) v += __shfl_xor(v, o);
    return v;
}
__device__ __forceinline__ float half_sum32(float v) {
#pragma unroll
    for (int o = 1; o < 32; o <<= 1) v += __shfl_xor(v, o);
    return v;
}
__device__ __forceinline__ float silu_f(float x) { return x / (1.f + __expf(-x)); }
__device__ __forceinline__ int crow(int r, int hi) { return (r & 3) + 8 * (r >> 2) + 4 * hi; }
#define MFMA32(a, b, c) __builtin_amdgcn_mfma_f32_32x32x16_bf16((a), (b), (c), 0, 0, 0)
#define LDS_WAIT() asm volatile("s_waitcnt lgkmcnt(0)" ::: "memory")
typedef short v4i16_t __attribute__((ext_vector_type(4)));
__device__ __forceinline__ s16x4 trrd(LAS const unsigned char* p) { return __builtin_bit_cast(s16x4, __builtin_amdgcn_ds_read_tr16_b64_v4i16((LAS v4i16_t*)p)); }
__device__ __forceinline__ bf16x8 cat8(s16x4 lo, s16x4 hi) { return (bf16x8){lo[0], lo[1], lo[2], lo[3], hi[0], hi[1], hi[2], hi[3]}; }
__device__ __forceinline__ u32x4 scale8(u32x4 v, float s) {
    u32x4 r;
#pragma unroll
    for (int i = 0; i < 4; ++i) r[i] = pk2(bf2f(v[i] & 0xffffu) * s, __uint_as_float(v[i] & 0xffff0000u) * s);
    return r;
}

__device__ __forceinline__ float* ws_ada(const Params& p) { return (float*)(p.ws + WS_ADA); }
__device__ __forceinline__ bf16* ws_z(const Params& p) { return (bf16*)(p.ws + WS_Z); }
__device__ __forceinline__ bf16* ws_hb(const Params& p) { return (bf16*)(p.ws + WS_HB); }
constexpr int KVH_ROWS = SEQ + CTX;
__device__ __forceinline__ bf16* ws_kvh(const Params& p) { return (bf16*)(p.ws + WS_ACT); }
__device__ __forceinline__ size_t kvh_off(int kind, int b, int h) { return (size_t)((kind * NB + b) * 8 + h) * KVH_ROWS * 64; }
__device__ __forceinline__ bf16* ws_xb(const Params& p) { return (bf16*)(p.ws + WS_XB); }

namespace pg8 {
struct GroupedOrder {
    StaticOrder S; int tpe;
    __device__ void init(int tpe_, int G_, int c_) { tpe = tpe_; S.init(16 * tpe_ * BM, 8 * BM, G_, c_); }
    __device__ bool next(int i, Unit& u) const { if (!S.next(i, u)) return false; u.pb = (u.pm / tpe) * 8 + u.pn; return true; }
    __device__ __forceinline__ void a_ready(const Unit&) const {}
    __device__ __forceinline__ void done(const Unit&) const {}
};
struct SkipOrder {
    StaticOrder S; int G, c;
    __device__ void init(int G_, int c_) { S.init(16384, 5888, G_, c_); G = G_; c = c_; }
    __device__ bool next(int i, Unit& u) const {
        if (S.next(i, u)) return true;
        const int j = i * G + c - 64 * 23; if (j < 0 || j >= 64) return false;
        const int t = j >> 3; u.pm = 64 + (j & 7); u.pn = t < 4 ? 2 + t : (t == 4 ? 16 : 14 + t); u.pb = u.pn; return true;
    }
    __device__ __forceinline__ void a_ready(const Unit&) const {}
    __device__ __forceinline__ void done(const Unit&) const {}
};
struct QuadOrder {
    int G, c;
    __device__ void init(int G_, int c_) { G = G_; c = c_; }
    __device__ bool next(int i, Unit& u) const {
        const int x = i * G + c; if (x >= 32) return false;
        u.pm = 64 + (x >> 2); u.pn = 22; u.pb = 22; u.q = x & 3; return true;
    }
    __device__ __forceinline__ void a_ready(const Unit&) const {}
    __device__ __forceinline__ void done(const Unit&) const {}
};
template <bool BASE_F32> struct EpiResGate {
    static constexpr bool PERM = true, AFTER_DRAIN = false;
    const float* base_lat; const float* base_ctx; bf16_t* xb; const float* ada; int goff;
    __device__ __forceinline__ void operator()(const f32x4 (&acc)[2][2][4][2], const Unit& u, int wr, int wc, int fr, int fq) const {
        const bool isctx = u.pm >= 64;
        const int grow = isctx ? 8 : (u.pm >> 3);
        const float* g = ada + grow * 12288 + goff;
        const float* basef = isctx ? base_ctx - (size_t)64 * BM * 2048 : base_lat;
        const int row0 = u.pm * BM + wr * 64 + fr, col0 = u.pn * BM + wc * 32 + 8 * fq;
        f32x4 gv[2][2];
#pragma unroll
        for (int bj = 0; bj < 2; ++bj)
#pragma unroll
            for (int n = 0; n < 2; ++n) gv[bj][n] = *(const f32x4*)(g + col0 + bj * HALF + 4 * n);
#pragma unroll
        for (int ai = 0; ai < 2; ++ai)
#pragma unroll
            for (int m = 0; m < 4; ++m) { const size_t off = (size_t)(row0 + ai * HALF + m * 16) * 2048 + col0;
#pragma unroll
                for (int bj = 0; bj < 2; ++bj) { f32x4 b0, b1;
                    if constexpr (BASE_F32) { b0 = *(const f32x4*)(basef + off + bj * HALF); b1 = *(const f32x4*)(basef + off + bj * HALF + 4); }
                    else { const u32x4 w = *(const u32x4*)(xb + off + bj * HALF);
                        b0 = (f32x4){__uint_as_float(w.x << 16), __uint_as_float(w.x & 0xffff0000u), __uint_as_float(w.y << 16), __uint_as_float(w.y & 0xffff0000u)};
                        b1 = (f32x4){__uint_as_float(w.z << 16), __uint_as_float(w.z & 0xffff0000u), __uint_as_float(w.w << 16), __uint_as_float(w.w & 0xffff0000u)}; }
                    const f32x4 v0 = b0 + gv[bj][0] * acc[ai][bj][m][0], v1 = b1 + gv[bj][1] * acc[ai][bj][m][1];
                    u32x4 o; o.x = cvt_pk_bf16(v0[0], v0[1]); o.y = cvt_pk_bf16(v0[2], v0[3]); o.z = cvt_pk_bf16(v1[0], v1[1]); o.w = cvt_pk_bf16(v1[2], v1[3]);
                    *(u32x4*)(xb + off + bj * HALF) = o; }
                asm volatile("" ::: "memory"); }
    }
};
struct EpiSiluMul {
    static constexpr bool PERM = true, AFTER_DRAIN = false;
    bf16_t* O;
    __device__ __forceinline__ void operator()(const f32x4 (&acc)[2][2][4][2], const Unit& u, int wr, int wc, int fr, int fq) const {
        const int row0 = u.pm * BM + wr * 64 + fr, col0 = u.pn * HALF + wc * 32 + 8 * fq;
#pragma unroll
        for (int ai = 0; ai < 2; ++ai)
#pragma unroll
            for (int m = 0; m < 4; ++m) { bf16_t* rowp = O + (size_t)(row0 + ai * HALF + m * 16) * 1024 + col0;
                float v[8];
#pragma unroll
                for (int n = 0; n < 2; ++n)
#pragma unroll
                    for (int j = 0; j < 4; ++j) { const float gg = acc[ai][0][m][n][j], uu = acc[ai][1][m][n][j]; v[n * 4 + j] = gg * __builtin_amdgcn_rcpf(1.f + __builtin_amdgcn_exp2f(-gg * 1.4426950408889634f)) * uu; }
                u32x4 w; w.x = cvt_pk_bf16(v[0], v[1]); w.y = cvt_pk_bf16(v[2], v[3]); w.z = cvt_pk_bf16(v[4], v[5]); w.w = cvt_pk_bf16(v[6], v[7]);
                *(u32x4*)rowp = w; }
    }
};
struct EpiDown {
    static constexpr bool PERM = true, AFTER_DRAIN = false;
    bf16_t* O; const float* gatev;
    __device__ __forceinline__ void operator()(const f32x4 (&acc)[2][2][4][2], const Unit& u, int wr, int wc, int fr, int fq) const {
        const int row0 = u.pm * BM + wr * 64 + fr, col0 = u.pn * BM + wc * 32 + 8 * fq;
        float sg[2][4];
#pragma unroll
        for (int ai = 0; ai < 2; ++ai)
#pragma unroll
            for (int m = 0; m < 4; ++m) sg[ai][m] = gatev[row0 + ai * HALF + m * 16];
#pragma unroll
        for (int ai = 0; ai < 2; ++ai)
#pragma unroll
            for (int m = 0; m < 4; ++m) { const int row = row0 + ai * HALF + m * 16; const float s = sg[ai][m]; bf16_t* rowp = O + (size_t)row * 2048 + col0;
#pragma unroll
                for (int bj = 0; bj < 2; ++bj) { const f32x4 v0 = acc[ai][bj][m][0] * s, v1 = acc[ai][bj][m][1] * s;
                    u32x4 w; w.x = cvt_pk_bf16(v0[0], v0[1]); w.y = cvt_pk_bf16(v0[2], v0[3]); w.z = cvt_pk_bf16(v1[0], v1[1]); w.w = cvt_pk_bf16(v1[2], v1[3]);
                    *(u32x4*)(rowp + bj * HALF) = w; } }
    }
};
struct EpiZRope {
    static constexpr bool PERM = true, AFTER_DRAIN = false;
    bf16_t* O; LAS const float* rcos; LAS const float* rsin; bf16_t* KV;
    __device__ __forceinline__ void quad(const f32x4 (&a)[4][2], const Unit& u, int wr, int wc, int fr, int fq) const {
        const int ai = u.q >> 1, bj = u.q & 1, tile = u.pn;
        const int b = (u.pm < 64) ? (u.pm >> 3) : (u.pm - 64), rloc0 = ((u.pm < 64) ? (u.pm & 7) * 256 : 2048) + wr * 64 + fr + ai * HALF;
        const int c = (tile - 19) * BM + wc * 32 + 8 * fq + bj * HALF;
        bf16_t* hp = KV + ((size_t)(((c >> 9) * 8 + b) * 8 + ((c >> 6) & 7)) * 2304 + rloc0) * 64 + (c & 63);
#pragma unroll
        for (int m = 0; m < 4; ++m) { const f32x4 v0 = a[m][0], v1 = a[m][1];
            u32x4 w; w.x = cvt_pk_bf16(v0[0], v0[1]); w.y = cvt_pk_bf16(v0[2], v0[3]); w.z = cvt_pk_bf16(v1[0], v1[1]); w.w = cvt_pk_bf16(v1[2], v1[3]);
            *(u32x4*)(hp + (m * 16) * 64) = w; }
    }
    __device__ __forceinline__ void operator()(const f32x4 (&acc)[2][2][4][2], const Unit& u, int wr, int wc, int fr, int fq) const {
        const int row0 = u.pm * BM + wr * 64 + fr, tile = u.pn;
        const bool rtile = (tile < 4) || (tile >= 14 && tile <= 16);
        if (tile >= 19) {
            const int b = (u.pm < 64) ? (u.pm >> 3) : (u.pm - 64), rloc0 = ((u.pm < 64) ? (u.pm & 7) * 256 : 2048) + wr * 64 + fr;
#pragma unroll
            for (int bj = 0; bj < 2; ++bj) { const int c = (tile - 19) * BM + wc * 32 + 8 * fq + bj * HALF;
                bf16_t* hp = KV + ((size_t)(((c >> 9) * 8 + b) * 8 + ((c >> 6) & 7)) * 2304 + rloc0) * 64 + (c & 63);
#pragma unroll
                for (int ai = 0; ai < 2; ++ai) {
#pragma unroll
                    for (int m = 0; m < 4; ++m) { const f32x4 v0 = acc[ai][bj][m][0], v1 = acc[ai][bj][m][1];
                        u32x4 w; w.x = cvt_pk_bf16(v0[0], v0[1]); w.y = cvt_pk_bf16(v0[2], v0[3]); w.z = cvt_pk_bf16(v1[0], v1[1]); w.w = cvt_pk_bf16(v1[2], v1[3]);
                        *(u32x4*)(hp + (ai * HALF + m * 16) * 64) = w; } } }
            return;
        }
        if (!rtile) {
            const int col0 = tile * BM + wc * 32 + 8 * fq;
#pragma unroll
            for (int ai = 0; ai < 2; ++ai)
#pragma unroll
                for (int m = 0; m < 4; ++m) { bf16_t* rowp = O + (size_t)(row0 + ai * HALF + m * 16) * 5888 + col0;
#pragma unroll
                    for (int bj = 0; bj < 2; ++bj) { const f32x4 v0 = acc[ai][bj][m][0], v1 = acc[ai][bj][m][1];
                        u32x4 w; w.x = cvt_pk_bf16(v0[0], v0[1]); w.y = cvt_pk_bf16(v0[2], v0[3]); w.z = cvt_pk_bf16(v1[0], v1[1]); w.w = cvt_pk_bf16(v1[2], v1[3]);
                        *(u32x4*)(rowp + bj * HALF) = w; } }
            return;
        }
        const bool pass = (tile == 16) && (wc >= 2);
        const int c1 = pass ? 4224 + (wc - 2) * 32 : tile * BM + wc * 64, c2 = pass ? c1 + 64 : c1 + 32;
        const bool rope = !pass && (u.pm < 64);
#pragma unroll
        for (int ai = 0; ai < 2; ++ai)
#pragma unroll
            for (int m = 0; m < 4; ++m) { const int row = row0 + ai * HALF + m * 16; bf16_t* rowp = O + (size_t)row * 5888 + 8 * fq;
                f32x4 a0 = acc[ai][0][m][0], a1 = acc[ai][0][m][1], b0 = acc[ai][1][m][0], b1 = acc[ai][1][m][1];
                if (rope) { const int t = row & 2047, pos = (fq < 2) ? (t >> 6) : (t & 63), ti = pos * 16 + 8 * (fq & 1);
                    const f32x4 cs0 = *(LAS const f32x4*)(rcos + ti), cs1 = *(LAS const f32x4*)(rcos + ti + 4), sn0 = *(LAS const f32x4*)(rsin + ti), sn1 = *(LAS const f32x4*)(rsin + ti + 4);
                    const f32x4 x0 = a0 * cs0 - b0 * sn0, x1 = a1 * cs1 - b1 * sn1, y0 = a0 * sn0 + b0 * cs0, y1 = a1 * sn1 + b1 * cs1;
                    a0 = x0; a1 = x1; b0 = y0; b1 = y1; }
                u32x4 w; w.x = cvt_pk_bf16(a0[0], a0[1]); w.y = cvt_pk_bf16(a0[2], a0[3]); w.z = cvt_pk_bf16(a1[0], a1[1]); w.w = cvt_pk_bf16(a1[2], a1[3]);
                *(u32x4*)(rowp + c1) = w;
                w.x = cvt_pk_bf16(b0[0], b0[1]); w.y = cvt_pk_bf16(b0[2], b0[3]); w.z = cvt_pk_bf16(b1[0], b1[1]); w.w = cvt_pk_bf16(b1[2], b1[3]);
                *(u32x4*)(rowp + c2) = w; }
    }
};
}

__device__ __forceinline__ void transpose_item(const float* W, int N, bf16* WT, int K, int k0, int n0, int drow0, LAS float* scr, int lane) {
#pragma unroll 8
    for (int i = 0; i < 32; ++i) { const int kk = 2 * i + (lane >> 5); scr[kk * 33 + (lane & 31)] = W[(size_t)(k0 + kk) * N + n0 + (lane & 31)]; }
    LDS_WAIT();
    const int c = lane & 7;
#pragma unroll
    for (int j = 0; j < 4; ++j) { const int n = (lane >> 3) + 8 * j; const LAS float* s = scr + (8 * c) * 33 + n;
        u32x4 o; o.x = pk2(s[0 * 33], s[1 * 33]); o.y = pk2(s[2 * 33], s[3 * 33]); o.z = pk2(s[4 * 33], s[5 * 33]); o.w = pk2(s[6 * 33], s[7 * 33]);
        *(u32x4*)(WT + (size_t)(drow0 + n) * K + k0 + 8 * c) = o; }
    LDS_WAIT();
}
__device__ __forceinline__ int win_dst_group(int sg) {
    const int tile = sg >> 3, r = sg & 7;
    if (tile < 4 || tile == 14 || tile == 15) return tile * 8 + (r & 1) * 4 + (r >> 1);
    if (tile == 16) return 128 + (r < 4 ? ((r & 1) * 4 + (r >> 1)) : (r < 6 ? r - 2 : r));
    return sg;
}
constexpr int I_IN = 32 * 184, I_OUT = 32 * 64, I_G = 16 * 32 * 32, I_D = 16 * 16 * 64, I_L = I_IN + I_OUT + 2 * I_G + I_D;

__device__ __forceinline__ void convert_item(const Params& p, int l, int r, LAS float* scr, int lane) {
    bf16* WIN = (bf16*)(p.ws + WS_WIN); bf16* WOUT = (bf16*)(p.ws + WS_WOUT); bf16* WGU = (bf16*)(p.ws + WS_WGU); bf16* WD = (bf16*)(p.ws + WS_WD);
    if (r < I_IN) { const int kb = r / 184, nb = r % 184; transpose_item(p.w_in + (size_t)l * 2048 * INC, INC, WIN + (size_t)l * INC * 2048, 2048, 64 * kb, 32 * nb, 32 * win_dst_group(nb), scr, lane); return; } r -= I_IN;
    if (r < I_OUT) { const int kb = r / 64, nb = r % 64; transpose_item(p.w_out + (size_t)l * 2048 * 2048, 2048, WOUT + (size_t)l * 2048 * 2048, 2048, 64 * kb, 32 * nb, 32 * nb, scr, lane); return; } r -= I_OUT;
    if (r < 2 * I_G) { const int isup = r >= I_G; if (isup) r -= I_G; const int e = r >> 10, rr = r & 1023, kb = rr >> 5, nb = rr & 31, n0 = 32 * nb;
        const float* W = (isup ? p.w_up : p.w_gate) + (size_t)(l * 16 + e) * 2048 * 1024;
        transpose_item(W, 1024, WGU + (size_t)(l * 16 + e) * 2048 * 2048, 2048, 64 * kb, n0, (n0 >> 7) * 256 + (n0 & 127) + (isup ? 128 : 0), scr, lane); return; } r -= 2 * I_G;
    { const int e = r >> 10, rr = r & 1023, kb = rr >> 6, nb = rr & 63;
      transpose_item(p.w_down + (size_t)(l * 16 + e) * 1024 * 2048, 2048, WD + (size_t)(l * 16 + e) * 2048 * 1024, 1024, 64 * kb, 32 * nb, 32 * nb, scr, lane); }
}
#ifndef TAIL_P2
#define TAIL_P2 0
#define TAIL_P6 (192 * 128)
#define TAIL_P9 0
#define TAIL_P10 0
#endif
constexpr int TAIL_OFF_P2 = 0, TAIL_OFF_P6 = TAIL_P2, TAIL_OFF_P9 = TAIL_P2 + TAIL_P6, TAIL_OFF_P10 = TAIL_P2 + TAIL_P6 + TAIL_P9, TAIL_ITEMS = TAIL_P2 + TAIL_P6 + TAIL_P9 + TAIL_P10;
static_assert(TAIL_ITEMS <= I_L, "tail items are layer-1 items");
__device__ __forceinline__ void ph_prologue(const Params& p, LAS unsigned char* lds) {
    const int tid = tid_opaque(), lane = tid & 63, wave = __builtin_amdgcn_readfirstlane(tid >> 6);
    const int G = gridDim.x;
    for (int u = blockIdx.x; u < 192; u += G) {
        const int l = u / 96, cg = u % 96;
        LAS float* s_sil = (LAS float*)lds; LAS float* s_red = (LAS float*)(lds + 73728);
        for (int i = tid; i < 9 * 2048; i += NTHR) { const int r = i >> 11, k = i & 2047; const float v = (r < 8) ? p.c[r * 2048 + k] : p.c_ctx[k]; s_sil[i] = silu_f(v); }
        __syncthreads();
        const float* W = p.w_ada + (size_t)l * 2048 * ADAW + cg * 128 + 2 * lane;
        float acc[9][2];
#pragma unroll
        for (int r = 0; r < 9; ++r) { acc[r][0] = 0.f; acc[r][1] = 0.f; }
        const int k0 = wave * 256;
        for (int kk = 0; kk < 256; kk += 8) {
            f32x2 w[8];
#pragma unroll
            for (int j = 0; j < 8; ++j) w[j] = *(const f32x2*)(W + (size_t)(k0 + kk + j) * ADAW);
#pragma unroll
            for (int r = 0; r < 9; ++r) {
                const f32x4 sa = *(LAS const f32x4*)(s_sil + r * 2048 + k0 + kk), sb = *(LAS const f32x4*)(s_sil + r * 2048 + k0 + kk + 4);
#pragma unroll
                for (int j = 0; j < 4; ++j) { acc[r][0] += sa[j] * w[j].x; acc[r][1] += sa[j] * w[j].y; acc[r][0] += sb[j] * w[4 + j].x; acc[r][1] += sb[j] * w[4 + j].y; }
            }
        }
#pragma unroll
        for (int r = 0; r < 9; ++r) { s_red[(wave * 9 + r) * 128 + 2 * lane] = acc[r][0]; s_red[(wave * 9 + r) * 128 + 2 * lane + 1] = acc[r][1]; }
        __syncthreads();
        for (int i = tid; i < 9 * 128; i += NTHR) { const int r = i >> 7, cc = i & 127; float s = p.b_ada[l * ADAW + cg * 128 + cc];
#pragma unroll
            for (int w = 0; w < 8; ++w) s += s_red[(w * 9 + r) * 128 + cc];
            ws_ada(p)[(size_t)(l * 9 + r) * ADAW + cg * 128 + cc] = s; }
        __syncthreads();
    }
    LAS float* scr = (LAS float*)(lds + wave * 8448);
    const int gw = blockIdx.x * NWAVES + wave, NGW = G * NWAVES;
    const int tail = (G == 256) ? TAIL_ITEMS : 0;
    for (int it = gw; it < 2 * I_L - tail; it += NGW) { const int g = it < I_L ? it : it + tail; convert_item(p, g / I_L, g % I_L, scr, lane); }
}
__device__ __forceinline__ void tail_convert(const Params& p, int off, int n, int rank, int nidle, LAS unsigned char* lds) {
    const int tid = tid_opaque(), lane = tid & 63, wave = __builtin_amdgcn_readfirstlane(tid >> 6);
    LAS float* scr = (LAS float*)(lds + wave * 8448);
    for (int it = rank * NWAVES + wave; it < n; it += nidle * NWAVES) convert_item(p, 1, off + it, scr, lane);
}

__device__ __forceinline__ void load_row8(f32x4 (&v)[8], const float* row, int lane) {
#pragma unroll
    for (int j = 0; j < 8; ++j) v[j] = *(const f32x4*)(row + 256 * j + 4 * lane);
}
__device__ __forceinline__ void load_row8_bf16(f32x4 (&v)[8], const bf16* row, int lane) {
#pragma unroll
    for (int j = 0; j < 8; ++j) { const u32x2 w = *(const u32x2*)(row + 256 * j + 4 * lane);
        v[j] = (f32x4){__uint_as_float(w.x << 16), __uint_as_float(w.x & 0xffff0000u), __uint_as_float(w.y << 16), __uint_as_float(w.y & 0xffff0000u)}; }
}
__device__ __forceinline__ float row_rstd(const f32x4 (&v)[8]) {
    float s = 0.f;
#pragma unroll
    for (int j = 0; j < 8; ++j) s += (v[j].x * v[j].x + v[j].y * v[j].y) + (v[j].z * v[j].z + v[j].w * v[j].w);
    return rsqrtf(wave_sum(s) * (1.f / 2048.f) + RMS_EPS);
}
__device__ __forceinline__ void modulate8(f32x4 (&v)[8], float rstd, const float* nw, const float* sc, const float* sh, int lane) {
#pragma unroll
    for (int j = 0; j < 8; ++j) { const int c = 256 * j + 4 * lane; const f32x4 w = *(const f32x4*)(nw + c), s1 = *(const f32x4*)(sc + c), s0 = *(const f32x4*)(sh + c);
        v[j] = v[j] * rstd * w * (1.f + s1) + s0; }
}
__device__ __forceinline__ void store_row8_bf16(const f32x4 (&v)[8], bf16* row, int lane) {
#pragma unroll
    for (int j = 0; j < 8; ++j) { u32x2 w; w.x = pk2(v[j].x, v[j].y); w.y = pk2(v[j].z, v[j].w); *(u32x2*)(row + 256 * j + 4 * lane) = w; }
}
__device__ __forceinline__ void load_coeffs(f32x4 (&wv)[8], f32x4 (&sv)[8], const float* nw, const float* sc, const float* sh, int lane) {
#pragma unroll
    for (int j = 0; j < 8; ++j) { const int c = 256 * j + 4 * lane; wv[j] = *(const f32x4*)(nw + c) * (1.f + *(const f32x4*)(sc + c)); sv[j] = *(const f32x4*)(sh + c); }
}
__device__ __forceinline__ void ph_modnorm0(const Params& p) {
    const int tid_ = tid_opaque(), lane = tid_ & 63, wave = __builtin_amdgcn_readfirstlane(tid_ >> 6);
    const int gw = blockIdx.x * NWAVES + wave, NGW = gridDim.x * NWAVES;
    const int rpw = (NROW + NGW - 1) / NGW, r0 = gw * rpw, r1 = (r0 + rpw < NROW) ? r0 + rpw : NROW;
    int cur = -1; f32x4 wv[8], sv[8], vn[8];
#define XROW0(r) (((r) < NLAT) ? p.x + (size_t)(r) * DM : p.ctx + (size_t)((r) - NLAT) * DM)
    if (r0 < r1) load_row8(vn, XROW0(r0), lane);
    for (int row = r0; row < r1; ++row) {
        f32x4 v[8];
#pragma unroll
        for (int j = 0; j < 8; ++j) v[j] = vn[j];
        if (row + 1 < r1) load_row8(vn, XROW0(row + 1), lane);
        const int arow = (row < NLAT) ? (row >> 11) : 8;
        if (arow != cur) { const float* ad = ws_ada(p) + (size_t)(0 * 9 + arow) * ADAW; load_coeffs(wv, sv, p.norm_mix, ad + 2048, ad, lane); cur = arow; }
        const float rstd = row_rstd(v);
#pragma unroll
        for (int j = 0; j < 8; ++j) v[j] = v[j] * rstd * wv[j] + sv[j];
        store_row8_bf16(v, ws_hb(p) + (size_t)row * DM, lane);
    }
#undef XROW0
}

namespace att {
__device__ __forceinline__ float xh_max(float v) { auto rr = __builtin_amdgcn_permlane32_swap(__float_as_uint(v), __float_as_uint(v), false, false); float a = __uint_as_float(rr[0]), b = __uint_as_float(rr[1]), r; asm("v_max_f32_e32 %0, %1, %2" : "=v"(r) : "v"(a), "v"(b)); return r; }
__device__ __forceinline__ float xh_sum(float v) { auto rr = __builtin_amdgcn_permlane32_swap(__float_as_uint(v), __float_as_uint(v), false, false); return __uint_as_float(rr[0]) + __uint_as_float(rr[1]); }
__device__ __forceinline__ float max3f(float a, float b, float c) { float r; asm("v_max3_f32 %0, %1, %2, %3" : "=v"(r) : "v"(a), "v"(b), "v"(c)); return r; }
constexpr int KB0 = 0, VB0 = 16384, SCR = 32768, RPB = 34816, BYTES = 36864;
struct TileRegs { u32x4 k, v; };
template <int PITCH = INC> __device__ __forceinline__ void tile_load(TileRegs& t, const bf16* kp, const bf16* vp, int tid) {
    const int key = tid >> 3, c = tid & 7;
    t.k = *(const u32x4*)(kp + (size_t)key * PITCH + c * 8);
    t.v = *(const u32x4*)(vp + (size_t)key * PITCH + c * 8);
}
__device__ __forceinline__ void tile_store(const TileRegs& t, LAS unsigned char* kb, LAS unsigned char* vb, int tid) {
    const int key = tid >> 3, c = tid & 7;
    *(LAS u32x4*)(kb + c * 1024 + key * 16) = t.k;
    *(LAS u32x4*)(vb + (c >> 2) * 4096 + (key >> 3) * 512 + (key & 7) * 64 + (c & 3) * 16) = t.v;
}
__device__ __forceinline__ void qk_tile(f32x16& p0, f32x16& p1, LAS const unsigned char* kbuf, const bf16x8 (&qr)[4], int r32, int hi) {
    LAS const unsigned char* kb = kbuf + hi * 1024 + r32 * 16;
    f32x16 z;
#pragma unroll
    for (int i = 0; i < 16; ++i) z[i] = 0.f;
    p0 = z; p1 = z;
#pragma unroll
    for (int d0 = 0; d0 < 4; ++d0) {
        const bf16x8 k0 = *(LAS const bf16x8*)(kb + d0 * 2048), k1 = *(LAS const bf16x8*)(kb + d0 * 2048 + 512);
        p0 = MFMA32(k0, qr[d0], p0); p1 = MFMA32(k1, qr[d0], p1);
    }
}
__device__ __forceinline__ void k_frags(bf16x8 (&kf)[8], LAS const unsigned char* kbuf, int r32, int hi) {
    LAS const unsigned char* kb = kbuf + hi * 1024 + r32 * 16;
#pragma unroll
    for (int d0 = 0; d0 < 4; ++d0) { kf[2 * d0] = *(LAS const bf16x8*)(kb + d0 * 2048); kf[2 * d0 + 1] = *(LAS const bf16x8*)(kb + d0 * 2048 + 512); }
}
__device__ __forceinline__ void qk_frags(f32x16& p0, f32x16& p1, const bf16x8 (&kf)[8], const bf16x8 (&qr)[4]) {
    f32x16 z;
#pragma unroll
    for (int i = 0; i < 16; ++i) z[i] = 0.f;
    p0 = z; p1 = z;
#pragma unroll
    for (int d0 = 0; d0 < 4; ++d0) { p0 = MFMA32(kf[2 * d0], qr[d0], p0); p1 = MFMA32(kf[2 * d0 + 1], qr[d0], p1); }
}
__device__ __forceinline__ void pv_tile(f32x16& o0, f32x16& o1, const f32x16& p0, const f32x16& p1, LAS const unsigned char* vl) {
    u32x4 pk[4];
#pragma unroll
    for (int i = 0; i < 4; ++i) { pk[0][i] = pk2(p0[2 * i], p0[2 * i + 1]); pk[1][i] = pk2(p0[8 + 2 * i], p0[9 + 2 * i]); pk[2][i] = pk2(p1[2 * i], p1[2 * i + 1]); pk[3][i] = pk2(p1[8 + 2 * i], p1[9 + 2 * i]); }
#pragma unroll
    for (int ks = 0; ks < 4; ++ks) {
        const bf16x8 a = __builtin_bit_cast(bf16x8, pk[ks]);
        const bf16x8 v0 = cat8(trrd(vl + ks * 1024), trrd(vl + ks * 1024 + 512));
        const bf16x8 v1 = cat8(trrd(vl + 4096 + ks * 1024), trrd(vl + 4096 + ks * 1024 + 512));
        o0 = MFMA32(v0, a, o0); o1 = MFMA32(v1, a, o1);
    }
}
__device__ __forceinline__ void softmax_pv(f32x16& p0, f32x16& p1, float& m, float& lsum, f32x16& o0, f32x16& o1, LAS float* scr, LAS const unsigned char* vl, int r32, int hi) {
    float mx = max3f(p0[0], p1[0], p0[1]), mx2 = max3f(p1[1], p0[2], p1[2]);
#pragma unroll
    for (int r = 3; r < 15; r += 2) { mx = max3f(mx, p0[r], p1[r]); mx2 = max3f(mx2, p0[r + 1], p1[r + 1]); }
    mx = xh_max(max3f(mx, mx2, max3f(p0[15], p1[15], p0[15])));
    if (__any(mx > m + 8.f)) {
        const float mnew = max3f(m, mx, mx), alpha = ex2(m - mnew);
        m = mnew; lsum *= alpha;
#pragma unroll
        for (int r = 0; r < 16; ++r) { o0[r] *= alpha; o1[r] *= alpha; }
    }
    float rs = 0.f;
#pragma unroll
    for (int r = 0; r < 16; ++r) { p0[r] = ex2(p0[r] - m); p1[r] = ex2(p1[r] - m); rs += p0[r] + p1[r]; }
    lsum += rs;
    pv_tile(o0, o1, p0, p1, vl);
}
__device__ __forceinline__ void qk_win(f32x16& p0, LAS const unsigned char* kwin, const bf16x8 (&qr)[4], int r32, int hi) {
    LAS const unsigned char* kb = kwin + hi * 1024 + r32 * 16;
#pragma unroll
    for (int i = 0; i < 16; ++i) p0[i] = 0.f;
#pragma unroll
    for (int d0 = 0; d0 < 4; ++d0) { const bf16x8 k0 = *(LAS const bf16x8*)(kb + d0 * 2048); p0 = MFMA32(k0, qr[d0], p0); }
}
__device__ __forceinline__ void softmax_pv_win(f32x16& p0, float& m, float& lsum, f32x16& o0, f32x16& o1, LAS const unsigned char* vwin) {
    float mx = max3f(p0[0], p0[1], p0[2]), mx2 = max3f(p0[3], p0[4], p0[5]);
#pragma unroll
    for (int r = 6; r < 14; r += 4) { mx = max3f(mx, p0[r], p0[r + 1]); mx2 = max3f(mx2, p0[r + 2], p0[r + 3]); }
    mx = xh_max(max3f(mx, mx2, max3f(p0[14], p0[15], p0[15])));
    if (__any(mx > m + 8.f)) {
        const float mnew = max3f(m, mx, mx), alpha = ex2(m - mnew);
        m = mnew; lsum *= alpha;
#pragma unroll
        for (int r = 0; r < 16; ++r) { o0[r] *= alpha; o1[r] *= alpha; }
    }
    float rs = 0.f;
#pragma unroll
    for (int r = 0; r < 16; ++r) { p0[r] = ex2(p0[r] - m); rs += p0[r]; }
    lsum += rs;
    u32x4 pk[2];
#pragma unroll
    for (int i = 0; i < 4; ++i) { pk[0][i] = pk2(p0[2 * i], p0[2 * i + 1]); pk[1][i] = pk2(p0[8 + 2 * i], p0[9 + 2 * i]); }
#pragma unroll
    for (int ks = 0; ks < 2; ++ks) {
        const bf16x8 a = __builtin_bit_cast(bf16x8, pk[ks]);
        const bf16x8 v0 = cat8(trrd(vwin + ks * 1024), trrd(vwin + ks * 1024 + 512));
        const bf16x8 v1 = cat8(trrd(vwin + 4096 + ks * 1024), trrd(vwin + 4096 + ks * 1024 + 512));
        o0 = MFMA32(v0, a, o0); o1 = MFMA32(v1, a, o1);
    }
}
__device__ __forceinline__ void finalize_store_lane(const f32x16& o0, const f32x16& o1, float lsum, bf16* orl, int hi);
__device__ __forceinline__ void finalize_store(const f32x16& o0, const f32x16& o1, float lsum, bf16* orow, LAS float* scr, int r32, int hi) {
    finalize_store_lane(o0, o1, lsum, orow + (size_t)r32 * DM, hi);
}
__device__ __forceinline__ void finalize_store_lane(const f32x16& o0, const f32x16& o1, float lsum, bf16* orl, int hi) {
    const float inv = 1.f / xh_sum(lsum);
    bf16* op = orl + 4 * hi;
#pragma unroll
    for (int g = 0; g < 4; ++g) {
        u32x2 w0, w1; w0.x = pk2(o0[4 * g] * inv, o0[4 * g + 1] * inv); w0.y = pk2(o0[4 * g + 2] * inv, o0[4 * g + 3] * inv); w1.x = pk2(o1[4 * g] * inv, o1[4 * g + 1] * inv); w1.y = pk2(o1[4 * g + 2] * inv, o1[4 * g + 3] * inv);
        *(u32x2*)(op + 8 * g) = w0; *(u32x2*)(op + 32 + 8 * g) = w1; }
}

__device__ __forceinline__ void swa_unit(const Params& p, int l, int b, int kvh, int qb, int gp, bool isctx, LAS unsigned char* L) {
    const int tid = tid_opaque(), lane = tid & 63, wave = __builtin_amdgcn_readfirstlane(tid >> 6), r32 = lane & 31, hi = lane >> 5;
    const bf16* Z = ws_z(p); bf16* Y = ws_hb(p);
    const int g = 2 * gp + (wave >> 2), rb = wave & 3, head = kvh * 4 + g;
    const size_t qrow0 = isctx ? (size_t)(NLAT + b * CTX + qb * 128) : (size_t)(b * SEQ + qb * 128);
    bf16x8 qr[4];
    { const bf16* qp = Z + (qrow0 + 32 * rb + r32) * INC + ZC_SQ + head * 64 + hi * 8;
#pragma unroll
      for (int d0 = 0; d0 < 4; ++d0) qr[d0] = *(const bf16x8*)(qp + d0 * 16); }
    float m = p.sink[l * 8 + head] * LOG2E, ls = (hi == 0) ? 1.f : 0.f; f32x16 o0, o1;
#pragma unroll
    for (int i = 0; i < 16; ++i) { o0[i] = 0.f; o1[i] = 0.f; }
    const int t0 = (qb == 0) ? 2 : 0, t1 = (qb == 15) ? 4 : 6;
    const int nwin = isctx ? 0 : (t1 - t0), nt = nwin + 4;
    const bf16* Kc = Z + ZC_SK + kvh * 64; const bf16* Vc = Z + ZC_SV + kvh * 64;
#define SWA_TROW(t) ((t) < nwin ? (size_t)(b * SEQ + 128 * (qb - 1) + 64 * (t0 + (t))) : (size_t)(NLAT + b * CTX + 64 * ((t) - nwin)))
    LAS float* scr = (LAS float*)(L + SCR) + wave * 64;
    const int vlo = ((lane >> 4) & 1) * 32 + (lane & 3) * 8 + (4 * hi + ((lane & 15) >> 2)) * 64;
    constexpr float SC = 0.125f * LOG2E;
    const int qi = 32 * rb + r32;
#define SWA_BODY(t, cur) { \
        const int wi = ((t) < nwin) ? t0 + (t) : -1; \
        const bool act = !(wi == 0 && rb >= 2) && !(wi == 5 && rb < 2); \
        if (act) { \
            f32x16 p0, p1; qk_tile(p0, p1, L + KB0 + (cur) * 8192, qr, r32, hi); \
            if ((wi == 0) || (wi == 1) || (wi == 4) || (wi == 5)) { \
                const int dbase = 64 * wi - 128 - qi; \
                _Pragma("unroll") for (int r = 0; r < 16; ++r) { const int d0 = dbase + crow(r, hi), d1 = d0 + 32; \
                    p0[r] = (d0 >= -128 && d0 <= 128) ? p0[r] * SC : -INFINITY; p1[r] = (d1 >= -128 && d1 <= 128) ? p1[r] * SC : -INFINITY; } \
            } else { \
                _Pragma("unroll") for (int r = 0; r < 16; ++r) { p0[r] *= SC; p1[r] *= SC; } \
            } \
            softmax_pv(p0, p1, m, ls, o0, o1, scr, L + VB0 + (cur) * 8192 + vlo, r32, hi); \
        } }
    TileRegs rA, rB, rC, rD;
    { const size_t r0 = SWA_TROW(0); tile_load(rA, Kc + r0 * INC, Vc + r0 * INC, tid); }
    { const size_t r1 = SWA_TROW(1); tile_load(rB, Kc + r1 * INC, Vc + r1 * INC, tid); }
    { const size_t r2 = SWA_TROW(2); tile_load(rC, Kc + r2 * INC, Vc + r2 * INC, tid); }
    { const size_t r3 = SWA_TROW(3); tile_load(rD, Kc + r3 * INC, Vc + r3 * INC, tid); }
    tile_store(rA, L + KB0, L + VB0, tid);
    __syncthreads();
#define SWA_STEP(tt, RL, RS, cur) { \
          \
        { const int tn = (tt) + 4 < nt ? (tt) + 4 : nt - 1; const size_t rn = SWA_TROW(tn); tile_load(RL, Kc + rn * INC, Vc + rn * INC, tid); } \
        SWA_BODY(tt, cur) \
        tile_store(RS, L + KB0 + ((cur) ^ 1) * 8192, L + VB0 + ((cur) ^ 1) * 8192, tid); \
        __syncthreads(); }
    int t = 0;
    for (; t + 4 <= nt; t += 4) {
        SWA_STEP(t, rA, rB, 0) SWA_STEP(t + 1, rB, rC, 1) SWA_STEP(t + 2, rC, rD, 0) SWA_STEP(t + 3, rD, rA, 1)
    }
    if (t < nt) { SWA_STEP(t, rA, rB, 0) if (t + 1 < nt) { SWA_STEP(t + 1, rB, rC, 1) if (t + 2 < nt) { SWA_STEP(t + 2, rC, rD, 0) } } }
#undef SWA_STEP
#undef SWA_BODY
#undef SWA_TROW
    finalize_store(o0, o1, ls, Y + (qrow0 + 32 * rb) * DM + YC_SWA + head * 64, scr, r32, hi);
}

__device__ __forceinline__ void na_unit(const Params& p, int l, int b, int h, int rg, bool isctx, LAS unsigned char* L, int rep = 0) {
    const int tid = tid_opaque(), lane = tid & 63, wave = __builtin_amdgcn_readfirstlane(tid >> 6), r32 = lane & 31, hi = lane >> 5;
    const bf16* Z = ws_z(p); bf16* Y = ws_hb(p);
    const int ig = wave & 3, gr0 = 4 * rg + 2 * (wave >> 2);
    const int rq = gr0 + (r32 >> 4), qcol = 16 * ig + (r32 & 15);
    const size_t qrow = isctx ? (size_t)(NLAT + b * CTX + 32 * wave + r32) : (size_t)(b * SEQ + rq * 64 + qcol);
    bf16x8 qr[4];
    { const bf16* qp = Z + qrow * INC + ZC_NQ + h * 64 + hi * 8;
#pragma unroll
      for (int d0 = 0; d0 < 4; ++d0) qr[d0] = *(const bf16x8*)(qp + d0 * 16); }
    LAS float* rpbl = (LAS float*)(L + RPB);
    if (tid < 465) rpbl[tid] = p.rpb[(size_t)(l * 8 + h) * 465 + tid] * LOG2E;
    float m = -1e30f, ls = 0.f; f32x16 o0, o1;
#pragma unroll
    for (int i = 0; i < 16; ++i) { o0[i] = 0.f; o1[i] = 0.f; }
    int R0 = 4 * rg - 4; R0 = R0 < 0 ? 0 : (R0 > 24 ? 24 : R0);
    int R1 = 4 * rg - 1; R1 = (R1 < 0 ? 0 : (R1 > 24 ? 24 : R1)) + 8;
    const int nband = isctx ? 0 : (R1 - R0), nt = nband + 4;
    int w0 = gr0 - 4; w0 = w0 < 0 ? 0 : (w0 > 24 ? 24 : w0);
    int w1 = gr0 - 3; w1 = (w1 < 0 ? 0 : (w1 > 24 ? 24 : w1)) + 8;
    int rs = rq - 4; rs = rs < 0 ? 0 : (rs > 24 ? 24 : rs);
    int cs = qcol - 8; cs = cs < 0 ? 0 : (cs > 48 ? 48 : cs);
    int key0 = 16 * ig - 8; key0 = key0 < 0 ? 0 : (key0 > 32 ? 32 : key0);
    const bf16* Kc = ws_kvh(p) + kvh_off(0, b, h); const bf16* Vc = ws_kvh(p) + kvh_off(1, b, h);
#define NA_TROW(t) ((t) < nband ? (size_t)(64 * (R0 + (t))) : (size_t)(SEQ + 64 * ((t) - nband)))
    LAS float* scr = (LAS float*)(L + SCR) + wave * 64;
    const int vlo = ((lane >> 4) & 1) * 32 + (lane & 3) * 8 + (4 * hi + ((lane & 15) >> 2)) * 64;
    constexpr float SC = 0.125f * LOG2E;
#define NA_BODY(t, cur) { \
        const int kr = ((t) < nband) ? R0 + (t) : -1; \
        if (kr < 0) { \
            f32x16 p0, p1; qk_tile(p0, p1, L + KB0 + (cur) * 8192, qr, r32, hi); \
            _Pragma("unroll") for (int r = 0; r < 16; ++r) { p0[r] *= SC; p1[r] *= SC; } \
            softmax_pv(p0, p1, m, ls, o0, o1, scr, L + VB0 + (cur) * 8192 + vlo, r32, hi); \
        } else if (kr >= w0 && kr < w1) { \
            f32x16 p0; qk_win(p0, L + KB0 + (cur) * 8192 + key0 * 16, qr, r32, hi); \
            const bool rowok = (kr >= rs) && (kr < rs + 8);                           \
            int dr = kr - rq + 7; dr = dr < 0 ? 0 : (dr > 14 ? 14 : dr); \
            LAS const float* tb = rpbl + dr * 31 + (15 - qcol);                       \
              \
            float bb[16]; \
            _Pragma("unroll") for (int r = 0; r < 16; ++r) { const int k = key0 + crow(r, hi); int kc = k < cs ? cs : k; kc = kc > cs + 15 ? cs + 15 : kc; bb[r] = tb[kc]; } \
            _Pragma("unroll") for (int r = 0; r < 16; ++r) asm volatile("" : "+v"(bb[r])); \
            _Pragma("unroll") for (int r = 0; r < 16; ++r) { const int k = key0 + crow(r, hi); const bool v = rowok && (k >= cs) && (k < cs + 16); p0[r] = v ? p0[r] * SC + bb[r] : -INFINITY; } \
            softmax_pv_win(p0, m, ls, o0, o1, L + VB0 + (cur) * 8192 + vlo + (key0 >> 3) * 512); \
        } }
    TileRegs rA, rB, rC, rD;
    { const size_t r0 = NA_TROW(0); tile_load<64>(rA, Kc + r0 * 64, Vc + r0 * 64, tid); }
    { const size_t r1 = NA_TROW(1); tile_load<64>(rB, Kc + r1 * 64, Vc + r1 * 64, tid); }
    { const size_t r2 = NA_TROW(2); tile_load<64>(rC, Kc + r2 * 64, Vc + r2 * 64, tid); }
    { const size_t r3 = NA_TROW(3); tile_load<64>(rD, Kc + r3 * 64, Vc + r3 * 64, tid); }
    tile_store(rA, L + KB0, L + VB0, tid);
    __syncthreads();
#define NA_STEP(tt, RL, RS, cur) { \
          \
        { const int tn = (tt) + 4 < nt ? (tt) + 4 : nt - 1; const size_t rn = NA_TROW(tn); tile_load<64>(RL, Kc + rn * 64, Vc + rn * 64, tid); } \
        NA_BODY(tt, cur) \
        tile_store(RS, L + KB0 + ((cur) ^ 1) * 8192, L + VB0 + ((cur) ^ 1) * 8192, tid); \
        __syncthreads(); }
    int t = 0;
    for (; t + 4 <= nt; t += 4) {
        NA_STEP(t, rA, rB, 0) NA_STEP(t + 1, rB, rC, 1) NA_STEP(t + 2, rC, rD, 0) NA_STEP(t + 3, rD, rA, 1)
    }
    if (t < nt) { NA_STEP(t, rA, rB, 0) if (t + 1 < nt) { NA_STEP(t + 1, rB, rC, 1) if (t + 2 < nt) { NA_STEP(t + 2, rC, rD, 0) } } }
#undef NA_STEP
#undef NA_BODY
#undef NA_TROW
    finalize_store_lane(o0, o1, ls, Y + qrow * DM + YC_NA + h * 64, hi);
}
}

__device__ __forceinline__ size_t ret_row(int b, int c, int j) { return c < 2 ? (size_t)(NLAT + b * CTX + 128 * c + j) : (size_t)(b * SEQ + 128 * (c - 2) + j); }
__device__ __forceinline__ float log2_sigmoid(float x) { return -log1pf(__expf(-x)) * LOG2E; }
__device__ __forceinline__ int tr_addr(int tile, int key, int cch) { return tile * 8192 + (cch >> 2) * 4096 + (key >> 3) * 512 + (key & 7) * 64 + (cch & 3) * 16; }

__device__ __forceinline__ void r1_unit(const Params& p, int l, int b, int h, int c, LAS unsigned char* L) {
    const int tid = tid_opaque(), lane = tid & 63, wave = __builtin_amdgcn_readfirstlane(tid >> 6), r32 = lane & 31, hi = lane >> 5;
    const bf16* Z = ws_z(p);
    const float lgf = log2_sigmoid(p.dec_f[l * 8 + h]), lgb = log2_sigmoid(p.dec_b[l * 8 + h]);
    LAS unsigned char* KT = L; LAS unsigned char* VF = L + 16384; LAS unsigned char* VBk = L + 32768;
#pragma unroll
    for (int i = 0; i < 2; ++i) { const int q = tid + 512 * i, tok = q >> 3, cch = q & 7;
        const bf16* rp = Z + ret_row(b, c, tok) * INC + h * 64 + cch * 8;
        const u32x4 kv = *(const u32x4*)(rp + ZC_RK), vv = *(const u32x4*)(rp + ZC_RV);
        const int a = tr_addr(tok >> 6, tok & 63, cch);
        *(LAS u32x4*)(KT + a) = kv;
        *(LAS u32x4*)(VF + a) = scale8(vv, ex2(lgf * (float)(127 - tok)));
        *(LAS u32x4*)(VBk + a) = scale8(vv, ex2(lgb * (float)tok)); }
    __syncthreads();
    const int dir = wave >> 2, dvb = (wave >> 1) & 1, dkb = wave & 1;
    const int vlo = ((lane >> 4) & 1) * 32 + (lane & 3) * 8 + (4 * hi + ((lane & 15) >> 2)) * 64;
    LAS const unsigned char* Ab = (dir ? VBk : VF) + dvb * 4096 + vlo; LAS const unsigned char* Bb = KT + dkb * 4096 + vlo;
    f32x16 acc;
#pragma unroll
    for (int i = 0; i < 16; ++i) acc[i] = 0.f;
#pragma unroll
    for (int ks = 0; ks < 8; ++ks) { const int off = (ks >> 2) * 8192 + (ks & 3) * 1024;
        const bf16x8 a = cat8(trrd(Ab + off), trrd(Ab + off + 512)), bb = cat8(trrd(Bb + off), trrd(Bb + off + 512));
        acc = MFMA32(a, bb, acc); }
    float* St = (float*)(p.ws + WS_SST) + ((size_t)((b * 8 + h) * 18 + c) * 2 + dir) * 4096;
#pragma unroll
    for (int r = 0; r < 16; ++r) St[(32 * dvb + crow(r, hi)) * 64 + 32 * dkb + r32] = acc[r];
    __syncthreads();
}

__device__ __forceinline__ void ph_ret_scan(const Params& p, int l) {
    const int tid = tid_opaque();
    const int task = blockIdx.x * 256 + tid;
    if (tid < 256) for (int tk = task; tk < 65536; tk += gridDim.x * 256) {
        const int cd = tk & 7, dv = (tk >> 3) & 63, dir = (tk >> 9) & 1, bh = tk >> 10, h = bh & 7;
        const float lg = log2_sigmoid((dir ? p.dec_b : p.dec_f)[l * 8 + h]), cdec = ex2(lg * 128.f);
        const float* Sb = (const float*)(p.ws + WS_SST) + (size_t)(bh * 18) * 2 * 4096 + dir * 4096 + dv * 64 + cd * 8;
        unsigned char* Ob = p.ws + WS_SIN + (size_t)(bh * 18) * 2 * 8192 + dir * 8192 + cd * 1024 + dv * 16;
        f32x4 a0 = {0.f, 0.f, 0.f, 0.f}, a1 = a0;
#pragma unroll
        for (int g = 0; g < 3; ++g) {
            f32x4 s0[6], s1[6];
#pragma unroll
            for (int k = 0; k < 6; ++k) { const int st = 6 * g + k, c = dir ? (st == 0 ? 1 : (st == 1 ? 0 : 19 - st)) : st; const float* sp = Sb + (size_t)c * 2 * 4096; s0[k] = *(const f32x4*)sp; s1[k] = *(const f32x4*)(sp + 4); }
#pragma unroll
            for (int k = 0; k < 6; ++k) { const int st = 6 * g + k, c = dir ? (st == 0 ? 1 : (st == 1 ? 0 : 19 - st)) : st;
                u32x4 w; w.x = pk2(a0.x, a0.y); w.y = pk2(a0.z, a0.w); w.z = pk2(a1.x, a1.y); w.w = pk2(a1.z, a1.w);
                *(u32x4*)(Ob + (size_t)c * 2 * 8192) = w;
                a0 = a0 * cdec + s0[k]; a1 = a1 * cdec + s1[k]; }
        }
    }
}

__device__ __forceinline__ void r3_pair(const Params& p, int l, int b, int h, int cp, LAS unsigned char* L, float decf, float decb) {
    const int tid = tid_opaque(), lane = tid & 63, wave = __builtin_amdgcn_readfirstlane(tid >> 6), r32 = lane & 31, hi = lane >> 5;
    const int half = wave >> 2, wq = wave & 3, c = 2 * cp + half, th = tid & 255;
    const bf16* Z = ws_z(p); bf16* Y = ws_hb(p);
    const float lgf = log2_sigmoid(decf), lgb = log2_sigmoid(decb);
    LAS unsigned char* Lh = L + half * 49152;
    LAS unsigned char* KT = Lh; LAS unsigned char* VT = Lh + 16384; LAS unsigned char* SF = Lh + 32768; LAS unsigned char* SBk = Lh + 40960;
    u32x4 kvr[4], vvr[4], snr[4];
#pragma unroll
    for (int i = 0; i < 4; ++i) { const int q = th + 256 * i, tok = q >> 3, cch = q & 7;
        const bf16* rp = Z + ret_row(b, c, tok) * INC + h * 64 + cch * 8;
        kvr[i] = *(const u32x4*)(rp + ZC_RK); vvr[i] = *(const u32x4*)(rp + ZC_RV); }
    { const unsigned char* src = p.ws + WS_SIN + (size_t)(((b * 8 + h) * 18 + c) * 2) * 8192;
#pragma unroll
      for (int i = 0; i < 4; ++i) { const int q = th + 256 * i; snr[i] = *(const u32x4*)(src + q * 16); } }
    const int qi = 32 * wq + r32;
    bf16x8 qr[4]; u32x2 gva[4], gvb[4];
    { const bf16* qp = Z + ret_row(b, c, qi) * INC + ZC_RQ + h * 64 + hi * 8;
#pragma unroll
      for (int d0 = 0; d0 < 4; ++d0) qr[d0] = *(const bf16x8*)(qp + d0 * 16);
      const bf16* gp0 = Z + ret_row(b, c, qi) * INC + ZC_RG + h * 64 + 4 * hi;
#pragma unroll
      for (int g = 0; g < 4; ++g) { gva[g] = *(const u32x2*)(gp0 + 8 * g); gvb[g] = *(const u32x2*)(gp0 + 32 + 8 * g); } }
    __builtin_amdgcn_sched_barrier(0);
#pragma unroll
    for (int i = 0; i < 4; ++i) { const int q = th + 256 * i, tok = q >> 3, cch = q & 7;
        *(LAS u32x4*)(KT + (tok >> 6) * 8192 + cch * 1024 + (tok & 63) * 16) = kvr[i];
        *(LAS u32x4*)(VT + tr_addr(tok >> 6, tok & 63, cch)) = vvr[i];
        *(LAS u32x4*)(SF + q * 16) = snr[i]; }
    __syncthreads();
    f32x16 o0, o1;
#pragma unroll
    for (int i = 0; i < 16; ++i) { o0[i] = 0.f; o1[i] = 0.f; }
    const int vlo = ((lane >> 4) & 1) * 32 + (lane & 3) * 8 + (4 * hi + ((lane & 15) >> 2)) * 64;
#pragma unroll
    for (int t = 0; t < 2; ++t) {
        f32x16 p0, p1; att::qk_tile(p0, p1, KT + t * 8192, qr, r32, hi);
#pragma unroll
        for (int r = 0; r < 16; ++r) { const int d0 = qi - (64 * t + crow(r, hi)), d1 = d0 - 32;
            p0[r] *= (d0 >= 0) ? ex2(lgf * (float)d0) : ex2(lgb * (float)(-d0));
            p1[r] *= (d1 >= 0) ? ex2(lgf * (float)d1) : ex2(lgb * (float)(-d1)); }
        att::pv_tile(o0, o1, p0, p1, VT + t * 8192 + vlo);
    }
    { const float xf = ex2(lgf * (float)(qi + 1)), xb = ex2(lgb * (float)(128 - qi));
#pragma unroll
      for (int s = 0; s < 4; ++s) {
          const bf16x8 af = __builtin_bit_cast(bf16x8, scale8(__builtin_bit_cast(u32x4, qr[s]), xf)), ab = __builtin_bit_cast(bf16x8, scale8(__builtin_bit_cast(u32x4, qr[s]), xb));
          LAS const unsigned char* sf = SF + (2 * s + hi) * 1024 + r32 * 16; LAS const unsigned char* sb = SBk + (2 * s + hi) * 1024 + r32 * 16;
          o0 = MFMA32(*(LAS const bf16x8*)sf, af, o0); o1 = MFMA32(*(LAS const bf16x8*)(sf + 512), af, o1);
          o0 = MFMA32(*(LAS const bf16x8*)sb, ab, o0); o1 = MFMA32(*(LAS const bf16x8*)(sb + 512), ab, o1); } }
    { float s1 = 0.f;
#pragma unroll
      for (int r = 0; r < 16; ++r) { o0[r] *= 0.125f; o1[r] *= 0.125f; s1 += o0[r] + o1[r]; }
      const float mean = att::xh_sum(s1) * (1.f / 64.f); float s2 = 0.f;
#pragma unroll
      for (int r = 0; r < 16; ++r) { o0[r] -= mean; o1[r] -= mean; s2 += o0[r] * o0[r] + o1[r] * o1[r]; }
      const float rstd = rsqrtf(att::xh_sum(s2) * (1.f / 64.f) + 1e-6f);
      const size_t row = ret_row(b, c, qi);
      bf16* yp = Y + row * DM + YC_RET + h * 64 + 4 * hi;
#pragma unroll
      for (int g = 0; g < 4; ++g) {
          const u32x2 ga = gva[g], gb = gvb[g]; u32x2 w0, w1;
          w0.x = pk2(silu_f(bf2f(ga.x & 0xffffu)) * o0[4 * g] * rstd, silu_f(__uint_as_float(ga.x & 0xffff0000u)) * o0[4 * g + 1] * rstd);
          w0.y = pk2(silu_f(bf2f(ga.y & 0xffffu)) * o0[4 * g + 2] * rstd, silu_f(__uint_as_float(ga.y & 0xffff0000u)) * o0[4 * g + 3] * rstd);
          w1.x = pk2(silu_f(bf2f(gb.x & 0xffffu)) * o1[4 * g] * rstd, silu_f(__uint_as_float(gb.x & 0xffff0000u)) * o1[4 * g + 1] * rstd);
          w1.y = pk2(silu_f(bf2f(gb.y & 0xffffu)) * o1[4 * g + 2] * rstd, silu_f(__uint_as_float(gb.y & 0xffff0000u)) * o1[4 * g + 3] * rstd);
          *(u32x2*)(yp + 8 * g) = w0; *(u32x2*)(yp + 32 + 8 * g) = w1; } }
    __syncthreads();
}

__device__ __forceinline__ void rope_task(const Params& p, int row, int task) {
    bf16* Z = ws_z(p);
    const int hq = task >> 2, i = task & 3, t = row & 2047;
    const int base = hq < 8 ? ZC_RQ + 64 * hq : (hq < 16 ? ZC_RK + 64 * (hq - 8) : (hq < 24 ? ZC_SQ + 64 * (hq - 16) : ZC_SK + 64 * (hq - 24)));
    const int pos = (i < 2) ? (t >> 6) : (t & 63), f0 = 8 * (i & 1);
    bf16* p1 = Z + (size_t)row * INC + base + 8 * i; bf16* p2 = p1 + 32;
    const u32x4 a = *(const u32x4*)p1, bq = *(const u32x4*)p2; u32x4 oa, ob;
#pragma unroll
    for (int k = 0; k < 4; ++k) {
        const float c0 = ROPE_COS[pos * 16 + f0 + 2 * k], s0 = ROPE_SIN[pos * 16 + f0 + 2 * k], c1 = ROPE_COS[pos * 16 + f0 + 2 * k + 1], s1 = ROPE_SIN[pos * 16 + f0 + 2 * k + 1];
        const float x1l = bf2f(a[k] & 0xffffu), x1h = __uint_as_float(a[k] & 0xffff0000u), x2l = bf2f(bq[k] & 0xffffu), x2h = __uint_as_float(bq[k] & 0xffff0000u);
        oa[k] = pk2(x1l * c0 - x2l * s0, x1h * c1 - x2h * s1); ob[k] = pk2(x1l * s0 + x2l * c0, x1h * s1 + x2h * c1); }
    *(u32x4*)p1 = oa; *(u32x4*)p2 = ob;
}
__device__ __forceinline__ void conv_task(const Params& p, int l, int row, int ch8) {
    const bf16* Z = ws_z(p); bf16* Y = ws_hb(p);
    const int t = (row < NLAT) ? (row & 2047) : ((row - NLAT) & 255), tl = (row < NLAT) ? 2047 : 255;
    const float* w = p.conv_w + (size_t)l * 3 * 512 + ch8 * 8;
    const bf16* zr = Z + (size_t)row * INC + ch8 * 8;
    float acc[8];
#pragma unroll
    for (int k = 0; k < 8; ++k) acc[k] = 0.f;
#pragma unroll
    for (int dt = -1; dt <= 1; ++dt) {
        if ((dt < 0 && t == 0) || (dt > 0 && t == tl)) continue;
        const bf16* zz = zr + (long)dt * INC;
        const u32x4 cc = *(const u32x4*)(zz + ZC_CC), hh = *(const u32x4*)(zz + ZC_CH);
        const f32x4 w0 = *(const f32x4*)(w + (dt + 1) * 512), w1 = *(const f32x4*)(w + (dt + 1) * 512 + 4);
#pragma unroll
        for (int k = 0; k < 4; ++k) { const float wl = (k < 2) ? w0[2 * k] : w1[2 * k - 4], wh = (k < 2) ? w0[2 * k + 1] : w1[2 * k - 3];
            acc[2 * k] += wl * bf2f(cc[k] & 0xffffu) * bf2f(hh[k] & 0xffffu); acc[2 * k + 1] += wh * __uint_as_float(cc[k] & 0xffff0000u) * __uint_as_float(hh[k] & 0xffff0000u); }
    }
    const u32x4 bb = *(const u32x4*)(zr + ZC_CB); u32x4 o;
#pragma unroll
    for (int k = 0; k < 4; ++k) o[k] = pk2(acc[2 * k] * bf2f(bb[k] & 0xffffu), acc[2 * k + 1] * __uint_as_float(bb[k] & 0xffff0000u));
    *(u32x4*)(Y + (size_t)row * DM + YC_CONV + ch8 * 8) = o;
}

__device__ __forceinline__ void ph_norm_router(const Params& p, int l, LAS unsigned char* lds) {
    const int tid = tid_opaque(), lane = tid & 63, wave = __builtin_amdgcn_readfirstlane(tid >> 6);
    constexpr int WPITCH = 4112;
    const float* wr = p.w_router + (size_t)l * 2048 * 16;
    { f32x4 t[16];
#pragma unroll
      for (int k = 0; k < 16; ++k) { const int n = tid + NTHR * k; t[k] = *(const f32x4*)(wr + (n >> 2) * 16 + (n & 3) * 4); }
#pragma unroll
      for (int k = 0; k < 16; ++k) { const int n = tid + NTHR * k, kk = n >> 2, q = n & 3;
#pragma unroll
          for (int i = 0; i < 4; ++i) *(LAS bf16*)(lds + (4 * q + i) * WPITCH + kk * 2) = (bf16)f2bf(t[k][i]); } }
    const int gw = blockIdx.x * NWAVES + wave, NGW = gridDim.x * NWAVES;
    const int nrows = (l == 0) ? NROW : NLAT;
    float* aff = (float*)(p.ws + WS_AFF);
    const int rpw = (nrows + NGW - 1) / NGW, r0 = gw * rpw, r1 = (r0 + rpw < nrows) ? r0 + rpw : nrows;
    { int cur = -1; f32x4 wv[8], sv[8], vn[8];
      if (r0 < r1) load_row8_bf16(vn, ws_xb(p) + (size_t)r0 * DM, lane);
      for (int row = r0; row < r1; ++row) {
          f32x4 v[8];
#pragma unroll
          for (int j = 0; j < 8; ++j) v[j] = vn[j];
          if (row + 1 < r1) load_row8_bf16(vn, ws_xb(p) + (size_t)(row + 1) * DM, lane);
          const int arow = (row < NLAT) ? (row >> 11) : 8;
          if (arow != cur) { const float* ad = ws_ada(p) + (size_t)(l * 9 + arow) * ADAW; load_coeffs(wv, sv, p.norm_ffn + l * DM, ad + 4 * 2048, ad + 3 * 2048, lane); cur = arow; }
          const float rstd = row_rstd(v);
#pragma unroll
          for (int j = 0; j < 8; ++j) v[j] = v[j] * rstd * wv[j] + sv[j];
          store_row8_bf16(v, ws_hb(p) + (size_t)row * DM, lane);
      } }
    asm volatile("s_waitcnt vmcnt(0)" ::: "memory");
    __syncthreads();
    if (tid < 64) { __builtin_amdgcn_fence(__ATOMIC_ACQUIRE, "agent"); asm volatile("s_waitcnt vmcnt(0)" ::: "memory"); }
    __syncthreads();
    const int R = rpw * NWAVES, R0 = blockIdx.x * R, R1 = (R0 + R < nrows) ? R0 + R : nrows;
    if (R0 + 16 * wave < R1) {
        const int fr = lane & 15, kg = lane >> 4;
        int arow_ = R0 + 16 * wave + fr; if (arow_ > R1 - 1) arow_ = R1 - 1;
        const bf16* ap = ws_hb(p) + (size_t)arow_ * DM + 8 * kg;
        LAS const unsigned char* bp = lds + fr * WPITCH + 16 * kg;
        f32x4 acc = {0.f, 0.f, 0.f, 0.f};
        for (int s0 = 0; s0 < 64; s0 += 8) {
            bf16x8 af[8];
#pragma unroll
            for (int s = 0; s < 8; ++s) af[s] = *(const bf16x8*)(ap + 32 * (s0 + s));
#pragma unroll
            for (int s = 0; s < 8; ++s) acc = __builtin_amdgcn_mfma_f32_16x16x32_bf16(af[s], *(LAS const bf16x8*)(bp + 64 * (s0 + s)), acc, 0, 0, 0);
        }
#pragma unroll
        for (int r = 0; r < 4; ++r) {
            float mx = acc[r];
#pragma unroll
            for (int o = 1; o < 16; o <<= 1) mx = fmaxf(mx, __shfl_xor(mx, o));
            const float ex = __expf(acc[r] - mx); float sum = ex;
#pragma unroll
            for (int o = 1; o < 16; o <<= 1) sum += __shfl_xor(sum, o);
            const int row = R0 + 16 * wave + 4 * kg + r;
            if (row < R1) aff[(size_t)row * 16 + fr] = ex / sum;
        }
    }
}

__device__ __forceinline__ int moe_mpe(int l) { return l == 0 ? 2304 : 2048; }
constexpr int CW_SCF = 8192;
constexpr int CW_TKF = 3072;
constexpr int RIDX_OFF = 131072 + 1024;
__device__ __forceinline__ void ph_topk(const Params& p, int l, LAS unsigned char* lds) {
    const int tid = tid_opaque(), lane = tid & 63, wave = __builtin_amdgcn_readfirstlane(tid >> 6);
    const int nprob = (l == 0) ? 256 : 128, MPE = moe_mpe(l);
    const float* aff = (const float*)(p.ws + WS_AFF); int* sel = (int*)(p.ws + WS_SEL); int* idx = (int*)(p.ws + WS_IDX); float* gatev = (float*)(p.ws + WS_GATEV);
    LAS int* lcnt = (LAS int*)lds;
    for (int prob = blockIdx.x; prob < nprob; prob += gridDim.x) {
        const bool isctx = prob >= 128; const int q = prob & 127, b = q >> 4, e = q & 15;
        const int T = isctx ? CTX : SEQ, cap = isctx ? 32 : 256, row0 = isctx ? NLAT + b * CTX : b * SEQ, slot0 = e * MPE + (isctx ? 2048 + b * 32 : b * 256);
        if (tid < 48) lcnt[tid] = 0;
        unsigned u[4];
#pragma unroll
        for (int k = 0; k < 4; ++k) { const int t = 256 * wave + 64 * k + lane; u[k] = (t < T) ? __float_as_uint(aff[(size_t)(row0 + t) * 16 + e]) : 0u; }
        __syncthreads();
        unsigned tau = 0u;
        for (int bit = 29; bit >= 0; --bit) {
            const unsigned cand = tau | (1u << bit); int cnt = 0;
#pragma unroll
            for (int k = 0; k < 4; ++k) cnt += __popcll(__ballot(u[k] >= cand));
            if (lane == 0 && cnt) __hip_atomic_fetch_add(&lcnt[bit], cnt, __ATOMIC_RELAXED, __HIP_MEMORY_SCOPE_WORKGROUP);
            __syncthreads();
            if (lcnt[bit] >= cap) tau = cand;
        }
        int ngt = 0, neq = 0;
#pragma unroll
        for (int k = 0; k < 4; ++k) { const int t = 256 * wave + 64 * k + lane; ngt += __popcll(__ballot(u[k] > tau)); neq += __popcll(__ballot((t < T) && u[k] == tau)); }
        if (lane == 0) { lcnt[32 + wave] = ngt; lcnt[40 + wave] = neq; }
        __syncthreads();
        int tgt = 0, eqb = 0;
#pragma unroll
        for (int w = 0; w < 8; ++w) { tgt += lcnt[32 + w]; }
        const int need_eq = cap - tgt;
        int base = 0;
#pragma unroll
        for (int w = 0; w < 8; ++w) if (w < wave) { const int ne = lcnt[40 + w]; int tk = need_eq - eqb; tk = tk < 0 ? 0 : (tk > ne ? ne : tk); base += lcnt[32 + w] + tk; eqb += ne; }
        const unsigned long long lt = (1ull << lane) - 1ull;
        int eqc = eqb;
#pragma unroll
        for (int k = 0; k < 4; ++k) { const int t = 256 * wave + 64 * k + lane; const bool valid = t < T;
            const bool gt = u[k] > tau, eq = valid && (u[k] == tau);
            const unsigned long long em = __ballot(eq);
            const bool take = gt || (eq && (eqc + __popcll(em & lt) < need_eq));
            const unsigned long long sm = __ballot(take);
            const int slot = base + __popcll(sm & lt);
            if (valid) { if (take) { idx[slot0 + slot] = row0 + t; gatev[slot0 + slot] = __uint_as_float(u[k]); }
                         sel[(size_t)(row0 + t) * 16 + e] = take ? slot : -1; }
            base += __popcll(sm); eqc += __popcll(em); }
        asm volatile("s_waitcnt vmcnt(0)" ::: "memory");
        __syncthreads();
        if (tid == 0) { __builtin_amdgcn_fence(__ATOMIC_RELEASE, "agent"); asm volatile("s_waitcnt vmcnt(0)" ::: "memory");
            __hip_atomic_store((unsigned*)(p.ws + WS_CTL) + CW_TKF + l * 256 + prob, 1u, __ATOMIC_RELAXED, __HIP_MEMORY_SCOPE_AGENT); }
    }
}
template <class Sched> __device__ __forceinline__ void topk_wait(const Params& p, int l, const Sched& S, int tpe, int tid) {
    if (tid < 64) {
        const int i = tid >> 3, sub = tid & 7; pg8::Unit u; int flag = -1;
        if (i < 6 && S.next(i, u)) { const int e = u.pm / tpe, j = u.pm % tpe; if (j < 8) { if (sub == 0) flag = j * 16 + e; } else flag = 128 + sub * 16 + e; }
        if (flag >= 0) { const unsigned* f = (const unsigned*)(p.ws + WS_CTL) + CW_TKF + l * 256 + flag; unsigned sp = 0;
            while (__hip_atomic_load(f, __ATOMIC_RELAXED, __HIP_MEMORY_SCOPE_AGENT) == 0u && ++sp < (1u << 20)) __builtin_amdgcn_s_sleep(2); }
        __builtin_amdgcn_fence(__ATOMIC_ACQUIRE, "agent"); asm volatile("s_waitcnt vmcnt(0)" ::: "memory");
    }
    __syncthreads();
}


__device__ __forceinline__ void ph_combine(const Params& p, int l) {
    const int tid_ = tid_opaque(), lane = tid_ & 63, wave = __builtin_amdgcn_readfirstlane(tid_ >> 6);
    const int gw = blockIdx.x * NWAVES + wave, NGW = gridDim.x * NWAVES;
    const int nrows = (l == 0) ? NROW : NLAT, MPE = moe_mpe(l);
    const int* sel = (const int*)(p.ws + WS_SEL); const bf16* YE = ws_z(p);
    const int rpw = (nrows + NGW - 1) / NGW, r0 = gw * rpw, r1 = (r0 + rpw < nrows) ? r0 + rpw : nrows;
    int cur = -1; f32x4 g2[8], vn[8]; int seln = -1;
    f32x4 wfin[8];
    if (l != 0) {
#pragma unroll
        for (int j = 0; j < 8; ++j) wfin[j] = *(const f32x4*)(p.norm_final + 256 * j + 4 * lane); }
    if (r0 < r1) { load_row8_bf16(vn, ws_xb(p) + (size_t)r0 * DM, lane); seln = (lane < 16) ? sel[(size_t)r0 * 16 + lane] : -1; }
    for (int row = r0; row < r1; ++row) {
        f32x4 v[8];
#pragma unroll
        for (int j = 0; j < 8; ++j) v[j] = vn[j];
        const int selv = seln;
        if (row + 1 < r1) { load_row8_bf16(vn, ws_xb(p) + (size_t)(row + 1) * DM, lane); seln = (lane < 16) ? sel[(size_t)(row + 1) * 16 + lane] : -1; }
        const bool isctx = row >= NLAT;
        const int arow = isctx ? 8 : (row >> 11);
        const int sbase = isctx ? 2048 + ((row - NLAT) >> 8) * 32 : (row >> 11) * 256;
        if (arow != cur) { const float* ad = ws_ada(p) + (size_t)(l * 9 + arow) * ADAW;
#pragma unroll
            for (int j = 0; j < 8; ++j) g2[j] = *(const f32x4*)(ad + 5 * 2048 + 256 * j + 4 * lane);
            cur = arow; }
        f32x4 acc[8];
#pragma unroll
        for (int j = 0; j < 8; ++j) acc[j] = (f32x4){0.f, 0.f, 0.f, 0.f};
        unsigned long long mask = __ballot(selv >= 0);
        while (mask) {
            const int e0 = __builtin_ctzll(mask); mask &= mask - 1;
            const bool two = mask != 0ull; const int e1 = two ? __builtin_ctzll(mask) : e0; if (two) mask &= mask - 1;
            const int s0 = __builtin_amdgcn_readlane(selv, e0), s1 = __builtin_amdgcn_readlane(selv, e1);
            const bf16* y0 = YE + (size_t)(e0 * MPE + sbase + s0) * DM + 4 * lane; const bf16* y1 = YE + (size_t)(e1 * MPE + sbase + s1) * DM + 4 * lane;
            u32x2 a[8], bq[8];
#pragma unroll
            for (int j = 0; j < 8; ++j) a[j] = *(const u32x2*)(y0 + 256 * j);
            if (two) {
#pragma unroll
                for (int j = 0; j < 8; ++j) bq[j] = *(const u32x2*)(y1 + 256 * j); }
#pragma unroll
            for (int j = 0; j < 8; ++j) { acc[j].x += bf2f(a[j].x & 0xffffu); acc[j].y += __uint_as_float(a[j].x & 0xffff0000u); acc[j].z += bf2f(a[j].y & 0xffffu); acc[j].w += __uint_as_float(a[j].y & 0xffff0000u); }
            if (two) {
#pragma unroll
                for (int j = 0; j < 8; ++j) { acc[j].x += bf2f(bq[j].x & 0xffffu); acc[j].y += __uint_as_float(bq[j].x & 0xffff0000u); acc[j].z += bf2f(bq[j].y & 0xffffu); acc[j].w += __uint_as_float(bq[j].y & 0xffff0000u); } }
        }
#pragma unroll
        for (int j = 0; j < 8; ++j) v[j] = v[j] + g2[j] * acc[j];
        const float rstd = row_rstd(v);
        if (l == 0) {
            store_row8_bf16(v, ws_xb(p) + (size_t)row * DM, lane);
            const float* ad1 = ws_ada(p) + (size_t)(1 * 9 + arow) * ADAW;
            modulate8(v, rstd, p.norm_mix + 1 * DM, ad1 + 2048, ad1, lane);
            store_row8_bf16(v, ws_hb(p) + (size_t)row * DM, lane);
        } else {
#pragma unroll
            for (int j = 0; j < 8; ++j) *(f32x4*)(p.out + (size_t)row * DM + 256 * j + 4 * lane) = v[j] * rstd * wfin[j];
        }
    }
}

constexpr int N_PHASES = 12;
template <int PH> __device__ __forceinline__ void run_phase(const Params& p, int l, LAS unsigned char* lds, int rep) {
    const int G = gridDim.x, bid = blockIdx.x, tid = tid_opaque();
    const bool need_ctx = (l == 0);
    const int vb = (G % 8 == 0) ? (bid & 7) * (G >> 3) + (bid >> 3) : bid;
    if constexpr (PH == 0) ph_prologue(p, lds);
    if constexpr (PH == 1) ph_modnorm0(p);
    if constexpr (PH == 2) {
        pg8::Gemm g{ws_hb(p), (const bf16*)(p.ws + WS_WIN) + (size_t)l * INC * 2048, NROW, INC, DM};
        { LAS float* rl = (LAS float*)(lds + ROPE_LDS);
          for (int i = tid; i < 1024; i += NTHR) { rl[i] = ROPE_COS[i]; rl[1024 + i] = ROPE_SIN[i]; } }
        __syncthreads();
        pg8::EpiZRope E{ws_z(p), (LAS const float*)(lds + ROPE_LDS), (LAS const float*)(lds + ROPE_LDS) + 1024, ws_kvh(p)};
        if (l == DEPTH - 1) { pg8::SkipOrder S; S.init(G, bid);
            pg8::gemm_phase<pg8::EpiZRope, pg8::SkipOrder, true, true>(lds, g, S, E);
            pg8::QuadOrder Q; Q.init(G, bid);
            pg8::gemm_phase<pg8::EpiZRope, pg8::QuadOrder, true, true, false, true>(lds, g, Q, E); }
        else { pg8::StaticOrder S; S.init(NROW, INC, G, bid);
            pg8::gemm_phase<pg8::EpiZRope, pg8::StaticOrder, true, true>(lds, g, S, E); }
        if (l == 0 && !rep && G == 256 && bid >= 120 && TAIL_P2 > 0) tail_convert(p, TAIL_OFF_P2, TAIL_P2, bid - 120, G - 120, lds);
    }
    if constexpr (PH == 3) {
        const int nu = 512 + (need_ctx ? 64 : 0);
        if (rep != 3) for (int u = vb; u < nu; u += G) {
            if (u < 576) { const bool ic = u >= 512; const int q = u - 512; att::na_unit(p, l, ic ? q >> 3 : u >> 6, ic ? q & 7 : (u >> 3) & 7, ic ? 0 : u & 7, ic, lds, rep); }
        }
        const int gt = bid * NTHR + tid, NT = G * NTHR;
        const int crows = need_ctx ? NROW : NLAT;
        if (rep != 2 && rep < 4) for (int i = gt; i < crows * 64; i += NT) conv_task(p, l, i >> 6, i & 63);
    }
    if constexpr (PH == 4) {
        const int nsu = 512 + (need_ctx ? 64 : 0);
        if (rep != 3) for (int u = (vb + 128) % G; u < nsu; u += G) { const bool ic = u >= 512; const int q = u - 512;
            att::swa_unit(p, l, ic ? q >> 3 : u >> 6, ic ? (q >> 2) & 1 : (u >> 5) & 1, ic ? (q >> 1) & 1 : (u >> 1) & 15, ic ? q & 1 : u & 1, ic, lds); }
        __syncthreads();
        if (rep != 2) for (int u = bid; u < 1152; u += G) { const int bh = u / 18, c = u % 18; r1_unit(p, l, bh >> 3, bh & 7, c, lds); }
    }
    if constexpr (PH == 5) {
        const int c0 = need_ctx ? 0 : 1, npair = 9 - c0;
        unsigned* sflag = (unsigned*)(p.ws + WS_CTL) + CW_SCF + l * 1024;
        if (!rep) { ph_ret_scan(p, l);
            asm volatile("s_waitcnt vmcnt(0)" ::: "memory"); __syncthreads();
            if (tid == 0) { __builtin_amdgcn_fence(__ATOMIC_RELEASE, "agent"); asm volatile("s_waitcnt vmcnt(0)" ::: "memory"); __hip_atomic_store(sflag + bid, 1u, __ATOMIC_RELAXED, __HIP_MEMORY_SCOPE_AGENT); } }
        const float dfall = p.dec_f[l * 8 + (tid & 7)], dball = p.dec_b[l * 8 + (tid & 7)];
        for (int u = bid; u < 64 * npair; u += G) { const int bh = u / npair, cp = c0 + u % npair;
            if (!rep) {
                if (tid < 64) { const int nf = (G == 256) ? 4 : G, f0 = (G == 256) ? 4 * bh : 0;
                    for (int f = tid; f < nf; f += 64) { unsigned sp = 0; while (__hip_atomic_load(sflag + f0 + f, __ATOMIC_RELAXED, __HIP_MEMORY_SCOPE_AGENT) == 0u && ++sp < (1u << 20)) __builtin_amdgcn_s_sleep(2); }
                    __builtin_amdgcn_fence(__ATOMIC_ACQUIRE, "agent"); asm volatile("s_waitcnt vmcnt(0)" ::: "memory"); }
                __syncthreads(); }
            r3_pair(p, l, bh >> 3, bh & 7, cp, lds, __uint_as_float(__builtin_amdgcn_readlane(__float_as_uint(dfall), bh & 7)), __uint_as_float(__builtin_amdgcn_readlane(__float_as_uint(dball), bh & 7))); }
    }
    if constexpr (PH == 6) { if (!(rep && l == 1)) {
        const int M = need_ctx ? NROW : NLAT;
        pg8::Gemm g{ws_hb(p), (const bf16*)(p.ws + WS_WOUT) + (size_t)l * 2048 * 2048, M, DM, DM}; pg8::StaticOrder S; S.init(M, DM, G, bid);
        if (l == 0) { pg8::EpiResGate<true> E{p.x, p.ctx, ws_xb(p), ws_ada(p) + (size_t)l * 9 * ADAW, 2 * 2048};
            pg8::gemm_phase<pg8::EpiResGate<true>, pg8::StaticOrder, true, true>(lds, g, S, E);
            if (!rep && G == 256 && bid >= 64 && TAIL_P6 > 0) tail_convert(p, TAIL_OFF_P6, TAIL_P6, bid - 64, G - 64, lds); }
        else { pg8::EpiResGate<false> E{nullptr, nullptr, ws_xb(p), ws_ada(p) + (size_t)l * 9 * ADAW, 2 * 2048};
            pg8::gemm_phase<pg8::EpiResGate<false>, pg8::StaticOrder, true, true>(lds, g, S, E); }
    } }
    if constexpr (PH == 7) ph_norm_router(p, l, lds);
    if constexpr (PH == 9) {
        const int tpe = need_ctx ? 9 : 8;
        pg8::GroupedOrder S; S.init(tpe, G, bid);
        if (!rep) { ph_topk(p, l, lds); topk_wait(p, l, S, tpe, tid); }
        { LAS int* rl = (LAS int*)(lds + RIDX_OFF); const int* idx = (const int*)(p.ws + WS_IDX); pg8::Unit u;
          for (int i = 0; S.next(i, u); ++i) if (tid < 256) rl[i * 256 + tid] = idx[u.pm * 256 + tid];
          __syncthreads(); }
        pg8::Gemm g{ws_hb(p), (const bf16*)(p.ws + WS_WGU) + (size_t)l * 16 * 2048 * 2048, 16 * tpe * 256, 2048, DM, (const LAS int*)(lds + RIDX_OFF)};
        pg8::EpiSiluMul E{(bf16*)(p.ws + WS_ACT)};
        pg8::gemm_phase<pg8::EpiSiluMul, pg8::GroupedOrder, true, true, true>(lds, g, S, E);
        if (l == 0 && !rep && G == 256 && bid >= 128 && TAIL_P9 > 0) tail_convert(p, TAIL_OFF_P9, TAIL_P9, bid - 128, G - 128, lds);
    }
    if constexpr (PH == 10) {
        const int tpe = need_ctx ? 9 : 8;
        pg8::Gemm g{(const bf16*)(p.ws + WS_ACT), (const bf16*)(p.ws + WS_WD) + (size_t)l * 16 * 2048 * 1024, 16 * tpe * 256, 2048, EFF}; pg8::GroupedOrder S; S.init(tpe, G, bid);
        pg8::EpiDown E{ws_z(p), (const float*)(p.ws + WS_GATEV)};
        pg8::gemm_phase<pg8::EpiDown, pg8::GroupedOrder, true, true>(lds, g, S, E);
        if (l == 0 && !rep && G == 256 && bid >= 128 && TAIL_P10 > 0) tail_convert(p, TAIL_OFF_P10, TAIL_P10, bid - 128, G - 128, lds);
    }
    if constexpr (PH == 11) { if (!rep) ph_combine(p, l); }
}

#ifndef MEGA
#define MEGA 1
#endif
template <int PH> __global__ void __launch_bounds__(NTHR, 2) k_phase(Params p, int l) {
    extern __shared__ __attribute__((aligned(16))) unsigned char lds_raw[];
    run_phase<PH>(p, l, (LAS unsigned char*)lds_raw, 0);
}

#if MEGA
__global__ void __launch_bounds__(NTHR, 2) k_mega(Params p) {
    extern __shared__ __attribute__((aligned(16))) unsigned char lds_raw[];
    LAS unsigned char* lds = (LAS unsigned char*)lds_raw;
    volatile LAS unsigned* MISC = (volatile LAS unsigned*)(lds + MISC_OFF);
    if (threadIdx.x < 32) MISC[threadIdx.x] = 0u;
    __syncthreads();
    XcdBarrier bar = xcd_barrier_post((unsigned*)(p.ws + WS_CTL) + CW_BAR, MISC + 8);
#ifndef REPEAT_MASK
#define REPEAT_MASK 0
#endif
#ifndef REPEAT_SUB
#define REPEAT_SUB 1
#endif
#define RP(k, l) do { run_phase<k>(p, l, lds, 0); xcd_barrier(bar); if ((REPEAT_MASK >> k) & 1) { run_phase<k>(p, l, lds, REPEAT_SUB); xcd_barrier(bar); } } while (0)
    RP(0, 0); RP(1, 0);
#ifdef EXTRA_BARRIERS
    for (int i_ = 0; i_ < EXTRA_BARRIERS; ++i_) xcd_barrier(bar);
#endif
#define LAYER_PHASES(l) RP(2, l); run_phase<3>(p, l, lds, 0); __syncthreads(); if ((REPEAT_MASK >> 3) & 1) { run_phase<3>(p, l, lds, REPEAT_SUB); __syncthreads(); } RP(4, l); RP(5, l); RP(6, l); RP(7, l); RP(9, l); RP(10, l);
    LAYER_PHASES(0) RP(11, 0);
    LAYER_PHASES(1) run_phase<11>(p, 1, lds, 0);
#undef RP
#undef LAYER_PHASES
}
#endif

template <int PH> static void launch_phase(const Params& p, int l, int grid, hipStream_t stream) {
    static bool attr_set = false;
    if (!attr_set) { (void)hipFuncSetAttribute((const void*)k_phase<PH>, hipFuncAttributeMaxDynamicSharedMemorySize, LDS_BYTES); attr_set = true; }
    hipLaunchKernelGGL(k_phase<PH>, dim3(grid), dim3(NTHR), LDS_BYTES, stream, p, l);
}

extern "C" void kernel_launch(void* const* d_in, const int* in_sizes, int n_in, void* d_out, int out_size, void* d_ws, size_t ws_size, hipStream_t stream) {
    static int grid = 0;
    if (grid == 0) {
        if (n_in != 20 || in_sizes[0] != NLAT * DM || out_size != NLAT * DM || ws_size < WS_END) {
            fprintf(stderr, "kernel_launch: unexpected problem shape (n_in %d, in0 %d, out %d, ws %zu; need ws >= %zu); nothing launched\n", n_in, n_in > 0 ? in_sizes[0] : -1, out_size, ws_size, (size_t)WS_END);
            grid = -1; return; }
        int dev = 0, cus = 0;
        if (hipGetDevice(&dev) != hipSuccess || hipDeviceGetAttribute(&cus, hipDeviceAttributeMultiprocessorCount, dev) != hipSuccess) { grid = -1; return; }
#if MEGA
        if (hipFuncSetAttribute((const void*)k_mega, hipFuncAttributeMaxDynamicSharedMemorySize, LDS_BYTES) != hipSuccess) { fprintf(stderr, "kernel_launch: hipFuncSetAttribute failed\n"); grid = -1; return; }
        int per_cu = 0;
        if (hipOccupancyMaxActiveBlocksPerMultiprocessor(&per_cu, (const void*)k_mega, NTHR, LDS_BYTES) != hipSuccess || per_cu < 1) { fprintf(stderr, "kernel_launch: occupancy query reports %d blocks per CU\n", per_cu); }
        (void)hipGetLastError();
#endif
        grid = cus;
    }
    if (grid < 0) return;
    Params p{};
    p.x = (const float*)d_in[0]; p.c = (const float*)d_in[1]; p.ctx = (const float*)d_in[2]; p.c_ctx = (const float*)d_in[3]; p.w_ada = (const float*)d_in[4]; p.b_ada = (const float*)d_in[5];
    p.norm_mix = (const float*)d_in[6]; p.norm_ffn = (const float*)d_in[7]; p.w_in = (const float*)d_in[8]; p.w_out = (const float*)d_in[9]; p.dec_f = (const float*)d_in[10]; p.dec_b = (const float*)d_in[11];
    p.conv_w = (const float*)d_in[12]; p.sink = (const float*)d_in[13]; p.rpb = (const float*)d_in[14]; p.w_router = (const float*)d_in[15]; p.w_gate = (const float*)d_in[16]; p.w_up = (const float*)d_in[17];
    p.w_down = (const float*)d_in[18]; p.norm_final = (const float*)d_in[19]; p.out = (float*)d_out; p.ws = (unsigned char*)d_ws;
    if (hipMemsetAsync((char*)d_ws + WS_CTL, 0, CTL_ZERO_BYTES, stream) != hipSuccess) { fprintf(stderr, "kernel_launch: memset failed\n"); return; }
#if MEGA
    hipLaunchKernelGGL(k_mega, dim3(grid), dim3(NTHR), LDS_BYTES, stream, p);
#else
    launch_phase<0>(p, 0, grid, stream); launch_phase<1>(p, 0, grid, stream);
    for (int l = 0; l < DEPTH; ++l) {
        launch_phase<2>(p, l, grid, stream); launch_phase<3>(p, l, grid, stream); launch_phase<4>(p, l, grid, stream); launch_phase<5>(p, l, grid, stream); launch_phase<6>(p, l, grid, stream);
        launch_phase<7>(p, l, grid, stream); launch_phase<9>(p, l, grid, stream); launch_phase<10>(p, l, grid, stream); launch_phase<11>(p, l, grid, stream);
    }
#endif
}
```

```cpp
#include <hip/hip_runtime.h>
#include <cstdio>
#include <cstdint>
__device__ __forceinline__ int tid_opaque() { int t = (int)threadIdx.x; asm volatile("" : "+v"(t)); return t; }
#define MEGA 1
namespace pg8 {
#define PG8_LAS __attribute__((address_space(3)))
typedef unsigned short bf16_t;
typedef short bf16x8 __attribute__((ext_vector_type(8)));
typedef float f32x4 __attribute__((ext_vector_type(4)));
typedef unsigned u32x4 __attribute__((ext_vector_type(4)));
constexpr int BM = 256, BK = 64, HALF = 128, HTB = HALF * BK * 2  , STAGE_BYTES = 8 * HTB, NXCD = 8, WGM = 8;

__host__ __device__ __forceinline__ int lds_byte(int r, int c) { const int st = (r >> 4) * 2 + (c >> 5), rr = r & 15, cc = c & 31, ob = rr * 64 + cc * 2; return st * 1024 + (ob ^ (((ob >> 9) & 1) << 5)); }
__host__ __device__ __forceinline__ void stage_rc(int b, int& R, int& C) { const int st = b / 1024, sb = b % 1024, swz = sb ^ (((sb >> 9) & 1) << 5); R = (st >> 1) * 16 + swz / 64; C = (st & 1) * 32 + (swz % 64) / 2; }
__host__ __device__ __forceinline__ int perm32(int rho) { const int n = rho >> 4, i = rho & 15; return 8 * (i >> 2) + 4 * n + (i & 3); }

struct Unit { int pm, pn, pb, q; };
struct Gemm { const bf16_t* A; const bf16_t* Bt; int M, N, K; const PG8_LAS int* ridx; };

struct StaticOrder {
    int nM, nN, nwg, G, c;
    __host__ __device__ void init(int M, int N, int G_, int c_) { nM = M / BM; nN = N / BM; nwg = nM * nN; G = G_; c = c_; }
    __host__ __device__ bool next(int i, Unit& u) const {
        const long L = (long)i * G + c; if (L >= nwg) return false;
        int wgid = (int)L; { const int q = nwg / NXCD, r = nwg % NXCD, xcd = wgid % NXCD, off = wgid / NXCD; wgid = (xcd < r ? xcd * (q + 1) : r * (q + 1) + (xcd - r) * q) + off; }
        const int nig = WGM * nN, gid = wgid / nig, fm = gid * WGM, gsz = (nM - fm) < WGM ? (nM - fm) : WGM;
        u.pm = fm + ((wgid % nig) % gsz); u.pn = (wgid % nig) / gsz; u.pb = u.pn; return true;
    }
    __device__ __forceinline__ void a_ready(const Unit&) const {}
    __device__ __forceinline__ void done(const Unit&) const {}
};

__device__ __forceinline__ unsigned cvt_pk_bf16(float lo, float hi) { unsigned r; asm volatile("v_cvt_pk_bf16_f32 %0, %1, %2" : "=v"(r) : "v"(lo), "v"(hi)); return r; }
typedef float f32x2 __attribute__((ext_vector_type(2)));
__device__ __forceinline__ f32x2 gelu_pk(f32x2 v) {
    const f32x2 av = __builtin_elementwise_abs(v), d = av * 0.2316418882f + 1.0f;
    f32x2 t; t.x = __builtin_amdgcn_rcpf(d.x); t.y = __builtin_amdgcn_rcpf(d.y);
    f32x2 q = t * 0.5307027145f + (-0.7265760135f); q = q * t + 0.7107068705f; q = q * t + (-0.142248368f); q = q * t + 0.127414796f; q = q * t;
    const f32x2 s = (v * v) * (-0.72134752044f);
    f32x2 e; e.x = __builtin_amdgcn_exp2f(s.x); e.y = __builtin_amdgcn_exp2f(s.y);
    const f32x2 m = v * (q * e), r = v - m;
    f32x2 o; o.x = v.x < 0.f ? m.x : r.x; o.y = v.y < 0.f ? m.y : r.y; return o;
}

template <int ACT  > struct EpiBf16 {
    static constexpr bool PERM = true, AFTER_DRAIN = false; static_assert(ACT == 0 || ACT == 1, "EpiBf16: ACT is 0 (none) or 1 (gelu_pk)");
    bf16_t* O; int ldc; const float* bias; int split_cols; size_t split_stride; float scale0;
    __device__ __forceinline__ void operator()(const f32x4 (&acc)[2][2][4][2], const Unit& u, int wr, int wc, int fr, int fq) const {
        const int row0 = u.pm * BM + wr * 64 + fr; int colt = u.pn * BM; bf16_t* base = O;
        float sc = 1.f; if (split_cols) { const int t = colt / split_cols; base += (size_t)t * split_stride; colt -= t * split_cols; if (t == 0) sc = scale0; }
        const int col0 = colt + wc * 32 + 8 * fq, bcol0 = u.pn * BM + wc * 32 + 8 * fq;
        f32x4 bv[2][2];
#pragma unroll
        for (int bj = 0; bj < 2; ++bj)
#pragma unroll
            for (int n = 0; n < 2; ++n) bv[bj][n] = bias ? *(const f32x4*)(bias + bcol0 + bj * HALF + 4 * n) : (f32x4){0.f, 0.f, 0.f, 0.f};
#pragma unroll
        for (int ai = 0; ai < 2; ++ai)
#pragma unroll
            for (int m = 0; m < 4; ++m) { bf16_t* rowp = base + (size_t)(row0 + ai * HALF + m * 16) * ldc + col0;
#pragma unroll
                for (int bj = 0; bj < 2; ++bj) { f32x4 v0 = acc[ai][bj][m][0] + bv[bj][0], v1 = acc[ai][bj][m][1] + bv[bj][1];
                    if (ACT == 1) { f32x2 a = gelu_pk((f32x2){v0[0], v0[1]}), b = gelu_pk((f32x2){v0[2], v0[3]}), c = gelu_pk((f32x2){v1[0], v1[1]}), d = gelu_pk((f32x2){v1[2], v1[3]});
                        v0 = (f32x4){a.x, a.y, b.x, b.y}; v1 = (f32x4){c.x, c.y, d.x, d.y}; }
                    v0 = v0 * sc; v1 = v1 * sc; u32x4 w; w.x = cvt_pk_bf16(v0[0], v0[1]); w.y = cvt_pk_bf16(v0[2], v0[3]); w.z = cvt_pk_bf16(v1[0], v1[1]); w.w = cvt_pk_bf16(v1[2], v1[3]);
                    *(u32x4*)(rowp + bj * HALF) = w; } }
    }
};

template <class Epi, class Sched, bool ALIGN_EPI = false, bool SP2 = false, bool GATHER = false, bool QUAD = false>
__device__ __forceinline__ void gemm_phase(PG8_LAS unsigned char* lds, const Gemm g, const Sched& S, const Epi& E) {
    const int tid = tid_opaque(), wid = __builtin_amdgcn_readfirstlane(tid >> 6), lane = tid & 63, wr = wid >> 2, wc = wid & 3, fr = lane & 15, fq = lane >> 4;
    const int K = g.K, nt = K / BK;
    unsigned voffA[2], voffB[2];
#pragma unroll
    for (int i = 0; i < 2; ++i) { int R, C; stage_rc(tid * 16 + i * 8192, R, C); const int Rb = Epi::PERM ? ((R & ~31) + perm32(R & 31)) : R;
        voffA[i] = (unsigned)(R * K + C) * 2u; voffB[i] = (unsigned)(Rb * K + C) * 2u; }
    unsigned cvA[2][2], nvA[2][2];
#define PG8_AOFFS(dst, unit, ord) do { _Pragma("unroll") for (int _h = 0; _h < 2; ++_h) _Pragma("unroll") for (int _i = 0; _i < 2; ++_i) { int R_, C_; stage_rc(tid * 16 + _i * 8192, R_, C_); \
        if constexpr (GATHER) dst[_h][_i] = (unsigned)(g.ridx[(ord) * BM + _h * HALF + R_] * K + C_) * 2u; else dst[_h][_i] = voffA[_i] + (unsigned)(_h * HALF * K * 2); } } while (0)
    const size_t kstep = (size_t)(BK * 2);
    const size_t hstep = (size_t)HALF * K * 2;
    const size_t tstep = 2 * hstep;
    const unsigned ldsw = (unsigned)wid * 1024u;
    const int aoff = lds_byte(wr * 64 + fr, fq * 8), boff = lds_byte(wc * 32 + fr, fq * 8);
#define PG8_SA(b, h) (((b) * 2 + (h)) * HTB)
#define PG8_SB(b, h) ((4 + (b) * 2 + (h)) * HTB)
#define PG8_STAGE(bufoff, gbase, voff) do { _Pragma("unroll") for (int _i = 0; _i < 2; ++_i) \
        __builtin_amdgcn_global_load_lds((const unsigned*)((const char*)(gbase) + (voff)[_i]), (PG8_LAS unsigned*)(lds + (bufoff) + ldsw + _i * 8192), 16, 0, 0); } while (0)
#define PG8_LDA(dst, b, h) do { _Pragma("unroll") for (int m = 0; m < 4; ++m) _Pragma("unroll") for (int k = 0; k < 2; ++k) dst[m][k] = *(const PG8_LAS bf16x8*)(lds + PG8_SA(b, h) + aoff + m * 2048 + k * 1024); } while (0)
#define PG8_LDB(dst, b, h) do { _Pragma("unroll") for (int n = 0; n < 2; ++n) _Pragma("unroll") for (int k = 0; k < 2; ++k) dst[n][k] = *(const PG8_LAS bf16x8*)(lds + PG8_SB(b, h) + boff + n * 2048 + k * 1024); } while (0)
#define PG8_MMA(ai, bj, At, Bt) do { __builtin_amdgcn_s_setprio(1); _Pragma("unroll") for (int m = 0; m < 4; ++m) _Pragma("unroll") for (int n = 0; n < 2; ++n) _Pragma("unroll") for (int k = 0; k < 2; ++k) \
        acc[QUAD ? 0 : (ai)][QUAD ? 0 : (bj)][m][n] = __builtin_amdgcn_mfma_f32_16x16x32_bf16(Bt[n][k], At[m][k], acc[QUAD ? 0 : (ai)][QUAD ? 0 : (bj)][m][n], 0, 0, 0); __builtin_amdgcn_s_setprio(0); } while (0)
#define PG8_QMMA(ai, bj, At, Bt) do { if (!QUAD || cur.q == 2 * (ai) + (bj)) PG8_MMA(ai, bj, At, Bt); } while (0)
#define PG8_WAIT_V(n) asm volatile("s_waitcnt vmcnt(" #n ")" ::: "memory")
#define PG8_WAIT_L(n) asm volatile("s_waitcnt lgkmcnt(" #n ")" ::: "memory")
#define PG8_BAR __builtin_amdgcn_s_barrier()
#define PG8_SCHED __builtin_amdgcn_sched_barrier(0)
    Unit cur, nxt; int ui = 0;
    if (!S.next(0, cur)) return;
    constexpr int NQ = QUAD ? 1 : 2;
    f32x4 acc[NQ][NQ][4][2];
#pragma unroll
    for (int a = 0; a < NQ; ++a)
#pragma unroll
        for (int b = 0; b < NQ; ++b)
#pragma unroll
            for (int m = 0; m < 4; ++m)
#pragma unroll
                for (int n = 0; n < 2; ++n) acc[a][b][m][n] = (f32x4){0.f, 0.f, 0.f, 0.f};
    bf16x8 At[4][2], B0[2][2], B1[2][2];
    const char* cA = (const char*)g.A + (GATHER ? (size_t)0 : (size_t)cur.pm * tstep); const char* cB = (const char*)g.Bt + (size_t)cur.pb * tstep;
    S.a_ready(cur);
    PG8_AOFFS(cvA, cur, 0);
    if constexpr (SP2) {
        PG8_STAGE(PG8_SB(0, 0), cB, voffB); PG8_STAGE(PG8_SB(0, 1), cB + hstep, voffB); PG8_STAGE(PG8_SA(0, 0), cA, cvA[0]); PG8_STAGE(PG8_SA(0, 1), cA, cvA[1]);
        if (wr == 1) PG8_BAR;
        PG8_WAIT_V(2); PG8_BAR;
        PG8_STAGE(PG8_SB(1, 0), cB + kstep, voffB); PG8_STAGE(PG8_SA(1, 0), cA + kstep, cvA[0]); PG8_STAGE(PG8_SB(1, 1), cB + hstep + kstep, voffB);
        PG8_WAIT_V(6); PG8_BAR;
    } else { static_assert(SP2, "only the SP2 loop is kept in this file"); }
    for (;;) {
        const bool has_next = S.next(ui + 1, nxt);
        const char* nA = (has_next && !GATHER) ? (const char*)g.A + (size_t)nxt.pm * tstep : cA;
        if constexpr (GATHER) { if (has_next) PG8_AOFFS(nvA, nxt, ui + 1); else { _Pragma("unroll") for (int _h = 0; _h < 2; ++_h) _Pragma("unroll") for (int _i = 0; _i < 2; ++_i) nvA[_h][_i] = cvA[_h][_i]; } }
        const char* nB = has_next ? (const char*)g.Bt + (size_t)nxt.pb * tstep : cB;
        for (int t = 0; t < nt; t += 2) {
            const bool last = (t == nt - 2);
            const char* a1 = cA + (size_t)(t + 1) * kstep;
            const char* a2 = last ? nA : cA + (size_t)(t + 2) * kstep; const char* b2 = last ? nB : cB + (size_t)(t + 2) * kstep;
            const char* a3 = a2 + kstep; const char* b3 = b2 + kstep;
            unsigned xA0[2], xA1[2];
#pragma unroll
            for (int _i = 0; _i < 2; ++_i) { xA0[_i] = (GATHER && last) ? nvA[0][_i] : cvA[0][_i]; xA1[_i] = (GATHER && last) ? nvA[1][_i] : cvA[1][_i]; }
            if (last && has_next) S.a_ready(nxt);
            if constexpr (SP2) {
            PG8_LDB(B0, 0, 0); PG8_LDB(B1, 0, 1); PG8_SCHED; PG8_LDA(At, 0, 0); PG8_STAGE(PG8_SA(1, 1), a1, cvA[1]);
            PG8_WAIT_V(8); PG8_WAIT_L(0); PG8_BAR; PG8_QMMA(0, 0, At, B0); PG8_QMMA(0, 1, At, B1); PG8_BAR; PG8_SCHED;
            PG8_LDA(At, 0, 1); PG8_STAGE(PG8_SB(0, 0), b2, voffB); PG8_STAGE(PG8_SB(0, 1), b2 + hstep, voffB); PG8_STAGE(PG8_SA(0, 0), a2, xA0);
            PG8_WAIT_V(8); PG8_WAIT_L(0); PG8_BAR; PG8_QMMA(1, 0, At, B0); PG8_QMMA(1, 1, At, B1); PG8_BAR; PG8_SCHED;
            PG8_LDB(B0, 1, 0); PG8_LDB(B1, 1, 1); PG8_SCHED; PG8_LDA(At, 1, 0); PG8_STAGE(PG8_SA(0, 1), a2, xA1);
            PG8_WAIT_V(8); PG8_WAIT_L(0); PG8_BAR; PG8_QMMA(0, 0, At, B0); PG8_QMMA(0, 1, At, B1); PG8_BAR; PG8_SCHED;
            PG8_LDA(At, 1, 1); PG8_STAGE(PG8_SB(1, 0), b3, voffB); PG8_STAGE(PG8_SB(1, 1), b3 + hstep, voffB); PG8_STAGE(PG8_SA(1, 0), a3, xA0);
            PG8_WAIT_V(8); PG8_WAIT_L(0); PG8_BAR; PG8_QMMA(1, 0, At, B0); PG8_QMMA(1, 1, At, B1); PG8_BAR; PG8_SCHED;
            }
        }
        if constexpr (ALIGN_EPI) { if (wr == 0) PG8_BAR; }
        if constexpr (QUAD) { E.quad(acc[0][0], cur, wr, wc, fr, fq); S.done(cur); }
        else if constexpr (!Epi::AFTER_DRAIN) { E(acc, cur, wr, wc, fr, fq); S.done(cur); }
        if (!has_next) break;
#pragma unroll
        for (int a = 0; a < NQ; ++a)
#pragma unroll
            for (int b = 0; b < NQ; ++b)
#pragma unroll
                for (int m = 0; m < 4; ++m)
#pragma unroll
                    for (int n = 0; n < 2; ++n) acc[a][b][m][n] = (f32x4){0.f, 0.f, 0.f, 0.f};
        cur = nxt; cA = nA; cB = nB; ++ui;
        if constexpr (GATHER) { _Pragma("unroll") for (int _h = 0; _h < 2; ++_h) _Pragma("unroll") for (int _i = 0; _i < 2; ++_i) cvA[_h][_i] = nvA[_h][_i]; }
        if constexpr (ALIGN_EPI) { if (wr == 1) PG8_BAR; }
    }
    PG8_WAIT_V(0);
    if constexpr (!ALIGN_EPI) { if (wr == 0) PG8_BAR; }
    PG8_BAR;
    if constexpr (!QUAD && Epi::AFTER_DRAIN) { E.fused(acc, cur, wr, wc, fr, fq, lds, wid, lane); S.done(cur); }
#undef PG8_SA
#undef PG8_SB
#undef PG8_STAGE
#undef PG8_LDA
#undef PG8_LDB
#undef PG8_MMA
#undef PG8_QMMA
#undef PG8_WAIT_V
#undef PG8_WAIT_L
#undef PG8_BAR
#undef PG8_SCHED
#undef PG8_AOFFS
}
}
#define LAS __attribute__((address_space(3)))
#define XB_TMO      128
#define XB_XCNT(j)  (256  + 64 * (j))
#define XB_XSUB(j)  (1280 + 64 * (j))
#define XB_XGEN(j)  (2304 + 64 * (j))
#define XB_TOP      3328
#define XB_TOPGEN   3392
#define XCD_BAR_WORDS 3456
#define XB_SPIN_CAP (1u << 18)

__device__ __forceinline__ unsigned xb_ld(unsigned* p)              { return __hip_atomic_load(p, __ATOMIC_RELAXED, __HIP_MEMORY_SCOPE_AGENT); }
__device__ __forceinline__ unsigned xb_add(unsigned* p, unsigned v) { return __hip_atomic_fetch_add(p, v, __ATOMIC_RELAXED, __HIP_MEMORY_SCOPE_AGENT); }
__device__ __forceinline__ unsigned xb_xcc_id() { return (unsigned)__builtin_amdgcn_s_getreg((3 << 11) | 20) & 0xFu; }
#define XB_SPIN(cond, bar) do { unsigned _sp = 0; while (cond) { __builtin_amdgcn_s_sleep(1); \
    if ((++_sp & 255u) == 0u) { if (xb_ld(&(bar)[XB_TMO])) break; if (_sp > XB_SPIN_CAP) { atomicAdd(&(bar)[XB_TMO], 1u); break; } } } } while (0)

struct XcdBarrier {
    unsigned* bar; unsigned x;
    volatile LAS unsigned* st;
};

__device__ __forceinline__ XcdBarrier xcd_barrier_post(unsigned* bar, volatile LAS unsigned* st) {
    XcdBarrier b; b.bar = bar; b.x = xb_xcc_id(); b.st = st;
    if (threadIdx.x == 0) (void)xb_add(&bar[XB_XCNT(b.x)], 1u);
    return b;
}
__device__ __forceinline__ void xcd_barrier_complete(unsigned* bar, unsigned x, unsigned& nloc, unsigned& nx) {
    const unsigned G = gridDim.x * gridDim.y * gridDim.z;
    unsigned sum, cnt, mine, sp = 0u;
    for (;;) {
        sum = 0u; cnt = 0u; mine = 0u;
#pragma unroll
        for (unsigned j = 0; j < 16; ++j) { const unsigned c = xb_ld(&bar[XB_XCNT(j)]); sum += c; cnt += (c > 0u) ? 1u : 0u; mine = (j == x) ? c : mine; }
        if (sum == G) break;
        __builtin_amdgcn_s_sleep(1);
        if ((++sp & 255u) == 0u) { if (xb_ld(&bar[XB_TMO])) break; if (sp > XB_SPIN_CAP) { atomicAdd(&bar[XB_TMO], 1u); break; } }
    }
    nloc = mine > 0u ? mine : 1u; nx = cnt > 0u ? cnt : 1u;
}

__device__ __forceinline__ void xcd_barrier(const XcdBarrier& b) {
    asm volatile("s_waitcnt vmcnt(0)" ::: "memory");
    __syncthreads();
    if (threadIdx.x == 0) {
        unsigned* bar = b.bar;
        __builtin_amdgcn_s_waitcnt(0);
        unsigned nloc = b.st[0], nx = b.st[1];
        if (nloc == 0u) { xcd_barrier_complete(bar, b.x, nloc, nx); b.st[0] = nloc; b.st[1] = nx; }
        const unsigned old = xb_add(&bar[XB_XSUB(b.x)], 1u);
        const unsigned gen = old / nloc;
        if (old + 1u == (gen + 1u) * nloc) {
            __builtin_amdgcn_fence(__ATOMIC_RELEASE, "agent");
            asm volatile("s_waitcnt vmcnt(0)" ::: "memory");
            const unsigned og = xb_add(&bar[XB_TOP], 1u);
            const unsigned tg = og / nx;
            if (og + 1u == (tg + 1u) * nx) xb_add(&bar[XB_TOPGEN], 1u);
            else XB_SPIN(xb_ld(&bar[XB_TOPGEN]) == tg, bar);
            __builtin_amdgcn_fence(__ATOMIC_ACQUIRE, "agent");
            xb_add(&bar[XB_XGEN(b.x)], 1u);
            asm volatile("s_waitcnt vmcnt(0)" ::: "memory");
        } else {
            XB_SPIN(xb_ld(&bar[XB_XGEN(b.x)]) == gen, bar);
            __builtin_amdgcn_fence(__ATOMIC_ACQUIRE, "agent");
            asm volatile("s_waitcnt vmcnt(0)" ::: "memory");
        }
    }
    __syncthreads();
}
#undef LAS
__constant__ float ROPE_COS[1024] = { 1.000000000e+00f, 1.000000000e+00f, 1.000000000e+00f, 1.000000000e+00f, 1.000000000e+00f, 1.000000000e+00f, 1.000000000e+00f, 1.000000000e+00f, 1.000000000e+00f, 1.000000000e+00f, 1.000000000e+00f, 1.000000000e+00f, 1.000000000e+00f, 1.000000000e+00f, 1.000000000e+00f, 1.000000000e+00f, 5.403022766e-01f, 8.460091352e-01f, 9.504152536e-01f, 9.842302203e-01f, 9.950041771e-01f, 9.984192848e-01f, 9.995000362e-01f, 9.998418689e-01f, 9.999499917e-01f, 9.999842048e-01f, 9.999949932e-01f, 9.999983907e-01f, 9.999995232e-01f, 9.999998212e-01f, 9.999999404e-01f, 1.000000000e+00f, -4.161468446e-01f, 4.314628243e-01f, 8.065783978e-01f, 9.374182820e-01f, 9.800665975e-01f, 9.936820865e-01f, 9.980006814e-01f, 9.993675947e-01f, 9.998000264e-01f, 9.999367595e-01f, 9.999799728e-01f, 9.999936819e-01f, 9.999979734e-01f, 9.999993443e-01f, 9.999998212e-01f, 9.999999404e-01f, -9.899924994e-01f, -1.159661636e-01f, 5.827536583e-01f, 8.610406518e-01f, 9.553365111e-01f, 9.858034849e-01f, 9.955033660e-01f, 9.985772967e-01f, 9.995500445e-01f, 9.998577237e-01f, 9.999549985e-01f, 9.999857545e-01f, 9.999955297e-01f, 9.999985695e-01f, 9.999995232e-01f, 9.999998808e-01f, -6.536436081e-01f, -6.276797056e-01f, 3.011374772e-01f, 7.575061917e-01f, 9.210609794e-01f, 9.748082757e-01f, 9.920106530e-01f, 9.974712729e-01f, 9.992001057e-01f, 9.997470379e-01f, 9.999200106e-01f, 9.999747276e-01f, 9.999920130e-01f, 9.999974966e-01f, 9.999992251e-01f, 9.999997616e-01f, 2.836622000e-01f, -9.460792542e-01f, -1.034233812e-02f, 6.300802827e-01f, 8.775825500e-01f, 9.607312679e-01f, 9.875259995e-01f, 9.960497618e-01f, 9.987502694e-01f, 9.996047616e-01f, 9.998750091e-01f, 9.999604821e-01f, 9.999874830e-01f, 9.999960661e-01f, 9.999987483e-01f, 9.999995828e-01f, 9.601702690e-01f, -9.731037021e-01f, -3.207964003e-01f, 4.827820361e-01f, 8.253356218e-01f, 9.436169863e-01f, 9.820539355e-01f, 9.943132997e-01f, 9.982005358e-01f, 9.994308352e-01f, 9.998199940e-01f, 9.999430776e-01f, 9.999819994e-01f, 9.999943376e-01f, 9.999982119e-01f, 9.999994040e-01f, 7.539022565e-01f, -7.004297972e-01f, -5.994374752e-01f, 3.202570081e-01f, 7.648422122e-01f, 9.235194325e-01f, 9.755998850e-01f, 9.922624230e-01f, 9.975510240e-01f, 9.992253184e-01f, 9.997550249e-01f, 9.999225140e-01f, 9.999755025e-01f, 9.999922514e-01f, 9.999975562e-01f, 9.999992251e-01f, -1.455000341e-01f, -2.120364457e-01f, -8.186324239e-01f, 1.476312131e-01f, 6.967067122e-01f, 9.005023241e-01f, 9.681702852e-01f, 9.898977876e-01f, 9.968017340e-01f, 9.989882708e-01f, 9.996800423e-01f, 9.998987913e-01f, 9.999679923e-01f, 9.999898672e-01f, 9.999967813e-01f, 9.999989867e-01f, -9.111302495e-01f, 3.416602612e-01f, -9.566441774e-01f, -2.965079620e-02f, 6.216099262e-01f, 8.746382594e-01f, 9.597726464e-01f, 9.872201085e-01f, 9.959527254e-01f, 9.987195730e-01f, 9.995950460e-01f, 9.998719096e-01f, 9.999595284e-01f, 9.999871850e-01f, 9.999959469e-01f, 9.999987483e-01f, -8.390715122e-01f, 7.901318669e-01f, -9.997860789e-01f, -2.059976310e-01f, 5.403022766e-01f, 8.460091352e-01f, 9.504153132e-01f, 9.842302203e-01f, 9.950041771e-01f, 9.984192848e-01f, 9.995000362e-01f, 9.998418689e-01f, 9.999499917e-01f, 9.999842048e-01f, 9.999949932e-01f, 9.999983907e-01f, 4.425697960e-03f, 9.952573776e-01f, -9.437797666e-01f, -3.758473992e-01f, 4.535960853e-01f, 8.147053123e-01f, 9.401075840e-01f, 9.809291363e-01f, 9.939560890e-01f, 9.980874062e-01f, 9.993950725e-01f, 9.998086691e-01f, 9.999395013e-01f, 9.999808669e-01f, 9.999939203e-01f, 9.999980927e-01f, 8.438539505e-01f, 8.938615918e-01f, -7.941793799e-01f, -5.338430405e-01f, 3.623577058e-01f, 7.808259130e-01f, 9.288598895e-01f, 9.773178697e-01f, 9.928086400e-01f, 9.977239966e-01f, 9.992800951e-01f, 9.997723103e-01f, 9.999279976e-01f, 9.999772310e-01f, 9.999927878e-01f, 9.999977350e-01f, 9.074468017e-01f, 5.171728730e-01f, -5.658205152e-01f, -6.750016809e-01f, 2.674987614e-01f, 7.444779873e-01f, 9.166833758e-01f, 9.733975530e-01f, 9.915618896e-01f, 9.973290563e-01f, 9.991551042e-01f, 9.997327924e-01f, 9.999154806e-01f, 9.999732971e-01f, 9.999915361e-01f, 9.999973178e-01f, 1.367372125e-01f, -1.879615150e-02f, -2.813494802e-01f, -7.948709130e-01f, 1.699671596e-01f, 7.057763934e-01f, 9.035902619e-01f, 9.691694379e-01f, 9.902160168e-01f, 9.969025850e-01f, 9.990201592e-01f, 9.996901155e-01f, 9.999020100e-01f, 9.999690056e-01f, 9.999902248e-01f, 9.999969006e-01f, -7.596879005e-01f, -5.489754677e-01f, 3.102235124e-02f, -8.896704316e-01f, 7.073719800e-02f, 6.648434997e-01f, 8.895936012e-01f, 9.646348357e-01f, 9.887710810e-01f, 9.964445233e-01f, 9.988752007e-01f, 9.996442795e-01f, 9.998875260e-01f, 9.999644160e-01f, 9.999887347e-01f, 9.999964237e-01f, -9.576594830e-01f, -9.100810885e-01f, 3.403181732e-01f, -9.564100504e-01f, -2.919954620e-02f, 6.218088269e-01f, 8.747074604e-01f, 9.597951770e-01f, 9.872272611e-01f, 9.959549904e-01f, 9.987202883e-01f, 9.995952845e-01f, 9.998720288e-01f, 9.999595284e-01f, 9.999871850e-01f, 9.999959469e-01f, -2.751633525e-01f, -9.908979535e-01f, 6.158648133e-01f, -9.929850101e-01f, -1.288445443e-01f, 5.768082738e-01f, 8.589466810e-01f, 9.546520114e-01f, 9.855847955e-01f, 9.954339862e-01f, 9.985553622e-01f, 9.995430708e-01f, 9.998555183e-01f, 9.999542832e-01f, 9.999855757e-01f, 9.999954104e-01f, 6.603167057e-01f, -7.665365338e-01f, 8.303361535e-01f, -9.982416630e-01f, -2.272021621e-01f, 5.299841762e-01f, 8.423270583e-01f, 9.492070079e-01f, 9.838436842e-01f, 9.948815107e-01f, 9.983804226e-01f, 9.994877577e-01f, 9.998379946e-01f, 9.999487996e-01f, 9.999837875e-01f, 9.999948740e-01f, 9.887046218e-01f, -3.060953915e-01f, 9.624637961e-01f, -9.720142484e-01f, -3.232895434e-01f, 4.814845920e-01f, 8.248651624e-01f, 9.434618354e-01f, 9.820042253e-01f, 9.942975044e-01f, 9.981955290e-01f, 9.994292855e-01f, 9.998195171e-01f, 9.999428988e-01f, 9.999819398e-01f, 9.999942780e-01f, 4.080820680e-01f, 2.486167252e-01f, 9.991443753e-01f, -9.151299596e-01f, -4.161468446e-01f, 4.314628243e-01f, 8.065784574e-01f, 9.374182820e-01f, 9.800665975e-01f, 9.936820865e-01f, 9.980006814e-01f, 9.993675947e-01f, 9.998000264e-01f, 9.999367595e-01f, 9.999799728e-01f, 9.999936819e-01f, -5.477292538e-01f, 7.267602682e-01f, 9.367404580e-01f, -8.293829560e-01f, -5.048462152e-01f, 3.800770044e-01f, 7.874851823e-01f, 9.310783744e-01f, 9.780309200e-01f, 9.930352569e-01f, 9.977958202e-01f, 9.993028045e-01f, 9.997795224e-01f, 9.999302626e-01f, 9.999779463e-01f, 9.999930263e-01f, -9.999608397e-01f, 9.810745716e-01f, 7.814403772e-01f, -7.174774408e-01f, -5.885011554e-01f, 3.274895847e-01f, 7.676045895e-01f, 9.244439602e-01f, 9.758974314e-01f, 9.923570156e-01f, 9.975810051e-01f, 9.992348552e-01f, 9.997580051e-01f, 9.999234676e-01f, 9.999758005e-01f, 9.999923706e-01f, -5.328330398e-01f, 9.332357645e-01f, 5.486452579e-01f, -5.829432607e-01f, -6.662759781e-01f, 2.738668323e-01f, 7.469564080e-01f, 9.175173044e-01f, 9.736663699e-01f, 9.916474223e-01f, 9.973561764e-01f, 9.991636872e-01f, 9.997355342e-01f, 9.999163747e-01f, 9.999735355e-01f, 9.999916553e-01f, 4.241790175e-01f, 5.979771614e-01f, 2.614416778e-01f, -4.300232828e-01f, -7.373937964e-01f, 2.193782777e-01f, 7.255613208e-01f, 9.103004336e-01f, 9.713379741e-01f, 9.909064770e-01f, 9.971213937e-01f, 9.990894198e-01f, 9.997119904e-01f, 9.999089241e-01f, 9.999712110e-01f, 9.999908805e-01f, 9.912028313e-01f, 7.855226099e-02f, -5.168933049e-02f, -2.635405958e-01f, -8.011435866e-01f, 1.641961634e-01f, 7.034407258e-01f, 9.027957320e-01f, 9.689124227e-01f, 9.901341200e-01f, 9.968766570e-01f, 9.990119338e-01f, 9.996874928e-01f, 9.999011755e-01f, 9.999687672e-01f, 9.999901056e-01f, 6.469193101e-01f, -4.650644958e-01f, -3.596943319e-01f, -8.874550462e-02f, -8.568888307e-01f, 1.084949449e-01f, 6.806167960e-01f, 8.950055838e-01f, 9.663899541e-01f, 9.893305302e-01f, 9.966219068e-01f, 9.989313483e-01f, 9.996620417e-01f, 9.998931289e-01f, 9.999662042e-01f, 9.999893308e-01f, -2.921388149e-01f, -8.654506207e-01f, -6.320286393e-01f, 8.884811401e-02f, -9.040721655e-01f, 5.245061591e-02f, 6.571123004e-01f, 8.869323730e-01f, 9.637709260e-01f, 9.884956479e-01f, 9.963572025e-01f, 9.988475442e-01f, 9.996355176e-01f, 9.998847246e-01f, 9.999635220e-01f, 9.999884963e-01f, -9.626058936e-01f, -9.992933869e-01f, -8.416849375e-01f, 2.636395097e-01f, -9.422222972e-01f, -3.759419080e-03f, 6.329506636e-01f, 8.785787225e-01f, 9.610554576e-01f, 9.876294732e-01f, 9.960825443e-01f, 9.987606406e-01f, 9.996080399e-01f, 9.998760223e-01f, 9.999607801e-01f, 9.999876022e-01f, -7.480575442e-01f, -8.253716230e-01f, -9.678714871e-01f, 4.301158488e-01f, -9.709581733e-01f, -5.995756760e-02f, 6.081562042e-01f, 8.699471951e-01f, 9.582439065e-01f, 9.867320657e-01f, 9.957979321e-01f, 9.986705780e-01f, 9.995795488e-01f, 9.998670220e-01f, 9.999579787e-01f, 9.999867082e-01f, 1.542514563e-01f, -3.972518742e-01f, -9.980752468e-01f, 5.830269456e-01f, -9.899924994e-01f, -1.159661636e-01f, 5.827536583e-01f, 8.610406518e-01f, 9.553365111e-01f, 9.858034849e-01f, 9.955033660e-01f, 9.985772967e-01f, 9.995500445e-01f, 9.998577237e-01f, 9.999549985e-01f, 9.999857545e-01f, 9.147423506e-01f, 1.532154828e-01f, -9.293003082e-01f, 7.175492048e-01f, -9.991351366e-01f, -1.716081351e-01f, 5.567683578e-01f, 8.518617749e-01f, 9.523335695e-01f, 9.848436713e-01f, 9.951988459e-01f, 9.984809160e-01f, 9.995195270e-01f, 9.998480678e-01f, 9.999519587e-01f, 9.999848008e-01f, 8.342233896e-01f, 6.564951539e-01f, -7.683671117e-01f, 8.294403553e-01f, -9.982947707e-01f, -2.267075777e-01f, 5.302263498e-01f, 8.424135447e-01f, 9.492354393e-01f, 9.838528037e-01f, 9.948843718e-01f, 9.983813763e-01f, 9.994880557e-01f, 9.998381138e-01f, 9.999487996e-01f, 9.999837875e-01f, -1.327674743e-02f, 9.575860500e-01f, -5.312352777e-01f, 9.151713848e-01f, -9.874798059e-01f, -2.810903192e-01f, 5.031541586e-01f, 8.326989412e-01f, 9.460423589e-01f, 9.828307629e-01f, 9.945599437e-01f, 9.982786179e-01f, 9.994555712e-01f, 9.998278022e-01f, 9.999455214e-01f, 9.999827743e-01f, -8.485702872e-01f, 9.637575150e-01f, -2.414211184e-01f, 9.720383286e-01f, -9.667981863e-01f, -3.345843852e-01f, 4.755789042e-01f, 8.227210045e-01f, 9.427546859e-01f, 9.817776680e-01f, 9.942255616e-01f, 9.981727600e-01f, 9.994220734e-01f, 9.998172522e-01f, 9.999421835e-01f, 9.999817014e-01f, -9.036921859e-01f, 6.731102467e-01f, 7.233466953e-02f, 9.982477427e-01f, -9.364566803e-01f, -3.870206773e-01f, 4.475280643e-01f, 8.124829531e-01f, 9.393727183e-01f, 9.806935191e-01f, 9.938812256e-01f, 9.980637431e-01f, 9.993875623e-01f, 9.998063445e-01f, 9.999387264e-01f, 9.999806285e-01f, -1.279636919e-01f, 1.751565337e-01f, 3.789161742e-01f, 9.929728508e-01f, -8.967583776e-01f, -4.382335544e-01f, 4.190297425e-01f, 8.019878864e-01f, 9.358968139e-01f, 9.795783162e-01f, 9.935269952e-01f, 9.979515672e-01f, 9.993520975e-01f, 9.997950792e-01f, 9.999352098e-01f, 9.999794960e-01f, 7.654140592e-01f, -3.767423034e-01f, 6.479216814e-01f, 9.563800097e-01f, -8.481000066e-01f, -4.880608618e-01f, 3.901124299e-01f, 7.912392616e-01f, 9.323273301e-01f, 9.784321785e-01f, 9.931628108e-01f, 9.978361726e-01f, 9.993155599e-01f, 9.997835755e-01f, 9.999315739e-01f, 9.999783635e-01f, 9.550736547e-01f, -8.126112223e-01f, 8.526731133e-01f, 8.896234632e-01f, -7.909677625e-01f, -5.363451838e-01f, 3.608050346e-01f, 7.802404165e-01f, 9.286646247e-01f, 9.772551060e-01f, 9.927886724e-01f, 9.977176785e-01f, 9.992780685e-01f, 9.997717142e-01f, 9.999278188e-01f, 9.999771714e-01f, 2.666429281e-01f, -9.982103705e-01f, 9.728653431e-01f, 7.948083878e-01f, -7.259322405e-01f, -5.829339027e-01f, 3.311368525e-01f, 7.689949274e-01f, 9.249090552e-01f, 9.760470986e-01f, 9.924046397e-01f, 9.975960255e-01f, 9.992396235e-01f, 9.997594953e-01f, 9.999239445e-01f, 9.999759793e-01f, -6.669380665e-01f, -8.763794303e-01f, 9.965789914e-01f, 6.749256253e-01f, -6.536436081e-01f, -6.276797056e-01f, 3.011375964e-01f, 7.575061917e-01f, 9.210609794e-01f, 9.748082757e-01f, 9.920106530e-01f, 9.974712729e-01f, 9.992001057e-01f, 9.997470379e-01f, 9.999200106e-01f, 9.999747276e-01f, -9.873392582e-01f, -4.846394062e-01f, 9.214623570e-01f, 5.337560773e-01f, -5.748240352e-01f, -6.704410911e-01f, 2.708370686e-01f, 7.457779050e-01f, 9.171208143e-01f, 9.735385776e-01f, 9.916067719e-01f, 9.973433018e-01f, 9.991596341e-01f, 9.997342229e-01f, 9.999159575e-01f, 9.999734163e-01f, -3.999853134e-01f, 5.636094138e-02f, 7.549653649e-01f, 3.757521510e-01f, -4.902605712e-01f, -7.110829353e-01f, 2.402658761e-01f, 7.338138223e-01f, 9.130889177e-01f, 9.722381234e-01f, 9.911929369e-01f, 9.972121716e-01f, 9.991181493e-01f, 9.997211099e-01f, 9.999117851e-01f, 9.999721050e-01f, 5.551133156e-01f, 5.800031424e-01f, 5.135984421e-01f, 2.058971673e-01f, -4.007990062e-01f, -7.494767308e-01f, 2.094544172e-01f, 7.216176391e-01f, 9.089657664e-01f, 9.709069133e-01f, 9.907692075e-01f, 9.970778823e-01f, 9.990756512e-01f, 9.997076392e-01f, 9.999075532e-01f, 9.999707937e-01f, 9.998432994e-01f, 9.250146747e-01f, 2.212981731e-01f, 2.954781987e-02f, -3.073327839e-01f, -7.855011225e-01f, 1.784335226e-01f, 7.091933489e-01f, 9.047516584e-01f, 9.695450068e-01f, 9.903355837e-01f, 9.969404936e-01f, 9.990321398e-01f, 9.996939301e-01f, 9.999032021e-01f, 9.999693632e-01f, 5.253219604e-01f, 9.851381779e-01f, -9.294810891e-02f, -1.477329880e-01f, -2.107958049e-01f, -8.190422058e-01f, 1.472342163e-01f, 6.965447664e-01f, 9.004471302e-01f, 9.681524038e-01f, 9.898920655e-01f, 9.967998862e-01f, 9.989876747e-01f, 9.996798635e-01f, 9.998987317e-01f, 9.999679923e-01f, -4.321779311e-01f, 7.418580055e-01f, -3.979767561e-01f, -3.203543723e-01f, -1.121526212e-01f, -8.499938846e-01f, 1.158876941e-01f, 6.836758852e-01f, 8.960524797e-01f, 9.667292237e-01f, 9.894386530e-01f, 9.966561794e-01f, 9.989421964e-01f, 9.996654391e-01f, 9.998942018e-01f, 9.999665618e-01f, -9.923354983e-01f, 2.700984478e-01f, -6.635382771e-01f, -4.828719497e-01f, -1.238837745e-02f, -8.782584071e-01f, 8.442528546e-02f, 6.705908775e-01f, 8.915683031e-01f, 9.652754664e-01f, 9.889753461e-01f, 9.965093136e-01f, 9.988957047e-01f, 9.996507764e-01f, 9.998895526e-01f, 9.999650717e-01f, -6.401443481e-01f, -2.848466039e-01f, -8.632965088e-01f, -6.301599741e-01f, 8.749917150e-02f, -9.037463665e-01f, 5.287845805e-02f, 6.572937369e-01f, 8.869948983e-01f, 9.637911916e-01f, 9.885020852e-01f, 9.963592887e-01f, 9.988481998e-01f, 9.996357560e-01f, 9.998847842e-01f, 9.999635816e-01f, 3.005925417e-01f, -7.520639896e-01f, -9.774427414e-01f, -7.575730681e-01f, 1.865124702e-01f, -9.263771176e-01f, 2.127875760e-02f, 6.437888145e-01f, 8.823328614e-01f, 9.622764587e-01f, 9.880189896e-01f, 9.962061048e-01f, 9.987997413e-01f, 9.996203780e-01f, 9.998799562e-01f, 9.999620318e-01f, 9.649659991e-01f, -9.876590967e-01f, -9.946564436e-01f, -8.610926867e-01f, 2.836622000e-01f, -9.460792542e-01f, -1.034221891e-02f, 6.300802827e-01f, 8.775825500e-01f, 9.607312679e-01f, 9.875259995e-01f, 9.960497618e-01f, 9.987502694e-01f, 9.996047616e-01f, 9.998750091e-01f, 9.999604821e-01f, 7.421541810e-01f, -9.190735221e-01f, -9.132301211e-01f, -9.374542236e-01f, 3.779776692e-01f, -9.627903700e-01f, -4.195285589e-02f, 6.161724925e-01f, 8.727445006e-01f, 9.591556787e-01f, 9.870231748e-01f, 9.958902597e-01f, 9.986997843e-01f, 9.995887876e-01f, 9.998699427e-01f, 9.999588728e-01f, -1.629907787e-01f, -5.674300194e-01f, -7.412399650e-01f, -9.842484593e-01f, 4.685169160e-01f, -9.764577150e-01f, -7.352153957e-02f, 6.020699143e-01f, 8.678191900e-01f, 9.575498104e-01f, 9.865104556e-01f, 9.957276583e-01f, 9.986482859e-01f, 9.995725155e-01f, 9.998648167e-01f, 9.999572635e-01f, -9.182828069e-01f, -4.102819040e-02f, -4.957418144e-01f, -1.000000000e+00f, 5.543745160e-01f, -9.870380163e-01f, -1.050167084e-01f, 5.877769589e-01f, 8.628070951e-01f, 9.559136033e-01f, 9.859878421e-01f, 9.955618382e-01f, 9.985958338e-01f, 9.995558858e-01f, 9.998595715e-01f, 9.999555945e-01f, -8.293098211e-01f, 4.980095923e-01f, -2.010796219e-01f, -9.842120409e-01f, 6.346929669e-01f, -9.944978952e-01f, -1.364068687e-01f, 5.732980371e-01f, 8.577086926e-01f, 9.542471766e-01f, 9.854553938e-01f, 9.953929186e-01f, 9.985423684e-01f, 9.995389581e-01f, 9.998542070e-01f, 9.999538660e-01f, 2.212675661e-02f, 8.836693168e-01f, 1.135217771e-01f, -9.373825192e-01f, 7.086697817e-01f, -9.988136292e-01f, -1.676606387e-01f, 5.586379170e-01f, 8.525245190e-01f, 9.525505900e-01f, 9.849131107e-01f, 9.952208400e-01f, 9.984878898e-01f, 9.995217323e-01f, 9.998487830e-01f, 9.999521971e-01f, 8.532201052e-01f, 9.971746206e-01f, 4.168670774e-01f, -8.609884381e-01f, 7.755658031e-01f, -9.999717474e-01f, -1.987468749e-01f, 5.438010693e-01f, 8.472551107e-01f, 9.508239031e-01f, 9.843609333e-01f, 9.950456619e-01f, 9.984323978e-01f, 9.995042086e-01f, 9.998431802e-01f, 9.999504089e-01f, 8.998668194e-01f, 8.035690784e-01f, 6.788702011e-01f, -7.574391961e-01f, 8.347129226e-01f, -9.979684949e-01f, -2.296342701e-01f, 5.287923217e-01f, 8.419010043e-01f, 9.490671158e-01f, 9.837989211e-01f, 9.948672652e-01f, 9.983759522e-01f, 9.994863272e-01f, 9.998375773e-01f, 9.999486208e-01f, 1.191801354e-01f, 3.624766767e-01f, 8.735505342e-01f, -6.300007105e-01f, 8.855196238e-01f, -9.928101897e-01f, -2.602920532e-01f, 5.136163235e-01f, 8.364626765e-01f, 9.472803473e-01f, 9.832270741e-01f, 9.946857691e-01f, 9.983184934e-01f, 9.994681478e-01f, 9.998317957e-01f, 9.999468327e-01f, -7.710801959e-01f, -1.902491003e-01f, 9.816020727e-01f, -4.826923311e-01f, 9.274784923e-01f, -9.845131636e-01f, -2.906895578e-01f, 4.982779026e-01f, 8.309407234e-01f, 9.454635978e-01f, 9.826454520e-01f, 9.945011139e-01f, 9.982600212e-01f, 9.994496703e-01f, 9.998259544e-01f, 9.999449849e-01f, -9.524129629e-01f, -6.843819022e-01f, 9.923083186e-01f, -3.201591671e-01f, 9.601702690e-01f, -9.731037021e-01f, -3.207964003e-01f, 4.827820361e-01f, 8.253356218e-01f, 9.436169863e-01f, 9.820539355e-01f, 9.943132997e-01f, 9.982005358e-01f, 9.994308352e-01f, 9.998199940e-01f, 9.999430776e-01f, -2.581016421e-01f, -9.677396417e-01f, 9.046075940e-01f, -1.475291997e-01f, 9.832684398e-01f, -9.586178064e-01f, -3.505824506e-01f, 4.671334028e-01f, 8.196480274e-01f, 9.417404532e-01f, 9.814526439e-01f, 9.941223264e-01f, 9.981400967e-01f, 9.994117022e-01f, 9.998139739e-01f, 9.999411702e-01f, 6.735071540e-01f, -9.530500174e-01f, 7.271980643e-01f, 2.975377068e-02f, 9.965420961e-01f, -9.411013126e-01f, -3.800179660e-01f, 4.513370395e-01f, 8.138784766e-01f, 9.398342371e-01f, 9.808415174e-01f, 9.939282537e-01f, 9.980786443e-01f, 9.993922710e-01f, 9.998078346e-01f, 9.999392033e-01f, 9.858965874e-01f, -6.448370218e-01f, 4.776714444e-01f, 2.060983330e-01f, 9.998586178e-01f, -9.206095338e-01f, -4.090735018e-01f, 4.353979528e-01f, 8.080275059e-01f, 9.378982186e-01f, 9.802205563e-01f, 9.937310219e-01f, 9.980161786e-01f, 9.993724823e-01f, 9.998015761e-01f, 9.999372363e-01f };
__constant__ float ROPE_SIN[1024] = { 0.000000000e+00f, 0.000000000e+00f, 0.000000000e+00f, 0.000000000e+00f, 0.000000000e+00f, 0.000000000e+00f, 0.000000000e+00f, 0.000000000e+00f, 0.000000000e+00f, 0.000000000e+00f, 0.000000000e+00f, 0.000000000e+00f, 0.000000000e+00f, 0.000000000e+00f, 0.000000000e+00f, 0.000000000e+00f, 8.414709568e-01f, 5.331684351e-01f, 3.109835982e-01f, 1.768921912e-01f, 9.983342141e-02f, 5.620449781e-02f, 3.161750361e-02f, 1.778185740e-02f, 9.999833070e-03f, 5.623383448e-03f, 3.162272274e-03f, 1.778278500e-03f, 9.999999311e-04f, 5.623412435e-04f, 3.162277571e-04f, 1.778279402e-04f, 9.092974067e-01f, 9.021307230e-01f, 5.911270976e-01f, 3.482052684e-01f, 1.986693293e-01f, 1.122313142e-01f, 6.320339441e-02f, 3.555808961e-02f, 1.999866590e-02f, 1.124658901e-02f, 6.324512884e-03f, 3.556551412e-03f, 1.999998698e-03f, 1.124682371e-03f, 6.324554561e-04f, 3.556558804e-04f, 1.411200017e-01f, 9.932531714e-01f, 8.126488924e-01f, 5.085361004e-01f, 2.955202162e-01f, 1.679033041e-01f, 9.472608566e-02f, 5.332308263e-02f, 2.999549918e-02f, 1.686943881e-02f, 9.486690164e-03f, 5.334813148e-03f, 2.999995602e-03f, 1.687023090e-03f, 9.486831259e-04f, 5.334838061e-04f, -7.568024993e-01f, 7.784717083e-01f, 9.535807371e-01f, 6.528279781e-01f, 3.894183338e-01f, 2.230444849e-01f, 1.261540651e-01f, 7.107120752e-02f, 3.998933360e-02f, 2.249175683e-02f, 1.264877338e-02f, 7.113057654e-03f, 3.999989480e-03f, 2.249363344e-03f, 1.264910679e-03f, 7.113117026e-04f, -9.589242935e-01f, 3.239352703e-01f, 9.999465346e-01f, 7.765299678e-01f, 4.794255495e-01f, 2.774805427e-01f, 1.574558765e-01f, 8.879686147e-02f, 4.997916520e-02f, 2.811336145e-02f, 1.581072807e-02f, 8.891279809e-03f, 4.999979399e-03f, 2.811702900e-03f, 1.581138116e-03f, 8.891395992e-04f, -2.794154882e-01f, -2.303675115e-01f, 9.471482038e-01f, 8.757405281e-01f, 5.646424890e-01f, 3.310393095e-01f, 1.886002719e-01f, 1.064944416e-01f, 5.996400490e-02f, 3.373407945e-02f, 1.897252724e-02f, 1.066947449e-02f, 5.999964196e-03f, 3.374041524e-03f, 1.897365320e-03f, 1.066967379e-03f, 6.569865942e-01f, -7.137212753e-01f, 8.004215956e-01f, 9.473307133e-01f, 6.442176700e-01f, 3.835515678e-01f, 2.195560932e-01f, 1.241583377e-01f, 6.994284689e-02f, 3.935372457e-02f, 2.213413455e-02f, 1.244763471e-02f, 6.999942940e-03f, 3.936378751e-03f, 2.213592408e-03f, 1.244795276e-03f, 9.893582463e-01f, -9.772617817e-01f, 5.743177533e-01f, 9.890424609e-01f, 7.173560858e-01f, 4.348512292e-01f, 2.502923310e-01f, 1.417829692e-01f, 7.991468906e-02f, 4.497213289e-02f, 2.529552206e-02f, 1.422575582e-02f, 7.999914698e-03f, 4.498715047e-03f, 2.529819263e-03f, 1.422623056e-03f, 4.121184945e-01f, -9.398235083e-01f, 2.912592292e-01f, 9.995602965e-01f, 7.833269238e-01f, 4.847761393e-01f, 2.807783186e-01f, 1.593627781e-01f, 8.987854421e-02f, 5.058911815e-02f, 2.845665626e-02f, 1.600383036e-02f, 8.999879472e-03f, 5.061050411e-03f, 2.846045885e-03f, 1.600450720e-03f, -5.440211296e-01f, -6.129369140e-01f, -2.068356983e-02f, 9.785524607e-01f, 8.414709568e-01f, 5.331684351e-01f, 3.109835684e-01f, 1.768921912e-01f, 9.983341396e-02f, 5.620449781e-02f, 3.161750361e-02f, 1.778185740e-02f, 9.999834001e-03f, 5.623383448e-03f, 3.162272274e-03f, 1.778278500e-03f, -9.999902248e-01f, -9.727645665e-02f, -3.305749595e-01f, 9.266815782e-01f, 8.912073970e-01f, 5.798751712e-01f, 3.408778608e-01f, 1.943656504e-01f, 1.097782999e-01f, 6.181810424e-02f, 3.477803990e-02f, 1.955982670e-02f, 1.099977922e-02f, 6.185714621e-03f, 3.478498431e-03f, 1.956106164e-03f, -5.365729332e-01f, 4.483429790e-01f, -6.076834202e-01f, 8.455836177e-01f, 9.320390821e-01f, 6.247486472e-01f, 3.704313040e-01f, 2.117776722e-01f, 1.197122037e-01f, 6.742975861e-02f, 3.793822229e-02f, 2.133773454e-02f, 1.199971233e-02f, 6.748044398e-03f, 3.794723889e-03f, 2.133933594e-03f, 4.201670289e-01f, 8.558809757e-01f, -8.245284557e-01f, 7.378162146e-01f, 9.635581970e-01f, 6.676470041e-01f, 3.996143043e-01f, 2.291227132e-01f, 1.296341419e-01f, 7.303927839e-02f, 4.109803215e-02f, 2.311557345e-02f, 1.299963426e-02f, 7.310371846e-03f, 4.110949114e-03f, 2.311761025e-03f, 9.906073809e-01f, 9.998233318e-01f, -9.596053958e-01f, 6.067785621e-01f, 9.854497313e-01f, 7.084347010e-01f, 4.283977747e-01f, 2.463953048e-01f, 1.395431161e-01f, 7.864648104e-02f, 4.425742477e-02f, 2.489333972e-02f, 1.399954315e-02f, 7.872696966e-03f, 4.427174106e-03f, 2.489588689e-03f, 6.502878666e-01f, 8.358384371e-01f, -9.995186925e-01f, 4.566032588e-01f, 9.974949956e-01f, 7.469826341e-01f, 4.567528665e-01f, 2.635899782e-01f, 1.494381279e-01f, 8.425120264e-02f, 4.741638154e-02f, 2.667102963e-02f, 1.499943808e-02f, 8.435020223e-03f, 4.743398633e-03f, 2.667415887e-03f, -2.879033089e-01f, 4.144302309e-01f, -9.403103590e-01f, 2.920270860e-01f, 9.995735884e-01f, 7.831690907e-01f, 4.846512377e-01f, 2.807013094e-01f, 1.593182087e-01f, 8.985326439e-02f, 5.057485774e-02f, 2.844863199e-02f, 1.599931903e-02f, 8.997339755e-03f, 5.059622694e-03f, 2.845243318e-03f, -9.613974690e-01f, -1.346151382e-01f, -7.878518701e-01f, 1.182405204e-01f, 9.916648269e-01f, 8.168795705e-01f, 5.120649934e-01f, 2.977238595e-01f, 1.691823453e-01f, 9.545248002e-02f, 5.373282731e-02f, 3.022614494e-02f, 1.699918136e-02f, 9.559656493e-03f, 5.375845823e-03f, 3.023070283e-03f, -7.509872317e-01f, -6.422007084e-01f, -5.572628975e-01f, -5.927551910e-02f, 9.738476276e-01f, 8.480075598e-01f, 5.389667153e-01f, 3.146522641e-01f, 1.790295690e-01f, 1.010486856e-01f, 5.689026415e-02f, 3.200356290e-02f, 1.799902879e-02f, 1.012197044e-02f, 5.692068953e-03f, 3.200897481e-03f, 1.498772055e-01f, -9.520008564e-01f, -2.714101076e-01f, -2.349217981e-01f, 9.463000894e-01f, 8.764545321e-01f, 5.653295517e-01f, 3.314811885e-01f, 1.888588965e-01f, 1.066416800e-01f, 6.004713103e-02f, 3.378088027e-02f, 1.899885759e-02f, 1.068428159e-02f, 6.008291151e-03f, 3.378724447e-03f, 9.129452705e-01f, -9.686019421e-01f, 4.135828838e-02f, -4.031589925e-01f, 9.092974067e-01f, 9.021307230e-01f, 5.911270380e-01f, 3.482052684e-01f, 1.986693144e-01f, 1.122313142e-01f, 6.320339441e-02f, 3.555808961e-02f, 1.999866776e-02f, 1.124658901e-02f, 6.324512884e-03f, 3.556551412e-03f, 8.366556168e-01f, -6.868911982e-01f, 3.500247598e-01f, -5.586805344e-01f, 8.632093072e-01f, 9.249548316e-01f, 6.163335443e-01f, 3.648192585e-01f, 2.084598988e-01f, 1.178173944e-01f, 6.635902822e-02f, 3.733518720e-02f, 2.099845745e-02f, 1.180889271e-02f, 6.640734151e-03f, 3.734378144e-03f, -8.851309307e-03f, -1.936302334e-01f, 6.239799261e-01f, -6.965817213e-01f, 8.084963560e-01f, 9.448547959e-01f, 6.409237385e-01f, 3.813178837e-01f, 2.182296216e-01f, 1.233997419e-01f, 6.951400638e-02f, 3.911216930e-02f, 2.199822664e-02f, 1.237119269e-02f, 6.956954487e-03f, 3.912204877e-03f, -8.462204337e-01f, 3.592645228e-01f, 8.360552788e-01f, -8.125128746e-01f, 7.457052469e-01f, 9.617676139e-01f, 6.648730636e-01f, 3.976959288e-01f, 2.279775143e-01f, 1.289781928e-01f, 7.266827673e-02f, 4.088902473e-02f, 2.299797349e-02f, 1.293348987e-02f, 7.273174357e-03f, 4.090031609e-03f, -9.055783749e-01f, 8.015131354e-01f, 9.652192593e-01f, -9.028177857e-01f, 6.754631400e-01f, 9.756398797e-01f, 6.881574988e-01f, 4.139482081e-01f, 2.377026230e-01f, 1.345525682e-01f, 7.582182437e-02f, 4.266574979e-02f, 2.399769612e-02f, 1.349578146e-02f, 7.589393295e-03f, 4.267857410e-03f, -1.323517561e-01f, 9.969099760e-01f, 9.986631870e-01f, -9.646483064e-01f, 5.984721184e-01f, 9.864277244e-01f, 7.107539177e-01f, 4.300695956e-01f, 2.474039644e-01f, 1.401226968e-01f, 7.897461206e-02f, 4.444234073e-02f, 2.499739639e-02f, 1.405806933e-02f, 7.905611768e-03f, 4.445684142e-03f, 7.625584602e-01f, 8.852767944e-01f, 9.330701828e-01f, -9.960543513e-01f, 5.155012608e-01f, 9.940969944e-01f, 7.326396108e-01f, 4.460549951e-01f, 2.570805550e-01f, 1.456883848e-01f, 8.212661743e-02f, 4.621879384e-02f, 2.599707060e-02f, 1.462035347e-02f, 8.221829310e-03f, 4.623509943e-03f, 9.563759565e-01f, 5.009942055e-01f, 7.749450207e-01f, -9.960451722e-01f, 4.273798466e-01f, 9.986234903e-01f, 7.537927032e-01f, 4.618993104e-01f, 2.667314112e-01f, 1.512494683e-01f, 8.527779579e-02f, 4.799510166e-02f, 2.699672058e-02f, 1.518263202e-02f, 8.538045920e-03f, 4.801335745e-03f, 2.709057927e-01f, -3.758566082e-02f, 5.399689674e-01f, -9.646213055e-01f, 3.349882066e-01f, 9.999929070e-01f, 7.741920948e-01f, 4.775975943e-01f, 2.763556540e-01f, 1.568057537e-01f, 8.842811733e-02f, 4.977125302e-02f, 2.799634263e-02f, 1.574490592e-02f, 8.854261599e-03f, 4.979162011e-03f, -6.636338830e-01f, -5.645897985e-01f, 2.514453232e-01f, -9.027736783e-01f, 2.392492294e-01f, 9.982009530e-01f, 7.938174009e-01f, 4.931448400e-01f, 2.859522104e-01f, 1.623570919e-01f, 9.157756716e-02f, 5.154724792e-02f, 2.899593674e-02f, 1.630717516e-02f, 9.170476347e-03f, 5.156987347e-03f, -9.880316257e-01f, -9.177096486e-01f, -6.201484054e-02f, -8.124528527e-01f, 1.411200017e-01f, 9.932531714e-01f, 8.126488924e-01f, 5.085361004e-01f, 2.955201864e-01f, 1.679033041e-01f, 9.472609311e-02f, 5.332308263e-02f, 2.999550104e-02f, 1.686943881e-02f, 9.486690164e-03f, 5.334813148e-03f, -4.040376544e-01f, -9.881927967e-01f, -3.693250120e-01f, -6.965078115e-01f, 4.158052057e-02f, 9.851652980e-01f, 8.306677938e-01f, 5.237666368e-01f, 3.050586283e-01f, 1.734442115e-01f, 9.787366539e-02f, 5.509874597e-02f, 3.099503554e-02f, 1.743169688e-02f, 9.802903049e-03f, 5.512638018e-03f, 5.514267087e-01f, -7.543302178e-01f, -6.400094032e-01f, -5.585952997e-01f, -5.837419257e-02f, 9.739628434e-01f, 8.478561044e-01f, 5.388315320e-01f, 3.145665526e-01f, 1.789796203e-01f, 1.010202691e-01f, 5.687423423e-02f, 3.199454024e-02f, 1.799395122e-02f, 1.011911593e-02f, 5.690463353e-03f, 9.999118447e-01f, -2.881473899e-01f, -8.472243547e-01f, -4.030649364e-01f, -1.577456445e-01f, 9.596813321e-01f, 8.641966581e-01f, 5.537260175e-01f, 3.240430057e-01f, 1.845093668e-01f, 1.041658595e-01f, 5.864954367e-02f, 3.299400955e-02f, 1.855619811e-02f, 1.043532696e-02f, 5.868288688e-03f, 5.290827155e-01f, 2.667797208e-01f, -9.704204202e-01f, -2.348221242e-01f, -2.555412054e-01f, 9.423658252e-01f, 8.796730638e-01f, 5.684453845e-01f, 3.334870934e-01f, 1.900332868e-01f, 1.073104069e-01f, 6.042466685e-02f, 3.399345279e-02f, 1.911843941e-02f, 1.075153705e-02f, 6.046113092e-03f, -4.281826615e-01f, 7.395421267e-01f, -9.973804355e-01f, -5.917267874e-02f, -3.507832289e-01f, 9.220710397e-01f, 8.942698836e-01f, 5.829849839e-01f, 3.428978026e-01f, 1.955512017e-01f, 1.104538813e-01f, 6.219960377e-02f, 3.499285504e-02f, 1.968067512e-02f, 1.106774528e-02f, 6.223937962e-03f, -9.917788506e-01f, 9.845405817e-01f, -9.254310131e-01f, 1.183425859e-01f, -4.425205588e-01f, 8.988611698e-01f, 9.079725146e-01f, 5.973402858e-01f, 3.522742093e-01f, 2.010629177e-01f, 1.135962531e-01f, 6.397433579e-02f, 3.599222749e-02f, 2.024290524e-02f, 1.138395350e-02f, 6.401761901e-03f, -6.435381174e-01f, 9.263181090e-01f, -7.617069483e-01f, 2.921253741e-01f, -5.298361778e-01f, 8.728095889e-01f, 9.207672477e-01f, 6.115067005e-01f, 3.616154492e-01f, 2.065682709e-01f, 1.167374924e-01f, 6.574887782e-02f, 3.699155897e-02f, 2.080512606e-02f, 1.170015987e-02f, 6.579586305e-03f, 2.963685691e-01f, 5.828061700e-01f, -5.224447846e-01f, 4.566946924e-01f, -6.118578315e-01f, 8.439987302e-01f, 9.326412678e-01f, 6.254796982e-01f, 3.709204793e-01f, 2.120671123e-01f, 1.198775545e-01f, 6.752320379e-02f, 3.799085692e-02f, 2.136734314e-02f, 1.201636530e-02f, 6.757410709e-03f, 9.637953639e-01f, 5.980031565e-02f, -2.313720137e-01f, 6.068604589e-01f, -6.877662539e-01f, 8.125196099e-01f, 9.435827136e-01f, 6.392549276e-01f, 3.801884055e-01f, 2.175592482e-01f, 1.230164245e-01f, 6.929731369e-02f, 3.899011388e-02f, 2.192955278e-02f, 1.233256981e-02f, 6.935234182e-03f, 7.451131344e-01f, -4.816212952e-01f, 8.264580369e-02f, 7.378857136e-01f, -7.568024993e-01f, 7.784717083e-01f, 9.535806775e-01f, 6.528279781e-01f, 3.894183338e-01f, 2.230444849e-01f, 1.261540651e-01f, 7.107120752e-02f, 3.998933733e-02f, 2.249175683e-02f, 1.264877338e-02f, 7.113057654e-03f, -1.586226672e-01f, -8.747140169e-01f, 3.884676993e-01f, 8.456384540e-01f, -8.182770610e-01f, 7.419627905e-01f, 9.626252055e-01f, 6.661946774e-01f, 3.986093104e-01f, 2.285226882e-01f, 1.292904317e-01f, 7.284487784e-02f, 4.098851606e-02f, 2.305394970e-02f, 1.296497509e-02f, 7.290880661e-03f, -9.165215492e-01f, -9.984104633e-01f, 6.557646990e-01f, 9.267202020e-01f, -8.715758920e-01f, 7.031081319e-01f, 9.707071185e-01f, 6.793506742e-01f, 4.077604413e-01f, 2.339936644e-01f, 1.324255317e-01f, 7.461831719e-02f, 4.198765755e-02f, 2.361613885e-02f, 1.328117587e-02f, 7.468704134e-03f, -8.317747712e-01f, -8.146142364e-01f, 8.580306768e-01f, 9.785736203e-01f, -9.161660075e-01f, 6.620306373e-01f, 9.778184295e-01f, 6.922917962e-01f, 4.168707728e-01f, 2.394572198e-01f, 1.355592906e-01f, 7.639151812e-02f, 4.298675060e-02f, 2.417832054e-02f, 1.359737478e-02f, 7.646527141e-03f, 1.770192571e-02f, -3.799313903e-01f, 9.752061963e-01f, 9.995633960e-01f, -9.516021013e-01f, 6.188601851e-01f, 9.839519858e-01f, 7.050140500e-01f, 4.259394705e-01f, 2.449132055e-01f, 1.386916935e-01f, 7.816448808e-02f, 4.398580641e-02f, 2.474049293e-02f, 1.391357277e-02f, 7.824349217e-03f, 8.509035110e-01f, 1.717635691e-01f, 9.956709743e-01f, 9.890272617e-01f, -9.775301218e-01f, 5.737332702e-01f, 9.891016483e-01f, 7.175133228e-01f, 4.349655211e-01f, 2.503614724e-01f, 1.418227106e-01f, 7.993719727e-02f, 4.498481750e-02f, 2.530265786e-02f, 1.422976889e-02f, 8.002171293e-03f, 9.017883539e-01f, 6.705570221e-01f, 9.173954725e-01f, 9.472977519e-01f, -9.936909676e-01f, 5.267925262e-01f, 9.932623506e-01f, 7.297857404e-01f, 4.439480901e-01f, 2.558017969e-01f, 1.449523121e-01f, 8.170966059e-02f, 4.598378390e-02f, 2.586481534e-02f, 1.454596408e-02f, 8.179994300e-03f, 1.235731244e-01f, 9.628326893e-01f, 7.481423616e-01f, 8.756909966e-01f, -9.999232888e-01f, 4.781863391e-01f, 9.964298010e-01f, 7.418274283e-01f, 4.528862834e-01f, 2.612340748e-01f, 1.480804533e-01f, 8.348185569e-02f, 4.698270187e-02f, 2.642696351e-02f, 1.486215740e-02f, 8.357816376e-03f, -7.682546377e-01f, 9.585731030e-01f, 5.046970844e-01f, 7.764653563e-01f, -9.961646199e-01f, 4.280683994e-01f, 9.986009598e-01f, 7.536345124e-01f, 4.617791772e-01f, 2.666580379e-01f, 1.512071192e-01f, 8.525379747e-02f, 4.798157141e-02f, 2.698910423e-02f, 1.517834887e-02f, 8.535637520e-03f, -9.537526369e-01f, 6.590901017e-01f, 2.112006545e-01f, 6.527503729e-01f, -9.824525714e-01f, 3.765971363e-01f, 9.997735620e-01f, 7.652031779e-01f, 4.706258774e-01f, 2.720735669e-01f, 1.543322802e-01f, 8.702547103e-02f, 4.898039624e-02f, 2.755123749e-02f, 1.549453940e-02f, 8.713459596e-03f, -2.623748481e-01f, 1.566190720e-01f, -1.032404602e-01f, 5.084479451e-01f, -9.589242935e-01f, 3.239352703e-01f, 9.999465346e-01f, 7.765299678e-01f, 4.794255495e-01f, 2.774805427e-01f, 1.574558914e-01f, 8.879686147e-02f, 4.997916892e-02f, 2.811335959e-02f, 1.581072807e-02f, 8.891279809e-03f, 6.702291965e-01f, -3.940860629e-01f, -4.074441493e-01f, 3.481085002e-01f, -9.258147478e-01f, 2.702493370e-01f, 9.991195798e-01f, 7.876111865e-01f, 4.881772399e-01f, 2.828786969e-01f, 1.605779380e-01f, 9.056797624e-02f, 5.097789690e-02f, 2.867547423e-02f, 1.612691768e-02f, 9.069100954e-03f, 9.866275787e-01f, -8.234215975e-01f, -6.712401509e-01f, 1.767906845e-01f, -8.834545016e-01f, 2.157090008e-01f, 9.972936511e-01f, 7.984433770e-01f, 4.968801141e-01f, 2.882679403e-01f, 1.636983752e-01f, 9.233880043e-02f, 5.197656900e-02f, 2.923758142e-02f, 1.644310169e-02f, 9.246920235e-03f, 3.959251642e-01f, -9.991579652e-01f, -8.684699535e-01f, -1.030206768e-04f, -8.322673440e-01f, 1.604867280e-01f, 9.944704771e-01f, 8.090230227e-01f, 5.055333376e-01f, 2.936480343e-01f, 1.668171734e-01f, 9.410934150e-02f, 5.297519267e-02f, 2.979967557e-02f, 1.675928757e-02f, 9.424741380e-03f, -5.587890744e-01f, -8.671715260e-01f, -9.795749187e-01f, -1.769934744e-01f, -7.727644444e-01f, 1.047568321e-01f, 9.906529188e-01f, 8.193469048e-01f, 5.141359568e-01f, 2.990188897e-01f, 1.699342877e-01f, 9.587957710e-02f, 5.397376046e-02f, 3.036176413e-02f, 1.707546785e-02f, 9.602561593e-03f, -9.997551441e-01f, -4.681116641e-01f, -9.935355186e-01f, -3.483016491e-01f, -7.055402994e-01f, 4.869600013e-02f, 9.858447909e-01f, 8.294116855e-01f, 5.226872563e-01f, 3.043802381e-01f, 1.730497181e-01f, 9.764950722e-02f, 5.497227982e-02f, 3.092384152e-02f, 1.739165001e-02f, 9.780380875e-03f, -5.215510130e-01f, 7.511820644e-02f, -9.089674354e-01f, -5.086245537e-01f, -6.312667131e-01f, -7.518785074e-03f, 9.800508618e-01f, 8.392141461e-01f, 5.311862230e-01f, 3.097319603e-01f, 1.761634201e-01f, 9.941913933e-02f, 5.597073585e-02f, 3.148590773e-02f, 1.770782843e-02f, 9.958200157e-03f, 4.361647666e-01f, 5.952115059e-01f, -7.342582941e-01f, -6.529057026e-01f, -5.506852865e-01f, -6.370979548e-02f, 9.732769728e-01f, 8.487512469e-01f, 5.396320224e-01f, 3.150739372e-01f, 1.792753637e-01f, 1.011884511e-01f, 5.696914345e-02f, 3.204796836e-02f, 1.802400686e-02f, 1.013601944e-02f, 9.928726554e-01f, 9.319928288e-01f, -4.867334962e-01f, -7.765945792e-01f, -4.646020234e-01f, -1.196993962e-01f, 9.655299187e-01f, 8.580200076e-01f, 5.480239391e-01f, 3.204059005e-01f, 1.823855042e-01f, 1.029574350e-01f, 5.796748772e-02f, 3.261001408e-02f, 1.834018156e-02f, 1.031383779e-02f, 6.367380023e-01f, 9.817358255e-01f, -1.909380108e-01f, -8.757900000e-01f, -3.738765717e-01f, -1.753105819e-01f, 9.568174481e-01f, 8.670173883e-01f, 5.563610196e-01f, 3.257277906e-01f, 1.854938269e-01f, 1.047261059e-01f, 5.896577984e-02f, 3.317204863e-02f, 1.865635626e-02f, 1.049165614e-02f, -3.048106134e-01f, 7.291237116e-01f, 1.237909496e-01f, -9.473637342e-01f, -2.794154882e-01f, -2.303675115e-01f, 9.471482038e-01f, 8.757405281e-01f, 5.646424294e-01f, 3.310393095e-01f, 1.886002868e-01f, 1.064944416e-01f, 5.996400863e-02f, 3.373407945e-02f, 1.897252724e-02f, 1.066947449e-02f, -9.661177993e-01f, 2.519522607e-01f, 4.262454212e-01f, -9.890577197e-01f, -1.821625978e-01f, -2.846961617e-01f, 9.365318418e-01f, 8.841868639e-01f, 5.728674531e-01f, 3.363404274e-01f, 1.917048544e-01f, 1.082624346e-01f, 6.096218154e-02f, 3.429609165e-02f, 1.928869821e-02f, 1.084729191e-02f, -7.391806841e-01f, -3.028128743e-01f, 6.864276528e-01f, -9.995572567e-01f, -8.308912069e-02f, -3.381247520e-01f, 9.249790907e-01f, 8.923535347e-01f, 5.810351372e-01f, 3.416308761e-01f, 1.948075294e-01f, 1.100300923e-01f, 6.196028739e-02f, 3.485809639e-02f, 1.960486546e-02f, 1.102510840e-02f, 1.673557013e-01f, -7.643200755e-01f, 8.785385489e-01f, -9.785313010e-01f, 1.681409031e-02f, -3.904843926e-01f, 9.125014544e-01f, 9.002380967e-01f, 5.891447663e-01f, 3.469105363e-01f, 1.979082376e-01f, 1.117973924e-01f, 6.295833737e-02f, 3.542009369e-02f, 1.992103085e-02f, 1.120292582e-02f };

#define LAS __attribute__((address_space(3)))
typedef unsigned short bf16;
typedef float f32x4 __attribute__((ext_vector_type(4)));
typedef float f32x2 __attribute__((ext_vector_type(2)));
typedef float f32x16 __attribute__((ext_vector_type(16)));
typedef short bf16x8 __attribute__((ext_vector_type(8)));
typedef short s16x4 __attribute__((ext_vector_type(4)));
typedef unsigned u32x4 __attribute__((ext_vector_type(4)));
typedef unsigned u32x2 __attribute__((ext_vector_type(2)));

constexpr int DM = 2048, NB = 8, SEQ = 2048, CTX = 256, DEPTH = 2;
constexpr int NLAT = NB * SEQ, NCTX = NB * CTX, NROW = NLAT + NCTX;
constexpr int INC = 5888, NEXP = 16, EFF = 1024, ADAW = 6 * DM;
constexpr int ZC_RQ = 0, ZC_RK = 512, ZC_RV = 1024, ZC_RG = 1536, ZC_CB = 2048, ZC_CC = 2560, ZC_CH = 3072, ZC_SQ = 3584, ZC_SK = 4096, ZC_SV = 4224, ZC_NQ = 4352, ZC_NK = 4864, ZC_NV = 5376;
constexpr int YC_RET = 0, YC_CONV = 512, YC_SWA = 1024, YC_NA = 1536;
constexpr float LOG2E = 1.4426950408889634f;
constexpr float RMS_EPS = 1e-6f;
constexpr int NWAVES = 8, NTHR = 512;

constexpr size_t MiB = (size_t)1 << 20;
constexpr size_t WS_CTL = 0, CTL_ZERO_BYTES = 1 * MiB;
constexpr size_t WS_ADA = 1 * MiB;
constexpr size_t WS_AFF = 2 * MiB;
constexpr size_t WS_SEL = 4 * MiB;
constexpr size_t WS_IDX = 6 * MiB;
constexpr size_t WS_GATEV = 6 * MiB + 256 * 1024;
constexpr size_t WS_WIN = 8 * MiB;
constexpr size_t WS_WOUT = 54 * MiB;
constexpr size_t WS_WGU = 70 * MiB;
constexpr size_t WS_WD = 326 * MiB;
constexpr size_t WS_XC = 454 * MiB;
constexpr size_t WS_HB = 470 * MiB;
constexpr size_t WS_Z = 542 * MiB;
constexpr size_t WS_ACT = 749 * MiB;
constexpr size_t WS_SST = 821 * MiB;
constexpr size_t WS_SIN = 857 * MiB;
constexpr size_t WS_XB = 876 * MiB;
constexpr size_t WS_END = 948 * MiB;
constexpr int CW_BAR = 4096;

constexpr int LDS_BYTES = 147456;
constexpr int MISC_OFF = 131072 + 320;
constexpr int ROPE_LDS = 131072 + 8192;

struct Params {
    const float* x; const float* c; const float* ctx; const float* c_ctx; const float* w_ada; const float* b_ada; const float* norm_mix; const float* norm_ffn;
    const float* w_in; const float* w_out; const float* dec_f; const float* dec_b; const float* conv_w; const float* sink; const float* rpb; const float* w_router;
    const float* w_gate; const float* w_up; const float* w_down; const float* norm_final;
    float* out; unsigned char* ws;
};

__device__ __forceinline__ float bf2f(unsigned v) { return __uint_as_float(v << 16); }
__device__ __forceinline__ unsigned f2bf(float f) { unsigned u = __float_as_uint(f); return (u + 0x7fffu + ((u >> 16) & 1u)) >> 16; }
__device__ __forceinline__ unsigned pk2(float lo, float hi) { unsigned r; asm volatile("v_cvt_pk_bf16_f32 %0, %1, %2" : "=v"(r) : "v"(lo), "v"(hi)); return r; }
__device__ __forceinline__ float ex2(float x) { return __builtin_amdgcn_exp2f(x); }
__device__ __forceinline__ float wave_sum(float v) {
#pragma unroll
    for (int o = 1; o < 64; o <<= 1) v += __shfl_xor(v, o);
    return v;
}
__device__ __forceinline__ float half_sum32(float v) {
#pragma unroll
    for (int o = 1; o < 32; o <<= 1) v += __shfl_xor(v, o);
    return v;
}
__device__ __forceinline__ float silu_f(float x) { return x / (1.f + __expf(-x)); }
__device__ __forceinline__ int crow(int r, int hi) { return (r & 3) + 8 * (r >> 2) + 4 * hi; }
#define MFMA32(a, b, c) __builtin_amdgcn_mfma_f32_32x32x16_bf16((a), (b), (c), 0, 0, 0)
#define LDS_WAIT() asm volatile("s_waitcnt lgkmcnt(0)" ::: "memory")
typedef short v4i16_t __attribute__((ext_vector_type(4)));
__device__ __forceinline__ s16x4 trrd(LAS const unsigned char* p) { return __builtin_bit_cast(s16x4, __builtin_amdgcn_ds_read_tr16_b64_v4i16((LAS v4i16_t*)p)); }
__device__ __forceinline__ bf16x8 cat8(s16x4 lo, s16x4 hi) { return (bf16x8){lo[0], lo[1], lo[2], lo[3], hi[0], hi[1], hi[2], hi[3]}; }
__device__ __forceinline__ u32x4 scale8(u32x4 v, float s) {
    u32x4 r;
#pragma unroll
    for (int i = 0; i < 4; ++i) r[i] = pk2(bf2f(v[i] & 0xffffu) * s, __uint_as_float(v[i] & 0xffff0000u) * s);
    return r;
}

__device__ __forceinline__ float* ws_ada(const Params& p) { return (float*)(p.ws + WS_ADA); }
__device__ __forceinline__ bf16* ws_z(const Params& p) { return (bf16*)(p.ws + WS_Z); }
__device__ __forceinline__ bf16* ws_hb(const Params& p) { return (bf16*)(p.ws + WS_HB); }
constexpr int KVH_ROWS = SEQ + CTX;
__device__ __forceinline__ bf16* ws_kvh(const Params& p) { return (bf16*)(p.ws + WS_ACT); }
__device__ __forceinline__ size_t kvh_off(int kind, int b, int h) { return (size_t)((kind * NB + b) * 8 + h) * KVH_ROWS * 64; }
__device__ __forceinline__ bf16* ws_xb(const Params& p) { return (bf16*)(p.ws + WS_XB); }

namespace pg8 {
struct GroupedOrder {
    StaticOrder S; int tpe;
    __device__ void init(int tpe_, int G_, int c_) { tpe = tpe_; S.init(16 * tpe_ * BM, 8 * BM, G_, c_); }
    __device__ bool next(int i, Unit& u) const { if (!S.next(i, u)) return false; u.pb = (u.pm / tpe) * 8 + u.pn; return true; }
    __device__ __forceinline__ void a_ready(const Unit&) const {}
    __device__ __forceinline__ void done(const Unit&) const {}
};
struct SkipOrder {
    StaticOrder S; int G, c;
    __device__ void init(int G_, int c_) { S.init(16384, 5888, G_, c_); G = G_; c = c_; }
    __device__ bool next(int i, Unit& u) const {
        if (S.next(i, u)) return true;
        const int j = i * G + c - 64 * 23; if (j < 0 || j >= 64) return false;
        const int t = j >> 3; u.pm = 64 + (j & 7); u.pn = t < 4 ? 2 + t : (t == 4 ? 16 : 14 + t); u.pb = u.pn; return true;
    }
    __device__ __forceinline__ void a_ready(const Unit&) const {}
    __device__ __forceinline__ void done(const Unit&) const {}
};
struct QuadOrder {
    int G, c;
    __device__ void init(int G_, int c_) { G = G_; c = c_; }
    __device__ bool next(int i, Unit& u) const {
        const int x = i * G + c; if (x >= 32) return false;
        u.pm = 64 + (x >> 2); u.pn = 22; u.pb = 22; u.q = x & 3; return true;
    }
    __device__ __forceinline__ void a_ready(const Unit&) const {}
    __device__ __forceinline__ void done(const Unit&) const {}
};
template <bool BASE_F32> struct EpiResGate {
    static constexpr bool PERM = true, AFTER_DRAIN = false;
    const float* base_lat; const float* base_ctx; bf16_t* xb; const float* ada; int goff;
    __device__ __forceinline__ void operator()(const f32x4 (&acc)[2][2][4][2], const Unit& u, int wr, int wc, int fr, int fq) const {
        const bool isctx = u.pm >= 64;
        const int grow = isctx ? 8 : (u.pm >> 3);
        const float* g = ada + grow * 12288 + goff;
        const float* basef = isctx ? base_ctx - (size_t)64 * BM * 2048 : base_lat;
        const int row0 = u.pm * BM + wr * 64 + fr, col0 = u.pn * BM + wc * 32 + 8 * fq;
        f32x4 gv[2][2];
#pragma unroll
        for (int bj = 0; bj < 2; ++bj)
#pragma unroll
            for (int n = 0; n < 2; ++n) gv[bj][n] = *(const f32x4*)(g + col0 + bj * HALF + 4 * n);
#pragma unroll
        for (int ai = 0; ai < 2; ++ai)
#pragma unroll
            for (int m = 0; m < 4; ++m) { const size_t off = (size_t)(row0 + ai * HALF + m * 16) * 2048 + col0;
#pragma unroll
                for (int bj = 0; bj < 2; ++bj) { f32x4 b0, b1;
                    if constexpr (BASE_F32) { b0 = *(const f32x4*)(basef + off + bj * HALF); b1 = *(const f32x4*)(basef + off + bj * HALF + 4); }
                    else { const u32x4 w = *(const u32x4*)(xb + off + bj * HALF);
                        b0 = (f32x4){__uint_as_float(w.x << 16), __uint_as_float(w.x & 0xffff0000u), __uint_as_float(w.y << 16), __uint_as_float(w.y & 0xffff0000u)};
                        b1 = (f32x4){__uint_as_float(w.z << 16), __uint_as_float(w.z & 0xffff0000u), __uint_as_float(w.w << 16), __uint_as_float(w.w & 0xffff0000u)}; }
                    const f32x4 v0 = b0 + gv[bj][0] * acc[ai][bj][m][0], v1 = b1 + gv[bj][1] * acc[ai][bj][m][1];
                    u32x4 o; o.x = cvt_pk_bf16(v0[0], v0[1]); o.y = cvt_pk_bf16(v0[2], v0[3]); o.z = cvt_pk_bf16(v1[0], v1[1]); o.w = cvt_pk_bf16(v1[2], v1[3]);
                    *(u32x4*)(xb + off + bj * HALF) = o; }
                asm volatile("" ::: "memory"); }
    }
};
struct EpiSiluMul {
    static constexpr bool PERM = true, AFTER_DRAIN = false;
    bf16_t* O;
    __device__ __forceinline__ void operator()(const f32x4 (&acc)[2][2][4][2], const Unit& u, int wr, int wc, int fr, int fq) const {
        const int row0 = u.pm * BM + wr * 64 + fr, col0 = u.pn * HALF + wc * 32 + 8 * fq;
#pragma unroll
        for (int ai = 0; ai < 2; ++ai)
#pragma unroll
            for (int m = 0; m < 4; ++m) { bf16_t* rowp = O + (size_t)(row0 + ai * HALF + m * 16) * 1024 + col0;
                float v[8];
#pragma unroll
                for (int n = 0; n < 2; ++n)
#pragma unroll
                    for (int j = 0; j < 4; ++j) { const float gg = acc[ai][0][m][n][j], uu = acc[ai][1][m][n][j]; v[n * 4 + j] = gg * __builtin_amdgcn_rcpf(1.f + __builtin_amdgcn_exp2f(-gg * 1.4426950408889634f)) * uu; }
                u32x4 w; w.x = cvt_pk_bf16(v[0], v[1]); w.y = cvt_pk_bf16(v[2], v[3]); w.z = cvt_pk_bf16(v[4], v[5]); w.w = cvt_pk_bf16(v[6], v[7]);
                *(u32x4*)rowp = w; }
    }
};
struct EpiDown {
    static constexpr bool PERM = true, AFTER_DRAIN = false;
    bf16_t* O; const float* gatev;
    __device__ __forceinline__ void operator()(const f32x4 (&acc)[2][2][4][2], const Unit& u, int wr, int wc, int fr, int fq) const {
        const int row0 = u.pm * BM + wr * 64 + fr, col0 = u.pn * BM + wc * 32 + 8 * fq;
        float sg[2][4];
#pragma unroll
        for (int ai = 0; ai < 2; ++ai)
#pragma unroll
            for (int m = 0; m < 4; ++m) sg[ai][m] = gatev[row0 + ai * HALF + m * 16];
#pragma unroll
        for (int ai = 0; ai < 2; ++ai)
#pragma unroll
            for (int m = 0; m < 4; ++m) { const int row = row0 + ai * HALF + m * 16; const float s = sg[ai][m]; bf16_t* rowp = O + (size_t)row * 2048 + col0;
#pragma unroll
                for (int bj = 0; bj < 2; ++bj) { const f32x4 v0 = acc[ai][bj][m][0] * s, v1 = acc[ai][bj][m][1] * s;
                    u32x4 w; w.x = cvt_pk_bf16(v0[0], v0[1]); w.y = cvt_pk_bf16(v0[2], v0[3]); w.z = cvt_pk_bf16(v1[0], v1[1]); w.w = cvt_pk_bf16(v1[2], v1[3]);
                    *(u32x4*)(rowp + bj * HALF) = w; } }
    }
};
struct EpiZRope {
    static constexpr bool PERM = true, AFTER_DRAIN = false;
    bf16_t* O; LAS const float* rcos; LAS const float* rsin; bf16_t* KV;
    __device__ __forceinline__ void quad(const f32x4 (&a)[4][2], const Unit& u, int wr, int wc, int fr, int fq) const {
        const int ai = u.q >> 1, bj = u.q & 1, tile = u.pn;
        const int b = (u.pm < 64) ? (u.pm >> 3) : (u.pm - 64), rloc0 = ((u.pm < 64) ? (u.pm & 7) * 256 : 2048) + wr * 64 + fr + ai * HALF;
        const int c = (tile - 19) * BM + wc * 32 + 8 * fq + bj * HALF;
        bf16_t* hp = KV + ((size_t)(((c >> 9) * 8 + b) * 8 + ((c >> 6) & 7)) * 2304 + rloc0) * 64 + (c & 63);
#pragma unroll
        for (int m = 0; m < 4; ++m) { const f32x4 v0 = a[m][0], v1 = a[m][1];
            u32x4 w; w.x = cvt_pk_bf16(v0[0], v0[1]); w.y = cvt_pk_bf16(v0[2], v0[3]); w.z = cvt_pk_bf16(v1[0], v1[1]); w.w = cvt_pk_bf16(v1[2], v1[3]);
            *(u32x4*)(hp + (m * 16) * 64) = w; }
    }
    __device__ __forceinline__ void operator()(const f32x4 (&acc)[2][2][4][2], const Unit& u, int wr, int wc, int fr, int fq) const {
        const int row0 = u.pm * BM + wr * 64 + fr, tile = u.pn;
        const bool rtile = (tile < 4) || (tile >= 14 && tile <= 16);
        if (tile >= 19) {
            const int b = (u.pm < 64) ? (u.pm >> 3) : (u.pm - 64), rloc0 = ((u.pm < 64) ? (u.pm & 7) * 256 : 2048) + wr * 64 + fr;
#pragma unroll
            for (int bj = 0; bj < 2; ++bj) { const int c = (tile - 19) * BM + wc * 32 + 8 * fq + bj * HALF;
                bf16_t* hp = KV + ((size_t)(((c >> 9) * 8 + b) * 8 + ((c >> 6) & 7)) * 2304 + rloc0) * 64 + (c & 63);
#pragma unroll
                for (int ai = 0; ai < 2; ++ai) {
#pragma unroll
                    for (int m = 0; m < 4; ++m) { const f32x4 v0 = acc[ai][bj][m][0], v1 = acc[ai][bj][m][1];
                        u32x4 w; w.x = cvt_pk_bf16(v0[0], v0[1]); w.y = cvt_pk_bf16(v0[2], v0[3]); w.z = cvt_pk_bf16(v1[0], v1[1]); w.w = cvt_pk_bf16(v1[2], v1[3]);
                        *(u32x4*)(hp + (ai * HALF + m * 16) * 64) = w; } } }
            return;
        }
        if (!rtile) {
            const int col0 = tile * BM + wc * 32 + 8 * fq;
#pragma unroll
            for (int ai = 0; ai < 2; ++ai)
#pragma unroll
                for (int m = 0; m < 4; ++m) { bf16_t* rowp = O + (size_t)(row0 + ai * HALF + m * 16) * 5888 + col0;
#pragma unroll
                    for (int bj = 0; bj < 2; ++bj) { const f32x4 v0 = acc[ai][bj][m][0], v1 = acc[ai][bj][m][1];
                        u32x4 w; w.x = cvt_pk_bf16(v0[0], v0[1]); w.y = cvt_pk_bf16(v0[2], v0[3]); w.z = cvt_pk_bf16(v1[0], v1[1]); w.w = cvt_pk_bf16(v1[2], v1[3]);
                        *(u32x4*)(rowp + bj * HALF) = w; } }
            return;
        }
        const bool pass = (tile == 16) && (wc >= 2);
        const int c1 = pass ? 4224 + (wc - 2) * 32 : tile * BM + wc * 64, c2 = pass ? c1 + 64 : c1 + 32;
        const bool rope = !pass && (u.pm < 64);
#pragma unroll
        for (int ai = 0; ai < 2; ++ai)
#pragma unroll
            for (int m = 0; m < 4; ++m) { const int row = row0 + ai * HALF + m * 16; bf16_t* rowp = O + (size_t)row * 5888 + 8 * fq;
                f32x4 a0 = acc[ai][0][m][0], a1 = acc[ai][0][m][1], b0 = acc[ai][1][m][0], b1 = acc[ai][1][m][1];
                if (rope) { const int t = row & 2047, pos = (fq < 2) ? (t >> 6) : (t & 63), ti = pos * 16 + 8 * (fq & 1);
                    const f32x4 cs0 = *(LAS const f32x4*)(rcos + ti), cs1 = *(LAS const f32x4*)(rcos + ti + 4), sn0 = *(LAS const f32x4*)(rsin + ti), sn1 = *(LAS const f32x4*)(rsin + ti + 4);
                    const f32x4 x0 = a0 * cs0 - b0 * sn0, x1 = a1 * cs1 - b1 * sn1, y0 = a0 * sn0 + b0 * cs0, y1 = a1 * sn1 + b1 * cs1;
                    a0 = x0; a1 = x1; b0 = y0; b1 = y1; }
                u32x4 w; w.x = cvt_pk_bf16(a0[0], a0[1]); w.y = cvt_pk_bf16(a0[2], a0[3]); w.z = cvt_pk_bf16(a1[0], a1[1]); w.w = cvt_pk_bf16(a1[2], a1[3]);
                *(u32x4*)(rowp + c1) = w;
                w.x = cvt_pk_bf16(b0[0], b0[1]); w.y = cvt_pk_bf16(b0[2], b0[3]); w.z = cvt_pk_bf16(b1[0], b1[1]); w.w = cvt_pk_bf16(b1[2], b1[3]);
                *(u32x4*)(rowp + c2) = w; }
    }
};
}

__device__ __forceinline__ void transpose_item(const float* W, int N, bf16* WT, int K, int k0, int n0, int drow0, LAS float* scr, int lane) {
#pragma unroll 8
    for (int i = 0; i < 32; ++i) { const int kk = 2 * i + (lane >> 5); scr[kk * 33 + (lane & 31)] = W[(size_t)(k0 + kk) * N + n0 + (lane & 31)]; }
    LDS_WAIT();
    const int c = lane & 7;
#pragma unroll
    for (int j = 0; j < 4; ++j) { const int n = (lane >> 3) + 8 * j; const LAS float* s = scr + (8 * c) * 33 + n;
        u32x4 o; o.x = pk2(s[0 * 33], s[1 * 33]); o.y = pk2(s[2 * 33], s[3 * 33]); o.z = pk2(s[4 * 33], s[5 * 33]); o.w = pk2(s[6 * 33], s[7 * 33]);
        *(u32x4*)(WT + (size_t)(drow0 + n) * K + k0 + 8 * c) = o; }
    LDS_WAIT();
}
__device__ __forceinline__ int win_dst_group(int sg) {
    const int tile = sg >> 3, r = sg & 7;
    if (tile < 4 || tile == 14 || tile == 15) return tile * 8 + (r & 1) * 4 + (r >> 1);
    if (tile == 16) return 128 + (r < 4 ? ((r & 1) * 4 + (r >> 1)) : (r < 6 ? r - 2 : r));
    return sg;
}
constexpr int I_IN = 32 * 184, I_OUT = 32 * 64, I_G = 16 * 32 * 32, I_D = 16 * 16 * 64, I_L = I_IN + I_OUT + 2 * I_G + I_D;

__device__ __forceinline__ void convert_item(const Params& p, int l, int r, LAS float* scr, int lane) {
    bf16* WIN = (bf16*)(p.ws + WS_WIN); bf16* WOUT = (bf16*)(p.ws + WS_WOUT); bf16* WGU = (bf16*)(p.ws + WS_WGU); bf16* WD = (bf16*)(p.ws + WS_WD);
    if (r < I_IN) { const int kb = r / 184, nb = r % 184; transpose_item(p.w_in + (size_t)l * 2048 * INC, INC, WIN + (size_t)l * INC * 2048, 2048, 64 * kb, 32 * nb, 32 * win_dst_group(nb), scr, lane); return; } r -= I_IN;
    if (r < I_OUT) { const int kb = r / 64, nb = r % 64; transpose_item(p.w_out + (size_t)l * 2048 * 2048, 2048, WOUT + (size_t)l * 2048 * 2048, 2048, 64 * kb, 32 * nb, 32 * nb, scr, lane); return; } r -= I_OUT;
    if (r < 2 * I_G) { const int isup = r >= I_G; if (isup) r -= I_G; const int e = r >> 10, rr = r & 1023, kb = rr >> 5, nb = rr & 31, n0 = 32 * nb;
        const float* W = (isup ? p.w_up : p.w_gate) + (size_t)(l * 16 + e) * 2048 * 1024;
        transpose_item(W, 1024, WGU + (size_t)(l * 16 + e) * 2048 * 2048, 2048, 64 * kb, n0, (n0 >> 7) * 256 + (n0 & 127) + (isup ? 128 : 0), scr, lane); return; } r -= 2 * I_G;
    { const int e = r >> 10, rr = r & 1023, kb = rr >> 6, nb = rr & 63;
      transpose_item(p.w_down + (size_t)(l * 16 + e) * 1024 * 2048, 2048, WD + (size_t)(l * 16 + e) * 2048 * 1024, 1024, 64 * kb, 32 * nb, 32 * nb, scr, lane); }
}
#ifndef TAIL_P2
#define TAIL_P2 0
#define TAIL_P6 (192 * 128)
#define TAIL_P9 0
#define TAIL_P10 0
#endif
constexpr int TAIL_OFF_P2 = 0, TAIL_OFF_P6 = TAIL_P2, TAIL_OFF_P9 = TAIL_P2 + TAIL_P6, TAIL_OFF_P10 = TAIL_P2 + TAIL_P6 + TAIL_P9, TAIL_ITEMS = TAIL_P2 + TAIL_P6 + TAIL_P9 + TAIL_P10;
static_assert(TAIL_ITEMS <= I_L, "tail items are layer-1 items");
__device__ __forceinline__ void ph_prologue(const Params& p, LAS unsigned char* lds) {
    const int tid = tid_opaque(), lane = tid & 63, wave = __builtin_amdgcn_readfirstlane(tid >> 6);
    const int G = gridDim.x;
    for (int u = blockIdx.x; u < 192; u += G) {
        const int l = u / 96, cg = u % 96;
        LAS float* s_sil = (LAS float*)lds; LAS float* s_red = (LAS float*)(lds + 73728);
        for (int i = tid; i < 9 * 2048; i += NTHR) { const int r = i >> 11, k = i & 2047; const float v = (r < 8) ? p.c[r * 2048 + k] : p.c_ctx[k]; s_sil[i] = silu_f(v); }
        __syncthreads();
        const float* W = p.w_ada + (size_t)l * 2048 * ADAW + cg * 128 + 2 * lane;
        float acc[9][2];
#pragma unroll
        for (int r = 0; r < 9; ++r) { acc[r][0] = 0.f; acc[r][1] = 0.f; }
        const int k0 = wave * 256;
        for (int kk = 0; kk < 256; kk += 8) {
            f32x2 w[8];
#pragma unroll
            for (int j = 0; j < 8; ++j) w[j] = *(const f32x2*)(W + (size_t)(k0 + kk + j) * ADAW);
#pragma unroll
            for (int r = 0; r < 9; ++r) {
                const f32x4 sa = *(LAS const f32x4*)(s_sil + r * 2048 + k0 + kk), sb = *(LAS const f32x4*)(s_sil + r * 2048 + k0 + kk + 4);
#pragma unroll
                for (int j = 0; j < 4; ++j) { acc[r][0] += sa[j] * w[j].x; acc[r][1] += sa[j] * w[j].y; acc[r][0] += sb[j] * w[4 + j].x; acc[r][1] += sb[j] * w[4 + j].y; }
            }
        }
#pragma unroll
        for (int r = 0; r < 9; ++r) { s_red[(wave * 9 + r) * 128 + 2 * lane] = acc[r][0]; s_red[(wave * 9 + r) * 128 + 2 * lane + 1] = acc[r][1]; }
        __syncthreads();
        for (int i = tid; i < 9 * 128; i += NTHR) { const int r = i >> 7, cc = i & 127; float s = p.b_ada[l * ADAW + cg * 128 + cc];
#pragma unroll
            for (int w = 0; w < 8; ++w) s += s_red[(w * 9 + r) * 128 + cc];
            ws_ada(p)[(size_t)(l * 9 + r) * ADAW + cg * 128 + cc] = s; }
        __syncthreads();
    }
    LAS float* scr = (LAS float*)(lds + wave * 8448);
    const int gw = blockIdx.x * NWAVES + wave, NGW = G * NWAVES;
    const int tail = (G == 256) ? TAIL_ITEMS : 0;
    for (int it = gw; it < 2 * I_L - tail; it += NGW) { const int g = it < I_L ? it : it + tail; convert_item(p, g / I_L, g % I_L, scr, lane); }
}
__device__ __forceinline__ void tail_convert(const Params& p, int off, int n, int rank, int nidle, LAS unsigned char* lds) {
    const int tid = tid_opaque(), lane = tid & 63, wave = __builtin_amdgcn_readfirstlane(tid >> 6);
    LAS float* scr = (LAS float*)(lds + wave * 8448);
    for (int it = rank * NWAVES + wave; it < n; it += nidle * NWAVES) convert_item(p, 1, off + it, scr, lane);
}

__device__ __forceinline__ void load_row8(f32x4 (&v)[8], const float* row, int lane) {
#pragma unroll
    for (int j = 0; j < 8; ++j) v[j] = *(const f32x4*)(row + 256 * j + 4 * lane);
}
__device__ __forceinline__ void load_row8_bf16(f32x4 (&v)[8], const bf16* row, int lane) {
#pragma unroll
    for (int j = 0; j < 8; ++j) { const u32x2 w = *(const u32x2*)(row + 256 * j + 4 * lane);
        v[j] = (f32x4){__uint_as_float(w.x << 16), __uint_as_float(w.x & 0xffff0000u), __uint_as_float(w.y << 16), __uint_as_float(w.y & 0xffff0000u)}; }
}
__device__ __forceinline__ float row_rstd(const f32x4 (&v)[8]) {
    float s = 0.f;
#pragma unroll
    for (int j = 0; j < 8; ++j) s += (v[j].x * v[j].x + v[j].y * v[j].y) + (v[j].z * v[j].z + v[j].w * v[j].w);
    return rsqrtf(wave_sum(s) * (1.f / 2048.f) + RMS_EPS);
}
__device__ __forceinline__ void modulate8(f32x4 (&v)[8], float rstd, const float* nw, const float* sc, const float* sh, int lane) {
#pragma unroll
    for (int j = 0; j < 8; ++j) { const int c = 256 * j + 4 * lane; const f32x4 w = *(const f32x4*)(nw + c), s1 = *(const f32x4*)(sc + c), s0 = *(const f32x4*)(sh + c);
        v[j] = v[j] * rstd * w * (1.f + s1) + s0; }
}
__device__ __forceinline__ void store_row8_bf16(const f32x4 (&v)[8], bf16* row, int lane) {
#pragma unroll
    for (int j = 0; j < 8; ++j) { u32x2 w; w.x = pk2(v[j].x, v[j].y); w.y = pk2(v[j].z, v[j].w); *(u32x2*)(row + 256 * j + 4 * lane) = w; }
}
__device__ __forceinline__ void load_coeffs(f32x4 (&wv)[8], f32x4 (&sv)[8], const float* nw, const float* sc, const float* sh, int lane) {
#pragma unroll
    for (int j = 0; j < 8; ++j) { const int c = 256 * j + 4 * lane; wv[j] = *(const f32x4*)(nw + c) * (1.f + *(const f32x4*)(sc + c)); sv[j] = *(const f32x4*)(sh + c); }
}
__device__ __forceinline__ void ph_modnorm0(const Params& p) {
    const int tid_ = tid_opaque(), lane = tid_ & 63, wave = __builtin_amdgcn_readfirstlane(tid_ >> 6);
    const int gw = blockIdx.x * NWAVES + wave, NGW = gridDim.x * NWAVES;
    const int rpw = (NROW + NGW - 1) / NGW, r0 = gw * rpw, r1 = (r0 + rpw < NROW) ? r0 + rpw : NROW;
    int cur = -1; f32x4 wv[8], sv[8], vn[8];
#define XROW0(r) (((r) < NLAT) ? p.x + (size_t)(r) * DM : p.ctx + (size_t)((r) - NLAT) * DM)
    if (r0 < r1) load_row8(vn, XROW0(r0), lane);
    for (int row = r0; row < r1; ++row) {
        f32x4 v[8];
#pragma unroll
        for (int j = 0; j < 8; ++j) v[j] = vn[j];
        if (row + 1 < r1) load_row8(vn, XROW0(row + 1), lane);
        const int arow = (row < NLAT) ? (row >> 11) : 8;
        if (arow != cur) { const float* ad = ws_ada(p) + (size_t)(0 * 9 + arow) * ADAW; load_coeffs(wv, sv, p.norm_mix, ad + 2048, ad, lane); cur = arow; }
        const float rstd = row_rstd(v);
#pragma unroll
        for (int j = 0; j < 8; ++j) v[j] = v[j] * rstd * wv[j] + sv[j];
        store_row8_bf16(v, ws_hb(p) + (size_t)row * DM, lane);
    }
#undef XROW0
}

namespace att {
__device__ __forceinline__ float xh_max(float v) { auto rr = __builtin_amdgcn_permlane32_swap(__float_as_uint(v), __float_as_uint(v), false, false); float a = __uint_as_float(rr[0]), b = __uint_as_float(rr[1]), r; asm("v_max_f32_e32 %0, %1, %2" : "=v"(r) : "v"(a), "v"(b)); return r; }
__device__ __forceinline__ float xh_sum(float v) { auto rr = __builtin_amdgcn_permlane32_swap(__float_as_uint(v), __float_as_uint(v), false, false); return __uint_as_float(rr[0]) + __uint_as_float(rr[1]); }
__device__ __forceinline__ float max3f(float a, float b, float c) { float r; asm("v_max3_f32 %0, %1, %2, %3" : "=v"(r) : "v"(a), "v"(b), "v"(c)); return r; }
constexpr int KB0 = 0, VB0 = 16384, SCR = 32768, RPB = 34816, BYTES = 36864;
struct TileRegs { u32x4 k, v; };
template <int PITCH = INC> __device__ __forceinline__ void tile_load(TileRegs& t, const bf16* kp, const bf16* vp, int tid) {
    const int key = tid >> 3, c = tid & 7;
    t.k = *(const u32x4*)(kp + (size_t)key * PITCH + c * 8);
    t.v = *(const u32x4*)(vp + (size_t)key * PITCH + c * 8);
}
__device__ __forceinline__ void tile_store(const TileRegs& t, LAS unsigned char* kb, LAS unsigned char* vb, int tid) {
    const int key = tid >> 3, c = tid & 7;
    *(LAS u32x4*)(kb + c * 1024 + key * 16) = t.k;
    *(LAS u32x4*)(vb + (c >> 2) * 4096 + (key >> 3) * 512 + (key & 7) * 64 + (c & 3) * 16) = t.v;
}
__device__ __forceinline__ void qk_tile(f32x16& p0, f32x16& p1, LAS const unsigned char* kbuf, const bf16x8 (&qr)[4], int r32, int hi) {
    LAS const unsigned char* kb = kbuf + hi * 1024 + r32 * 16;
    f32x16 z;
#pragma unroll
    for (int i = 0; i < 16; ++i) z[i] = 0.f;
    p0 = z; p1 = z;
#pragma unroll
    for (int d0 = 0; d0 < 4; ++d0) {
        const bf16x8 k0 = *(LAS const bf16x8*)(kb + d0 * 2048), k1 = *(LAS const bf16x8*)(kb + d0 * 2048 + 512);
        p0 = MFMA32(k0, qr[d0], p0); p1 = MFMA32(k1, qr[d0], p1);
    }
}
__device__ __forceinline__ void k_frags(bf16x8 (&kf)[8], LAS const unsigned char* kbuf, int r32, int hi) {
    LAS const unsigned char* kb = kbuf + hi * 1024 + r32 * 16;
#pragma unroll
    for (int d0 = 0; d0 < 4; ++d0) { kf[2 * d0] = *(LAS const bf16x8*)(kb + d0 * 2048); kf[2 * d0 + 1] = *(LAS const bf16x8*)(kb + d0 * 2048 + 512); }
}
__device__ __forceinline__ void qk_frags(f32x16& p0, f32x16& p1, const bf16x8 (&kf)[8], const bf16x8 (&qr)[4]) {
    f32x16 z;
#pragma unroll
    for (int i = 0; i < 16; ++i) z[i] = 0.f;
    p0 = z; p1 = z;
#pragma unroll
    for (int d0 = 0; d0 < 4; ++d0) { p0 = MFMA32(kf[2 * d0], qr[d0], p0); p1 = MFMA32(kf[2 * d0 + 1], qr[d0], p1); }
}
__device__ __forceinline__ void pv_tile(f32x16& o0, f32x16& o1, const f32x16& p0, const f32x16& p1, LAS const unsigned char* vl) {
    u32x4 pk[4];
#pragma unroll
    for (int i = 0; i < 4; ++i) { pk[0][i] = pk2(p0[2 * i], p0[2 * i + 1]); pk[1][i] = pk2(p0[8 + 2 * i], p0[9 + 2 * i]); pk[2][i] = pk2(p1[2 * i], p1[2 * i + 1]); pk[3][i] = pk2(p1[8 + 2 * i], p1[9 + 2 * i]); }
#pragma unroll
    for (int ks = 0; ks < 4; ++ks) {
        const bf16x8 a = __builtin_bit_cast(bf16x8, pk[ks]);
        const bf16x8 v0 = cat8(trrd(vl + ks * 1024), trrd(vl + ks * 1024 + 512));
        const bf16x8 v1 = cat8(trrd(vl + 4096 + ks * 1024), trrd(vl + 4096 + ks * 1024 + 512));
        o0 = MFMA32(v0, a, o0); o1 = MFMA32(v1, a, o1);
    }
}
__device__ __forceinline__ void softmax_pv(f32x16& p0, f32x16& p1, float& m, float& lsum, f32x16& o0, f32x16& o1, LAS float* scr, LAS const unsigned char* vl, int r32, int hi) {
    float mx = max3f(p0[0], p1[0], p0[1]), mx2 = max3f(p1[1], p0[2], p1[2]);
#pragma unroll
    for (int r = 3; r < 15; r += 2) { mx = max3f(mx, p0[r], p1[r]); mx2 = max3f(mx2, p0[r + 1], p1[r + 1]); }
    mx = xh_max(max3f(mx, mx2, max3f(p0[15], p1[15], p0[15])));
    if (__any(mx > m + 8.f)) {
        const float mnew = max3f(m, mx, mx), alpha = ex2(m - mnew);
        m = mnew; lsum *= alpha;
#pragma unroll
        for (int r = 0; r < 16; ++r) { o0[r] *= alpha; o1[r] *= alpha; }
    }
    float rs = 0.f;
#pragma unroll
    for (int r = 0; r < 16; ++r) { p0[r] = ex2(p0[r] - m); p1[r] = ex2(p1[r] - m); rs += p0[r] + p1[r]; }
    lsum += rs;
    pv_tile(o0, o1, p0, p1, vl);
}
__device__ __forceinline__ void qk_win(f32x16& p0, LAS const unsigned char* kwin, const bf16x8 (&qr)[4], int r32, int hi) {
    LAS const unsigned char* kb = kwin + hi * 1024 + r32 * 16;
#pragma unroll
    for (int i = 0; i < 16; ++i) p0[i] = 0.f;
#pragma unroll
    for (int d0 = 0; d0 < 4; ++d0) { const bf16x8 k0 = *(LAS const bf16x8*)(kb + d0 * 2048); p0 = MFMA32(k0, qr[d0], p0); }
}
__device__ __forceinline__ void softmax_pv_win(f32x16& p0, float& m, float& lsum, f32x16& o0, f32x16& o1, LAS const unsigned char* vwin) {
    float mx = max3f(p0[0], p0[1], p0[2]), mx2 = max3f(p0[3], p0[4], p0[5]);
#pragma unroll
    for (int r = 6; r < 14; r += 4) { mx = max3f(mx, p0[r], p0[r + 1]); mx2 = max3f(mx2, p0[r + 2], p0[r + 3]); }
    mx = xh_max(max3f(mx, mx2, max3f(p0[14], p0[15], p0[15])));
    if (__any(mx > m + 8.f)) {
        const float mnew = max3f(m, mx, mx), alpha = ex2(m - mnew);
        m = mnew; lsum *= alpha;
#pragma unroll
        for (int r = 0; r < 16; ++r) { o0[r] *= alpha; o1[r] *= alpha; }
    }
    float rs = 0.f;
#pragma unroll
    for (int r = 0; r < 16; ++r) { p0[r] = ex2(p0[r] - m); rs += p0[r]; }
    lsum += rs;
    u32x4 pk[2];
#pragma unroll
    for (int i = 0; i < 4; ++i) { pk[0][i] = pk2(p0[2 * i], p0[2 * i + 1]); pk[1][i] = pk2(p0[8 + 2 * i], p0[9 + 2 * i]); }
#pragma unroll
    for (int ks = 0; ks < 2; ++ks) {
        const bf16x8 a = __builtin_bit_cast(bf16x8, pk[ks]);
        const bf16x8 v0 = cat8(trrd(vwin + ks * 1024), trrd(vwin + ks * 1024 + 512));
        const bf16x8 v1 = cat8(trrd(vwin + 4096 + ks * 1024), trrd(vwin + 4096 + ks * 1024 + 512));
        o0 = MFMA32(v0, a, o0); o1 = MFMA32(v1, a, o1);
    }
}
__device__ __forceinline__ void finalize_store_lane(const f32x16& o0, const f32x16& o1, float lsum, bf16* orl, int hi);
__device__ __forceinline__ void finalize_store(const f32x16& o0, const f32x16& o1, float lsum, bf16* orow, LAS float* scr, int r32, int hi) {
    finalize_store_lane(o0, o1, lsum, orow + (size_t)r32 * DM, hi);
}
__device__ __forceinline__ void finalize_store_lane(const f32x16& o0, const f32x16& o1, float lsum, bf16* orl, int hi) {
    const float inv = 1.f / xh_sum(lsum);
    bf16* op = orl + 4 * hi;
#pragma unroll
    for (int g = 0; g < 4; ++g) {
        u32x2 w0, w1; w0.x = pk2(o0[4 * g] * inv, o0[4 * g + 1] * inv); w0.y = pk2(o0[4 * g + 2] * inv, o0[4 * g + 3] * inv); w1.x = pk2(o1[4 * g] * inv, o1[4 * g + 1] * inv); w1.y = pk2(o1[4 * g + 2] * inv, o1[4 * g + 3] * inv);
        *(u32x2*)(op + 8 * g) = w0; *(u32x2*)(op + 32 + 8 * g) = w1; }
}

__device__ __forceinline__ void swa_unit(const Params& p, int l, int b, int kvh, int qb, int gp, bool isctx, LAS unsigned char* L) {
    const int tid = tid_opaque(), lane = tid & 63, wave = __builtin_amdgcn_readfirstlane(tid >> 6), r32 = lane & 31, hi = lane >> 5;
    const bf16* Z = ws_z(p); bf16* Y = ws_hb(p);
    const int g = 2 * gp + (wave >> 2), rb = wave & 3, head = kvh * 4 + g;
    const size_t qrow0 = isctx ? (size_t)(NLAT + b * CTX + qb * 128) : (size_t)(b * SEQ + qb * 128);
    bf16x8 qr[4];
    { const bf16* qp = Z + (qrow0 + 32 * rb + r32) * INC + ZC_SQ + head * 64 + hi * 8;
#pragma unroll
      for (int d0 = 0; d0 < 4; ++d0) qr[d0] = *(const bf16x8*)(qp + d0 * 16); }
    float m = p.sink[l * 8 + head] * LOG2E, ls = (hi == 0) ? 1.f : 0.f; f32x16 o0, o1;
#pragma unroll
    for (int i = 0; i < 16; ++i) { o0[i] = 0.f; o1[i] = 0.f; }
    const int t0 = (qb == 0) ? 2 : 0, t1 = (qb == 15) ? 4 : 6;
    const int nwin = isctx ? 0 : (t1 - t0), nt = nwin + 4;
    const bf16* Kc = Z + ZC_SK + kvh * 64; const bf16* Vc = Z + ZC_SV + kvh * 64;
#define SWA_TROW(t) ((t) < nwin ? (size_t)(b * SEQ + 128 * (qb - 1) + 64 * (t0 + (t))) : (size_t)(NLAT + b * CTX + 64 * ((t) - nwin)))
    LAS float* scr = (LAS float*)(L + SCR) + wave * 64;
    const int vlo = ((lane >> 4) & 1) * 32 + (lane & 3) * 8 + (4 * hi + ((lane & 15) >> 2)) * 64;
    constexpr float SC = 0.125f * LOG2E;
    const int qi = 32 * rb + r32;
#define SWA_BODY(t, cur) { \
        const int wi = ((t) < nwin) ? t0 + (t) : -1; \
        const bool act = !(wi == 0 && rb >= 2) && !(wi == 5 && rb < 2); \
        if (act) { \
            f32x16 p0, p1; qk_tile(p0, p1, L + KB0 + (cur) * 8192, qr, r32, hi); \
            if ((wi == 0) || (wi == 1) || (wi == 4) || (wi == 5)) { \
                const int dbase = 64 * wi - 128 - qi; \
                _Pragma("unroll") for (int r = 0; r < 16; ++r) { const int d0 = dbase + crow(r, hi), d1 = d0 + 32; \
                    p0[r] = (d0 >= -128 && d0 <= 128) ? p0[r] * SC : -INFINITY; p1[r] = (d1 >= -128 && d1 <= 128) ? p1[r] * SC : -INFINITY; } \
            } else { \
                _Pragma("unroll") for (int r = 0; r < 16; ++r) { p0[r] *= SC; p1[r] *= SC; } \
            } \
            softmax_pv(p0, p1, m, ls, o0, o1, scr, L + VB0 + (cur) * 8192 + vlo, r32, hi); \
        } }
    TileRegs rA, rB, rC, rD;
    { const size_t r0 = SWA_TROW(0); tile_load(rA, Kc + r0 * INC, Vc + r0 * INC, tid); }
    { const size_t r1 = SWA_TROW(1); tile_load(rB, Kc + r1 * INC, Vc + r1 * INC, tid); }
    { const size_t r2 = SWA_TROW(2); tile_load(rC, Kc + r2 * INC, Vc + r2 * INC, tid); }
    { const size_t r3 = SWA_TROW(3); tile_load(rD, Kc + r3 * INC, Vc + r3 * INC, tid); }
    tile_store(rA, L + KB0, L + VB0, tid);
    __syncthreads();
#define SWA_STEP(tt, RL, RS, cur) { \
          \
        { const int tn = (tt) + 4 < nt ? (tt) + 4 : nt - 1; const size_t rn = SWA_TROW(tn); tile_load(RL, Kc + rn * INC, Vc + rn * INC, tid); } \
        SWA_BODY(tt, cur) \
        tile_store(RS, L + KB0 + ((cur) ^ 1) * 8192, L + VB0 + ((cur) ^ 1) * 8192, tid); \
        __syncthreads(); }
    int t = 0;
    for (; t + 4 <= nt; t += 4) {
        SWA_STEP(t, rA, rB, 0) SWA_STEP(t + 1, rB, rC, 1) SWA_STEP(t + 2, rC, rD, 0) SWA_STEP(t + 3, rD, rA, 1)
    }
    if (t < nt) { SWA_STEP(t, rA, rB, 0) if (t + 1 < nt) { SWA_STEP(t + 1, rB, rC, 1) if (t + 2 < nt) { SWA_STEP(t + 2, rC, rD, 0) } } }
#undef SWA_STEP
#undef SWA_BODY
#undef SWA_TROW
    finalize_store(o0, o1, ls, Y + (qrow0 + 32 * rb) * DM + YC_SWA + head * 64, scr, r32, hi);
}

__device__ __forceinline__ void na_unit(const Params& p, int l, int b, int h, int rg, bool isctx, LAS unsigned char* L, int rep = 0) {
    const int tid = tid_opaque(), lane = tid & 63, wave = __builtin_amdgcn_readfirstlane(tid >> 6), r32 = lane & 31, hi = lane >> 5;
    const bf16* Z = ws_z(p); bf16* Y = ws_hb(p);
    const int ig = wave & 3, gr0 = 4 * rg + 2 * (wave >> 2);
    const int rq = gr0 + (r32 >> 4), qcol = 16 * ig + (r32 & 15);
    const size_t qrow = isctx ? (size_t)(NLAT + b * CTX + 32 * wave + r32) : (size_t)(b * SEQ + rq * 64 + qcol);
    bf16x8 qr[4];
    { const bf16* qp = Z + qrow * INC + ZC_NQ + h * 64 + hi * 8;
#pragma unroll
      for (int d0 = 0; d0 < 4; ++d0) qr[d0] = *(const bf16x8*)(qp + d0 * 16); }
    LAS float* rpbl = (LAS float*)(L + RPB);
    const float rpbv = p.rpb[(size_t)(l * 8 + h) * 465 + (tid < 465 ? tid : 464)];
    float m = -1e30f, ls = 0.f; f32x16 o0, o1;
#pragma unroll
    for (int i = 0; i < 16; ++i) { o0[i] = 0.f; o1[i] = 0.f; }
    int R0 = 4 * rg - 4; R0 = R0 < 0 ? 0 : (R0 > 24 ? 24 : R0);
    int R1 = 4 * rg - 1; R1 = (R1 < 0 ? 0 : (R1 > 24 ? 24 : R1)) + 8;
    const int nband = isctx ? 0 : (R1 - R0), nt = nband + 4;
    int w0 = gr0 - 4; w0 = w0 < 0 ? 0 : (w0 > 24 ? 24 : w0);
    int w1 = gr0 - 3; w1 = (w1 < 0 ? 0 : (w1 > 24 ? 24 : w1)) + 8;
    int rs = rq - 4; rs = rs < 0 ? 0 : (rs > 24 ? 24 : rs);
    int cs = qcol - 8; cs = cs < 0 ? 0 : (cs > 48 ? 48 : cs);
    int key0 = 16 * ig - 8; key0 = key0 < 0 ? 0 : (key0 > 32 ? 32 : key0);
    const bf16* Kc = ws_kvh(p) + kvh_off(0, b, h); const bf16* Vc = ws_kvh(p) + kvh_off(1, b, h);
#define NA_TROW(t) ((t) < nband ? (size_t)(64 * (R0 + (t))) : (size_t)(SEQ + 64 * ((t) - nband)))
    LAS float* scr = (LAS float*)(L + SCR) + wave * 64;
    const int vlo = ((lane >> 4) & 1) * 32 + (lane & 3) * 8 + (4 * hi + ((lane & 15) >> 2)) * 64;
    constexpr float SC = 0.125f * LOG2E;
#define NA_BODY(t, cur) { \
        const int kr = ((t) < nband) ? R0 + (t) : -1; \
        if (kr < 0) { \
            f32x16 p0, p1; qk_tile(p0, p1, L + KB0 + (cur) * 8192, qr, r32, hi); \
            _Pragma("unroll") for (int r = 0; r < 16; ++r) { p0[r] *= SC; p1[r] *= SC; } \
            softmax_pv(p0, p1, m, ls, o0, o1, scr, L + VB0 + (cur) * 8192 + vlo, r32, hi); \
        } else if (kr >= w0 && kr < w1) { \
            f32x16 p0; qk_win(p0, L + KB0 + (cur) * 8192 + key0 * 16, qr, r32, hi); \
            const bool rowok = (kr >= rs) && (kr < rs + 8);                           \
            int dr = kr - rq + 7; dr = dr < 0 ? 0 : (dr > 14 ? 14 : dr); \
            LAS const float* tb = rpbl + dr * 31 + (15 - qcol);                       \
              \
            float bb[16]; \
            _Pragma("unroll") for (int r = 0; r < 16; ++r) { const int k = key0 + crow(r, hi); int kc = k < cs ? cs : k; kc = kc > cs + 15 ? cs + 15 : kc; bb[r] = tb[kc]; } \
            _Pragma("unroll") for (int r = 0; r < 16; ++r) asm volatile("" : "+v"(bb[r])); \
            _Pragma("unroll") for (int r = 0; r < 16; ++r) { const int k = key0 + crow(r, hi); const bool v = rowok && (k >= cs) && (k < cs + 16); p0[r] = v ? p0[r] * SC + bb[r] : -INFINITY; } \
            softmax_pv_win(p0, m, ls, o0, o1, L + VB0 + (cur) * 8192 + vlo + (key0 >> 3) * 512); \
        } }
    TileRegs rA, rB, rC, rD;
    { const size_t r0 = NA_TROW(0); tile_load<64>(rA, Kc + r0 * 64, Vc + r0 * 64, tid); }
    { const size_t r1 = NA_TROW(1); tile_load<64>(rB, Kc + r1 * 64, Vc + r1 * 64, tid); }
    { const size_t r2 = NA_TROW(2); tile_load<64>(rC, Kc + r2 * 64, Vc + r2 * 64, tid); }
    { const size_t r3 = NA_TROW(3); tile_load<64>(rD, Kc + r3 * 64, Vc + r3 * 64, tid); }
    if (tid < 465) rpbl[tid] = rpbv * LOG2E;
    tile_store(rA, L + KB0, L + VB0, tid);
    __syncthreads();
#define NA_STEP(tt, RL, RS, cur) { \
          \
        { const int tn = (tt) + 4 < nt ? (tt) + 4 : nt - 1; const size_t rn = NA_TROW(tn); tile_load<64>(RL, Kc + rn * 64, Vc + rn * 64, tid); } \
        NA_BODY(tt, cur) \
        tile_store(RS, L + KB0 + ((cur) ^ 1) * 8192, L + VB0 + ((cur) ^ 1) * 8192, tid); \
        __syncthreads(); }
    int t = 0;
    for (; t + 4 <= nt; t += 4) {
        NA_STEP(t, rA, rB, 0) NA_STEP(t + 1, rB, rC, 1) NA_STEP(t + 2, rC, rD, 0) NA_STEP(t + 3, rD, rA, 1)
    }
    if (t < nt) { NA_STEP(t, rA, rB, 0) if (t + 1 < nt) { NA_STEP(t + 1, rB, rC, 1) if (t + 2 < nt) { NA_STEP(t + 2, rC, rD, 0) } } }
#undef NA_STEP
#undef NA_BODY
#undef NA_TROW
    finalize_store_lane(o0, o1, ls, Y + qrow * DM + YC_NA + h * 64, hi);
}
}

__device__ __forceinline__ size_t ret_row(int b, int c, int j) { return c < 2 ? (size_t)(NLAT + b * CTX + 128 * c + j) : (size_t)(b * SEQ + 128 * (c - 2) + j); }
__device__ __forceinline__ float log2_sigmoid(float x) { return -log1pf(__expf(-x)) * LOG2E; }
__device__ __forceinline__ int tr_addr(int tile, int key, int cch) { return tile * 8192 + (cch >> 2) * 4096 + (key >> 3) * 512 + (key & 7) * 64 + (cch & 3) * 16; }

__device__ __forceinline__ void r1_unit(const Params& p, int l, int b, int h, int c, LAS unsigned char* L) {
    const int tid = tid_opaque(), lane = tid & 63, wave = __builtin_amdgcn_readfirstlane(tid >> 6), r32 = lane & 31, hi = lane >> 5;
    const bf16* Z = ws_z(p);
    const float lgf = log2_sigmoid(p.dec_f[l * 8 + h]), lgb = log2_sigmoid(p.dec_b[l * 8 + h]);
    LAS unsigned char* KT = L; LAS unsigned char* VF = L + 16384; LAS unsigned char* VBk = L + 32768;
#pragma unroll
    for (int i = 0; i < 2; ++i) { const int q = tid + 512 * i, tok = q >> 3, cch = q & 7;
        const bf16* rp = Z + ret_row(b, c, tok) * INC + h * 64 + cch * 8;
        const u32x4 kv = *(const u32x4*)(rp + ZC_RK), vv = *(const u32x4*)(rp + ZC_RV);
        const int a = tr_addr(tok >> 6, tok & 63, cch);
        *(LAS u32x4*)(KT + a) = kv;
        *(LAS u32x4*)(VF + a) = scale8(vv, ex2(lgf * (float)(127 - tok)));
        *(LAS u32x4*)(VBk + a) = scale8(vv, ex2(lgb * (float)tok)); }
    __syncthreads();
    const int dir = wave >> 2, dvb = (wave >> 1) & 1, dkb = wave & 1;
    const int vlo = ((lane >> 4) & 1) * 32 + (lane & 3) * 8 + (4 * hi + ((lane & 15) >> 2)) * 64;
    LAS const unsigned char* Ab = (dir ? VBk : VF) + dvb * 4096 + vlo; LAS const unsigned char* Bb = KT + dkb * 4096 + vlo;
    f32x16 acc;
#pragma unroll
    for (int i = 0; i < 16; ++i) acc[i] = 0.f;
#pragma unroll
    for (int ks = 0; ks < 8; ++ks) { const int off = (ks >> 2) * 8192 + (ks & 3) * 1024;
        const bf16x8 a = cat8(trrd(Ab + off), trrd(Ab + off + 512)), bb = cat8(trrd(Bb + off), trrd(Bb + off + 512));
        acc = MFMA32(a, bb, acc); }
    float* St = (float*)(p.ws + WS_SST) + ((size_t)((b * 8 + h) * 18 + c) * 2 + dir) * 4096;
#pragma unroll
    for (int r = 0; r < 16; ++r) St[(32 * dvb + crow(r, hi)) * 64 + 32 * dkb + r32] = acc[r];
    __syncthreads();
}

__device__ __forceinline__ void ph_ret_scan(const Params& p, int l) {
    const int tid = tid_opaque();
    const int task = blockIdx.x * 256 + tid;
    if (tid < 256) for (int tk = task; tk < 65536; tk += gridDim.x * 256) {
        const int cd = tk & 7, dv = (tk >> 3) & 63, dir = (tk >> 9) & 1, bh = tk >> 10, h = bh & 7;
        const float lg = log2_sigmoid((dir ? p.dec_b : p.dec_f)[l * 8 + h]), cdec = ex2(lg * 128.f);
        const float* Sb = (const float*)(p.ws + WS_SST) + (size_t)(bh * 18) * 2 * 4096 + dir * 4096 + dv * 64 + cd * 8;
        unsigned char* Ob = p.ws + WS_SIN + (size_t)(bh * 18) * 2 * 8192 + dir * 8192 + cd * 1024 + dv * 16;
        f32x4 a0 = {0.f, 0.f, 0.f, 0.f}, a1 = a0;
#pragma unroll
        for (int g = 0; g < 3; ++g) {
            f32x4 s0[6], s1[6];
#pragma unroll
            for (int k = 0; k < 6; ++k) { const int st = 6 * g + k, c = dir ? (st == 0 ? 1 : (st == 1 ? 0 : 19 - st)) : st; const float* sp = Sb + (size_t)c * 2 * 4096; s0[k] = *(const f32x4*)sp; s1[k] = *(const f32x4*)(sp + 4); }
#pragma unroll
            for (int k = 0; k < 6; ++k) { const int st = 6 * g + k, c = dir ? (st == 0 ? 1 : (st == 1 ? 0 : 19 - st)) : st;
                u32x4 w; w.x = pk2(a0.x, a0.y); w.y = pk2(a0.z, a0.w); w.z = pk2(a1.x, a1.y); w.w = pk2(a1.z, a1.w);
                *(u32x4*)(Ob + (size_t)c * 2 * 8192) = w;
                a0 = a0 * cdec + s0[k]; a1 = a1 * cdec + s1[k]; }
        }
    }
}

__device__ __forceinline__ void r3_pair(const Params& p, int l, int b, int h, int cp, LAS unsigned char* L, float decf, float decb) {
    const int tid = tid_opaque(), lane = tid & 63, wave = __builtin_amdgcn_readfirstlane(tid >> 6), r32 = lane & 31, hi = lane >> 5;
    const int half = wave >> 2, wq = wave & 3, c = 2 * cp + half, th = tid & 255;
    const bf16* Z = ws_z(p); bf16* Y = ws_hb(p);
    const float lgf = log2_sigmoid(decf), lgb = log2_sigmoid(decb);
    LAS unsigned char* Lh = L + half * 49152;
    LAS unsigned char* KT = Lh; LAS unsigned char* VT = Lh + 16384; LAS unsigned char* SF = Lh + 32768; LAS unsigned char* SBk = Lh + 40960;
    u32x4 kvr[4], vvr[4], snr[4];
#pragma unroll
    for (int i = 0; i < 4; ++i) { const int q = th + 256 * i, tok = q >> 3, cch = q & 7;
        const bf16* rp = Z + ret_row(b, c, tok) * INC + h * 64 + cch * 8;
        kvr[i] = *(const u32x4*)(rp + ZC_RK); vvr[i] = *(const u32x4*)(rp + ZC_RV); }
    { const unsigned char* src = p.ws + WS_SIN + (size_t)(((b * 8 + h) * 18 + c) * 2) * 8192;
#pragma unroll
      for (int i = 0; i < 4; ++i) { const int q = th + 256 * i; snr[i] = *(const u32x4*)(src + q * 16); } }
    const int qi = 32 * wq + r32;
    bf16x8 qr[4]; u32x2 gva[4], gvb[4];
    { const bf16* qp = Z + ret_row(b, c, qi) * INC + ZC_RQ + h * 64 + hi * 8;
#pragma unroll
      for (int d0 = 0; d0 < 4; ++d0) qr[d0] = *(const bf16x8*)(qp + d0 * 16);
      const bf16* gp0 = Z + ret_row(b, c, qi) * INC + ZC_RG + h * 64 + 4 * hi;
#pragma unroll
      for (int g = 0; g < 4; ++g) { gva[g] = *(const u32x2*)(gp0 + 8 * g); gvb[g] = *(const u32x2*)(gp0 + 32 + 8 * g); } }
    __builtin_amdgcn_sched_barrier(0);
#pragma unroll
    for (int i = 0; i < 4; ++i) { const int q = th + 256 * i, tok = q >> 3, cch = q & 7;
        *(LAS u32x4*)(KT + (tok >> 6) * 8192 + cch * 1024 + (tok & 63) * 16) = kvr[i];
        *(LAS u32x4*)(VT + tr_addr(tok >> 6, tok & 63, cch)) = vvr[i];
        *(LAS u32x4*)(SF + q * 16) = snr[i]; }
    __syncthreads();
    f32x16 o0, o1;
#pragma unroll
    for (int i = 0; i < 16; ++i) { o0[i] = 0.f; o1[i] = 0.f; }
    const int vlo = ((lane >> 4) & 1) * 32 + (lane & 3) * 8 + (4 * hi + ((lane & 15) >> 2)) * 64;
#pragma unroll
    for (int t = 0; t < 2; ++t) {
        f32x16 p0, p1; att::qk_tile(p0, p1, KT + t * 8192, qr, r32, hi);
#pragma unroll
        for (int r = 0; r < 16; ++r) { const int d0 = qi - (64 * t + crow(r, hi)), d1 = d0 - 32;
            p0[r] *= (d0 >= 0) ? ex2(lgf * (float)d0) : ex2(lgb * (float)(-d0));
            p1[r] *= (d1 >= 0) ? ex2(lgf * (float)d1) : ex2(lgb * (float)(-d1)); }
        att::pv_tile(o0, o1, p0, p1, VT + t * 8192 + vlo);
    }
    { const float xf = ex2(lgf * (float)(qi + 1)), xb = ex2(lgb * (float)(128 - qi));
#pragma unroll
      for (int s = 0; s < 4; ++s) {
          const bf16x8 af = __builtin_bit_cast(bf16x8, scale8(__builtin_bit_cast(u32x4, qr[s]), xf)), ab = __builtin_bit_cast(bf16x8, scale8(__builtin_bit_cast(u32x4, qr[s]), xb));
          LAS const unsigned char* sf = SF + (2 * s + hi) * 1024 + r32 * 16; LAS const unsigned char* sb = SBk + (2 * s + hi) * 1024 + r32 * 16;
          o0 = MFMA32(*(LAS const bf16x8*)sf, af, o0); o1 = MFMA32(*(LAS const bf16x8*)(sf + 512), af, o1);
          o0 = MFMA32(*(LAS const bf16x8*)sb, ab, o0); o1 = MFMA32(*(LAS const bf16x8*)(sb + 512), ab, o1); } }
    { float s1 = 0.f;
#pragma unroll
      for (int r = 0; r < 16; ++r) { o0[r] *= 0.125f; o1[r] *= 0.125f; s1 += o0[r] + o1[r]; }
      const float mean = att::xh_sum(s1) * (1.f / 64.f); float s2 = 0.f;
#pragma unroll
      for (int r = 0; r < 16; ++r) { o0[r] -= mean; o1[r] -= mean; s2 += o0[r] * o0[r] + o1[r] * o1[r]; }
      const float rstd = rsqrtf(att::xh_sum(s2) * (1.f / 64.f) + 1e-6f);
      const size_t row = ret_row(b, c, qi);
      bf16* yp = Y + row * DM + YC_RET + h * 64 + 4 * hi;
#pragma unroll
      for (int g = 0; g < 4; ++g) {
          const u32x2 ga = gva[g], gb = gvb[g]; u32x2 w0, w1;
          w0.x = pk2(silu_f(bf2f(ga.x & 0xffffu)) * o0[4 * g] * rstd, silu_f(__uint_as_float(ga.x & 0xffff0000u)) * o0[4 * g + 1] * rstd);
          w0.y = pk2(silu_f(bf2f(ga.y & 0xffffu)) * o0[4 * g + 2] * rstd, silu_f(__uint_as_float(ga.y & 0xffff0000u)) * o0[4 * g + 3] * rstd);
          w1.x = pk2(silu_f(bf2f(gb.x & 0xffffu)) * o1[4 * g] * rstd, silu_f(__uint_as_float(gb.x & 0xffff0000u)) * o1[4 * g + 1] * rstd);
          w1.y = pk2(silu_f(bf2f(gb.y & 0xffffu)) * o1[4 * g + 2] * rstd, silu_f(__uint_as_float(gb.y & 0xffff0000u)) * o1[4 * g + 3] * rstd);
          *(u32x2*)(yp + 8 * g) = w0; *(u32x2*)(yp + 32 + 8 * g) = w1; } }
    __syncthreads();
}

__device__ __forceinline__ void rope_task(const Params& p, int row, int task) {
    bf16* Z = ws_z(p);
    const int hq = task >> 2, i = task & 3, t = row & 2047;
    const int base = hq < 8 ? ZC_RQ + 64 * hq : (hq < 16 ? ZC_RK + 64 * (hq - 8) : (hq < 24 ? ZC_SQ + 64 * (hq - 16) : ZC_SK + 64 * (hq - 24)));
    const int pos = (i < 2) ? (t >> 6) : (t & 63), f0 = 8 * (i & 1);
    bf16* p1 = Z + (size_t)row * INC + base + 8 * i; bf16* p2 = p1 + 32;
    const u32x4 a = *(const u32x4*)p1, bq = *(const u32x4*)p2; u32x4 oa, ob;
#pragma unroll
    for (int k = 0; k < 4; ++k) {
        const float c0 = ROPE_COS[pos * 16 + f0 + 2 * k], s0 = ROPE_SIN[pos * 16 + f0 + 2 * k], c1 = ROPE_COS[pos * 16 + f0 + 2 * k + 1], s1 = ROPE_SIN[pos * 16 + f0 + 2 * k + 1];
        const float x1l = bf2f(a[k] & 0xffffu), x1h = __uint_as_float(a[k] & 0xffff0000u), x2l = bf2f(bq[k] & 0xffffu), x2h = __uint_as_float(bq[k] & 0xffff0000u);
        oa[k] = pk2(x1l * c0 - x2l * s0, x1h * c1 - x2h * s1); ob[k] = pk2(x1l * s0 + x2l * c0, x1h * s1 + x2h * c1); }
    *(u32x4*)p1 = oa; *(u32x4*)p2 = ob;
}
__device__ __forceinline__ void conv_task(const Params& p, int l, int row, int ch8) {
    const bf16* Z = ws_z(p); bf16* Y = ws_hb(p);
    const int t = (row < NLAT) ? (row & 2047) : ((row - NLAT) & 255), tl = (row < NLAT) ? 2047 : 255;
    const float* w = p.conv_w + (size_t)l * 3 * 512 + ch8 * 8;
    const bf16* zr = Z + (size_t)row * INC + ch8 * 8;
    float acc[8];
#pragma unroll
    for (int k = 0; k < 8; ++k) acc[k] = 0.f;
#pragma unroll
    for (int dt = -1; dt <= 1; ++dt) {
        if ((dt < 0 && t == 0) || (dt > 0 && t == tl)) continue;
        const bf16* zz = zr + (long)dt * INC;
        const u32x4 cc = *(const u32x4*)(zz + ZC_CC), hh = *(const u32x4*)(zz + ZC_CH);
        const f32x4 w0 = *(const f32x4*)(w + (dt + 1) * 512), w1 = *(const f32x4*)(w + (dt + 1) * 512 + 4);
#pragma unroll
        for (int k = 0; k < 4; ++k) { const float wl = (k < 2) ? w0[2 * k] : w1[2 * k - 4], wh = (k < 2) ? w0[2 * k + 1] : w1[2 * k - 3];
            acc[2 * k] += wl * bf2f(cc[k] & 0xffffu) * bf2f(hh[k] & 0xffffu); acc[2 * k + 1] += wh * __uint_as_float(cc[k] & 0xffff0000u) * __uint_as_float(hh[k] & 0xffff0000u); }
    }
    const u32x4 bb = *(const u32x4*)(zr + ZC_CB); u32x4 o;
#pragma unroll
    for (int k = 0; k < 4; ++k) o[k] = pk2(acc[2 * k] * bf2f(bb[k] & 0xffffu), acc[2 * k + 1] * __uint_as_float(bb[k] & 0xffff0000u));
    *(u32x4*)(Y + (size_t)row * DM + YC_CONV + ch8 * 8) = o;
}
__device__ __forceinline__ void conv_run(const Params& p, int l, int gt, int NT, int ntask) {
    const bf16* Z = ws_z(p); bf16* Y = ws_hb(p);
    const int ch8 = gt & 63;
    f32x4 wt[3][2];
    { const float* w = p.conv_w + (size_t)l * 3 * 512 + ch8 * 8;
#pragma unroll
      for (int k = 0; k < 3; ++k) { wt[k][0] = *(const f32x4*)(w + k * 512); wt[k][1] = *(const f32x4*)(w + k * 512 + 4); } }
    for (int i = gt; i < ntask; i += 2 * NT) {
        const bool v1 = i + NT < ntask;
        int row[2]; row[0] = i >> 6; row[1] = v1 ? (i + NT) >> 6 : row[0];
        u32x4 cc[2][3], hh[2][3], bb[2]; float fm[2], fp[2];
#pragma unroll
        for (int s = 0; s < 2; ++s) {
            const int r = row[s], t = (r < NLAT) ? (r & 2047) : ((r - NLAT) & 255), tl = (r < NLAT) ? 2047 : 255;
            const bool vm = t != 0, vp = t != tl; fm[s] = vm ? 1.f : 0.f; fp[s] = vp ? 1.f : 0.f;
            const bf16* zr = Z + (size_t)r * INC + ch8 * 8;
            const bf16* zm = vm ? zr - INC : zr; const bf16* zp = vp ? zr + INC : zr;
            cc[s][0] = *(const u32x4*)(zm + ZC_CC); hh[s][0] = *(const u32x4*)(zm + ZC_CH);
            cc[s][1] = *(const u32x4*)(zr + ZC_CC); hh[s][1] = *(const u32x4*)(zr + ZC_CH);
            cc[s][2] = *(const u32x4*)(zp + ZC_CC); hh[s][2] = *(const u32x4*)(zp + ZC_CH);
            bb[s] = *(const u32x4*)(zr + ZC_CB); }
        __builtin_amdgcn_sched_barrier(0);
#pragma unroll
        for (int s = 0; s < 2; ++s) {
            float acc[8];
#pragma unroll
            for (int k = 0; k < 8; ++k) acc[k] = 0.f;
#pragma unroll
            for (int d = 0; d < 3; ++d) { const float f = (d == 0) ? fm[s] : ((d == 2) ? fp[s] : 1.f);
#pragma unroll
                for (int k = 0; k < 4; ++k) { const float wl = wt[d][k >> 1][2 * (k & 1)] * f, wh = wt[d][k >> 1][2 * (k & 1) + 1] * f;
                    acc[2 * k] += wl * bf2f(cc[s][d][k] & 0xffffu) * bf2f(hh[s][d][k] & 0xffffu); acc[2 * k + 1] += wh * __uint_as_float(cc[s][d][k] & 0xffff0000u) * __uint_as_float(hh[s][d][k] & 0xffff0000u); } }
            u32x4 o;
#pragma unroll
            for (int k = 0; k < 4; ++k) o[k] = pk2(acc[2 * k] * bf2f(bb[s][k] & 0xffffu), acc[2 * k + 1] * __uint_as_float(bb[s][k] & 0xffff0000u));
            if (s == 0 || v1) *(u32x4*)(Y + (size_t)row[s] * DM + YC_CONV + ch8 * 8) = o;
        }
    }
}

__device__ __forceinline__ void ph_norm_router(const Params& p, int l, LAS unsigned char* lds) {
    const int tid = tid_opaque(), lane = tid & 63, wave = __builtin_amdgcn_readfirstlane(tid >> 6);
    constexpr int WPITCH = 4112;
    const float* wr = p.w_router + (size_t)l * 2048 * 16;
    { f32x4 t[16];
#pragma unroll
      for (int k = 0; k < 16; ++k) { const int n = tid + NTHR * k; t[k] = *(const f32x4*)(wr + (n >> 2) * 16 + (n & 3) * 4); }
#pragma unroll
      for (int k = 0; k < 16; ++k) { const int n = tid + NTHR * k, kk = n >> 2, q = n & 3;
#pragma unroll
          for (int i = 0; i < 4; ++i) *(LAS bf16*)(lds + (4 * q + i) * WPITCH + kk * 2) = (bf16)f2bf(t[k][i]); } }
    const int gw = blockIdx.x * NWAVES + wave, NGW = gridDim.x * NWAVES;
    const int nrows = (l == 0) ? NROW : NLAT;
    float* aff = (float*)(p.ws + WS_AFF);
    const int rpw = (nrows + NGW - 1) / NGW, r0 = gw * rpw, r1 = (r0 + rpw < nrows) ? r0 + rpw : nrows;
    { int cur = -1; f32x4 wv[8], sv[8], vn[8];
      if (r0 < r1) load_row8_bf16(vn, ws_xb(p) + (size_t)r0 * DM, lane);
      for (int row = r0; row < r1; ++row) {
          f32x4 v[8];
#pragma unroll
          for (int j = 0; j < 8; ++j) v[j] = vn[j];
          if (row + 1 < r1) load_row8_bf16(vn, ws_xb(p) + (size_t)(row + 1) * DM, lane);
          const int arow = (row < NLAT) ? (row >> 11) : 8;
          if (arow != cur) { const float* ad = ws_ada(p) + (size_t)(l * 9 + arow) * ADAW; load_coeffs(wv, sv, p.norm_ffn + l * DM, ad + 4 * 2048, ad + 3 * 2048, lane); cur = arow; }
          const float rstd = row_rstd(v);
#pragma unroll
          for (int j = 0; j < 8; ++j) v[j] = v[j] * rstd * wv[j] + sv[j];
          store_row8_bf16(v, ws_hb(p) + (size_t)row * DM, lane);
      } }
    asm volatile("s_waitcnt vmcnt(0)" ::: "memory");
    __syncthreads();
    if (tid < 64) { __builtin_amdgcn_fence(__ATOMIC_ACQUIRE, "agent"); asm volatile("s_waitcnt vmcnt(0)" ::: "memory"); }
    __syncthreads();
    const int R = rpw * NWAVES, R0 = blockIdx.x * R, R1 = (R0 + R < nrows) ? R0 + R : nrows;
    if (R0 + 16 * wave < R1) {
        const int fr = lane & 15, kg = lane >> 4;
        int arow_ = R0 + 16 * wave + fr; if (arow_ > R1 - 1) arow_ = R1 - 1;
        const bf16* ap = ws_hb(p) + (size_t)arow_ * DM + 8 * kg;
        LAS const unsigned char* bp = lds + fr * WPITCH + 16 * kg;
        f32x4 acc = {0.f, 0.f, 0.f, 0.f};
        for (int s0 = 0; s0 < 64; s0 += 8) {
            bf16x8 af[8];
#pragma unroll
            for (int s = 0; s < 8; ++s) af[s] = *(const bf16x8*)(ap + 32 * (s0 + s));
#pragma unroll
            for (int s = 0; s < 8; ++s) acc = __builtin_amdgcn_mfma_f32_16x16x32_bf16(af[s], *(LAS const bf16x8*)(bp + 64 * (s0 + s)), acc, 0, 0, 0);
        }
#pragma unroll
        for (int r = 0; r < 4; ++r) {
            float mx = acc[r];
#pragma unroll
            for (int o = 1; o < 16; o <<= 1) mx = fmaxf(mx, __shfl_xor(mx, o));
            const float ex = __expf(acc[r] - mx); float sum = ex;
#pragma unroll
            for (int o = 1; o < 16; o <<= 1) sum += __shfl_xor(sum, o);
            const int row = R0 + 16 * wave + 4 * kg + r;
            if (row < R1) aff[(size_t)row * 16 + fr] = ex / sum;
        }
    }
}

__device__ __forceinline__ int moe_mpe(int l) { return l == 0 ? 2304 : 2048; }
constexpr int CW_SCF = 8192;
constexpr int CW_TKF = 3072;
constexpr int RIDX_OFF = 131072 + 1024;
__device__ __forceinline__ void ph_topk(const Params& p, int l, LAS unsigned char* lds) {
    const int tid = tid_opaque(), lane = tid & 63, wave = __builtin_amdgcn_readfirstlane(tid >> 6);
    const int nprob = (l == 0) ? 256 : 128, MPE = moe_mpe(l);
    const float* aff = (const float*)(p.ws + WS_AFF); int* sel = (int*)(p.ws + WS_SEL); int* idx = (int*)(p.ws + WS_IDX); float* gatev = (float*)(p.ws + WS_GATEV);
    LAS int* lcnt = (LAS int*)lds;
    for (int prob = blockIdx.x; prob < nprob; prob += gridDim.x) {
        const bool isctx = prob >= 128; const int q = prob & 127, b = q >> 4, e = q & 15;
        const int T = isctx ? CTX : SEQ, cap = isctx ? 32 : 256, row0 = isctx ? NLAT + b * CTX : b * SEQ, slot0 = e * MPE + (isctx ? 2048 + b * 32 : b * 256);
        if (tid < 48) lcnt[tid] = 0;
        unsigned u[4];
#pragma unroll
        for (int k = 0; k < 4; ++k) { const int t = 256 * wave + 64 * k + lane; u[k] = (t < T) ? __float_as_uint(aff[(size_t)(row0 + t) * 16 + e]) : 0u; }
        __syncthreads();
        unsigned tau = 0u;
        for (int bit = 29; bit >= 0; --bit) {
            const unsigned cand = tau | (1u << bit); int cnt = 0;
#pragma unroll
            for (int k = 0; k < 4; ++k) cnt += __popcll(__ballot(u[k] >= cand));
            if (lane == 0 && cnt) __hip_atomic_fetch_add(&lcnt[bit], cnt, __ATOMIC_RELAXED, __HIP_MEMORY_SCOPE_WORKGROUP);
            __syncthreads();
            if (lcnt[bit] >= cap) tau = cand;
        }
        int ngt = 0, neq = 0;
#pragma unroll
        for (int k = 0; k < 4; ++k) { const int t = 256 * wave + 64 * k + lane; ngt += __popcll(__ballot(u[k] > tau)); neq += __popcll(__ballot((t < T) && u[k] == tau)); }
        if (lane == 0) { lcnt[32 + wave] = ngt; lcnt[40 + wave] = neq; }
        __syncthreads();
        int tgt = 0, eqb = 0;
#pragma unroll
        for (int w = 0; w < 8; ++w) { tgt += lcnt[32 + w]; }
        const int need_eq = cap - tgt;
        int base = 0;
#pragma unroll
        for (int w = 0; w < 8; ++w) if (w < wave) { const int ne = lcnt[40 + w]; int tk = need_eq - eqb; tk = tk < 0 ? 0 : (tk > ne ? ne : tk); base += lcnt[32 + w] + tk; eqb += ne; }
        const unsigned long long lt = (1ull << lane) - 1ull;
        int eqc = eqb;
#pragma unroll
        for (int k = 0; k < 4; ++k) { const int t = 256 * wave + 64 * k + lane; const bool valid = t < T;
            const bool gt = u[k] > tau, eq = valid && (u[k] == tau);
            const unsigned long long em = __ballot(eq);
            const bool take = gt || (eq && (eqc + __popcll(em & lt) < need_eq));
            const unsigned long long sm = __ballot(take);
            const int slot = base + __popcll(sm & lt);
            if (valid) { if (take) { idx[slot0 + slot] = row0 + t; gatev[slot0 + slot] = __uint_as_float(u[k]); }
                         sel[(size_t)(row0 + t) * 16 + e] = take ? slot : -1; }
            base += __popcll(sm); eqc += __popcll(em); }
        asm volatile("s_waitcnt vmcnt(0)" ::: "memory");
        __syncthreads();
        if (tid == 0) { __builtin_amdgcn_fence(__ATOMIC_RELEASE, "agent"); asm volatile("s_waitcnt vmcnt(0)" ::: "memory");
            __hip_atomic_store((unsigned*)(p.ws + WS_CTL) + CW_TKF + l * 256 + prob, 1u, __ATOMIC_RELAXED, __HIP_MEMORY_SCOPE_AGENT); }
    }
}
template <class Sched> __device__ __forceinline__ void topk_wait(const Params& p, int l, const Sched& S, int tpe, int tid) {
    if (tid < 64) {
        const int i = tid >> 3, sub = tid & 7; pg8::Unit u; int flag = -1;
        if (i < 6 && S.next(i, u)) { const int e = u.pm / tpe, j = u.pm % tpe; if (j < 8) { if (sub == 0) flag = j * 16 + e; } else flag = 128 + sub * 16 + e; }
        if (flag >= 0) { const unsigned* f = (const unsigned*)(p.ws + WS_CTL) + CW_TKF + l * 256 + flag; unsigned sp = 0;
            while (__hip_atomic_load(f, __ATOMIC_RELAXED, __HIP_MEMORY_SCOPE_AGENT) == 0u && ++sp < (1u << 20)) __builtin_amdgcn_s_sleep(2); }
        __builtin_amdgcn_fence(__ATOMIC_ACQUIRE, "agent"); asm volatile("s_waitcnt vmcnt(0)" ::: "memory");
    }
    __syncthreads();
}


__device__ __forceinline__ void ph_combine(const Params& p, int l) {
    const int tid_ = tid_opaque(), lane = tid_ & 63, wave = __builtin_amdgcn_readfirstlane(tid_ >> 6);
    const int gw = blockIdx.x * NWAVES + wave, NGW = gridDim.x * NWAVES;
    const int nrows = (l == 0) ? NROW : NLAT, MPE = moe_mpe(l);
    const int* sel = (const int*)(p.ws + WS_SEL); const bf16* YE = ws_z(p);
    const int rpw = (nrows + NGW - 1) / NGW, r0 = gw * rpw, r1 = (r0 + rpw < nrows) ? r0 + rpw : nrows;
    int cur = -1; f32x4 g2[8], vn[8]; int seln = -1;
    f32x4 wfin[8];
    if (l != 0) {
#pragma unroll
        for (int j = 0; j < 8; ++j) wfin[j] = *(const f32x4*)(p.norm_final + 256 * j + 4 * lane); }
    if (r0 < r1) { load_row8_bf16(vn, ws_xb(p) + (size_t)r0 * DM, lane); seln = (lane < 16) ? sel[(size_t)r0 * 16 + lane] : -1; }
    for (int row = r0; row < r1; ++row) {
        f32x4 v[8];
#pragma unroll
        for (int j = 0; j < 8; ++j) v[j] = vn[j];
        const int selv = seln;
        if (row + 1 < r1) { load_row8_bf16(vn, ws_xb(p) + (size_t)(row + 1) * DM, lane); seln = (lane < 16) ? sel[(size_t)(row + 1) * 16 + lane] : -1; }
        const bool isctx = row >= NLAT;
        const int arow = isctx ? 8 : (row >> 11);
        const int sbase = isctx ? 2048 + ((row - NLAT) >> 8) * 32 : (row >> 11) * 256;
        if (arow != cur) { const float* ad = ws_ada(p) + (size_t)(l * 9 + arow) * ADAW;
#pragma unroll
            for (int j = 0; j < 8; ++j) g2[j] = *(const f32x4*)(ad + 5 * 2048 + 256 * j + 4 * lane);
            cur = arow; }
        f32x4 acc[8];
#pragma unroll
        for (int j = 0; j < 8; ++j) acc[j] = (f32x4){0.f, 0.f, 0.f, 0.f};
        unsigned long long mask = __ballot(selv >= 0);
        while (mask) {
            const int e0 = __builtin_ctzll(mask); mask &= mask - 1;
            const bool two = mask != 0ull; const int e1 = two ? __builtin_ctzll(mask) : e0; if (two) mask &= mask - 1;
            const int s0 = __builtin_amdgcn_readlane(selv, e0), s1 = __builtin_amdgcn_readlane(selv, e1);
            const bf16* y0 = YE + (size_t)(e0 * MPE + sbase + s0) * DM + 4 * lane; const bf16* y1 = YE + (size_t)(e1 * MPE + sbase + s1) * DM + 4 * lane;
            u32x2 a[8], bq[8];
#pragma unroll
            for (int j = 0; j < 8; ++j) a[j] = *(const u32x2*)(y0 + 256 * j);
            if (two) {
#pragma unroll
                for (int j = 0; j < 8; ++j) bq[j] = *(const u32x2*)(y1 + 256 * j); }
#pragma unroll
            for (int j = 0; j < 8; ++j) { acc[j].x += bf2f(a[j].x & 0xffffu); acc[j].y += __uint_as_float(a[j].x & 0xffff0000u); acc[j].z += bf2f(a[j].y & 0xffffu); acc[j].w += __uint_as_float(a[j].y & 0xffff0000u); }
            if (two) {
#pragma unroll
                for (int j = 0; j < 8; ++j) { acc[j].x += bf2f(bq[j].x & 0xffffu); acc[j].y += __uint_as_float(bq[j].x & 0xffff0000u); acc[j].z += bf2f(bq[j].y & 0xffffu); acc[j].w += __uint_as_float(bq[j].y & 0xffff0000u); } }
        }
#pragma unroll
        for (int j = 0; j < 8; ++j) v[j] = v[j] + g2[j] * acc[j];
        const float rstd = row_rstd(v);
        if (l == 0) {
            store_row8_bf16(v, ws_xb(p) + (size_t)row * DM, lane);
            const float* ad1 = ws_ada(p) + (size_t)(1 * 9 + arow) * ADAW;
            modulate8(v, rstd, p.norm_mix + 1 * DM, ad1 + 2048, ad1, lane);
            store_row8_bf16(v, ws_hb(p) + (size_t)row * DM, lane);
        } else {
#pragma unroll
            for (int j = 0; j < 8; ++j) *(f32x4*)(p.out + (size_t)row * DM + 256 * j + 4 * lane) = v[j] * rstd * wfin[j];
        }
    }
}

constexpr int N_PHASES = 12;
template <int PH> __device__ __forceinline__ void run_phase(const Params& p, int l, LAS unsigned char* lds, int rep) {
    const int G = gridDim.x, bid = blockIdx.x, tid = tid_opaque();
    const bool need_ctx = (l == 0);
    const int vb = (G % 8 == 0) ? (bid & 7) * (G >> 3) + (bid >> 3) : bid;
    if constexpr (PH == 0) ph_prologue(p, lds);
    if constexpr (PH == 1) ph_modnorm0(p);
    if constexpr (PH == 2) {
        pg8::Gemm g{ws_hb(p), (const bf16*)(p.ws + WS_WIN) + (size_t)l * INC * 2048, NROW, INC, DM};
        { LAS float* rl = (LAS float*)(lds + ROPE_LDS);
          for (int i = tid; i < 1024; i += NTHR) { rl[i] = ROPE_COS[i]; rl[1024 + i] = ROPE_SIN[i]; } }
        __syncthreads();
        pg8::EpiZRope E{ws_z(p), (LAS const float*)(lds + ROPE_LDS), (LAS const float*)(lds + ROPE_LDS) + 1024, ws_kvh(p)};
        if (l == DEPTH - 1) { pg8::SkipOrder S; S.init(G, bid);
            pg8::gemm_phase<pg8::EpiZRope, pg8::SkipOrder, true, true>(lds, g, S, E);
            pg8::QuadOrder Q; Q.init(G, bid);
            pg8::gemm_phase<pg8::EpiZRope, pg8::QuadOrder, true, true, false, true>(lds, g, Q, E); }
        else { pg8::StaticOrder S; S.init(NROW, INC, G, bid);
            pg8::gemm_phase<pg8::EpiZRope, pg8::StaticOrder, true, true>(lds, g, S, E); }
        if (l == 0 && !rep && G == 256 && bid >= 120 && TAIL_P2 > 0) tail_convert(p, TAIL_OFF_P2, TAIL_P2, bid - 120, G - 120, lds);
    }
    if constexpr (PH == 3) {
        const int nu = 512 + (need_ctx ? 64 : 0);
        if (rep != 3) for (int u = vb; u < nu; u += G) {
            if (u < 576) { const bool ic = u >= 512; const int q = u - 512; att::na_unit(p, l, ic ? q >> 3 : u >> 6, ic ? q & 7 : (u >> 3) & 7, ic ? 0 : u & 7, ic, lds, rep); }
        }
        const int gt = bid * NTHR + tid, NT = G * NTHR;
        const int crows = need_ctx ? NROW : NLAT;
        if (rep != 2 && rep < 4) conv_run(p, l, gt, NT, crows * 64);
    }
    if constexpr (PH == 4) {
        const int nsu = 512 + (need_ctx ? 64 : 0);
        if (rep != 3) for (int u = (vb + 128) % G; u < nsu; u += G) { const bool ic = u >= 512; const int q = u - 512;
            att::swa_unit(p, l, ic ? q >> 3 : u >> 6, ic ? (q >> 2) & 1 : (u >> 5) & 1, ic ? (q >> 1) & 1 : (u >> 1) & 15, ic ? q & 1 : u & 1, ic, lds); }
        __syncthreads();
        if (rep != 2) for (int u = bid; u < 1152; u += G) { const int bh = u / 18, c = u % 18; r1_unit(p, l, bh >> 3, bh & 7, c, lds); }
    }
    if constexpr (PH == 5) {
        const int c0 = need_ctx ? 0 : 1, npair = 9 - c0;
        unsigned* sflag = (unsigned*)(p.ws + WS_CTL) + CW_SCF + l * 1024;
        if (!rep) { ph_ret_scan(p, l);
            asm volatile("s_waitcnt vmcnt(0)" ::: "memory"); __syncthreads();
            if (tid == 0) { __builtin_amdgcn_fence(__ATOMIC_RELEASE, "agent"); asm volatile("s_waitcnt vmcnt(0)" ::: "memory"); __hip_atomic_store(sflag + bid, 1u, __ATOMIC_RELAXED, __HIP_MEMORY_SCOPE_AGENT); } }
        const float dfall = p.dec_f[l * 8 + (tid & 7)], dball = p.dec_b[l * 8 + (tid & 7)];
        for (int u = bid; u < 64 * npair; u += G) { const int bh = u / npair, cp = c0 + u % npair;
            if (!rep) {
                if (tid < 64) { const int nf = (G == 256) ? 4 : G, f0 = (G == 256) ? 4 * bh : 0;
                    for (int f = tid; f < nf; f += 64) { unsigned sp = 0; while (__hip_atomic_load(sflag + f0 + f, __ATOMIC_RELAXED, __HIP_MEMORY_SCOPE_AGENT) == 0u && ++sp < (1u << 20)) __builtin_amdgcn_s_sleep(2); }
                    __builtin_amdgcn_fence(__ATOMIC_ACQUIRE, "agent"); asm volatile("s_waitcnt vmcnt(0)" ::: "memory"); }
                __syncthreads(); }
            r3_pair(p, l, bh >> 3, bh & 7, cp, lds, __uint_as_float(__builtin_amdgcn_readlane(__float_as_uint(dfall), bh & 7)), __uint_as_float(__builtin_amdgcn_readlane(__float_as_uint(dball), bh & 7))); }
    }
    if constexpr (PH == 6) { if (!(rep && l == 1)) {
        const int M = need_ctx ? NROW : NLAT;
        pg8::Gemm g{ws_hb(p), (const bf16*)(p.ws + WS_WOUT) + (size_t)l * 2048 * 2048, M, DM, DM}; pg8::StaticOrder S; S.init(M, DM, G, bid);
        if (l == 0) { pg8::EpiResGate<true> E{p.x, p.ctx, ws_xb(p), ws_ada(p) + (size_t)l * 9 * ADAW, 2 * 2048};
            pg8::gemm_phase<pg8::EpiResGate<true>, pg8::StaticOrder, true, true>(lds, g, S, E);
            if (!rep && G == 256 && bid >= 64 && TAIL_P6 > 0) tail_convert(p, TAIL_OFF_P6, TAIL_P6, bid - 64, G - 64, lds); }
        else { pg8::EpiResGate<false> E{nullptr, nullptr, ws_xb(p), ws_ada(p) + (size_t)l * 9 * ADAW, 2 * 2048};
            pg8::gemm_phase<pg8::EpiResGate<false>, pg8::StaticOrder, true, true>(lds, g, S, E); }
    } }
    if constexpr (PH == 7) ph_norm_router(p, l, lds);
    if constexpr (PH == 9) {
        const int tpe = need_ctx ? 9 : 8;
        pg8::GroupedOrder S; S.init(tpe, G, bid);
        if (!rep) { ph_topk(p, l, lds); topk_wait(p, l, S, tpe, tid); }
        { LAS int* rl = (LAS int*)(lds + RIDX_OFF); const int* idx = (const int*)(p.ws + WS_IDX); pg8::Unit u;
          for (int i = 0; S.next(i, u); ++i) if (tid < 256) rl[i * 256 + tid] = idx[u.pm * 256 + tid];
          __syncthreads(); }
        pg8::Gemm g{ws_hb(p), (const bf16*)(p.ws + WS_WGU) + (size_t)l * 16 * 2048 * 2048, 16 * tpe * 256, 2048, DM, (const LAS int*)(lds + RIDX_OFF)};
        pg8::EpiSiluMul E{(bf16*)(p.ws + WS_ACT)};
        pg8::gemm_phase<pg8::EpiSiluMul, pg8::GroupedOrder, true, true, true>(lds, g, S, E);
        if (l == 0 && !rep && G == 256 && bid >= 128 && TAIL_P9 > 0) tail_convert(p, TAIL_OFF_P9, TAIL_P9, bid - 128, G - 128, lds);
    }
    if constexpr (PH == 10) {
        const int tpe = need_ctx ? 9 : 8;
        pg8::Gemm g{(const bf16*)(p.ws + WS_ACT), (const bf16*)(p.ws + WS_WD) + (size_t)l * 16 * 2048 * 1024, 16 * tpe * 256, 2048, EFF}; pg8::GroupedOrder S; S.init(tpe, G, bid);
        pg8::EpiDown E{ws_z(p), (const float*)(p.ws + WS_GATEV)};
        pg8::gemm_phase<pg8::EpiDown, pg8::GroupedOrder, true, true>(lds, g, S, E);
        if (l == 0 && !rep && G == 256 && bid >= 128 && TAIL_P10 > 0) tail_convert(p, TAIL_OFF_P10, TAIL_P10, bid - 128, G - 128, lds);
    }
    if constexpr (PH == 11) { if (!rep) ph_combine(p, l); }
}

#ifndef MEGA
#define MEGA 1
#endif
template <int PH> __global__ void __launch_bounds__(NTHR, 2) k_phase(Params p, int l) {
    extern __shared__ __attribute__((aligned(16))) unsigned char lds_raw[];
    run_phase<PH>(p, l, (LAS unsigned char*)lds_raw, 0);
}

#if MEGA
__global__ void __launch_bounds__(NTHR, 2) k_mega(Params p) {
    extern __shared__ __attribute__((aligned(16))) unsigned char lds_raw[];
    LAS unsigned char* lds = (LAS unsigned char*)lds_raw;
    volatile LAS unsigned* MISC = (volatile LAS unsigned*)(lds + MISC_OFF);
    if (threadIdx.x < 32) MISC[threadIdx.x] = 0u;
    __syncthreads();
    XcdBarrier bar = xcd_barrier_post((unsigned*)(p.ws + WS_CTL) + CW_BAR, MISC + 8);
#ifndef REPEAT_MASK
#define REPEAT_MASK 0
#endif
#ifndef REPEAT_SUB
#define REPEAT_SUB 1
#endif
#define RP(k, l) do { run_phase<k>(p, l, lds, 0); xcd_barrier(bar); if ((REPEAT_MASK >> k) & 1) { run_phase<k>(p, l, lds, REPEAT_SUB); xcd_barrier(bar); } } while (0)
    RP(0, 0); RP(1, 0);
#ifdef EXTRA_BARRIERS
    for (int i_ = 0; i_ < EXTRA_BARRIERS; ++i_) xcd_barrier(bar);
#endif
#define LAYER_PHASES(l) RP(2, l); run_phase<3>(p, l, lds, 0); __syncthreads(); if ((REPEAT_MASK >> 3) & 1) { run_phase<3>(p, l, lds, REPEAT_SUB); __syncthreads(); } RP(4, l); RP(5, l); RP(6, l); RP(7, l); RP(9, l); RP(10, l);
    LAYER_PHASES(0) RP(11, 0);
    LAYER_PHASES(1) run_phase<11>(p, 1, lds, 0);
#undef RP
#undef LAYER_PHASES
}
#endif

template <int PH> static void launch_phase(const Params& p, int l, int grid, hipStream_t stream) {
    static bool attr_set = false;
    if (!attr_set) { (void)hipFuncSetAttribute((const void*)k_phase<PH>, hipFuncAttributeMaxDynamicSharedMemorySize, LDS_BYTES); attr_set = true; }
    hipLaunchKernelGGL(k_phase<PH>, dim3(grid), dim3(NTHR), LDS_BYTES, stream, p, l);
}

extern "C" void kernel_launch(void* const* d_in, const int* in_sizes, int n_in, void* d_out, int out_size, void* d_ws, size_t ws_size, hipStream_t stream) {
    static int grid = 0;
    if (grid == 0) {
        if (n_in != 20 || in_sizes[0] != NLAT * DM || out_size != NLAT * DM || ws_size < WS_END) {
            fprintf(stderr, "kernel_launch: unexpected problem shape (n_in %d, in0 %d, out %d, ws %zu; need ws >= %zu); nothing launched\n", n_in, n_in > 0 ? in_sizes[0] : -1, out_size, ws_size, (size_t)WS_END);
            grid = -1; return; }
        int dev = 0, cus = 0;
        if (hipGetDevice(&dev) != hipSuccess || hipDeviceGetAttribute(&cus, hipDeviceAttributeMultiprocessorCount, dev) != hipSuccess) { grid = -1; return; }
#if MEGA
        if (hipFuncSetAttribute((const void*)k_mega, hipFuncAttributeMaxDynamicSharedMemorySize, LDS_BYTES) != hipSuccess) { fprintf(stderr, "kernel_launch: hipFuncSetAttribute failed\n"); grid = -1; return; }
        int per_cu = 0;
        if (hipOccupancyMaxActiveBlocksPerMultiprocessor(&per_cu, (const void*)k_mega, NTHR, LDS_BYTES) != hipSuccess || per_cu < 1) { fprintf(stderr, "kernel_launch: occupancy query reports %d blocks per CU\n", per_cu); }
        (void)hipGetLastError();
#endif
        grid = cus;
    }
    if (grid < 0) return;
    Params p{};
    p.x = (const float*)d_in[0]; p.c = (const float*)d_in[1]; p.ctx = (const float*)d_in[2]; p.c_ctx = (const float*)d_in[3]; p.w_ada = (const float*)d_in[4]; p.b_ada = (const float*)d_in[5];
    p.norm_mix = (const float*)d_in[6]; p.norm_ffn = (const float*)d_in[7]; p.w_in = (const float*)d_in[8]; p.w_out = (const float*)d_in[9]; p.dec_f = (const float*)d_in[10]; p.dec_b = (const float*)d_in[11];
    p.conv_w = (const float*)d_in[12]; p.sink = (const float*)d_in[13]; p.rpb = (const float*)d_in[14]; p.w_router = (const float*)d_in[15]; p.w_gate = (const float*)d_in[16]; p.w_up = (const float*)d_in[17];
    p.w_down = (const float*)d_in[18]; p.norm_final = (const float*)d_in[19]; p.out = (float*)d_out; p.ws = (unsigned char*)d_ws;
    if (hipMemsetAsync((char*)d_ws + WS_CTL, 0, CTL_ZERO_BYTES, stream) != hipSuccess) { fprintf(stderr, "kernel_launch: memset failed\n"); return; }
#if MEGA
    hipLaunchKernelGGL(k_mega, dim3(grid), dim3(NTHR), LDS_BYTES, stream, p);
#else
    launch_phase<0>(p, 0, grid, stream); launch_phase<1>(p, 0, grid, stream);
    for (int l = 0; l < DEPTH; ++l) {
        launch_phase<2>(p, l, grid, stream); launch_phase<3>(p, l, grid, stream); launch_phase<4>(p, l, grid, stream); launch_phase<5>(p, l, grid, stream); launch_phase<6>(p, l, grid, stream);
        launch_phase<7>(p, l, grid, stream); launch_phase<9>(p, l, grid, stream); launch_phase<10>(p, l, grid, stream); launch_phase<11>(p, l, grid, stream);
    }
#endif
}
```

```cpp
#include <hip/hip_runtime.h>
#include <cstdio>
#include <cstdint>
__device__ __forceinline__ int tid_opaque() { int t = (int)threadIdx.x; asm volatile("" : "+v"(t)); return t; }
#define MEGA 1
namespace pg8 {
#define PG8_LAS __attribute__((address_space(3)))
typedef unsigned short bf16_t;
typedef short bf16x8 __attribute__((ext_vector_type(8)));
typedef float f32x4 __attribute__((ext_vector_type(4)));
typedef unsigned u32x4 __attribute__((ext_vector_type(4)));
constexpr int BM = 256, BK = 64, HALF = 128, HTB = HALF * BK * 2  , STAGE_BYTES = 8 * HTB, NXCD = 8, WGM = 8;

__host__ __device__ __forceinline__ int lds_byte(int r, int c) { const int st = (r >> 4) * 2 + (c >> 5), rr = r & 15, cc = c & 31, ob = rr * 64 + cc * 2; return st * 1024 + (ob ^ (((ob >> 9) & 1) << 5)); }
__host__ __device__ __forceinline__ void stage_rc(int b, int& R, int& C) { const int st = b / 1024, sb = b % 1024, swz = sb ^ (((sb >> 9) & 1) << 5); R = (st >> 1) * 16 + swz / 64; C = (st & 1) * 32 + (swz % 64) / 2; }
__host__ __device__ __forceinline__ int perm32(int rho) { const int n = rho >> 4, i = rho & 15; return 8 * (i >> 2) + 4 * n + (i & 3); }

struct Unit { int pm, pn, pb, q; };
struct Gemm { const bf16_t* A; const bf16_t* Bt; int M, N, K; const PG8_LAS int* ridx; };

struct StaticOrder {
    int nM, nN, nwg, G, c;
    __host__ __device__ void init(int M, int N, int G_, int c_) { nM = M / BM; nN = N / BM; nwg = nM * nN; G = G_; c = c_; }
    __host__ __device__ bool next(int i, Unit& u) const {
        const long L = (long)i * G + c; if (L >= nwg) return false;
        int wgid = (int)L; { const int q = nwg / NXCD, r = nwg % NXCD, xcd = wgid % NXCD, off = wgid / NXCD; wgid = (xcd < r ? xcd * (q + 1) : r * (q + 1) + (xcd - r) * q) + off; }
        const int nig = WGM * nN, gid = wgid / nig, fm = gid * WGM, gsz = (nM - fm) < WGM ? (nM - fm) : WGM;
        u.pm = fm + ((wgid % nig) % gsz); u.pn = (wgid % nig) / gsz; u.pb = u.pn; return true;
    }
    __device__ __forceinline__ void a_ready(const Unit&) const {}
    __device__ __forceinline__ void done(const Unit&) const {}
};

__device__ __forceinline__ unsigned cvt_pk_bf16(float lo, float hi) { unsigned r; asm volatile("v_cvt_pk_bf16_f32 %0, %1, %2" : "=v"(r) : "v"(lo), "v"(hi)); return r; }
typedef float f32x2 __attribute__((ext_vector_type(2)));
__device__ __forceinline__ f32x2 gelu_pk(f32x2 v) {
    const f32x2 av = __builtin_elementwise_abs(v), d = av * 0.2316418882f + 1.0f;
    f32x2 t; t.x = __builtin_amdgcn_rcpf(d.x); t.y = __builtin_amdgcn_rcpf(d.y);
    f32x2 q = t * 0.5307027145f + (-0.7265760135f); q = q * t + 0.7107068705f; q = q * t + (-0.142248368f); q = q * t + 0.127414796f; q = q * t;
    const f32x2 s = (v * v) * (-0.72134752044f);
    f32x2 e; e.x = __builtin_amdgcn_exp2f(s.x); e.y = __builtin_amdgcn_exp2f(s.y);
    const f32x2 m = v * (q * e), r = v - m;
    f32x2 o; o.x = v.x < 0.f ? m.x : r.x; o.y = v.y < 0.f ? m.y : r.y; return o;
}

template <int ACT  > struct EpiBf16 {
    static constexpr bool PERM = true, AFTER_DRAIN = false; static_assert(ACT == 0 || ACT == 1, "EpiBf16: ACT is 0 (none) or 1 (gelu_pk)");
    bf16_t* O; int ldc; const float* bias; int split_cols; size_t split_stride; float scale0;
    __device__ __forceinline__ void operator()(const f32x4 (&acc)[2][2][4][2], const Unit& u, int wr, int wc, int fr, int fq) const {
        const int row0 = u.pm * BM + wr * 64 + fr; int colt = u.pn * BM; bf16_t* base = O;
        float sc = 1.f; if (split_cols) { const int t = colt / split_cols; base += (size_t)t * split_stride; colt -= t * split_cols; if (t == 0) sc = scale0; }
        const int col0 = colt + wc * 32 + 8 * fq, bcol0 = u.pn * BM + wc * 32 + 8 * fq;
        f32x4 bv[2][2];
#pragma unroll
        for (int bj = 0; bj < 2; ++bj)
#pragma unroll
            for (int n = 0; n < 2; ++n) bv[bj][n] = bias ? *(const f32x4*)(bias + bcol0 + bj * HALF + 4 * n) : (f32x4){0.f, 0.f, 0.f, 0.f};
#pragma unroll
        for (int ai = 0; ai < 2; ++ai)
#pragma unroll
            for (int m = 0; m < 4; ++m) { bf16_t* rowp = base + (size_t)(row0 + ai * HALF + m * 16) * ldc + col0;
#pragma unroll
                for (int bj = 0; bj < 2; ++bj) { f32x4 v0 = acc[ai][bj][m][0] + bv[bj][0], v1 = acc[ai][bj][m][1] + bv[bj][1];
                    if (ACT == 1) { f32x2 a = gelu_pk((f32x2){v0[0], v0[1]}), b = gelu_pk((f32x2){v0[2], v0[3]}), c = gelu_pk((f32x2){v1[0], v1[1]}), d = gelu_pk((f32x2){v1[2], v1[3]});
                        v0 = (f32x4){a.x, a.y, b.x, b.y}; v1 = (f32x4){c.x, c.y, d.x, d.y}; }
                    v0 = v0 * sc; v1 = v1 * sc; u32x4 w; w.x = cvt_pk_bf16(v0[0], v0[1]); w.y = cvt_pk_bf16(v0[2], v0[3]); w.z = cvt_pk_bf16(v1[0], v1[1]); w.w = cvt_pk_bf16(v1[2], v1[3]);
                    *(u32x4*)(rowp + bj * HALF) = w; } }
    }
};

template <class Epi, class Sched, bool ALIGN_EPI = false, bool SP2 = false, bool GATHER = false, bool QUAD = false>
__device__ __forceinline__ void gemm_phase(PG8_LAS unsigned char* lds, const Gemm g, const Sched& S, const Epi& E) {
    const int tid = tid_opaque(), wid = __builtin_amdgcn_readfirstlane(tid >> 6), lane = tid & 63, wr = wid >> 2, wc = wid & 3, fr = lane & 15, fq = lane >> 4;
    const int K = g.K, nt = K / BK;
    unsigned voffA[2], voffB[2];
#pragma unroll
    for (int i = 0; i < 2; ++i) { int R, C; stage_rc(tid * 16 + i * 8192, R, C); const int Rb = Epi::PERM ? ((R & ~31) + perm32(R & 31)) : R;
        voffA[i] = (unsigned)(R * K + C) * 2u; voffB[i] = (unsigned)(Rb * K + C) * 2u; }
    unsigned cvA[2][2], nvA[2][2];
#define PG8_AOFFS(dst, unit, ord) do { _Pragma("unroll") for (int _h = 0; _h < 2; ++_h) _Pragma("unroll") for (int _i = 0; _i < 2; ++_i) { int R_, C_; stage_rc(tid * 16 + _i * 8192, R_, C_); \
        if constexpr (GATHER) dst[_h][_i] = (unsigned)(g.ridx[(ord) * BM + _h * HALF + R_] * K + C_) * 2u; else dst[_h][_i] = voffA[_i] + (unsigned)(_h * HALF * K * 2); } } while (0)
    const size_t kstep = (size_t)(BK * 2);
    const size_t hstep = (size_t)HALF * K * 2;
    const size_t tstep = 2 * hstep;
    const unsigned ldsw = (unsigned)wid * 1024u;
    const int aoff = lds_byte(wr * 64 + fr, fq * 8), boff = lds_byte(wc * 32 + fr, fq * 8);
#define PG8_SA(b, h) (((b) * 2 + (h)) * HTB)
#define PG8_SB(b, h) ((4 + (b) * 2 + (h)) * HTB)
#define PG8_STAGE(bufoff, gbase, voff) do { _Pragma("unroll") for (int _i = 0; _i < 2; ++_i) \
        __builtin_amdgcn_global_load_lds((const unsigned*)((const char*)(gbase) + (voff)[_i]), (PG8_LAS unsigned*)(lds + (bufoff) + ldsw + _i * 8192), 16, 0, 0); } while (0)
#define PG8_LDA(dst, b, h) do { _Pragma("unroll") for (int m = 0; m < 4; ++m) _Pragma("unroll") for (int k = 0; k < 2; ++k) dst[m][k] = *(const PG8_LAS bf16x8*)(lds + PG8_SA(b, h) + aoff + m * 2048 + k * 1024); } while (0)
#define PG8_LDB(dst, b, h) do { _Pragma("unroll") for (int n = 0; n < 2; ++n) _Pragma("unroll") for (int k = 0; k < 2; ++k) dst[n][k] = *(const PG8_LAS bf16x8*)(lds + PG8_SB(b, h) + boff + n * 2048 + k * 1024); } while (0)
#define PG8_MMA(ai, bj, At, Bt) do { __builtin_amdgcn_s_setprio(1); _Pragma("unroll") for (int m = 0; m < 4; ++m) _Pragma("unroll") for (int n = 0; n < 2; ++n) _Pragma("unroll") for (int k = 0; k < 2; ++k) \
        acc[QUAD ? 0 : (ai)][QUAD ? 0 : (bj)][m][n] = __builtin_amdgcn_mfma_f32_16x16x32_bf16(Bt[n][k], At[m][k], acc[QUAD ? 0 : (ai)][QUAD ? 0 : (bj)][m][n], 0, 0, 0); __builtin_amdgcn_s_setprio(0); } while (0)
#define PG8_QMMA(ai, bj, At, Bt) do { if (!QUAD || cur.q == 2 * (ai) + (bj)) PG8_MMA(ai, bj, At, Bt); } while (0)
#define PG8_WAIT_V(n) asm volatile("s_waitcnt vmcnt(" #n ")" ::: "memory")
#define PG8_WAIT_L(n) asm volatile("s_waitcnt lgkmcnt(" #n ")" ::: "memory")
#define PG8_BAR __builtin_amdgcn_s_barrier()
#define PG8_SCHED __builtin_amdgcn_sched_barrier(0)
    Unit cur, nxt; int ui = 0;
    if (!S.next(0, cur)) return;
    constexpr int NQ = QUAD ? 1 : 2;
    f32x4 acc[NQ][NQ][4][2];
#pragma unroll
    for (int a = 0; a < NQ; ++a)
#pragma unroll
        for (int b = 0; b < NQ; ++b)
#pragma unroll
            for (int m = 0; m < 4; ++m)
#pragma unroll
                for (int n = 0; n < 2; ++n) acc[a][b][m][n] = (f32x4){0.f, 0.f, 0.f, 0.f};
    bf16x8 At[4][2], B0[2][2], B1[2][2];
    const char* cA = (const char*)g.A + (GATHER ? (size_t)0 : (size_t)cur.pm * tstep); const char* cB = (const char*)g.Bt + (size_t)cur.pb * tstep;
    S.a_ready(cur);
    PG8_AOFFS(cvA, cur, 0);
    if constexpr (SP2) {
        PG8_STAGE(PG8_SB(0, 0), cB, voffB); PG8_STAGE(PG8_SB(0, 1), cB + hstep, voffB); PG8_STAGE(PG8_SA(0, 0), cA, cvA[0]); PG8_STAGE(PG8_SA(0, 1), cA, cvA[1]);
        if (wr == 1) PG8_BAR;
        PG8_WAIT_V(2); PG8_BAR;
        PG8_STAGE(PG8_SB(1, 0), cB + kstep, voffB); PG8_STAGE(PG8_SA(1, 0), cA + kstep, cvA[0]); PG8_STAGE(PG8_SB(1, 1), cB + hstep + kstep, voffB);
        PG8_WAIT_V(6); PG8_BAR;
    } else { static_assert(SP2, "only the SP2 loop is kept in this file"); }
    for (;;) {
        const bool has_next = S.next(ui + 1, nxt);
        const char* nA = (has_next && !GATHER) ? (const char*)g.A + (size_t)nxt.pm * tstep : cA;
        if constexpr (GATHER) { if (has_next) PG8_AOFFS(nvA, nxt, ui + 1); else { _Pragma("unroll") for (int _h = 0; _h < 2; ++_h) _Pragma("unroll") for (int _i = 0; _i < 2; ++_i) nvA[_h][_i] = cvA[_h][_i]; } }
        const char* nB = has_next ? (const char*)g.Bt + (size_t)nxt.pb * tstep : cB;
        for (int t = 0; t < nt; t += 2) {
            const bool last = (t == nt - 2);
            const char* a1 = cA + (size_t)(t + 1) * kstep;
            const char* a2 = last ? nA : cA + (size_t)(t + 2) * kstep; const char* b2 = last ? nB : cB + (size_t)(t + 2) * kstep;
            const char* a3 = a2 + kstep; const char* b3 = b2 + kstep;
            unsigned xA0[2], xA1[2];
#pragma unroll
            for (int _i = 0; _i < 2; ++_i) { xA0[_i] = (GATHER && last) ? nvA[0][_i] : cvA[0][_i]; xA1[_i] = (GATHER && last) ? nvA[1][_i] : cvA[1][_i]; }
            if (last && has_next) S.a_ready(nxt);
            if constexpr (SP2) {
            PG8_LDB(B0, 0, 0); PG8_LDB(B1, 0, 1); PG8_SCHED; PG8_LDA(At, 0, 0); PG8_STAGE(PG8_SA(1, 1), a1, cvA[1]);
            PG8_WAIT_V(8); PG8_WAIT_L(0); PG8_BAR; PG8_QMMA(0, 0, At, B0); PG8_QMMA(0, 1, At, B1); PG8_BAR; PG8_SCHED;
            PG8_LDA(At, 0, 1); PG8_STAGE(PG8_SB(0, 0), b2, voffB); PG8_STAGE(PG8_SB(0, 1), b2 + hstep, voffB); PG8_STAGE(PG8_SA(0, 0), a2, xA0);
            PG8_WAIT_V(8); PG8_WAIT_L(0); PG8_BAR; PG8_QMMA(1, 0, At, B0); PG8_QMMA(1, 1, At, B1); PG8_BAR; PG8_SCHED;
            PG8_LDB(B0, 1, 0); PG8_LDB(B1, 1, 1); PG8_SCHED; PG8_LDA(At, 1, 0); PG8_STAGE(PG8_SA(0, 1), a2, xA1);
            PG8_WAIT_V(8); PG8_WAIT_L(0); PG8_BAR; PG8_QMMA(0, 0, At, B0); PG8_QMMA(0, 1, At, B1); PG8_BAR; PG8_SCHED;
            PG8_LDA(At, 1, 1); PG8_STAGE(PG8_SB(1, 0), b3, voffB); PG8_STAGE(PG8_SB(1, 1), b3 + hstep, voffB); PG8_STAGE(PG8_SA(1, 0), a3, xA0);
            PG8_WAIT_V(8); PG8_WAIT_L(0); PG8_BAR; PG8_QMMA(1, 0, At, B0); PG8_QMMA(1, 1, At, B1); PG8_BAR; PG8_SCHED;
            }
        }
        if constexpr (ALIGN_EPI) { if (wr == 0) PG8_BAR; }
        if constexpr (QUAD) { E.quad(acc[0][0], cur, wr, wc, fr, fq); S.done(cur); }
        else if constexpr (!Epi::AFTER_DRAIN) { E(acc, cur, wr, wc, fr, fq); S.done(cur); }
        if (!has_next) break;
#pragma unroll
        for (int a = 0; a < NQ; ++a)
#pragma unroll
            for (int b = 0; b < NQ; ++b)
#pragma unroll
                for (int m = 0; m < 4; ++m)
#pragma unroll
                    for (int n = 0; n < 2; ++n) acc[a][b][m][n] = (f32x4){0.f, 0.f, 0.f, 0.f};
        cur = nxt; cA = nA; cB = nB; ++ui;
        if constexpr (GATHER) { _Pragma("unroll") for (int _h = 0; _h < 2; ++_h) _Pragma("unroll") for (int _i = 0; _i < 2; ++_i) cvA[_h][_i] = nvA[_h][_i]; }
        if constexpr (ALIGN_EPI) { if (wr == 1) PG8_BAR; }
    }
    PG8_WAIT_V(0);
    if constexpr (!ALIGN_EPI) { if (wr == 0) PG8_BAR; }
    PG8_BAR;
    if constexpr (!QUAD && Epi::AFTER_DRAIN) { E.fused(acc, cur, wr, wc, fr, fq, lds, wid, lane); S.done(cur); }
#undef PG8_SA
#undef PG8_SB
#undef PG8_STAGE
#undef PG8_LDA
#undef PG8_LDB
#undef PG8_MMA
#undef PG8_QMMA
#undef PG8_WAIT_V
#undef PG8_WAIT_L
#undef PG8_BAR
#undef PG8_SCHED
#undef PG8_AOFFS
}
}
#define LAS __attribute__((address_space(3)))
#define XB_TMO      128
#define XB_XCNT(j)  (256  + 64 * (j))
#define XB_XSUB(j)  (1280 + 64 * (j))
#define XB_XGEN(j)  (2304 + 64 * (j))
#define XB_TOP      3328
#define XB_TOPGEN   3392
#define XCD_BAR_WORDS 3456
#define XB_SPIN_CAP (1u << 18)

__device__ __forceinline__ unsigned xb_ld(unsigned* p)              { return __hip_atomic_load(p, __ATOMIC_RELAXED, __HIP_MEMORY_SCOPE_AGENT); }
__device__ __forceinline__ unsigned xb_add(unsigned* p, unsigned v) { return __hip_atomic_fetch_add(p, v, __ATOMIC_RELAXED, __HIP_MEMORY_SCOPE_AGENT); }
__device__ __forceinline__ unsigned xb_xcc_id() { return (unsigned)__builtin_amdgcn_s_getreg((3 << 11) | 20) & 0xFu; }
#define XB_SPIN(cond, bar) do { unsigned _sp = 0; while (cond) { __builtin_amdgcn_s_sleep(1); \
    if ((++_sp & 255u) == 0u) { if (xb_ld(&(bar)[XB_TMO])) break; if (_sp > XB_SPIN_CAP) { atomicAdd(&(bar)[XB_TMO], 1u); break; } } } } while (0)

struct XcdBarrier {
    unsigned* bar; unsigned x;
    volatile LAS unsigned* st;
};

__device__ __forceinline__ XcdBarrier xcd_barrier_post(unsigned* bar, volatile LAS unsigned* st) {
    XcdBarrier b; b.bar = bar; b.x = xb_xcc_id(); b.st = st;
    if (threadIdx.x == 0) (void)xb_add(&bar[XB_XCNT(b.x)], 1u);
    return b;
}
__device__ __forceinline__ void xcd_barrier_complete(unsigned* bar, unsigned x, unsigned& nloc, unsigned& nx) {
    const unsigned G = gridDim.x * gridDim.y * gridDim.z;
    unsigned sum, cnt, mine, sp = 0u;
    for (;;) {
        sum = 0u; cnt = 0u; mine = 0u;
#pragma unroll
        for (unsigned j = 0; j < 16; ++j) { const unsigned c = xb_ld(&bar[XB_XCNT(j)]); sum += c; cnt += (c > 0u) ? 1u : 0u; mine = (j == x) ? c : mine; }
        if (sum == G) break;
        __builtin_amdgcn_s_sleep(1);
        if ((++sp & 255u) == 0u) { if (xb_ld(&bar[XB_TMO])) break; if (sp > XB_SPIN_CAP) { atomicAdd(&bar[XB_TMO], 1u); break; } }
    }
    nloc = mine > 0u ? mine : 1u; nx = cnt > 0u ? cnt : 1u;
}

__device__ __forceinline__ void xcd_barrier(const XcdBarrier& b) {
    asm volatile("s_waitcnt vmcnt(0)" ::: "memory");
    __syncthreads();
    if (threadIdx.x == 0) {
        unsigned* bar = b.bar;
        __builtin_amdgcn_s_waitcnt(0);
        unsigned nloc = b.st[0], nx = b.st[1];
        if (nloc == 0u) { xcd_barrier_complete(bar, b.x, nloc, nx); b.st[0] = nloc; b.st[1] = nx; }
        const unsigned old = xb_add(&bar[XB_XSUB(b.x)], 1u);
        const unsigned gen = old / nloc;
        if (old + 1u == (gen + 1u) * nloc) {
            __builtin_amdgcn_fence(__ATOMIC_RELEASE, "agent");
            asm volatile("s_waitcnt vmcnt(0)" ::: "memory");
            const unsigned og = xb_add(&bar[XB_TOP], 1u);
            const unsigned tg = og / nx;
            if (og + 1u == (tg + 1u) * nx) xb_add(&bar[XB_TOPGEN], 1u);
            else XB_SPIN(xb_ld(&bar[XB_TOPGEN]) == tg, bar);
            __builtin_amdgcn_fence(__ATOMIC_ACQUIRE, "agent");
            xb_add(&bar[XB_XGEN(b.x)], 1u);
            asm volatile("s_waitcnt vmcnt(0)" ::: "memory");
        } else {
            XB_SPIN(xb_ld(&bar[XB_XGEN(b.x)]) == gen, bar);
            __builtin_amdgcn_fence(__ATOMIC_ACQUIRE, "agent");
            asm volatile("s_waitcnt vmcnt(0)" ::: "memory");
        }
    }
    __syncthreads();
}
#undef LAS
__constant__ float ROPE_COS[1024] = { 1.000000000e+00f, 1.000000000e+00f, 1.000000000e+00f, 1.000000000e+00f, 1.000000000e+00f, 1.000000000e+00f, 1.000000000e+00f, 1.000000000e+00f, 1.000000000e+00f, 1.000000000e+00f, 1.000000000e+00f, 1.000000000e+00f, 1.000000000e+00f, 1.000000000e+00f, 1.000000000e+00f, 1.000000000e+00f, 5.403022766e-01f, 8.460091352e-01f, 9.504152536e-01f, 9.842302203e-01f, 9.950041771e-01f, 9.984192848e-01f, 9.995000362e-01f, 9.998418689e-01f, 9.999499917e-01f, 9.999842048e-01f, 9.999949932e-01f, 9.999983907e-01f, 9.999995232e-01f, 9.999998212e-01f, 9.999999404e-01f, 1.000000000e+00f, -4.161468446e-01f, 4.314628243e-01f, 8.065783978e-01f, 9.374182820e-01f, 9.800665975e-01f, 9.936820865e-01f, 9.980006814e-01f, 9.993675947e-01f, 9.998000264e-01f, 9.999367595e-01f, 9.999799728e-01f, 9.999936819e-01f, 9.999979734e-01f, 9.999993443e-01f, 9.999998212e-01f, 9.999999404e-01f, -9.899924994e-01f, -1.159661636e-01f, 5.827536583e-01f, 8.610406518e-01f, 9.553365111e-01f, 9.858034849e-01f, 9.955033660e-01f, 9.985772967e-01f, 9.995500445e-01f, 9.998577237e-01f, 9.999549985e-01f, 9.999857545e-01f, 9.999955297e-01f, 9.999985695e-01f, 9.999995232e-01f, 9.999998808e-01f, -6.536436081e-01f, -6.276797056e-01f, 3.011374772e-01f, 7.575061917e-01f, 9.210609794e-01f, 9.748082757e-01f, 9.920106530e-01f, 9.974712729e-01f, 9.992001057e-01f, 9.997470379e-01f, 9.999200106e-01f, 9.999747276e-01f, 9.999920130e-01f, 9.999974966e-01f, 9.999992251e-01f, 9.999997616e-01f, 2.836622000e-01f, -9.460792542e-01f, -1.034233812e-02f, 6.300802827e-01f, 8.775825500e-01f, 9.607312679e-01f, 9.875259995e-01f, 9.960497618e-01f, 9.987502694e-01f, 9.996047616e-01f, 9.998750091e-01f, 9.999604821e-01f, 9.999874830e-01f, 9.999960661e-01f, 9.999987483e-01f, 9.999995828e-01f, 9.601702690e-01f, -9.731037021e-01f, -3.207964003e-01f, 4.827820361e-01f, 8.253356218e-01f, 9.436169863e-01f, 9.820539355e-01f, 9.943132997e-01f, 9.982005358e-01f, 9.994308352e-01f, 9.998199940e-01f, 9.999430776e-01f, 9.999819994e-01f, 9.999943376e-01f, 9.999982119e-01f, 9.999994040e-01f, 7.539022565e-01f, -7.004297972e-01f, -5.994374752e-01f, 3.202570081e-01f, 7.648422122e-01f, 9.235194325e-01f, 9.755998850e-01f, 9.922624230e-01f, 9.975510240e-01f, 9.992253184e-01f, 9.997550249e-01f, 9.999225140e-01f, 9.999755025e-01f, 9.999922514e-01f, 9.999975562e-01f, 9.999992251e-01f, -1.455000341e-01f, -2.120364457e-01f, -8.186324239e-01f, 1.476312131e-01f, 6.967067122e-01f, 9.005023241e-01f, 9.681702852e-01f, 9.898977876e-01f, 9.968017340e-01f, 9.989882708e-01f, 9.996800423e-01f, 9.998987913e-01f, 9.999679923e-01f, 9.999898672e-01f, 9.999967813e-01f, 9.999989867e-01f, -9.111302495e-01f, 3.416602612e-01f, -9.566441774e-01f, -2.965079620e-02f, 6.216099262e-01f, 8.746382594e-01f, 9.597726464e-01f, 9.872201085e-01f, 9.959527254e-01f, 9.987195730e-01f, 9.995950460e-01f, 9.998719096e-01f, 9.999595284e-01f, 9.999871850e-01f, 9.999959469e-01f, 9.999987483e-01f, -8.390715122e-01f, 7.901318669e-01f, -9.997860789e-01f, -2.059976310e-01f, 5.403022766e-01f, 8.460091352e-01f, 9.504153132e-01f, 9.842302203e-01f, 9.950041771e-01f, 9.984192848e-01f, 9.995000362e-01f, 9.998418689e-01f, 9.999499917e-01f, 9.999842048e-01f, 9.999949932e-01f, 9.999983907e-01f, 4.425697960e-03f, 9.952573776e-01f, -9.437797666e-01f, -3.758473992e-01f, 4.535960853e-01f, 8.147053123e-01f, 9.401075840e-01f, 9.809291363e-01f, 9.939560890e-01f, 9.980874062e-01f, 9.993950725e-01f, 9.998086691e-01f, 9.999395013e-01f, 9.999808669e-01f, 9.999939203e-01f, 9.999980927e-01f, 8.438539505e-01f, 8.938615918e-01f, -7.941793799e-01f, -5.338430405e-01f, 3.623577058e-01f, 7.808259130e-01f, 9.288598895e-01f, 9.773178697e-01f, 9.928086400e-01f, 9.977239966e-01f, 9.992800951e-01f, 9.997723103e-01f, 9.999279976e-01f, 9.999772310e-01f, 9.999927878e-01f, 9.999977350e-01f, 9.074468017e-01f, 5.171728730e-01f, -5.658205152e-01f, -6.750016809e-01f, 2.674987614e-01f, 7.444779873e-01f, 9.166833758e-01f, 9.733975530e-01f, 9.915618896e-01f, 9.973290563e-01f, 9.991551042e-01f, 9.997327924e-01f, 9.999154806e-01f, 9.999732971e-01f, 9.999915361e-01f, 9.999973178e-01f, 1.367372125e-01f, -1.879615150e-02f, -2.813494802e-01f, -7.948709130e-01f, 1.699671596e-01f, 7.057763934e-01f, 9.035902619e-01f, 9.691694379e-01f, 9.902160168e-01f, 9.969025850e-01f, 9.990201592e-01f, 9.996901155e-01f, 9.999020100e-01f, 9.999690056e-01f, 9.999902248e-01f, 9.999969006e-01f, -7.596879005e-01f, -5.489754677e-01f, 3.102235124e-02f, -8.896704316e-01f, 7.073719800e-02f, 6.648434997e-01f, 8.895936012e-01f, 9.646348357e-01f, 9.887710810e-01f, 9.964445233e-01f, 9.988752007e-01f, 9.996442795e-01f, 9.998875260e-01f, 9.999644160e-01f, 9.999887347e-01f, 9.999964237e-01f, -9.576594830e-01f, -9.100810885e-01f, 3.403181732e-01f, -9.564100504e-01f, -2.919954620e-02f, 6.218088269e-01f, 8.747074604e-01f, 9.597951770e-01f, 9.872272611e-01f, 9.959549904e-01f, 9.987202883e-01f, 9.995952845e-01f, 9.998720288e-01f, 9.999595284e-01f, 9.999871850e-01f, 9.999959469e-01f, -2.751633525e-01f, -9.908979535e-01f, 6.158648133e-01f, -9.929850101e-01f, -1.288445443e-01f, 5.768082738e-01f, 8.589466810e-01f, 9.546520114e-01f, 9.855847955e-01f, 9.954339862e-01f, 9.985553622e-01f, 9.995430708e-01f, 9.998555183e-01f, 9.999542832e-01f, 9.999855757e-01f, 9.999954104e-01f, 6.603167057e-01f, -7.665365338e-01f, 8.303361535e-01f, -9.982416630e-01f, -2.272021621e-01f, 5.299841762e-01f, 8.423270583e-01f, 9.492070079e-01f, 9.838436842e-01f, 9.948815107e-01f, 9.983804226e-01f, 9.994877577e-01f, 9.998379946e-01f, 9.999487996e-01f, 9.999837875e-01f, 9.999948740e-01f, 9.887046218e-01f, -3.060953915e-01f, 9.624637961e-01f, -9.720142484e-01f, -3.232895434e-01f, 4.814845920e-01f, 8.248651624e-01f, 9.434618354e-01f, 9.820042253e-01f, 9.942975044e-01f, 9.981955290e-01f, 9.994292855e-01f, 9.998195171e-01f, 9.999428988e-01f, 9.999819398e-01f, 9.999942780e-01f, 4.080820680e-01f, 2.486167252e-01f, 9.991443753e-01f, -9.151299596e-01f, -4.161468446e-01f, 4.314628243e-01f, 8.065784574e-01f, 9.374182820e-01f, 9.800665975e-01f, 9.936820865e-01f, 9.980006814e-01f, 9.993675947e-01f, 9.998000264e-01f, 9.999367595e-01f, 9.999799728e-01f, 9.999936819e-01f, -5.477292538e-01f, 7.267602682e-01f, 9.367404580e-01f, -8.293829560e-01f, -5.048462152e-01f, 3.800770044e-01f, 7.874851823e-01f, 9.310783744e-01f, 9.780309200e-01f, 9.930352569e-01f, 9.977958202e-01f, 9.993028045e-01f, 9.997795224e-01f, 9.999302626e-01f, 9.999779463e-01f, 9.999930263e-01f, -9.999608397e-01f, 9.810745716e-01f, 7.814403772e-01f, -7.174774408e-01f, -5.885011554e-01f, 3.274895847e-01f, 7.676045895e-01f, 9.244439602e-01f, 9.758974314e-01f, 9.923570156e-01f, 9.975810051e-01f, 9.992348552e-01f, 9.997580051e-01f, 9.999234676e-01f, 9.999758005e-01f, 9.999923706e-01f, -5.328330398e-01f, 9.332357645e-01f, 5.486452579e-01f, -5.829432607e-01f, -6.662759781e-01f, 2.738668323e-01f, 7.469564080e-01f, 9.175173044e-01f, 9.736663699e-01f, 9.916474223e-01f, 9.973561764e-01f, 9.991636872e-01f, 9.997355342e-01f, 9.999163747e-01f, 9.999735355e-01f, 9.999916553e-01f, 4.241790175e-01f, 5.979771614e-01f, 2.614416778e-01f, -4.300232828e-01f, -7.373937964e-01f, 2.193782777e-01f, 7.255613208e-01f, 9.103004336e-01f, 9.713379741e-01f, 9.909064770e-01f, 9.971213937e-01f, 9.990894198e-01f, 9.997119904e-01f, 9.999089241e-01f, 9.999712110e-01f, 9.999908805e-01f, 9.912028313e-01f, 7.855226099e-02f, -5.168933049e-02f, -2.635405958e-01f, -8.011435866e-01f, 1.641961634e-01f, 7.034407258e-01f, 9.027957320e-01f, 9.689124227e-01f, 9.901341200e-01f, 9.968766570e-01f, 9.990119338e-01f, 9.996874928e-01f, 9.999011755e-01f, 9.999687672e-01f, 9.999901056e-01f, 6.469193101e-01f, -4.650644958e-01f, -3.596943319e-01f, -8.874550462e-02f, -8.568888307e-01f, 1.084949449e-01f, 6.806167960e-01f, 8.950055838e-01f, 9.663899541e-01f, 9.893305302e-01f, 9.966219068e-01f, 9.989313483e-01f, 9.996620417e-01f, 9.998931289e-01f, 9.999662042e-01f, 9.999893308e-01f, -2.921388149e-01f, -8.654506207e-01f, -6.320286393e-01f, 8.884811401e-02f, -9.040721655e-01f, 5.245061591e-02f, 6.571123004e-01f, 8.869323730e-01f, 9.637709260e-01f, 9.884956479e-01f, 9.963572025e-01f, 9.988475442e-01f, 9.996355176e-01f, 9.998847246e-01f, 9.999635220e-01f, 9.999884963e-01f, -9.626058936e-01f, -9.992933869e-01f, -8.416849375e-01f, 2.636395097e-01f, -9.422222972e-01f, -3.759419080e-03f, 6.329506636e-01f, 8.785787225e-01f, 9.610554576e-01f, 9.876294732e-01f, 9.960825443e-01f, 9.987606406e-01f, 9.996080399e-01f, 9.998760223e-01f, 9.999607801e-01f, 9.999876022e-01f, -7.480575442e-01f, -8.253716230e-01f, -9.678714871e-01f, 4.301158488e-01f, -9.709581733e-01f, -5.995756760e-02f, 6.081562042e-01f, 8.699471951e-01f, 9.582439065e-01f, 9.867320657e-01f, 9.957979321e-01f, 9.986705780e-01f, 9.995795488e-01f, 9.998670220e-01f, 9.999579787e-01f, 9.999867082e-01f, 1.542514563e-01f, -3.972518742e-01f, -9.980752468e-01f, 5.830269456e-01f, -9.899924994e-01f, -1.159661636e-01f, 5.827536583e-01f, 8.610406518e-01f, 9.553365111e-01f, 9.858034849e-01f, 9.955033660e-01f, 9.985772967e-01f, 9.995500445e-01f, 9.998577237e-01f, 9.999549985e-01f, 9.999857545e-01f, 9.147423506e-01f, 1.532154828e-01f, -9.293003082e-01f, 7.175492048e-01f, -9.991351366e-01f, -1.716081351e-01f, 5.567683578e-01f, 8.518617749e-01f, 9.523335695e-01f, 9.848436713e-01f, 9.951988459e-01f, 9.984809160e-01f, 9.995195270e-01f, 9.998480678e-01f, 9.999519587e-01f, 9.999848008e-01f, 8.342233896e-01f, 6.564951539e-01f, -7.683671117e-01f, 8.294403553e-01f, -9.982947707e-01f, -2.267075777e-01f, 5.302263498e-01f, 8.424135447e-01f, 9.492354393e-01f, 9.838528037e-01f, 9.948843718e-01f, 9.983813763e-01f, 9.994880557e-01f, 9.998381138e-01f, 9.999487996e-01f, 9.999837875e-01f, -1.327674743e-02f, 9.575860500e-01f, -5.312352777e-01f, 9.151713848e-01f, -9.874798059e-01f, -2.810903192e-01f, 5.031541586e-01f, 8.326989412e-01f, 9.460423589e-01f, 9.828307629e-01f, 9.945599437e-01f, 9.982786179e-01f, 9.994555712e-01f, 9.998278022e-01f, 9.999455214e-01f, 9.999827743e-01f, -8.485702872e-01f, 9.637575150e-01f, -2.414211184e-01f, 9.720383286e-01f, -9.667981863e-01f, -3.345843852e-01f, 4.755789042e-01f, 8.227210045e-01f, 9.427546859e-01f, 9.817776680e-01f, 9.942255616e-01f, 9.981727600e-01f, 9.994220734e-01f, 9.998172522e-01f, 9.999421835e-01f, 9.999817014e-01f, -9.036921859e-01f, 6.731102467e-01f, 7.233466953e-02f, 9.982477427e-01f, -9.364566803e-01f, -3.870206773e-01f, 4.475280643e-01f, 8.124829531e-01f, 9.393727183e-01f, 9.806935191e-01f, 9.938812256e-01f, 9.980637431e-01f, 9.993875623e-01f, 9.998063445e-01f, 9.999387264e-01f, 9.999806285e-01f, -1.279636919e-01f, 1.751565337e-01f, 3.789161742e-01f, 9.929728508e-01f, -8.967583776e-01f, -4.382335544e-01f, 4.190297425e-01f, 8.019878864e-01f, 9.358968139e-01f, 9.795783162e-01f, 9.935269952e-01f, 9.979515672e-01f, 9.993520975e-01f, 9.997950792e-01f, 9.999352098e-01f, 9.999794960e-01f, 7.654140592e-01f, -3.767423034e-01f, 6.479216814e-01f, 9.563800097e-01f, -8.481000066e-01f, -4.880608618e-01f, 3.901124299e-01f, 7.912392616e-01f, 9.323273301e-01f, 9.784321785e-01f, 9.931628108e-01f, 9.978361726e-01f, 9.993155599e-01f, 9.997835755e-01f, 9.999315739e-01f, 9.999783635e-01f, 9.550736547e-01f, -8.126112223e-01f, 8.526731133e-01f, 8.896234632e-01f, -7.909677625e-01f, -5.363451838e-01f, 3.608050346e-01f, 7.802404165e-01f, 9.286646247e-01f, 9.772551060e-01f, 9.927886724e-01f, 9.977176785e-01f, 9.992780685e-01f, 9.997717142e-01f, 9.999278188e-01f, 9.999771714e-01f, 2.666429281e-01f, -9.982103705e-01f, 9.728653431e-01f, 7.948083878e-01f, -7.259322405e-01f, -5.829339027e-01f, 3.311368525e-01f, 7.689949274e-01f, 9.249090552e-01f, 9.760470986e-01f, 9.924046397e-01f, 9.975960255e-01f, 9.992396235e-01f, 9.997594953e-01f, 9.999239445e-01f, 9.999759793e-01f, -6.669380665e-01f, -8.763794303e-01f, 9.965789914e-01f, 6.749256253e-01f, -6.536436081e-01f, -6.276797056e-01f, 3.011375964e-01f, 7.575061917e-01f, 9.210609794e-01f, 9.748082757e-01f, 9.920106530e-01f, 9.974712729e-01f, 9.992001057e-01f, 9.997470379e-01f, 9.999200106e-01f, 9.999747276e-01f, -9.873392582e-01f, -4.846394062e-01f, 9.214623570e-01f, 5.337560773e-01f, -5.748240352e-01f, -6.704410911e-01f, 2.708370686e-01f, 7.457779050e-01f, 9.171208143e-01f, 9.735385776e-01f, 9.916067719e-01f, 9.973433018e-01f, 9.991596341e-01f, 9.997342229e-01f, 9.999159575e-01f, 9.999734163e-01f, -3.999853134e-01f, 5.636094138e-02f, 7.549653649e-01f, 3.757521510e-01f, -4.902605712e-01f, -7.110829353e-01f, 2.402658761e-01f, 7.338138223e-01f, 9.130889177e-01f, 9.722381234e-01f, 9.911929369e-01f, 9.972121716e-01f, 9.991181493e-01f, 9.997211099e-01f, 9.999117851e-01f, 9.999721050e-01f, 5.551133156e-01f, 5.800031424e-01f, 5.135984421e-01f, 2.058971673e-01f, -4.007990062e-01f, -7.494767308e-01f, 2.094544172e-01f, 7.216176391e-01f, 9.089657664e-01f, 9.709069133e-01f, 9.907692075e-01f, 9.970778823e-01f, 9.990756512e-01f, 9.997076392e-01f, 9.999075532e-01f, 9.999707937e-01f, 9.998432994e-01f, 9.250146747e-01f, 2.212981731e-01f, 2.954781987e-02f, -3.073327839e-01f, -7.855011225e-01f, 1.784335226e-01f, 7.091933489e-01f, 9.047516584e-01f, 9.695450068e-01f, 9.903355837e-01f, 9.969404936e-01f, 9.990321398e-01f, 9.996939301e-01f, 9.999032021e-01f, 9.999693632e-01f, 5.253219604e-01f, 9.851381779e-01f, -9.294810891e-02f, -1.477329880e-01f, -2.107958049e-01f, -8.190422058e-01f, 1.472342163e-01f, 6.965447664e-01f, 9.004471302e-01f, 9.681524038e-01f, 9.898920655e-01f, 9.967998862e-01f, 9.989876747e-01f, 9.996798635e-01f, 9.998987317e-01f, 9.999679923e-01f, -4.321779311e-01f, 7.418580055e-01f, -3.979767561e-01f, -3.203543723e-01f, -1.121526212e-01f, -8.499938846e-01f, 1.158876941e-01f, 6.836758852e-01f, 8.960524797e-01f, 9.667292237e-01f, 9.894386530e-01f, 9.966561794e-01f, 9.989421964e-01f, 9.996654391e-01f, 9.998942018e-01f, 9.999665618e-01f, -9.923354983e-01f, 2.700984478e-01f, -6.635382771e-01f, -4.828719497e-01f, -1.238837745e-02f, -8.782584071e-01f, 8.442528546e-02f, 6.705908775e-01f, 8.915683031e-01f, 9.652754664e-01f, 9.889753461e-01f, 9.965093136e-01f, 9.988957047e-01f, 9.996507764e-01f, 9.998895526e-01f, 9.999650717e-01f, -6.401443481e-01f, -2.848466039e-01f, -8.632965088e-01f, -6.301599741e-01f, 8.749917150e-02f, -9.037463665e-01f, 5.287845805e-02f, 6.572937369e-01f, 8.869948983e-01f, 9.637911916e-01f, 9.885020852e-01f, 9.963592887e-01f, 9.988481998e-01f, 9.996357560e-01f, 9.998847842e-01f, 9.999635816e-01f, 3.005925417e-01f, -7.520639896e-01f, -9.774427414e-01f, -7.575730681e-01f, 1.865124702e-01f, -9.263771176e-01f, 2.127875760e-02f, 6.437888145e-01f, 8.823328614e-01f, 9.622764587e-01f, 9.880189896e-01f, 9.962061048e-01f, 9.987997413e-01f, 9.996203780e-01f, 9.998799562e-01f, 9.999620318e-01f, 9.649659991e-01f, -9.876590967e-01f, -9.946564436e-01f, -8.610926867e-01f, 2.836622000e-01f, -9.460792542e-01f, -1.034221891e-02f, 6.300802827e-01f, 8.775825500e-01f, 9.607312679e-01f, 9.875259995e-01f, 9.960497618e-01f, 9.987502694e-01f, 9.996047616e-01f, 9.998750091e-01f, 9.999604821e-01f, 7.421541810e-01f, -9.190735221e-01f, -9.132301211e-01f, -9.374542236e-01f, 3.779776692e-01f, -9.627903700e-01f, -4.195285589e-02f, 6.161724925e-01f, 8.727445006e-01f, 9.591556787e-01f, 9.870231748e-01f, 9.958902597e-01f, 9.986997843e-01f, 9.995887876e-01f, 9.998699427e-01f, 9.999588728e-01f, -1.629907787e-01f, -5.674300194e-01f, -7.412399650e-01f, -9.842484593e-01f, 4.685169160e-01f, -9.764577150e-01f, -7.352153957e-02f, 6.020699143e-01f, 8.678191900e-01f, 9.575498104e-01f, 9.865104556e-01f, 9.957276583e-01f, 9.986482859e-01f, 9.995725155e-01f, 9.998648167e-01f, 9.999572635e-01f, -9.182828069e-01f, -4.102819040e-02f, -4.957418144e-01f, -1.000000000e+00f, 5.543745160e-01f, -9.870380163e-01f, -1.050167084e-01f, 5.877769589e-01f, 8.628070951e-01f, 9.559136033e-01f, 9.859878421e-01f, 9.955618382e-01f, 9.985958338e-01f, 9.995558858e-01f, 9.998595715e-01f, 9.999555945e-01f, -8.293098211e-01f, 4.980095923e-01f, -2.010796219e-01f, -9.842120409e-01f, 6.346929669e-01f, -9.944978952e-01f, -1.364068687e-01f, 5.732980371e-01f, 8.577086926e-01f, 9.542471766e-01f, 9.854553938e-01f, 9.953929186e-01f, 9.985423684e-01f, 9.995389581e-01f, 9.998542070e-01f, 9.999538660e-01f, 2.212675661e-02f, 8.836693168e-01f, 1.135217771e-01f, -9.373825192e-01f, 7.086697817e-01f, -9.988136292e-01f, -1.676606387e-01f, 5.586379170e-01f, 8.525245190e-01f, 9.525505900e-01f, 9.849131107e-01f, 9.952208400e-01f, 9.984878898e-01f, 9.995217323e-01f, 9.998487830e-01f, 9.999521971e-01f, 8.532201052e-01f, 9.971746206e-01f, 4.168670774e-01f, -8.609884381e-01f, 7.755658031e-01f, -9.999717474e-01f, -1.987468749e-01f, 5.438010693e-01f, 8.472551107e-01f, 9.508239031e-01f, 9.843609333e-01f, 9.950456619e-01f, 9.984323978e-01f, 9.995042086e-01f, 9.998431802e-01f, 9.999504089e-01f, 8.998668194e-01f, 8.035690784e-01f, 6.788702011e-01f, -7.574391961e-01f, 8.347129226e-01f, -9.979684949e-01f, -2.296342701e-01f, 5.287923217e-01f, 8.419010043e-01f, 9.490671158e-01f, 9.837989211e-01f, 9.948672652e-01f, 9.983759522e-01f, 9.994863272e-01f, 9.998375773e-01f, 9.999486208e-01f, 1.191801354e-01f, 3.624766767e-01f, 8.735505342e-01f, -6.300007105e-01f, 8.855196238e-01f, -9.928101897e-01f, -2.602920532e-01f, 5.136163235e-01f, 8.364626765e-01f, 9.472803473e-01f, 9.832270741e-01f, 9.946857691e-01f, 9.983184934e-01f, 9.994681478e-01f, 9.998317957e-01f, 9.999468327e-01f, -7.710801959e-01f, -1.902491003e-01f, 9.816020727e-01f, -4.826923311e-01f, 9.274784923e-01f, -9.845131636e-01f, -2.906895578e-01f, 4.982779026e-01f, 8.309407234e-01f, 9.454635978e-01f, 9.826454520e-01f, 9.945011139e-01f, 9.982600212e-01f, 9.994496703e-01f, 9.998259544e-01f, 9.999449849e-01f, -9.524129629e-01f, -6.843819022e-01f, 9.923083186e-01f, -3.201591671e-01f, 9.601702690e-01f, -9.731037021e-01f, -3.207964003e-01f, 4.827820361e-01f, 8.253356218e-01f, 9.436169863e-01f, 9.820539355e-01f, 9.943132997e-01f, 9.982005358e-01f, 9.994308352e-01f, 9.998199940e-01f, 9.999430776e-01f, -2.581016421e-01f, -9.677396417e-01f, 9.046075940e-01f, -1.475291997e-01f, 9.832684398e-01f, -9.586178064e-01f, -3.505824506e-01f, 4.671334028e-01f, 8.196480274e-01f, 9.417404532e-01f, 9.814526439e-01f, 9.941223264e-01f, 9.981400967e-01f, 9.994117022e-01f, 9.998139739e-01f, 9.999411702e-01f, 6.735071540e-01f, -9.530500174e-01f, 7.271980643e-01f, 2.975377068e-02f, 9.965420961e-01f, -9.411013126e-01f, -3.800179660e-01f, 4.513370395e-01f, 8.138784766e-01f, 9.398342371e-01f, 9.808415174e-01f, 9.939282537e-01f, 9.980786443e-01f, 9.993922710e-01f, 9.998078346e-01f, 9.999392033e-01f, 9.858965874e-01f, -6.448370218e-01f, 4.776714444e-01f, 2.060983330e-01f, 9.998586178e-01f, -9.206095338e-01f, -4.090735018e-01f, 4.353979528e-01f, 8.080275059e-01f, 9.378982186e-01f, 9.802205563e-01f, 9.937310219e-01f, 9.980161786e-01f, 9.993724823e-01f, 9.998015761e-01f, 9.999372363e-01f };
__constant__ float ROPE_SIN[1024] = { 0.000000000e+00f, 0.000000000e+00f, 0.000000000e+00f, 0.000000000e+00f, 0.000000000e+00f, 0.000000000e+00f, 0.000000000e+00f, 0.000000000e+00f, 0.000000000e+00f, 0.000000000e+00f, 0.000000000e+00f, 0.000000000e+00f, 0.000000000e+00f, 0.000000000e+00f, 0.000000000e+00f, 0.000000000e+00f, 8.414709568e-01f, 5.331684351e-01f, 3.109835982e-01f, 1.768921912e-01f, 9.983342141e-02f, 5.620449781e-02f, 3.161750361e-02f, 1.778185740e-02f, 9.999833070e-03f, 5.623383448e-03f, 3.162272274e-03f, 1.778278500e-03f, 9.999999311e-04f, 5.623412435e-04f, 3.162277571e-04f, 1.778279402e-04f, 9.092974067e-01f, 9.021307230e-01f, 5.911270976e-01f, 3.482052684e-01f, 1.986693293e-01f, 1.122313142e-01f, 6.320339441e-02f, 3.555808961e-02f, 1.999866590e-02f, 1.124658901e-02f, 6.324512884e-03f, 3.556551412e-03f, 1.999998698e-03f, 1.124682371e-03f, 6.324554561e-04f, 3.556558804e-04f, 1.411200017e-01f, 9.932531714e-01f, 8.126488924e-01f, 5.085361004e-01f, 2.955202162e-01f, 1.679033041e-01f, 9.472608566e-02f, 5.332308263e-02f, 2.999549918e-02f, 1.686943881e-02f, 9.486690164e-03f, 5.334813148e-03f, 2.999995602e-03f, 1.687023090e-03f, 9.486831259e-04f, 5.334838061e-04f, -7.568024993e-01f, 7.784717083e-01f, 9.535807371e-01f, 6.528279781e-01f, 3.894183338e-01f, 2.230444849e-01f, 1.261540651e-01f, 7.107120752e-02f, 3.998933360e-02f, 2.249175683e-02f, 1.264877338e-02f, 7.113057654e-03f, 3.999989480e-03f, 2.249363344e-03f, 1.264910679e-03f, 7.113117026e-04f, -9.589242935e-01f, 3.239352703e-01f, 9.999465346e-01f, 7.765299678e-01f, 4.794255495e-01f, 2.774805427e-01f, 1.574558765e-01f, 8.879686147e-02f, 4.997916520e-02f, 2.811336145e-02f, 1.581072807e-02f, 8.891279809e-03f, 4.999979399e-03f, 2.811702900e-03f, 1.581138116e-03f, 8.891395992e-04f, -2.794154882e-01f, -2.303675115e-01f, 9.471482038e-01f, 8.757405281e-01f, 5.646424890e-01f, 3.310393095e-01f, 1.886002719e-01f, 1.064944416e-01f, 5.996400490e-02f, 3.373407945e-02f, 1.897252724e-02f, 1.066947449e-02f, 5.999964196e-03f, 3.374041524e-03f, 1.897365320e-03f, 1.066967379e-03f, 6.569865942e-01f, -7.137212753e-01f, 8.004215956e-01f, 9.473307133e-01f, 6.442176700e-01f, 3.835515678e-01f, 2.195560932e-01f, 1.241583377e-01f, 6.994284689e-02f, 3.935372457e-02f, 2.213413455e-02f, 1.244763471e-02f, 6.999942940e-03f, 3.936378751e-03f, 2.213592408e-03f, 1.244795276e-03f, 9.893582463e-01f, -9.772617817e-01f, 5.743177533e-01f, 9.890424609e-01f, 7.173560858e-01f, 4.348512292e-01f, 2.502923310e-01f, 1.417829692e-01f, 7.991468906e-02f, 4.497213289e-02f, 2.529552206e-02f, 1.422575582e-02f, 7.999914698e-03f, 4.498715047e-03f, 2.529819263e-03f, 1.422623056e-03f, 4.121184945e-01f, -9.398235083e-01f, 2.912592292e-01f, 9.995602965e-01f, 7.833269238e-01f, 4.847761393e-01f, 2.807783186e-01f, 1.593627781e-01f, 8.987854421e-02f, 5.058911815e-02f, 2.845665626e-02f, 1.600383036e-02f, 8.999879472e-03f, 5.061050411e-03f, 2.846045885e-03f, 1.600450720e-03f, -5.440211296e-01f, -6.129369140e-01f, -2.068356983e-02f, 9.785524607e-01f, 8.414709568e-01f, 5.331684351e-01f, 3.109835684e-01f, 1.768921912e-01f, 9.983341396e-02f, 5.620449781e-02f, 3.161750361e-02f, 1.778185740e-02f, 9.999834001e-03f, 5.623383448e-03f, 3.162272274e-03f, 1.778278500e-03f, -9.999902248e-01f, -9.727645665e-02f, -3.305749595e-01f, 9.266815782e-01f, 8.912073970e-01f, 5.798751712e-01f, 3.408778608e-01f, 1.943656504e-01f, 1.097782999e-01f, 6.181810424e-02f, 3.477803990e-02f, 1.955982670e-02f, 1.099977922e-02f, 6.185714621e-03f, 3.478498431e-03f, 1.956106164e-03f, -5.365729332e-01f, 4.483429790e-01f, -6.076834202e-01f, 8.455836177e-01f, 9.320390821e-01f, 6.247486472e-01f, 3.704313040e-01f, 2.117776722e-01f, 1.197122037e-01f, 6.742975861e-02f, 3.793822229e-02f, 2.133773454e-02f, 1.199971233e-02f, 6.748044398e-03f, 3.794723889e-03f, 2.133933594e-03f, 4.201670289e-01f, 8.558809757e-01f, -8.245284557e-01f, 7.378162146e-01f, 9.635581970e-01f, 6.676470041e-01f, 3.996143043e-01f, 2.291227132e-01f, 1.296341419e-01f, 7.303927839e-02f, 4.109803215e-02f, 2.311557345e-02f, 1.299963426e-02f, 7.310371846e-03f, 4.110949114e-03f, 2.311761025e-03f, 9.906073809e-01f, 9.998233318e-01f, -9.596053958e-01f, 6.067785621e-01f, 9.854497313e-01f, 7.084347010e-01f, 4.283977747e-01f, 2.463953048e-01f, 1.395431161e-01f, 7.864648104e-02f, 4.425742477e-02f, 2.489333972e-02f, 1.399954315e-02f, 7.872696966e-03f, 4.427174106e-03f, 2.489588689e-03f, 6.502878666e-01f, 8.358384371e-01f, -9.995186925e-01f, 4.566032588e-01f, 9.974949956e-01f, 7.469826341e-01f, 4.567528665e-01f, 2.635899782e-01f, 1.494381279e-01f, 8.425120264e-02f, 4.741638154e-02f, 2.667102963e-02f, 1.499943808e-02f, 8.435020223e-03f, 4.743398633e-03f, 2.667415887e-03f, -2.879033089e-01f, 4.144302309e-01f, -9.403103590e-01f, 2.920270860e-01f, 9.995735884e-01f, 7.831690907e-01f, 4.846512377e-01f, 2.807013094e-01f, 1.593182087e-01f, 8.985326439e-02f, 5.057485774e-02f, 2.844863199e-02f, 1.599931903e-02f, 8.997339755e-03f, 5.059622694e-03f, 2.845243318e-03f, -9.613974690e-01f, -1.346151382e-01f, -7.878518701e-01f, 1.182405204e-01f, 9.916648269e-01f, 8.168795705e-01f, 5.120649934e-01f, 2.977238595e-01f, 1.691823453e-01f, 9.545248002e-02f, 5.373282731e-02f, 3.022614494e-02f, 1.699918136e-02f, 9.559656493e-03f, 5.375845823e-03f, 3.023070283e-03f, -7.509872317e-01f, -6.422007084e-01f, -5.572628975e-01f, -5.927551910e-02f, 9.738476276e-01f, 8.480075598e-01f, 5.389667153e-01f, 3.146522641e-01f, 1.790295690e-01f, 1.010486856e-01f, 5.689026415e-02f, 3.200356290e-02f, 1.799902879e-02f, 1.012197044e-02f, 5.692068953e-03f, 3.200897481e-03f, 1.498772055e-01f, -9.520008564e-01f, -2.714101076e-01f, -2.349217981e-01f, 9.463000894e-01f, 8.764545321e-01f, 5.653295517e-01f, 3.314811885e-01f, 1.888588965e-01f, 1.066416800e-01f, 6.004713103e-02f, 3.378088027e-02f, 1.899885759e-02f, 1.068428159e-02f, 6.008291151e-03f, 3.378724447e-03f, 9.129452705e-01f, -9.686019421e-01f, 4.135828838e-02f, -4.031589925e-01f, 9.092974067e-01f, 9.021307230e-01f, 5.911270380e-01f, 3.482052684e-01f, 1.986693144e-01f, 1.122313142e-01f, 6.320339441e-02f, 3.555808961e-02f, 1.999866776e-02f, 1.124658901e-02f, 6.324512884e-03f, 3.556551412e-03f, 8.366556168e-01f, -6.868911982e-01f, 3.500247598e-01f, -5.586805344e-01f, 8.632093072e-01f, 9.249548316e-01f, 6.163335443e-01f, 3.648192585e-01f, 2.084598988e-01f, 1.178173944e-01f, 6.635902822e-02f, 3.733518720e-02f, 2.099845745e-02f, 1.180889271e-02f, 6.640734151e-03f, 3.734378144e-03f, -8.851309307e-03f, -1.936302334e-01f, 6.239799261e-01f, -6.965817213e-01f, 8.084963560e-01f, 9.448547959e-01f, 6.409237385e-01f, 3.813178837e-01f, 2.182296216e-01f, 1.233997419e-01f, 6.951400638e-02f, 3.911216930e-02f, 2.199822664e-02f, 1.237119269e-02f, 6.956954487e-03f, 3.912204877e-03f, -8.462204337e-01f, 3.592645228e-01f, 8.360552788e-01f, -8.125128746e-01f, 7.457052469e-01f, 9.617676139e-01f, 6.648730636e-01f, 3.976959288e-01f, 2.279775143e-01f, 1.289781928e-01f, 7.266827673e-02f, 4.088902473e-02f, 2.299797349e-02f, 1.293348987e-02f, 7.273174357e-03f, 4.090031609e-03f, -9.055783749e-01f, 8.015131354e-01f, 9.652192593e-01f, -9.028177857e-01f, 6.754631400e-01f, 9.756398797e-01f, 6.881574988e-01f, 4.139482081e-01f, 2.377026230e-01f, 1.345525682e-01f, 7.582182437e-02f, 4.266574979e-02f, 2.399769612e-02f, 1.349578146e-02f, 7.589393295e-03f, 4.267857410e-03f, -1.323517561e-01f, 9.969099760e-01f, 9.986631870e-01f, -9.646483064e-01f, 5.984721184e-01f, 9.864277244e-01f, 7.107539177e-01f, 4.300695956e-01f, 2.474039644e-01f, 1.401226968e-01f, 7.897461206e-02f, 4.444234073e-02f, 2.499739639e-02f, 1.405806933e-02f, 7.905611768e-03f, 4.445684142e-03f, 7.625584602e-01f, 8.852767944e-01f, 9.330701828e-01f, -9.960543513e-01f, 5.155012608e-01f, 9.940969944e-01f, 7.326396108e-01f, 4.460549951e-01f, 2.570805550e-01f, 1.456883848e-01f, 8.212661743e-02f, 4.621879384e-02f, 2.599707060e-02f, 1.462035347e-02f, 8.221829310e-03f, 4.623509943e-03f, 9.563759565e-01f, 5.009942055e-01f, 7.749450207e-01f, -9.960451722e-01f, 4.273798466e-01f, 9.986234903e-01f, 7.537927032e-01f, 4.618993104e-01f, 2.667314112e-01f, 1.512494683e-01f, 8.527779579e-02f, 4.799510166e-02f, 2.699672058e-02f, 1.518263202e-02f, 8.538045920e-03f, 4.801335745e-03f, 2.709057927e-01f, -3.758566082e-02f, 5.399689674e-01f, -9.646213055e-01f, 3.349882066e-01f, 9.999929070e-01f, 7.741920948e-01f, 4.775975943e-01f, 2.763556540e-01f, 1.568057537e-01f, 8.842811733e-02f, 4.977125302e-02f, 2.799634263e-02f, 1.574490592e-02f, 8.854261599e-03f, 4.979162011e-03f, -6.636338830e-01f, -5.645897985e-01f, 2.514453232e-01f, -9.027736783e-01f, 2.392492294e-01f, 9.982009530e-01f, 7.938174009e-01f, 4.931448400e-01f, 2.859522104e-01f, 1.623570919e-01f, 9.157756716e-02f, 5.154724792e-02f, 2.899593674e-02f, 1.630717516e-02f, 9.170476347e-03f, 5.156987347e-03f, -9.880316257e-01f, -9.177096486e-01f, -6.201484054e-02f, -8.124528527e-01f, 1.411200017e-01f, 9.932531714e-01f, 8.126488924e-01f, 5.085361004e-01f, 2.955201864e-01f, 1.679033041e-01f, 9.472609311e-02f, 5.332308263e-02f, 2.999550104e-02f, 1.686943881e-02f, 9.486690164e-03f, 5.334813148e-03f, -4.040376544e-01f, -9.881927967e-01f, -3.693250120e-01f, -6.965078115e-01f, 4.158052057e-02f, 9.851652980e-01f, 8.306677938e-01f, 5.237666368e-01f, 3.050586283e-01f, 1.734442115e-01f, 9.787366539e-02f, 5.509874597e-02f, 3.099503554e-02f, 1.743169688e-02f, 9.802903049e-03f, 5.512638018e-03f, 5.514267087e-01f, -7.543302178e-01f, -6.400094032e-01f, -5.585952997e-01f, -5.837419257e-02f, 9.739628434e-01f, 8.478561044e-01f, 5.388315320e-01f, 3.145665526e-01f, 1.789796203e-01f, 1.010202691e-01f, 5.687423423e-02f, 3.199454024e-02f, 1.799395122e-02f, 1.011911593e-02f, 5.690463353e-03f, 9.999118447e-01f, -2.881473899e-01f, -8.472243547e-01f, -4.030649364e-01f, -1.577456445e-01f, 9.596813321e-01f, 8.641966581e-01f, 5.537260175e-01f, 3.240430057e-01f, 1.845093668e-01f, 1.041658595e-01f, 5.864954367e-02f, 3.299400955e-02f, 1.855619811e-02f, 1.043532696e-02f, 5.868288688e-03f, 5.290827155e-01f, 2.667797208e-01f, -9.704204202e-01f, -2.348221242e-01f, -2.555412054e-01f, 9.423658252e-01f, 8.796730638e-01f, 5.684453845e-01f, 3.334870934e-01f, 1.900332868e-01f, 1.073104069e-01f, 6.042466685e-02f, 3.399345279e-02f, 1.911843941e-02f, 1.075153705e-02f, 6.046113092e-03f, -4.281826615e-01f, 7.395421267e-01f, -9.973804355e-01f, -5.917267874e-02f, -3.507832289e-01f, 9.220710397e-01f, 8.942698836e-01f, 5.829849839e-01f, 3.428978026e-01f, 1.955512017e-01f, 1.104538813e-01f, 6.219960377e-02f, 3.499285504e-02f, 1.968067512e-02f, 1.106774528e-02f, 6.223937962e-03f, -9.917788506e-01f, 9.845405817e-01f, -9.254310131e-01f, 1.183425859e-01f, -4.425205588e-01f, 8.988611698e-01f, 9.079725146e-01f, 5.973402858e-01f, 3.522742093e-01f, 2.010629177e-01f, 1.135962531e-01f, 6.397433579e-02f, 3.599222749e-02f, 2.024290524e-02f, 1.138395350e-02f, 6.401761901e-03f, -6.435381174e-01f, 9.263181090e-01f, -7.617069483e-01f, 2.921253741e-01f, -5.298361778e-01f, 8.728095889e-01f, 9.207672477e-01f, 6.115067005e-01f, 3.616154492e-01f, 2.065682709e-01f, 1.167374924e-01f, 6.574887782e-02f, 3.699155897e-02f, 2.080512606e-02f, 1.170015987e-02f, 6.579586305e-03f, 2.963685691e-01f, 5.828061700e-01f, -5.224447846e-01f, 4.566946924e-01f, -6.118578315e-01f, 8.439987302e-01f, 9.326412678e-01f, 6.254796982e-01f, 3.709204793e-01f, 2.120671123e-01f, 1.198775545e-01f, 6.752320379e-02f, 3.799085692e-02f, 2.136734314e-02f, 1.201636530e-02f, 6.757410709e-03f, 9.637953639e-01f, 5.980031565e-02f, -2.313720137e-01f, 6.068604589e-01f, -6.877662539e-01f, 8.125196099e-01f, 9.435827136e-01f, 6.392549276e-01f, 3.801884055e-01f, 2.175592482e-01f, 1.230164245e-01f, 6.929731369e-02f, 3.899011388e-02f, 2.192955278e-02f, 1.233256981e-02f, 6.935234182e-03f, 7.451131344e-01f, -4.816212952e-01f, 8.264580369e-02f, 7.378857136e-01f, -7.568024993e-01f, 7.784717083e-01f, 9.535806775e-01f, 6.528279781e-01f, 3.894183338e-01f, 2.230444849e-01f, 1.261540651e-01f, 7.107120752e-02f, 3.998933733e-02f, 2.249175683e-02f, 1.264877338e-02f, 7.113057654e-03f, -1.586226672e-01f, -8.747140169e-01f, 3.884676993e-01f, 8.456384540e-01f, -8.182770610e-01f, 7.419627905e-01f, 9.626252055e-01f, 6.661946774e-01f, 3.986093104e-01f, 2.285226882e-01f, 1.292904317e-01f, 7.284487784e-02f, 4.098851606e-02f, 2.305394970e-02f, 1.296497509e-02f, 7.290880661e-03f, -9.165215492e-01f, -9.984104633e-01f, 6.557646990e-01f, 9.267202020e-01f, -8.715758920e-01f, 7.031081319e-01f, 9.707071185e-01f, 6.793506742e-01f, 4.077604413e-01f, 2.339936644e-01f, 1.324255317e-01f, 7.461831719e-02f, 4.198765755e-02f, 2.361613885e-02f, 1.328117587e-02f, 7.468704134e-03f, -8.317747712e-01f, -8.146142364e-01f, 8.580306768e-01f, 9.785736203e-01f, -9.161660075e-01f, 6.620306373e-01f, 9.778184295e-01f, 6.922917962e-01f, 4.168707728e-01f, 2.394572198e-01f, 1.355592906e-01f, 7.639151812e-02f, 4.298675060e-02f, 2.417832054e-02f, 1.359737478e-02f, 7.646527141e-03f, 1.770192571e-02f, -3.799313903e-01f, 9.752061963e-01f, 9.995633960e-01f, -9.516021013e-01f, 6.188601851e-01f, 9.839519858e-01f, 7.050140500e-01f, 4.259394705e-01f, 2.449132055e-01f, 1.386916935e-01f, 7.816448808e-02f, 4.398580641e-02f, 2.474049293e-02f, 1.391357277e-02f, 7.824349217e-03f, 8.509035110e-01f, 1.717635691e-01f, 9.956709743e-01f, 9.890272617e-01f, -9.775301218e-01f, 5.737332702e-01f, 9.891016483e-01f, 7.175133228e-01f, 4.349655211e-01f, 2.503614724e-01f, 1.418227106e-01f, 7.993719727e-02f, 4.498481750e-02f, 2.530265786e-02f, 1.422976889e-02f, 8.002171293e-03f, 9.017883539e-01f, 6.705570221e-01f, 9.173954725e-01f, 9.472977519e-01f, -9.936909676e-01f, 5.267925262e-01f, 9.932623506e-01f, 7.297857404e-01f, 4.439480901e-01f, 2.558017969e-01f, 1.449523121e-01f, 8.170966059e-02f, 4.598378390e-02f, 2.586481534e-02f, 1.454596408e-02f, 8.179994300e-03f, 1.235731244e-01f, 9.628326893e-01f, 7.481423616e-01f, 8.756909966e-01f, -9.999232888e-01f, 4.781863391e-01f, 9.964298010e-01f, 7.418274283e-01f, 4.528862834e-01f, 2.612340748e-01f, 1.480804533e-01f, 8.348185569e-02f, 4.698270187e-02f, 2.642696351e-02f, 1.486215740e-02f, 8.357816376e-03f, -7.682546377e-01f, 9.585731030e-01f, 5.046970844e-01f, 7.764653563e-01f, -9.961646199e-01f, 4.280683994e-01f, 9.986009598e-01f, 7.536345124e-01f, 4.617791772e-01f, 2.666580379e-01f, 1.512071192e-01f, 8.525379747e-02f, 4.798157141e-02f, 2.698910423e-02f, 1.517834887e-02f, 8.535637520e-03f, -9.537526369e-01f, 6.590901017e-01f, 2.112006545e-01f, 6.527503729e-01f, -9.824525714e-01f, 3.765971363e-01f, 9.997735620e-01f, 7.652031779e-01f, 4.706258774e-01f, 2.720735669e-01f, 1.543322802e-01f, 8.702547103e-02f, 4.898039624e-02f, 2.755123749e-02f, 1.549453940e-02f, 8.713459596e-03f, -2.623748481e-01f, 1.566190720e-01f, -1.032404602e-01f, 5.084479451e-01f, -9.589242935e-01f, 3.239352703e-01f, 9.999465346e-01f, 7.765299678e-01f, 4.794255495e-01f, 2.774805427e-01f, 1.574558914e-01f, 8.879686147e-02f, 4.997916892e-02f, 2.811335959e-02f, 1.581072807e-02f, 8.891279809e-03f, 6.702291965e-01f, -3.940860629e-01f, -4.074441493e-01f, 3.481085002e-01f, -9.258147478e-01f, 2.702493370e-01f, 9.991195798e-01f, 7.876111865e-01f, 4.881772399e-01f, 2.828786969e-01f, 1.605779380e-01f, 9.056797624e-02f, 5.097789690e-02f, 2.867547423e-02f, 1.612691768e-02f, 9.069100954e-03f, 9.866275787e-01f, -8.234215975e-01f, -6.712401509e-01f, 1.767906845e-01f, -8.834545016e-01f, 2.157090008e-01f, 9.972936511e-01f, 7.984433770e-01f, 4.968801141e-01f, 2.882679403e-01f, 1.636983752e-01f, 9.233880043e-02f, 5.197656900e-02f, 2.923758142e-02f, 1.644310169e-02f, 9.246920235e-03f, 3.959251642e-01f, -9.991579652e-01f, -8.684699535e-01f, -1.030206768e-04f, -8.322673440e-01f, 1.604867280e-01f, 9.944704771e-01f, 8.090230227e-01f, 5.055333376e-01f, 2.936480343e-01f, 1.668171734e-01f, 9.410934150e-02f, 5.297519267e-02f, 2.979967557e-02f, 1.675928757e-02f, 9.424741380e-03f, -5.587890744e-01f, -8.671715260e-01f, -9.795749187e-01f, -1.769934744e-01f, -7.727644444e-01f, 1.047568321e-01f, 9.906529188e-01f, 8.193469048e-01f, 5.141359568e-01f, 2.990188897e-01f, 1.699342877e-01f, 9.587957710e-02f, 5.397376046e-02f, 3.036176413e-02f, 1.707546785e-02f, 9.602561593e-03f, -9.997551441e-01f, -4.681116641e-01f, -9.935355186e-01f, -3.483016491e-01f, -7.055402994e-01f, 4.869600013e-02f, 9.858447909e-01f, 8.294116855e-01f, 5.226872563e-01f, 3.043802381e-01f, 1.730497181e-01f, 9.764950722e-02f, 5.497227982e-02f, 3.092384152e-02f, 1.739165001e-02f, 9.780380875e-03f, -5.215510130e-01f, 7.511820644e-02f, -9.089674354e-01f, -5.086245537e-01f, -6.312667131e-01f, -7.518785074e-03f, 9.800508618e-01f, 8.392141461e-01f, 5.311862230e-01f, 3.097319603e-01f, 1.761634201e-01f, 9.941913933e-02f, 5.597073585e-02f, 3.148590773e-02f, 1.770782843e-02f, 9.958200157e-03f, 4.361647666e-01f, 5.952115059e-01f, -7.342582941e-01f, -6.529057026e-01f, -5.506852865e-01f, -6.370979548e-02f, 9.732769728e-01f, 8.487512469e-01f, 5.396320224e-01f, 3.150739372e-01f, 1.792753637e-01f, 1.011884511e-01f, 5.696914345e-02f, 3.204796836e-02f, 1.802400686e-02f, 1.013601944e-02f, 9.928726554e-01f, 9.319928288e-01f, -4.867334962e-01f, -7.765945792e-01f, -4.646020234e-01f, -1.196993962e-01f, 9.655299187e-01f, 8.580200076e-01f, 5.480239391e-01f, 3.204059005e-01f, 1.823855042e-01f, 1.029574350e-01f, 5.796748772e-02f, 3.261001408e-02f, 1.834018156e-02f, 1.031383779e-02f, 6.367380023e-01f, 9.817358255e-01f, -1.909380108e-01f, -8.757900000e-01f, -3.738765717e-01f, -1.753105819e-01f, 9.568174481e-01f, 8.670173883e-01f, 5.563610196e-01f, 3.257277906e-01f, 1.854938269e-01f, 1.047261059e-01f, 5.896577984e-02f, 3.317204863e-02f, 1.865635626e-02f, 1.049165614e-02f, -3.048106134e-01f, 7.291237116e-01f, 1.237909496e-01f, -9.473637342e-01f, -2.794154882e-01f, -2.303675115e-01f, 9.471482038e-01f, 8.757405281e-01f, 5.646424294e-01f, 3.310393095e-01f, 1.886002868e-01f, 1.064944416e-01f, 5.996400863e-02f, 3.373407945e-02f, 1.897252724e-02f, 1.066947449e-02f, -9.661177993e-01f, 2.519522607e-01f, 4.262454212e-01f, -9.890577197e-01f, -1.821625978e-01f, -2.846961617e-01f, 9.365318418e-01f, 8.841868639e-01f, 5.728674531e-01f, 3.363404274e-01f, 1.917048544e-01f, 1.082624346e-01f, 6.096218154e-02f, 3.429609165e-02f, 1.928869821e-02f, 1.084729191e-02f, -7.391806841e-01f, -3.028128743e-01f, 6.864276528e-01f, -9.995572567e-01f, -8.308912069e-02f, -3.381247520e-01f, 9.249790907e-01f, 8.923535347e-01f, 5.810351372e-01f, 3.416308761e-01f, 1.948075294e-01f, 1.100300923e-01f, 6.196028739e-02f, 3.485809639e-02f, 1.960486546e-02f, 1.102510840e-02f, 1.673557013e-01f, -7.643200755e-01f, 8.785385489e-01f, -9.785313010e-01f, 1.681409031e-02f, -3.904843926e-01f, 9.125014544e-01f, 9.002380967e-01f, 5.891447663e-01f, 3.469105363e-01f, 1.979082376e-01f, 1.117973924e-01f, 6.295833737e-02f, 3.542009369e-02f, 1.992103085e-02f, 1.120292582e-02f };

#define LAS __attribute__((address_space(3)))
typedef unsigned short bf16;
typedef float f32x4 __attribute__((ext_vector_type(4)));
typedef float f32x2 __attribute__((ext_vector_type(2)));
typedef float f32x16 __attribute__((ext_vector_type(16)));
typedef short bf16x8 __attribute__((ext_vector_type(8)));
typedef short s16x4 __attribute__((ext_vector_type(4)));
typedef unsigned u32x4 __attribute__((ext_vector_type(4)));
typedef unsigned u32x2 __attribute__((ext_vector_type(2)));

constexpr int DM = 2048, NB = 8, SEQ = 2048, CTX = 256, DEPTH = 2;
constexpr int NLAT = NB * SEQ, NCTX = NB * CTX, NROW = NLAT + NCTX;
constexpr int INC = 5888, NEXP = 16, EFF = 1024, ADAW = 6 * DM;
constexpr int ZC_RQ = 0, ZC_RK = 512, ZC_RV = 1024, ZC_RG = 1536, ZC_CB = 2048, ZC_CC = 2560, ZC_CH = 3072, ZC_SQ = 3584, ZC_SK = 4096, ZC_SV = 4224, ZC_NQ = 4352, ZC_NK = 4864, ZC_NV = 5376;
constexpr int YC_RET = 0, YC_CONV = 512, YC_SWA = 1024, YC_NA = 1536;
constexpr float LOG2E = 1.4426950408889634f;
constexpr float RMS_EPS = 1e-6f;
constexpr int NWAVES = 8, NTHR = 512;

constexpr size_t MiB = (size_t)1 << 20;
constexpr size_t WS_CTL = 0, CTL_ZERO_BYTES = 1 * MiB;
constexpr size_t WS_ADA = 1 * MiB;
constexpr size_t WS_AFF = 2 * MiB;
constexpr size_t WS_SEL = 4 * MiB;
constexpr size_t WS_IDX = 6 * MiB;
constexpr size_t WS_GATEV = 6 * MiB + 256 * 1024;
constexpr size_t WS_WIN = 8 * MiB;
constexpr size_t WS_WOUT = 54 * MiB;
constexpr size_t WS_WGU = 70 * MiB;
constexpr size_t WS_WD = 326 * MiB;
constexpr size_t WS_XC = 454 * MiB;
constexpr size_t WS_HB = 470 * MiB;
constexpr size_t WS_Z = 542 * MiB;
constexpr size_t WS_ACT = 749 * MiB;
constexpr size_t WS_SST = 821 * MiB;
constexpr size_t WS_SIN = 857 * MiB;
constexpr size_t WS_XB = 876 * MiB;
constexpr size_t WS_END = 948 * MiB;
constexpr int CW_BAR = 4096;

constexpr int LDS_BYTES = 147456;
constexpr int MISC_OFF = 131072 + 320;
constexpr int ROPE_LDS = 131072 + 8192;

struct Params {
    const float* x; const float* c; const float* ctx; const float* c_ctx; const float* w_ada; const float* b_ada; const float* norm_mix; const float* norm_ffn;
    const float* w_in; const float* w_out; const float* dec_f; const float* dec_b; const float* conv_w; const float* sink; const float* rpb; const float* w_router;
    const float* w_gate; const float* w_up; const float* w_down; const float* norm_final;
    float* out; unsigned char* ws;
};

__device__ __forceinline__ float bf2f(unsigned v) { return __uint_as_float(v << 16); }
__device__ __forceinline__ unsigned f2bf(float f) { unsigned u = __float_as_uint(f); return (u + 0x7fffu + ((u >> 16) & 1u)) >> 16; }
__device__ __forceinline__ unsigned pk2(float lo, float hi) { unsigned r; asm volatile("v_cvt_pk_bf16_f32 %0, %1, %2" : "=v"(r) : "v"(lo), "v"(hi)); return r; }
__device__ __forceinline__ float ex2(float x) { return __builtin_amdgcn_exp2f(x); }
__device__ __forceinline__ float wave_sum(float v) {
#pragma unroll
    for (int o = 1; o < 64; o <<= 1) v += __shfl_xor(v, o);
    return v;
}
__device__ __forceinline__ float half_sum32(float v) {
#pragma unroll
    for (int o = 1; o < 32; o <<= 1) v += __shfl_xor(v, o);
    return v;
}
__device__ __forceinline__ float silu_f(float x) { return x / (1.f + __expf(-x)); }
__device__ __forceinline__ int crow(int r, int hi) { return (r & 3) + 8 * (r >> 2) + 4 * hi; }
#define MFMA32(a, b, c) __builtin_amdgcn_mfma_f32_32x32x16_bf16((a), (b), (c), 0, 0, 0)
#define LDS_WAIT() asm volatile("s_waitcnt lgkmcnt(0)" ::: "memory")
typedef short v4i16_t __attribute__((ext_vector_type(4)));
__device__ __forceinline__ s16x4 trrd(LAS const unsigned char* p) { return __builtin_bit_cast(s16x4, __builtin_amdgcn_ds_read_tr16_b64_v4i16((LAS v4i16_t*)p)); }
__device__ __forceinline__ bf16x8 cat8(s16x4 lo, s16x4 hi) { return (bf16x8){lo[0], lo[1], lo[2], lo[3], hi[0], hi[1], hi[2], hi[3]}; }
__device__ __forceinline__ u32x4 scale8(u32x4 v, float s) {
    u32x4 r;
#pragma unroll
    for (int i = 0; i < 4; ++i) r[i] = pk2(bf2f(v[i] & 0xffffu) * s, __uint_as_float(v[i] & 0xffff0000u) * s);
    return r;
}

__device__ __forceinline__ float* ws_ada(const Params& p) { return (float*)(p.ws + WS_ADA); }
__device__ __forceinline__ bf16* ws_z(const Params& p) { return (bf16*)(p.ws + WS_Z); }
__device__ __forceinline__ bf16* ws_hb(const Params& p) { return (bf16*)(p.ws + WS_HB); }
constexpr int KVH_ROWS = SEQ + CTX;
__device__ __forceinline__ bf16* ws_kvh(const Params& p) { return (bf16*)(p.ws + WS_ACT); }
__device__ __forceinline__ size_t kvh_off(int kind, int b, int h) { return (size_t)((kind * NB + b) * 8 + h) * KVH_ROWS * 64; }
__device__ __forceinline__ bf16* ws_xb(const Params& p) { return (bf16*)(p.ws + WS_XB); }

namespace pg8 {
struct GroupedOrder {
    StaticOrder S; int tpe;
    __device__ void init(int tpe_, int G_, int c_) { tpe = tpe_; S.init(16 * tpe_ * BM, 8 * BM, G_, c_); }
    __device__ bool next(int i, Unit& u) const { if (!S.next(i, u)) return false; u.pb = (u.pm / tpe) * 8 + u.pn; return true; }
    __device__ __forceinline__ void a_ready(const Unit&) const {}
    __device__ __forceinline__ void done(const Unit&) const {}
};
struct SkipOrder {
    StaticOrder S; int G, c;
    __device__ void init(int G_, int c_) { S.init(16384, 5888, G_, c_); G = G_; c = c_; }
    __device__ bool next(int i, Unit& u) const {
        if (S.next(i, u)) return true;
        const int j = i * G + c - 64 * 23; if (j < 0 || j >= 64) return false;
        const int t = j >> 3; u.pm = 64 + (j & 7); u.pn = t < 4 ? 2 + t : (t == 4 ? 16 : 14 + t); u.pb = u.pn; return true;
    }
    __device__ __forceinline__ void a_ready(const Unit&) const {}
    __device__ __forceinline__ void done(const Unit&) const {}
};
struct QuadOrder {
    int G, c;
    __device__ void init(int G_, int c_) { G = G_; c = c_; }
    __device__ bool next(int i, Unit& u) const {
        const int x = i * G + c; if (x >= 32) return false;
        u.pm = 64 + (x >> 2); u.pn = 22; u.pb = 22; u.q = x & 3; return true;
    }
    __device__ __forceinline__ void a_ready(const Unit&) const {}
    __device__ __forceinline__ void done(const Unit&) const {}
};
template <bool BASE_F32> struct EpiResGate {
    static constexpr bool PERM = true, AFTER_DRAIN = false;
    const float* base_lat; const float* base_ctx; bf16_t* xb; const float* ada; int goff;
    __device__ __forceinline__ void operator()(const f32x4 (&acc)[2][2][4][2], const Unit& u, int wr, int wc, int fr, int fq) const {
        const bool isctx = u.pm >= 64;
        const int grow = isctx ? 8 : (u.pm >> 3);
        const float* g = ada + grow * 12288 + goff;
        const float* basef = isctx ? base_ctx - (size_t)64 * BM * 2048 : base_lat;
        const int row0 = u.pm * BM + wr * 64 + fr, col0 = u.pn * BM + wc * 32 + 8 * fq;
        f32x4 gv[2][2];
#pragma unroll
        for (int bj = 0; bj < 2; ++bj)
#pragma unroll
            for (int n = 0; n < 2; ++n) gv[bj][n] = *(const f32x4*)(g + col0 + bj * HALF + 4 * n);
#pragma unroll
        for (int ai = 0; ai < 2; ++ai)
#pragma unroll
            for (int m = 0; m < 4; ++m) { const size_t off = (size_t)(row0 + ai * HALF + m * 16) * 2048 + col0;
#pragma unroll
                for (int bj = 0; bj < 2; ++bj) { f32x4 b0, b1;
                    if constexpr (BASE_F32) { b0 = *(const f32x4*)(basef + off + bj * HALF); b1 = *(const f32x4*)(basef + off + bj * HALF + 4); }
                    else { const u32x4 w = *(const u32x4*)(xb + off + bj * HALF);
                        b0 = (f32x4){__uint_as_float(w.x << 16), __uint_as_float(w.x & 0xffff0000u), __uint_as_float(w.y << 16), __uint_as_float(w.y & 0xffff0000u)};
                        b1 = (f32x4){__uint_as_float(w.z << 16), __uint_as_float(w.z & 0xffff0000u), __uint_as_float(w.w << 16), __uint_as_float(w.w & 0xffff0000u)}; }
                    const f32x4 v0 = b0 + gv[bj][0] * acc[ai][bj][m][0], v1 = b1 + gv[bj][1] * acc[ai][bj][m][1];
                    u32x4 o; o.x = cvt_pk_bf16(v0[0], v0[1]); o.y = cvt_pk_bf16(v0[2], v0[3]); o.z = cvt_pk_bf16(v1[0], v1[1]); o.w = cvt_pk_bf16(v1[2], v1[3]);
                    *(u32x4*)(xb + off + bj * HALF) = o; }
                asm volatile("" ::: "memory"); }
    }
};
struct EpiSiluMul {
    static constexpr bool PERM = true, AFTER_DRAIN = false;
    bf16_t* O;
    __device__ __forceinline__ void operator()(const f32x4 (&acc)[2][2][4][2], const Unit& u, int wr, int wc, int fr, int fq) const {
        const int row0 = u.pm * BM + wr * 64 + fr, col0 = u.pn * HALF + wc * 32 + 8 * fq;
#pragma unroll
        for (int ai = 0; ai < 2; ++ai)
#pragma unroll
            for (int m = 0; m < 4; ++m) { bf16_t* rowp = O + (size_t)(row0 + ai * HALF + m * 16) * 1024 + col0;
                float v[8];
#pragma unroll
                for (int n = 0; n < 2; ++n)
#pragma unroll
                    for (int j = 0; j < 4; ++j) { const float gg = acc[ai][0][m][n][j], uu = acc[ai][1][m][n][j]; v[n * 4 + j] = gg * __builtin_amdgcn_rcpf(1.f + __builtin_amdgcn_exp2f(-gg * 1.4426950408889634f)) * uu; }
                u32x4 w; w.x = cvt_pk_bf16(v[0], v[1]); w.y = cvt_pk_bf16(v[2], v[3]); w.z = cvt_pk_bf16(v[4], v[5]); w.w = cvt_pk_bf16(v[6], v[7]);
                *(u32x4*)rowp = w; }
    }
};
struct EpiDown {
    static constexpr bool PERM = true, AFTER_DRAIN = false;
    bf16_t* O; const float* gatev;
    __device__ __forceinline__ void operator()(const f32x4 (&acc)[2][2][4][2], const Unit& u, int wr, int wc, int fr, int fq) const {
        const int row0 = u.pm * BM + wr * 64 + fr, col0 = u.pn * BM + wc * 32 + 8 * fq;
        float sg[2][4];
#pragma unroll
        for (int ai = 0; ai < 2; ++ai)
#pragma unroll
            for (int m = 0; m < 4; ++m) sg[ai][m] = gatev[row0 + ai * HALF + m * 16];
#pragma unroll
        for (int ai = 0; ai < 2; ++ai)
#pragma unroll
            for (int m = 0; m < 4; ++m) { const int row = row0 + ai * HALF + m * 16; const float s = sg[ai][m]; bf16_t* rowp = O + (size_t)row * 2048 + col0;
#pragma unroll
                for (int bj = 0; bj < 2; ++bj) { const f32x4 v0 = acc[ai][bj][m][0] * s, v1 = acc[ai][bj][m][1] * s;
                    u32x4 w; w.x = cvt_pk_bf16(v0[0], v0[1]); w.y = cvt_pk_bf16(v0[2], v0[3]); w.z = cvt_pk_bf16(v1[0], v1[1]); w.w = cvt_pk_bf16(v1[2], v1[3]);
                    *(u32x4*)(rowp + bj * HALF) = w; } }
    }
};
struct EpiZRope {
    static constexpr bool PERM = true, AFTER_DRAIN = false;
    bf16_t* O; LAS const float* rcos; LAS const float* rsin; bf16_t* KV;
    __device__ __forceinline__ void quad(const f32x4 (&a)[4][2], const Unit& u, int wr, int wc, int fr, int fq) const {
        const int ai = u.q >> 1, bj = u.q & 1, tile = u.pn;
        const int b = (u.pm < 64) ? (u.pm >> 3) : (u.pm - 64), rloc0 = ((u.pm < 64) ? (u.pm & 7) * 256 : 2048) + wr * 64 + fr + ai * HALF;
        const int c = (tile - 19) * BM + wc * 32 + 8 * fq + bj * HALF;
        bf16_t* hp = KV + ((size_t)(((c >> 9) * 8 + b) * 8 + ((c >> 6) & 7)) * 2304 + rloc0) * 64 + (c & 63);
#pragma unroll
        for (int m = 0; m < 4; ++m) { const f32x4 v0 = a[m][0], v1 = a[m][1];
            u32x4 w; w.x = cvt_pk_bf16(v0[0], v0[1]); w.y = cvt_pk_bf16(v0[2], v0[3]); w.z = cvt_pk_bf16(v1[0], v1[1]); w.w = cvt_pk_bf16(v1[2], v1[3]);
            *(u32x4*)(hp + (m * 16) * 64) = w; }
    }
    __device__ __forceinline__ void operator()(const f32x4 (&acc)[2][2][4][2], const Unit& u, int wr, int wc, int fr, int fq) const {
        const int row0 = u.pm * BM + wr * 64 + fr, tile = u.pn;
        const bool rtile = (tile < 4) || (tile >= 14 && tile <= 16);
        if (tile >= 19) {
            const int b = (u.pm < 64) ? (u.pm >> 3) : (u.pm - 64), rloc0 = ((u.pm < 64) ? (u.pm & 7) * 256 : 2048) + wr * 64 + fr;
#pragma unroll
            for (int bj = 0; bj < 2; ++bj) { const int c = (tile - 19) * BM + wc * 32 + 8 * fq + bj * HALF;
                bf16_t* hp = KV + ((size_t)(((c >> 9) * 8 + b) * 8 + ((c >> 6) & 7)) * 2304 + rloc0) * 64 + (c & 63);
#pragma unroll
                for (int ai = 0; ai < 2; ++ai) {
#pragma unroll
                    for (int m = 0; m < 4; ++m) { const f32x4 v0 = acc[ai][bj][m][0], v1 = acc[ai][bj][m][1];
                        u32x4 w; w.x = cvt_pk_bf16(v0[0], v0[1]); w.y = cvt_pk_bf16(v0[2], v0[3]); w.z = cvt_pk_bf16(v1[0], v1[1]); w.w = cvt_pk_bf16(v1[2], v1[3]);
                        *(u32x4*)(hp + (ai * HALF + m * 16) * 64) = w; } } }
            return;
        }
        if (!rtile) {
            const int col0 = tile * BM + wc * 32 + 8 * fq;
#pragma unroll
            for (int ai = 0; ai < 2; ++ai)
#pragma unroll
                for (int m = 0; m < 4; ++m) { bf16_t* rowp = O + (size_t)(row0 + ai * HALF + m * 16) * 5888 + col0;
#pragma unroll
                    for (int bj = 0; bj < 2; ++bj) { const f32x4 v0 = acc[ai][bj][m][0], v1 = acc[ai][bj][m][1];
                        u32x4 w; w.x = cvt_pk_bf16(v0[0], v0[1]); w.y = cvt_pk_bf16(v0[2], v0[3]); w.z = cvt_pk_bf16(v1[0], v1[1]); w.w = cvt_pk_bf16(v1[2], v1[3]);
                        *(u32x4*)(rowp + bj * HALF) = w; } }
            return;
        }
        const bool pass = (tile == 16) && (wc >= 2);
        const int c1 = pass ? 4224 + (wc - 2) * 32 : tile * BM + wc * 64, c2 = pass ? c1 + 64 : c1 + 32;
        const bool rope = !pass && (u.pm < 64);
#pragma unroll
        for (int ai = 0; ai < 2; ++ai)
#pragma unroll
            for (int m = 0; m < 4; ++m) { const int row = row0 + ai * HALF + m * 16; bf16_t* rowp = O + (size_t)row * 5888 + 8 * fq;
                f32x4 a0 = acc[ai][0][m][0], a1 = acc[ai][0][m][1], b0 = acc[ai][1][m][0], b1 = acc[ai][1][m][1];
                if (rope) { const int t = row & 2047, pos = (fq < 2) ? (t >> 6) : (t & 63), ti = pos * 16 + 8 * (fq & 1);
                    const f32x4 cs0 = *(LAS const f32x4*)(rcos + ti), cs1 = *(LAS const f32x4*)(rcos + ti + 4), sn0 = *(LAS const f32x4*)(rsin + ti), sn1 = *(LAS const f32x4*)(rsin + ti + 4);
                    const f32x4 x0 = a0 * cs0 - b0 * sn0, x1 = a1 * cs1 - b1 * sn1, y0 = a0 * sn0 + b0 * cs0, y1 = a1 * sn1 + b1 * cs1;
                    a0 = x0; a1 = x1; b0 = y0; b1 = y1; }
                u32x4 w; w.x = cvt_pk_bf16(a0[0], a0[1]); w.y = cvt_pk_bf16(a0[2], a0[3]); w.z = cvt_pk_bf16(a1[0], a1[1]); w.w = cvt_pk_bf16(a1[2], a1[3]);
                *(u32x4*)(rowp + c1) = w;
                w.x = cvt_pk_bf16(b0[0], b0[1]); w.y = cvt_pk_bf16(b0[2], b0[3]); w.z = cvt_pk_bf16(b1[0], b1[1]); w.w = cvt_pk_bf16(b1[2], b1[3]);
                *(u32x4*)(rowp + c2) = w; }
    }
};
}

__device__ __forceinline__ void transpose_item(const float* W, int N, bf16* WT, int K, int k0, int n0, int drow0, LAS float* scr, int lane) {
#pragma unroll 8
    for (int i = 0; i < 32; ++i) { const int kk = 2 * i + (lane >> 5); scr[kk * 33 + (lane & 31)] = W[(size_t)(k0 + kk) * N + n0 + (lane & 31)]; }
    LDS_WAIT();
    const int c = lane & 7;
#pragma unroll
    for (int j = 0; j < 4; ++j) { const int n = (lane >> 3) + 8 * j; const LAS float* s = scr + (8 * c) * 33 + n;
        u32x4 o; o.x = pk2(s[0 * 33], s[1 * 33]); o.y = pk2(s[2 * 33], s[3 * 33]); o.z = pk2(s[4 * 33], s[5 * 33]); o.w = pk2(s[6 * 33], s[7 * 33]);
        *(u32x4*)(WT + (size_t)(drow0 + n) * K + k0 + 8 * c) = o; }
    LDS_WAIT();
}
__device__ __forceinline__ int win_dst_group(int sg) {
    const int tile = sg >> 3, r = sg & 7;
    if (tile < 4 || tile == 14 || tile == 15) return tile * 8 + (r & 1) * 4 + (r >> 1);
    if (tile == 16) return 128 + (r < 4 ? ((r & 1) * 4 + (r >> 1)) : (r < 6 ? r - 2 : r));
    return sg;
}
constexpr int I_IN = 32 * 184, I_OUT = 32 * 64, I_G = 16 * 32 * 32, I_D = 16 * 16 * 64, I_L = I_IN + I_OUT + 2 * I_G + I_D;

__device__ __forceinline__ void convert_item(const Params& p, int l, int r, LAS float* scr, int lane) {
    bf16* WIN = (bf16*)(p.ws + WS_WIN); bf16* WOUT = (bf16*)(p.ws + WS_WOUT); bf16* WGU = (bf16*)(p.ws + WS_WGU); bf16* WD = (bf16*)(p.ws + WS_WD);
    if (r < I_IN) { const int kb = r / 184, nb = r % 184; transpose_item(p.w_in + (size_t)l * 2048 * INC, INC, WIN + (size_t)l * INC * 2048, 2048, 64 * kb, 32 * nb, 32 * win_dst_group(nb), scr, lane); return; } r -= I_IN;
    if (r < I_OUT) { const int kb = r / 64, nb = r % 64; transpose_item(p.w_out + (size_t)l * 2048 * 2048, 2048, WOUT + (size_t)l * 2048 * 2048, 2048, 64 * kb, 32 * nb, 32 * nb, scr, lane); return; } r -= I_OUT;
    if (r < 2 * I_G) { const int isup = r >= I_G; if (isup) r -= I_G; const int e = r >> 10, rr = r & 1023, kb = rr >> 5, nb = rr & 31, n0 = 32 * nb;
        const float* W = (isup ? p.w_up : p.w_gate) + (size_t)(l * 16 + e) * 2048 * 1024;
        transpose_item(W, 1024, WGU + (size_t)(l * 16 + e) * 2048 * 2048, 2048, 64 * kb, n0, (n0 >> 7) * 256 + (n0 & 127) + (isup ? 128 : 0), scr, lane); return; } r -= 2 * I_G;
    { const int e = r >> 10, rr = r & 1023, kb = rr >> 6, nb = rr & 63;
      transpose_item(p.w_down + (size_t)(l * 16 + e) * 1024 * 2048, 2048, WD + (size_t)(l * 16 + e) * 2048 * 1024, 1024, 64 * kb, 32 * nb, 32 * nb, scr, lane); }
}
#ifndef TAIL_P2
#define TAIL_P2 0
#define TAIL_P6 (192 * 128)
#define TAIL_P9 0
#define TAIL_P10 0
#endif
constexpr int TAIL_OFF_P2 = 0, TAIL_OFF_P6 = TAIL_P2, TAIL_OFF_P9 = TAIL_P2 + TAIL_P6, TAIL_OFF_P10 = TAIL_P2 + TAIL_P6 + TAIL_P9, TAIL_ITEMS = TAIL_P2 + TAIL_P6 + TAIL_P9 + TAIL_P10;
static_assert(TAIL_ITEMS <= I_L, "tail items are layer-1 items");
__device__ __forceinline__ void ph_prologue(const Params& p, LAS unsigned char* lds) {
    const int tid = tid_opaque(), lane = tid & 63, wave = __builtin_amdgcn_readfirstlane(tid >> 6);
    const int G = gridDim.x;
    for (int u = blockIdx.x; u < 192; u += G) {
        const int l = u / 96, cg = u % 96;
        LAS float* s_sil = (LAS float*)lds; LAS float* s_red = (LAS float*)(lds + 73728);
        for (int i = tid; i < 9 * 2048; i += NTHR) { const int r = i >> 11, k = i & 2047; const float v = (r < 8) ? p.c[r * 2048 + k] : p.c_ctx[k]; s_sil[i] = silu_f(v); }
        __syncthreads();
        const float* W = p.w_ada + (size_t)l * 2048 * ADAW + cg * 128 + 2 * lane;
        float acc[9][2];
#pragma unroll
        for (int r = 0; r < 9; ++r) { acc[r][0] = 0.f; acc[r][1] = 0.f; }
        const int k0 = wave * 256;
        for (int kk = 0; kk < 256; kk += 8) {
            f32x2 w[8];
#pragma unroll
            for (int j = 0; j < 8; ++j) w[j] = *(const f32x2*)(W + (size_t)(k0 + kk + j) * ADAW);
#pragma unroll
            for (int r = 0; r < 9; ++r) {
                const f32x4 sa = *(LAS const f32x4*)(s_sil + r * 2048 + k0 + kk), sb = *(LAS const f32x4*)(s_sil + r * 2048 + k0 + kk + 4);
#pragma unroll
                for (int j = 0; j < 4; ++j) { acc[r][0] += sa[j] * w[j].x; acc[r][1] += sa[j] * w[j].y; acc[r][0] += sb[j] * w[4 + j].x; acc[r][1] += sb[j] * w[4 + j].y; }
            }
        }
#pragma unroll
        for (int r = 0; r < 9; ++r) { s_red[(wave * 9 + r) * 128 + 2 * lane] = acc[r][0]; s_red[(wave * 9 + r) * 128 + 2 * lane + 1] = acc[r][1]; }
        __syncthreads();
        for (int i = tid; i < 9 * 128; i += NTHR) { const int r = i >> 7, cc = i & 127; float s = p.b_ada[l * ADAW + cg * 128 + cc];
#pragma unroll
            for (int w = 0; w < 8; ++w) s += s_red[(w * 9 + r) * 128 + cc];
            ws_ada(p)[(size_t)(l * 9 + r) * ADAW + cg * 128 + cc] = s; }
        __syncthreads();
    }
    LAS float* scr = (LAS float*)(lds + wave * 8448);
    const int gw = blockIdx.x * NWAVES + wave, NGW = G * NWAVES;
    const int tail = (G == 256) ? TAIL_ITEMS : 0;
    for (int it = gw; it < 2 * I_L - tail; it += NGW) { const int g = it < I_L ? it : it + tail; convert_item(p, g / I_L, g % I_L, scr, lane); }
}
__device__ __forceinline__ void tail_convert(const Params& p, int off, int n, int rank, int nidle, LAS unsigned char* lds) {
    const int tid = tid_opaque(), lane = tid & 63, wave = __builtin_amdgcn_readfirstlane(tid >> 6);
    LAS float* scr = (LAS float*)(lds + wave * 8448);
    for (int it = rank * NWAVES + wave; it < n; it += nidle * NWAVES) convert_item(p, 1, off + it, scr, lane);
}

__device__ __forceinline__ void load_row8(f32x4 (&v)[8], const float* row, int lane) {
#pragma unroll
    for (int j = 0; j < 8; ++j) v[j] = *(const f32x4*)(row + 256 * j + 4 * lane);
}
__device__ __forceinline__ void load_row8_bf16(f32x4 (&v)[8], const bf16* row, int lane) {
#pragma unroll
    for (int j = 0; j < 8; ++j) { const u32x2 w = *(const u32x2*)(row + 256 * j + 4 * lane);
        v[j] = (f32x4){__uint_as_float(w.x << 16), __uint_as_float(w.x & 0xffff0000u), __uint_as_float(w.y << 16), __uint_as_float(w.y & 0xffff0000u)}; }
}
__device__ __forceinline__ float row_rstd(const f32x4 (&v)[8]) {
    float s = 0.f;
#pragma unroll
    for (int j = 0; j < 8; ++j) s += (v[j].x * v[j].x + v[j].y * v[j].y) + (v[j].z * v[j].z + v[j].w * v[j].w);
    return rsqrtf(wave_sum(s) * (1.f / 2048.f) + RMS_EPS);
}
__device__ __forceinline__ void modulate8(f32x4 (&v)[8], float rstd, const float* nw, const float* sc, const float* sh, int lane) {
#pragma unroll
    for (int j = 0; j < 8; ++j) { const int c = 256 * j + 4 * lane; const f32x4 w = *(const f32x4*)(nw + c), s1 = *(const f32x4*)(sc + c), s0 = *(const f32x4*)(sh + c);
        v[j] = v[j] * rstd * w * (1.f + s1) + s0; }
}
__device__ __forceinline__ void store_row8_bf16(const f32x4 (&v)[8], bf16* row, int lane) {
#pragma unroll
    for (int j = 0; j < 8; ++j) { u32x2 w; w.x = pk2(v[j].x, v[j].y); w.y = pk2(v[j].z, v[j].w); *(u32x2*)(row + 256 * j + 4 * lane) = w; }
}
__device__ __forceinline__ void load_coeffs(f32x4 (&wv)[8], f32x4 (&sv)[8], const float* nw, const float* sc, const float* sh, int lane) {
#pragma unroll
    for (int j = 0; j < 8; ++j) { const int c = 256 * j + 4 * lane; wv[j] = *(const f32x4*)(nw + c) * (1.f + *(const f32x4*)(sc + c)); sv[j] = *(const f32x4*)(sh + c); }
}
__device__ __forceinline__ void ph_modnorm0(const Params& p) {
    const int tid_ = tid_opaque(), lane = tid_ & 63, wave = __builtin_amdgcn_readfirstlane(tid_ >> 6);
    const int gw = blockIdx.x * NWAVES + wave, NGW = gridDim.x * NWAVES;
    const int rpw = (NROW + NGW - 1) / NGW, r0 = gw * rpw, r1 = (r0 + rpw < NROW) ? r0 + rpw : NROW;
    int cur = -1; f32x4 wv[8], sv[8], vn[8];
#define XROW0(r) (((r) < NLAT) ? p.x + (size_t)(r) * DM : p.ctx + (size_t)((r) - NLAT) * DM)
    if (r0 < r1) load_row8(vn, XROW0(r0), lane);
    for (int row = r0; row < r1; ++row) {
        f32x4 v[8];
#pragma unroll
        for (int j = 0; j < 8; ++j) v[j] = vn[j];
        if (row + 1 < r1) load_row8(vn, XROW0(row + 1), lane);
        const int arow = (row < NLAT) ? (row >> 11) : 8;
        if (arow != cur) { const float* ad = ws_ada(p) + (size_t)(0 * 9 + arow) * ADAW; load_coeffs(wv, sv, p.norm_mix, ad + 2048, ad, lane); cur = arow; }
        const float rstd = row_rstd(v);
#pragma unroll
        for (int j = 0; j < 8; ++j) v[j] = v[j] * rstd * wv[j] + sv[j];
        store_row8_bf16(v, ws_hb(p) + (size_t)row * DM, lane);
    }
#undef XROW0
}

namespace att {
__device__ __forceinline__ float xh_max(float v) { auto rr = __builtin_amdgcn_permlane32_swap(__float_as_uint(v), __float_as_uint(v), false, false); float a = __uint_as_float(rr[0]), b = __uint_as_float(rr[1]), r; asm("v_max_f32_e32 %0, %1, %2" : "=v"(r) : "v"(a), "v"(b)); return r; }
__device__ __forceinline__ float xh_sum(float v) { auto rr = __builtin_amdgcn_permlane32_swap(__float_as_uint(v), __float_as_uint(v), false, false); return __uint_as_float(rr[0]) + __uint_as_float(rr[1]); }
__device__ __forceinline__ float max3f(float a, float b, float c) { float r; asm("v_max3_f32 %0, %1, %2, %3" : "=v"(r) : "v"(a), "v"(b), "v"(c)); return r; }
constexpr int KB0 = 0, VB0 = 16384, SCR = 32768, RPB = 34816, BYTES = 36864;
struct TileRegs { u32x4 k, v; };
template <int PITCH = INC> __device__ __forceinline__ void tile_load(TileRegs& t, const bf16* kp, const bf16* vp, int tid) {
    const int key = tid >> 3, c = tid & 7;
    t.k = *(const u32x4*)(kp + (size_t)key * PITCH + c * 8);
    t.v = *(const u32x4*)(vp + (size_t)key * PITCH + c * 8);
}
__device__ __forceinline__ void tile_store(const TileRegs& t, LAS unsigned char* kb, LAS unsigned char* vb, int tid) {
    const int key = tid >> 3, c = tid & 7;
    *(LAS u32x4*)(kb + c * 1024 + key * 16) = t.k;
    *(LAS u32x4*)(vb + (c >> 2) * 4096 + (key >> 3) * 512 + (key & 7) * 64 + (c & 3) * 16) = t.v;
}
__device__ __forceinline__ void qk_tile(f32x16& p0, f32x16& p1, LAS const unsigned char* kbuf, const bf16x8 (&qr)[4], int r32, int hi) {
    LAS const unsigned char* kb = kbuf + hi * 1024 + r32 * 16;
    f32x16 z;
#pragma unroll
    for (int i = 0; i < 16; ++i) z[i] = 0.f;
    p0 = z; p1 = z;
#pragma unroll
    for (int d0 = 0; d0 < 4; ++d0) {
        const bf16x8 k0 = *(LAS const bf16x8*)(kb + d0 * 2048), k1 = *(LAS const bf16x8*)(kb + d0 * 2048 + 512);
        p0 = MFMA32(k0, qr[d0], p0); p1 = MFMA32(k1, qr[d0], p1);
    }
}
__device__ __forceinline__ void k_frags(bf16x8 (&kf)[8], LAS const unsigned char* kbuf, int r32, int hi) {
    LAS const unsigned char* kb = kbuf + hi * 1024 + r32 * 16;
#pragma unroll
    for (int d0 = 0; d0 < 4; ++d0) { kf[2 * d0] = *(LAS const bf16x8*)(kb + d0 * 2048); kf[2 * d0 + 1] = *(LAS const bf16x8*)(kb + d0 * 2048 + 512); }
}
__device__ __forceinline__ void qk_frags(f32x16& p0, f32x16& p1, const bf16x8 (&kf)[8], const bf16x8 (&qr)[4]) {
    f32x16 z;
#pragma unroll
    for (int i = 0; i < 16; ++i) z[i] = 0.f;
    p0 = z; p1 = z;
#pragma unroll
    for (int d0 = 0; d0 < 4; ++d0) { p0 = MFMA32(kf[2 * d0], qr[d0], p0); p1 = MFMA32(kf[2 * d0 + 1], qr[d0], p1); }
}
__device__ __forceinline__ void pv_tile(f32x16& o0, f32x16& o1, const f32x16& p0, const f32x16& p1, LAS const unsigned char* vl) {
    u32x4 pk[4];
#pragma unroll
    for (int i = 0; i < 4; ++i) { pk[0][i] = pk2(p0[2 * i], p0[2 * i + 1]); pk[1][i] = pk2(p0[8 + 2 * i], p0[9 + 2 * i]); pk[2][i] = pk2(p1[2 * i], p1[2 * i + 1]); pk[3][i] = pk2(p1[8 + 2 * i], p1[9 + 2 * i]); }
#pragma unroll
    for (int ks = 0; ks < 4; ++ks) {
        const bf16x8 a = __builtin_bit_cast(bf16x8, pk[ks]);
        const bf16x8 v0 = cat8(trrd(vl + ks * 1024), trrd(vl + ks * 1024 + 512));
        const bf16x8 v1 = cat8(trrd(vl + 4096 + ks * 1024), trrd(vl + 4096 + ks * 1024 + 512));
        o0 = MFMA32(v0, a, o0); o1 = MFMA32(v1, a, o1);
    }
}
__device__ __forceinline__ void softmax_pv(f32x16& p0, f32x16& p1, float& m, float& lsum, f32x16& o0, f32x16& o1, LAS float* scr, LAS const unsigned char* vl, int r32, int hi) {
    float mx = max3f(p0[0], p1[0], p0[1]), mx2 = max3f(p1[1], p0[2], p1[2]);
#pragma unroll
    for (int r = 3; r < 15; r += 2) { mx = max3f(mx, p0[r], p1[r]); mx2 = max3f(mx2, p0[r + 1], p1[r + 1]); }
    mx = xh_max(max3f(mx, mx2, max3f(p0[15], p1[15], p0[15])));
    if (__any(mx > m + 8.f)) {
        const float mnew = max3f(m, mx, mx), alpha = ex2(m - mnew);
        m = mnew; lsum *= alpha;
#pragma unroll
        for (int r = 0; r < 16; ++r) { o0[r] *= alpha; o1[r] *= alpha; }
    }
    float rs = 0.f;
#pragma unroll
    for (int r = 0; r < 16; ++r) { p0[r] = ex2(p0[r] - m); p1[r] = ex2(p1[r] - m); rs += p0[r] + p1[r]; }
    lsum += rs;
    pv_tile(o0, o1, p0, p1, vl);
}
__device__ __forceinline__ void qk_win(f32x16& p0, LAS const unsigned char* kwin, const bf16x8 (&qr)[4], int r32, int hi) {
    LAS const unsigned char* kb = kwin + hi * 1024 + r32 * 16;
#pragma unroll
    for (int i = 0; i < 16; ++i) p0[i] = 0.f;
#pragma unroll
    for (int d0 = 0; d0 < 4; ++d0) { const bf16x8 k0 = *(LAS const bf16x8*)(kb + d0 * 2048); p0 = MFMA32(k0, qr[d0], p0); }
}
__device__ __forceinline__ void softmax_pv_win(f32x16& p0, float& m, float& lsum, f32x16& o0, f32x16& o1, LAS const unsigned char* vwin) {
    float mx = max3f(p0[0], p0[1], p0[2]), mx2 = max3f(p0[3], p0[4], p0[5]);
#pragma unroll
    for (int r = 6; r < 14; r += 4) { mx = max3f(mx, p0[r], p0[r + 1]); mx2 = max3f(mx2, p0[r + 2], p0[r + 3]); }
    mx = xh_max(max3f(mx, mx2, max3f(p0[14], p0[15], p0[15])));
    if (__any(mx > m + 8.f)) {
        const float mnew = max3f(m, mx, mx), alpha = ex2(m - mnew);
        m = mnew; lsum *= alpha;
#pragma unroll
        for (int r = 0; r < 16; ++r) { o0[r] *= alpha; o1[r] *= alpha; }
    }
    float rs = 0.f;
#pragma unroll
    for (int r = 0; r < 16; ++r) { p0[r] = ex2(p0[r] - m); rs += p0[r]; }
    lsum += rs;
    u32x4 pk[2];
#pragma unroll
    for (int i = 0; i < 4; ++i) { pk[0][i] = pk2(p0[2 * i], p0[2 * i + 1]); pk[1][i] = pk2(p0[8 + 2 * i], p0[9 + 2 * i]); }
#pragma unroll
    for (int ks = 0; ks < 2; ++ks) {
        const bf16x8 a = __builtin_bit_cast(bf16x8, pk[ks]);
        const bf16x8 v0 = cat8(trrd(vwin + ks * 1024), trrd(vwin + ks * 1024 + 512));
        const bf16x8 v1 = cat8(trrd(vwin + 4096 + ks * 1024), trrd(vwin + 4096 + ks * 1024 + 512));
        o0 = MFMA32(v0, a, o0); o1 = MFMA32(v1, a, o1);
    }
}
__device__ __forceinline__ void finalize_store_lane(const f32x16& o0, const f32x16& o1, float lsum, bf16* orl, int hi);
__device__ __forceinline__ void finalize_store(const f32x16& o0, const f32x16& o1, float lsum, bf16* orow, LAS float* scr, int r32, int hi) {
    finalize_store_lane(o0, o1, lsum, orow + (size_t)r32 * DM, hi);
}
__device__ __forceinline__ void finalize_store_lane(const f32x16& o0, const f32x16& o1, float lsum, bf16* orl, int hi) {
    const float inv = 1.f / xh_sum(lsum);
    bf16* op = orl + 4 * hi;
#pragma unroll
    for (int g = 0; g < 4; ++g) {
        u32x2 w0, w1; w0.x = pk2(o0[4 * g] * inv, o0[4 * g + 1] * inv); w0.y = pk2(o0[4 * g + 2] * inv, o0[4 * g + 3] * inv); w1.x = pk2(o1[4 * g] * inv, o1[4 * g + 1] * inv); w1.y = pk2(o1[4 * g + 2] * inv, o1[4 * g + 3] * inv);
        *(u32x2*)(op + 8 * g) = w0; *(u32x2*)(op + 32 + 8 * g) = w1; }
}

__device__ __forceinline__ void swa_unit(const Params& p, int l, int b, int kvh, int qb, int gp, bool isctx, LAS unsigned char* L) {
    const int tid = tid_opaque(), lane = tid & 63, wave = __builtin_amdgcn_readfirstlane(tid >> 6), r32 = lane & 31, hi = lane >> 5;
    const bf16* Z = ws_z(p); bf16* Y = ws_hb(p);
    const int g = 2 * gp + (wave >> 2), rb = wave & 3, head = kvh * 4 + g;
    const size_t qrow0 = isctx ? (size_t)(NLAT + b * CTX + qb * 128) : (size_t)(b * SEQ + qb * 128);
    bf16x8 qr[4];
    { const bf16* qp = Z + (qrow0 + 32 * rb + r32) * INC + ZC_SQ + head * 64 + hi * 8;
#pragma unroll
      for (int d0 = 0; d0 < 4; ++d0) qr[d0] = *(const bf16x8*)(qp + d0 * 16); }
    float m = p.sink[l * 8 + head] * LOG2E, ls = (hi == 0) ? 1.f : 0.f; f32x16 o0, o1;
#pragma unroll
    for (int i = 0; i < 16; ++i) { o0[i] = 0.f; o1[i] = 0.f; }
    const int t0 = (qb == 0) ? 2 : 0, t1 = (qb == 15) ? 4 : 6;
    const int nwin = isctx ? 0 : (t1 - t0), nt = nwin + 4;
    const bf16* Kc = Z + ZC_SK + kvh * 64; const bf16* Vc = Z + ZC_SV + kvh * 64;
#define SWA_TROW(t) ((t) < nwin ? (size_t)(b * SEQ + 128 * (qb - 1) + 64 * (t0 + (t))) : (size_t)(NLAT + b * CTX + 64 * ((t) - nwin)))
    LAS float* scr = (LAS float*)(L + SCR) + wave * 64;
    const int vlo = ((lane >> 4) & 1) * 32 + (lane & 3) * 8 + (4 * hi + ((lane & 15) >> 2)) * 64;
    constexpr float SC = 0.125f * LOG2E;
    const int qi = 32 * rb + r32;
#define SWA_BODY(t, cur) { \
        const int wi = ((t) < nwin) ? t0 + (t) : -1; \
        const bool act = !(wi == 0 && rb >= 2) && !(wi == 5 && rb < 2); \
        if (act) { \
            f32x16 p0, p1; qk_tile(p0, p1, L + KB0 + (cur) * 8192, qr, r32, hi); \
            if ((wi == 0) || (wi == 1) || (wi == 4) || (wi == 5)) { \
                const int dbase = 64 * wi - 128 - qi; \
                _Pragma("unroll") for (int r = 0; r < 16; ++r) { const int d0 = dbase + crow(r, hi), d1 = d0 + 32; \
                    p0[r] = (d0 >= -128 && d0 <= 128) ? p0[r] * SC : -INFINITY; p1[r] = (d1 >= -128 && d1 <= 128) ? p1[r] * SC : -INFINITY; } \
            } else { \
                _Pragma("unroll") for (int r = 0; r < 16; ++r) { p0[r] *= SC; p1[r] *= SC; } \
            } \
            softmax_pv(p0, p1, m, ls, o0, o1, scr, L + VB0 + (cur) * 8192 + vlo, r32, hi); \
        } }
    TileRegs rA, rB, rC, rD;
    { const size_t r0 = SWA_TROW(0); tile_load(rA, Kc + r0 * INC, Vc + r0 * INC, tid); }
    { const size_t r1 = SWA_TROW(1); tile_load(rB, Kc + r1 * INC, Vc + r1 * INC, tid); }
    { const size_t r2 = SWA_TROW(2); tile_load(rC, Kc + r2 * INC, Vc + r2 * INC, tid); }
    { const size_t r3 = SWA_TROW(3); tile_load(rD, Kc + r3 * INC, Vc + r3 * INC, tid); }
    tile_store(rA, L + KB0, L + VB0, tid);
    __syncthreads();
#define SWA_STEP(tt, RL, RS, cur) { \
          \
        { const int tn = (tt) + 4 < nt ? (tt) + 4 : nt - 1; const size_t rn = SWA_TROW(tn); tile_load(RL, Kc + rn * INC, Vc + rn * INC, tid); } \
        SWA_BODY(tt, cur) \
        tile_store(RS, L + KB0 + ((cur) ^ 1) * 8192, L + VB0 + ((cur) ^ 1) * 8192, tid); \
        __syncthreads(); }
    int t = 0;
    for (; t + 4 <= nt; t += 4) {
        SWA_STEP(t, rA, rB, 0) SWA_STEP(t + 1, rB, rC, 1) SWA_STEP(t + 2, rC, rD, 0) SWA_STEP(t + 3, rD, rA, 1)
    }
    if (t < nt) { SWA_STEP(t, rA, rB, 0) if (t + 1 < nt) { SWA_STEP(t + 1, rB, rC, 1) if (t + 2 < nt) { SWA_STEP(t + 2, rC, rD, 0) } } }
#undef SWA_STEP
#undef SWA_BODY
#undef SWA_TROW
    finalize_store(o0, o1, ls, Y + (qrow0 + 32 * rb) * DM + YC_SWA + head * 64, scr, r32, hi);
}

__device__ __forceinline__ void na_unit(const Params& p, int l, int b, int h, int rg, bool isctx, LAS unsigned char* L, int rep = 0) {
    const int tid = tid_opaque(), lane = tid & 63, wave = __builtin_amdgcn_readfirstlane(tid >> 6), r32 = lane & 31, hi = lane >> 5;
    const bf16* Z = ws_z(p); bf16* Y = ws_hb(p);
    const int ig = wave & 3, gr0 = 4 * rg + 2 * (wave >> 2);
    const int rq = gr0 + (r32 >> 4), qcol = 16 * ig + (r32 & 15);
    const size_t qrow = isctx ? (size_t)(NLAT + b * CTX + 32 * wave + r32) : (size_t)(b * SEQ + rq * 64 + qcol);
    bf16x8 qr[4];
    { const bf16* qp = Z + qrow * INC + ZC_NQ + h * 64 + hi * 8;
#pragma unroll
      for (int d0 = 0; d0 < 4; ++d0) qr[d0] = *(const bf16x8*)(qp + d0 * 16); }
    LAS float* rpbl = (LAS float*)(L + RPB);
    const float rpbv = p.rpb[(size_t)(l * 8 + h) * 465 + (tid < 465 ? tid : 464)];
    float m = -1e30f, ls = 0.f; f32x16 o0, o1;
#pragma unroll
    for (int i = 0; i < 16; ++i) { o0[i] = 0.f; o1[i] = 0.f; }
    int R0 = 4 * rg - 4; R0 = R0 < 0 ? 0 : (R0 > 24 ? 24 : R0);
    int R1 = 4 * rg - 1; R1 = (R1 < 0 ? 0 : (R1 > 24 ? 24 : R1)) + 8;
    const int nband = isctx ? 0 : (R1 - R0), nt = nband + 4;
    int w0 = gr0 - 4; w0 = w0 < 0 ? 0 : (w0 > 24 ? 24 : w0);
    int w1 = gr0 - 3; w1 = (w1 < 0 ? 0 : (w1 > 24 ? 24 : w1)) + 8;
    int rs = rq - 4; rs = rs < 0 ? 0 : (rs > 24 ? 24 : rs);
    int cs = qcol - 8; cs = cs < 0 ? 0 : (cs > 48 ? 48 : cs);
    int key0 = 16 * ig - 8; key0 = key0 < 0 ? 0 : (key0 > 32 ? 32 : key0);
    const bf16* Kc = ws_kvh(p) + kvh_off(0, b, h); const bf16* Vc = ws_kvh(p) + kvh_off(1, b, h);
#define NA_TROW(t) ((t) < nband ? (size_t)(64 * (R0 + (t))) : (size_t)(SEQ + 64 * ((t) - nband)))
    LAS float* scr = (LAS float*)(L + SCR) + wave * 64;
    const int vlo = ((lane >> 4) & 1) * 32 + (lane & 3) * 8 + (4 * hi + ((lane & 15) >> 2)) * 64;
    constexpr float SC = 0.125f * LOG2E;
#define NA_BODY(t, cur) { \
        const int kr = ((t) < nband) ? R0 + (t) : -1; \
        if (kr < 0) { \
            f32x16 p0, p1; qk_tile(p0, p1, L + KB0 + (cur) * 8192, qr, r32, hi); \
            _Pragma("unroll") for (int r = 0; r < 16; ++r) { p0[r] *= SC; p1[r] *= SC; } \
            softmax_pv(p0, p1, m, ls, o0, o1, scr, L + VB0 + (cur) * 8192 + vlo, r32, hi); \
        } else if (kr >= w0 && kr < w1) { \
            f32x16 p0; qk_win(p0, L + KB0 + (cur) * 8192 + key0 * 16, qr, r32, hi); \
            const bool rowok = (kr >= rs) && (kr < rs + 8);                           \
            int dr = kr - rq + 7; dr = dr < 0 ? 0 : (dr > 14 ? 14 : dr); \
            LAS const float* tb = rpbl + dr * 31 + (15 - qcol);                       \
              \
            float bb[16]; \
            _Pragma("unroll") for (int r = 0; r < 16; ++r) { const int k = key0 + crow(r, hi); int kc = k < cs ? cs : k; kc = kc > cs + 15 ? cs + 15 : kc; bb[r] = tb[kc]; } \
            _Pragma("unroll") for (int r = 0; r < 16; ++r) asm volatile("" : "+v"(bb[r])); \
            _Pragma("unroll") for (int r = 0; r < 16; ++r) { const int k = key0 + crow(r, hi); const bool v = rowok && (k >= cs) && (k < cs + 16); p0[r] = v ? p0[r] * SC + bb[r] : -INFINITY; } \
            softmax_pv_win(p0, m, ls, o0, o1, L + VB0 + (cur) * 8192 + vlo + (key0 >> 3) * 512); \
        } }
    TileRegs rA, rB, rC, rD;
    { const size_t r0 = NA_TROW(0); tile_load<64>(rA, Kc + r0 * 64, Vc + r0 * 64, tid); }
    { const size_t r1 = NA_TROW(1); tile_load<64>(rB, Kc + r1 * 64, Vc + r1 * 64, tid); }
    { const size_t r2 = NA_TROW(2); tile_load<64>(rC, Kc + r2 * 64, Vc + r2 * 64, tid); }
    { const size_t r3 = NA_TROW(3); tile_load<64>(rD, Kc + r3 * 64, Vc + r3 * 64, tid); }
    if (tid < 465) rpbl[tid] = rpbv * LOG2E;
    tile_store(rA, L + KB0, L + VB0, tid);
    __syncthreads();
#define NA_STEP(tt, RL, RS, cur) { \
          \
        { const int tn = (tt) + 4 < nt ? (tt) + 4 : nt - 1; const size_t rn = NA_TROW(tn); tile_load<64>(RL, Kc + rn * 64, Vc + rn * 64, tid); } \
        NA_BODY(tt, cur) \
        tile_store(RS, L + KB0 + ((cur) ^ 1) * 8192, L + VB0 + ((cur) ^ 1) * 8192, tid); \
        __syncthreads(); }
    int t = 0;
    for (; t + 4 <= nt; t += 4) {
        NA_STEP(t, rA, rB, 0) NA_STEP(t + 1, rB, rC, 1) NA_STEP(t + 2, rC, rD, 0) NA_STEP(t + 3, rD, rA, 1)
    }
    if (t < nt) { NA_STEP(t, rA, rB, 0) if (t + 1 < nt) { NA_STEP(t + 1, rB, rC, 1) if (t + 2 < nt) { NA_STEP(t + 2, rC, rD, 0) } } }
#undef NA_STEP
#undef NA_BODY
#undef NA_TROW
    finalize_store_lane(o0, o1, ls, Y + qrow * DM + YC_NA + h * 64, hi);
}
}

__device__ __forceinline__ size_t ret_row(int b, int c, int j) { return c < 2 ? (size_t)(NLAT + b * CTX + 128 * c + j) : (size_t)(b * SEQ + 128 * (c - 2) + j); }
__device__ __forceinline__ float log2_sigmoid(float x) { return -log1pf(__expf(-x)) * LOG2E; }
__device__ __forceinline__ int tr_addr(int tile, int key, int cch) { return tile * 8192 + (cch >> 2) * 4096 + (key >> 3) * 512 + (key & 7) * 64 + (cch & 3) * 16; }

__device__ __forceinline__ void r1_unit(const Params& p, int l, int b, int h, int c, LAS unsigned char* L) {
    const int tid = tid_opaque(), lane = tid & 63, wave = __builtin_amdgcn_readfirstlane(tid >> 6), r32 = lane & 31, hi = lane >> 5;
    const bf16* Z = ws_z(p);
    const float lgf = log2_sigmoid(p.dec_f[l * 8 + h]), lgb = log2_sigmoid(p.dec_b[l * 8 + h]);
    LAS unsigned char* KT = L; LAS unsigned char* VF = L + 16384; LAS unsigned char* VBk = L + 32768;
#pragma unroll
    for (int i = 0; i < 2; ++i) { const int q = tid + 512 * i, tok = q >> 3, cch = q & 7;
        const bf16* rp = Z + ret_row(b, c, tok) * INC + h * 64 + cch * 8;
        const u32x4 kv = *(const u32x4*)(rp + ZC_RK), vv = *(const u32x4*)(rp + ZC_RV);
        const int a = tr_addr(tok >> 6, tok & 63, cch);
        *(LAS u32x4*)(KT + a) = kv;
        *(LAS u32x4*)(VF + a) = scale8(vv, ex2(lgf * (float)(127 - tok)));
        *(LAS u32x4*)(VBk + a) = scale8(vv, ex2(lgb * (float)tok)); }
    __syncthreads();
    const int dir = wave >> 2, dvb = (wave >> 1) & 1, dkb = wave & 1;
    const int vlo = ((lane >> 4) & 1) * 32 + (lane & 3) * 8 + (4 * hi + ((lane & 15) >> 2)) * 64;
    LAS const unsigned char* Ab = (dir ? VBk : VF) + dvb * 4096 + vlo; LAS const unsigned char* Bb = KT + dkb * 4096 + vlo;
    f32x16 acc;
#pragma unroll
    for (int i = 0; i < 16; ++i) acc[i] = 0.f;
#pragma unroll
    for (int ks = 0; ks < 8; ++ks) { const int off = (ks >> 2) * 8192 + (ks & 3) * 1024;
        const bf16x8 a = cat8(trrd(Ab + off), trrd(Ab + off + 512)), bb = cat8(trrd(Bb + off), trrd(Bb + off + 512));
        acc = MFMA32(a, bb, acc); }
    float* St = (float*)(p.ws + WS_SST) + ((size_t)((b * 8 + h) * 18 + c) * 2 + dir) * 4096;
#pragma unroll
    for (int r = 0; r < 16; ++r) St[(32 * dvb + crow(r, hi)) * 64 + 32 * dkb + r32] = acc[r];
    __syncthreads();
}

__device__ __forceinline__ void ph_ret_scan(const Params& p, int l) {
    const int tid = tid_opaque();
    const int task = blockIdx.x * 256 + tid;
    if (tid < 256) for (int tk = task; tk < 65536; tk += gridDim.x * 256) {
        const int cd = tk & 7, dv = (tk >> 3) & 63, dir = (tk >> 9) & 1, bh = tk >> 10, h = bh & 7;
        const float lg = log2_sigmoid((dir ? p.dec_b : p.dec_f)[l * 8 + h]), cdec = ex2(lg * 128.f);
        const float* Sb = (const float*)(p.ws + WS_SST) + (size_t)(bh * 18) * 2 * 4096 + dir * 4096 + dv * 64 + cd * 8;
        unsigned char* Ob = p.ws + WS_SIN + (size_t)(bh * 18) * 2 * 8192 + dir * 8192 + cd * 1024 + dv * 16;
        f32x4 a0 = {0.f, 0.f, 0.f, 0.f}, a1 = a0;
#pragma unroll
        for (int g = 0; g < 3; ++g) {
            f32x4 s0[6], s1[6];
#pragma unroll
            for (int k = 0; k < 6; ++k) { const int st = 6 * g + k, c = dir ? (st == 0 ? 1 : (st == 1 ? 0 : 19 - st)) : st; const float* sp = Sb + (size_t)c * 2 * 4096; s0[k] = *(const f32x4*)sp; s1[k] = *(const f32x4*)(sp + 4); }
#pragma unroll
            for (int k = 0; k < 6; ++k) { const int st = 6 * g + k, c = dir ? (st == 0 ? 1 : (st == 1 ? 0 : 19 - st)) : st;
                u32x4 w; w.x = pk2(a0.x, a0.y); w.y = pk2(a0.z, a0.w); w.z = pk2(a1.x, a1.y); w.w = pk2(a1.z, a1.w);
                *(u32x4*)(Ob + (size_t)c * 2 * 8192) = w;
                a0 = a0 * cdec + s0[k]; a1 = a1 * cdec + s1[k]; }
        }
    }
}

__device__ __forceinline__ void r3_pair(const Params& p, int l, int b, int h, int cp, LAS unsigned char* L, float decf, float decb) {
    const int tid = tid_opaque(), lane = tid & 63, wave = __builtin_amdgcn_readfirstlane(tid >> 6), r32 = lane & 31, hi = lane >> 5;
    const int half = wave >> 2, wq = wave & 3, c = 2 * cp + half, th = tid & 255;
    const bf16* Z = ws_z(p); bf16* Y = ws_hb(p);
    const float lgf = log2_sigmoid(decf), lgb = log2_sigmoid(decb);
    LAS unsigned char* Lh = L + half * 49152;
    LAS unsigned char* KT = Lh; LAS unsigned char* VT = Lh + 16384; LAS unsigned char* SF = Lh + 32768; LAS unsigned char* SBk = Lh + 40960;
    u32x4 kvr[4], vvr[4], snr[4];
#pragma unroll
    for (int i = 0; i < 4; ++i) { const int q = th + 256 * i, tok = q >> 3, cch = q & 7;
        const bf16* rp = Z + ret_row(b, c, tok) * INC + h * 64 + cch * 8;
        kvr[i] = *(const u32x4*)(rp + ZC_RK); vvr[i] = *(const u32x4*)(rp + ZC_RV); }
    { const unsigned char* src = p.ws + WS_SIN + (size_t)(((b * 8 + h) * 18 + c) * 2) * 8192;
#pragma unroll
      for (int i = 0; i < 4; ++i) { const int q = th + 256 * i; snr[i] = *(const u32x4*)(src + q * 16); } }
    const int qi = 32 * wq + r32;
    bf16x8 qr[4]; u32x2 gva[4], gvb[4];
    { const bf16* qp = Z + ret_row(b, c, qi) * INC + ZC_RQ + h * 64 + hi * 8;
#pragma unroll
      for (int d0 = 0; d0 < 4; ++d0) qr[d0] = *(const bf16x8*)(qp + d0 * 16);
      const bf16* gp0 = Z + ret_row(b, c, qi) * INC + ZC_RG + h * 64 + 4 * hi;
#pragma unroll
      for (int g = 0; g < 4; ++g) { gva[g] = *(const u32x2*)(gp0 + 8 * g); gvb[g] = *(const u32x2*)(gp0 + 32 + 8 * g); } }
    __builtin_amdgcn_sched_barrier(0);
#pragma unroll
    for (int i = 0; i < 4; ++i) { const int q = th + 256 * i, tok = q >> 3, cch = q & 7;
        *(LAS u32x4*)(KT + (tok >> 6) * 8192 + cch * 1024 + (tok & 63) * 16) = kvr[i];
        *(LAS u32x4*)(VT + tr_addr(tok >> 6, tok & 63, cch)) = vvr[i];
        *(LAS u32x4*)(SF + q * 16) = snr[i]; }
    __syncthreads();
    f32x16 o0, o1;
#pragma unroll
    for (int i = 0; i < 16; ++i) { o0[i] = 0.f; o1[i] = 0.f; }
    const int vlo = ((lane >> 4) & 1) * 32 + (lane & 3) * 8 + (4 * hi + ((lane & 15) >> 2)) * 64;
#pragma unroll
    for (int t = 0; t < 2; ++t) {
        f32x16 p0, p1; att::qk_tile(p0, p1, KT + t * 8192, qr, r32, hi);
#pragma unroll
        for (int r = 0; r < 16; ++r) { const int d0 = qi - (64 * t + crow(r, hi)), d1 = d0 - 32;
            p0[r] *= (d0 >= 0) ? ex2(lgf * (float)d0) : ex2(lgb * (float)(-d0));
            p1[r] *= (d1 >= 0) ? ex2(lgf * (float)d1) : ex2(lgb * (float)(-d1)); }
        att::pv_tile(o0, o1, p0, p1, VT + t * 8192 + vlo);
    }
    { const float xf = ex2(lgf * (float)(qi + 1)), xb = ex2(lgb * (float)(128 - qi));
#pragma unroll
      for (int s = 0; s < 4; ++s) {
          const bf16x8 af = __builtin_bit_cast(bf16x8, scale8(__builtin_bit_cast(u32x4, qr[s]), xf)), ab = __builtin_bit_cast(bf16x8, scale8(__builtin_bit_cast(u32x4, qr[s]), xb));
          LAS const unsigned char* sf = SF + (2 * s + hi) * 1024 + r32 * 16; LAS const unsigned char* sb = SBk + (2 * s + hi) * 1024 + r32 * 16;
          o0 = MFMA32(*(LAS const bf16x8*)sf, af, o0); o1 = MFMA32(*(LAS const bf16x8*)(sf + 512), af, o1);
          o0 = MFMA32(*(LAS const bf16x8*)sb, ab, o0); o1 = MFMA32(*(LAS const bf16x8*)(sb + 512), ab, o1); } }
    { float s1 = 0.f;
#pragma unroll
      for (int r = 0; r < 16; ++r) { o0[r] *= 0.125f; o1[r] *= 0.125f; s1 += o0[r] + o1[r]; }
      const float mean = att::xh_sum(s1) * (1.f / 64.f); float s2 = 0.f;
#pragma unroll
      for (int r = 0; r < 16; ++r) { o0[r] -= mean; o1[r] -= mean; s2 += o0[r] * o0[r] + o1[r] * o1[r]; }
      const float rstd = rsqrtf(att::xh_sum(s2) * (1.f / 64.f) + 1e-6f);
      const size_t row = ret_row(b, c, qi);
      bf16* yp = Y + row * DM + YC_RET + h * 64 + 4 * hi;
#pragma unroll
      for (int g = 0; g < 4; ++g) {
          const u32x2 ga = gva[g], gb = gvb[g]; u32x2 w0, w1;
          w0.x = pk2(silu_f(bf2f(ga.x & 0xffffu)) * o0[4 * g] * rstd, silu_f(__uint_as_float(ga.x & 0xffff0000u)) * o0[4 * g + 1] * rstd);
          w0.y = pk2(silu_f(bf2f(ga.y & 0xffffu)) * o0[4 * g + 2] * rstd, silu_f(__uint_as_float(ga.y & 0xffff0000u)) * o0[4 * g + 3] * rstd);
          w1.x = pk2(silu_f(bf2f(gb.x & 0xffffu)) * o1[4 * g] * rstd, silu_f(__uint_as_float(gb.x & 0xffff0000u)) * o1[4 * g + 1] * rstd);
          w1.y = pk2(silu_f(bf2f(gb.y & 0xffffu)) * o1[4 * g + 2] * rstd, silu_f(__uint_as_float(gb.y & 0xffff0000u)) * o1[4 * g + 3] * rstd);
          *(u32x2*)(yp + 8 * g) = w0; *(u32x2*)(yp + 32 + 8 * g) = w1; } }
    __syncthreads();
}

__device__ __forceinline__ void rope_task(const Params& p, int row, int task) {
    bf16* Z = ws_z(p);
    const int hq = task >> 2, i = task & 3, t = row & 2047;
    const int base = hq < 8 ? ZC_RQ + 64 * hq : (hq < 16 ? ZC_RK + 64 * (hq - 8) : (hq < 24 ? ZC_SQ + 64 * (hq - 16) : ZC_SK + 64 * (hq - 24)));
    const int pos = (i < 2) ? (t >> 6) : (t & 63), f0 = 8 * (i & 1);
    bf16* p1 = Z + (size_t)row * INC + base + 8 * i; bf16* p2 = p1 + 32;
    const u32x4 a = *(const u32x4*)p1, bq = *(const u32x4*)p2; u32x4 oa, ob;
#pragma unroll
    for (int k = 0; k < 4; ++k) {
        const float c0 = ROPE_COS[pos * 16 + f0 + 2 * k], s0 = ROPE_SIN[pos * 16 + f0 + 2 * k], c1 = ROPE_COS[pos * 16 + f0 + 2 * k + 1], s1 = ROPE_SIN[pos * 16 + f0 + 2 * k + 1];
        const float x1l = bf2f(a[k] & 0xffffu), x1h = __uint_as_float(a[k] & 0xffff0000u), x2l = bf2f(bq[k] & 0xffffu), x2h = __uint_as_float(bq[k] & 0xffff0000u);
        oa[k] = pk2(x1l * c0 - x2l * s0, x1h * c1 - x2h * s1); ob[k] = pk2(x1l * s0 + x2l * c0, x1h * s1 + x2h * c1); }
    *(u32x4*)p1 = oa; *(u32x4*)p2 = ob;
}
__device__ __forceinline__ void conv_task(const Params& p, int l, int row, int ch8) {
    const bf16* Z = ws_z(p); bf16* Y = ws_hb(p);
    const int t = (row < NLAT) ? (row & 2047) : ((row - NLAT) & 255), tl = (row < NLAT) ? 2047 : 255;
    const float* w = p.conv_w + (size_t)l * 3 * 512 + ch8 * 8;
    const bf16* zr = Z + (size_t)row * INC + ch8 * 8;
    float acc[8];
#pragma unroll
    for (int k = 0; k < 8; ++k) acc[k] = 0.f;
#pragma unroll
    for (int dt = -1; dt <= 1; ++dt) {
        if ((dt < 0 && t == 0) || (dt > 0 && t == tl)) continue;
        const bf16* zz = zr + (long)dt * INC;
        const u32x4 cc = *(const u32x4*)(zz + ZC_CC), hh = *(const u32x4*)(zz + ZC_CH);
        const f32x4 w0 = *(const f32x4*)(w + (dt + 1) * 512), w1 = *(const f32x4*)(w + (dt + 1) * 512 + 4);
#pragma unroll
        for (int k = 0; k < 4; ++k) { const float wl = (k < 2) ? w0[2 * k] : w1[2 * k - 4], wh = (k < 2) ? w0[2 * k + 1] : w1[2 * k - 3];
            acc[2 * k] += wl * bf2f(cc[k] & 0xffffu) * bf2f(hh[k] & 0xffffu); acc[2 * k + 1] += wh * __uint_as_float(cc[k] & 0xffff0000u) * __uint_as_float(hh[k] & 0xffff0000u); }
    }
    const u32x4 bb = *(const u32x4*)(zr + ZC_CB); u32x4 o;
#pragma unroll
    for (int k = 0; k < 4; ++k) o[k] = pk2(acc[2 * k] * bf2f(bb[k] & 0xffffu), acc[2 * k + 1] * __uint_as_float(bb[k] & 0xffff0000u));
    *(u32x4*)(Y + (size_t)row * DM + YC_CONV + ch8 * 8) = o;
}
__device__ __forceinline__ void conv_run(const Params& p, int l, int gt, int NT, int ntask) {
    const bf16* Z = ws_z(p); bf16* Y = ws_hb(p);
    const int ch8 = gt & 63;
    f32x4 wt[3][2];
    { const float* w = p.conv_w + (size_t)l * 3 * 512 + ch8 * 8;
#pragma unroll
      for (int k = 0; k < 3; ++k) { wt[k][0] = *(const f32x4*)(w + k * 512); wt[k][1] = *(const f32x4*)(w + k * 512 + 4); } }
    for (int i = gt; i < ntask; i += 2 * NT) {
        const bool v1 = i + NT < ntask;
        int row[2]; row[0] = i >> 6; row[1] = v1 ? (i + NT) >> 6 : row[0];
        u32x4 cc[2][3], hh[2][3], bb[2]; float fm[2], fp[2];
#pragma unroll
        for (int s = 0; s < 2; ++s) {
            const int r = row[s], t = (r < NLAT) ? (r & 2047) : ((r - NLAT) & 255), tl = (r < NLAT) ? 2047 : 255;
            const bool vm = t != 0, vp = t != tl; fm[s] = vm ? 1.f : 0.f; fp[s] = vp ? 1.f : 0.f;
            const bf16* zr = Z + (size_t)r * INC + ch8 * 8;
            const bf16* zm = vm ? zr - INC : zr; const bf16* zp = vp ? zr + INC : zr;
            cc[s][0] = *(const u32x4*)(zm + ZC_CC); hh[s][0] = *(const u32x4*)(zm + ZC_CH);
            cc[s][1] = *(const u32x4*)(zr + ZC_CC); hh[s][1] = *(const u32x4*)(zr + ZC_CH);
            cc[s][2] = *(const u32x4*)(zp + ZC_CC); hh[s][2] = *(const u32x4*)(zp + ZC_CH);
            bb[s] = *(const u32x4*)(zr + ZC_CB); }
        __builtin_amdgcn_sched_barrier(0);
#pragma unroll
        for (int s = 0; s < 2; ++s) {
            float acc[8];
#pragma unroll
            for (int k = 0; k < 8; ++k) acc[k] = 0.f;
#pragma unroll
            for (int d = 0; d < 3; ++d) { const float f = (d == 0) ? fm[s] : ((d == 2) ? fp[s] : 1.f);
#pragma unroll
                for (int k = 0; k < 4; ++k) { const float wl = wt[d][k >> 1][2 * (k & 1)] * f, wh = wt[d][k >> 1][2 * (k & 1) + 1] * f;
                    acc[2 * k] += wl * bf2f(cc[s][d][k] & 0xffffu) * bf2f(hh[s][d][k] & 0xffffu); acc[2 * k + 1] += wh * __uint_as_float(cc[s][d][k] & 0xffff0000u) * __uint_as_float(hh[s][d][k] & 0xffff0000u); } }
            u32x4 o;
#pragma unroll
            for (int k = 0; k < 4; ++k) o[k] = pk2(acc[2 * k] * bf2f(bb[s][k] & 0xffffu), acc[2 * k + 1] * __uint_as_float(bb[s][k] & 0xffff0000u));
            if (s == 0 || v1) *(u32x4*)(Y + (size_t)row[s] * DM + YC_CONV + ch8 * 8) = o;
        }
    }
}

__device__ __forceinline__ void ph_norm_router(const Params& p, int l, LAS unsigned char* lds) {
    const int tid = tid_opaque(), lane = tid & 63, wave = __builtin_amdgcn_readfirstlane(tid >> 6);
    constexpr int WPITCH = 4112;
    const float* wr = p.w_router + (size_t)l * 2048 * 16;
    { f32x4 t[16];
#pragma unroll
      for (int k = 0; k < 16; ++k) { const int n = tid + NTHR * k; t[k] = *(const f32x4*)(wr + (n >> 2) * 16 + (n & 3) * 4); }
#pragma unroll
      for (int k = 0; k < 16; ++k) { const int n = tid + NTHR * k, kk = n >> 2, q = n & 3;
#pragma unroll
          for (int i = 0; i < 4; ++i) *(LAS bf16*)(lds + (4 * q + i) * WPITCH + kk * 2) = (bf16)f2bf(t[k][i]); } }
    const int gw = blockIdx.x * NWAVES + wave, NGW = gridDim.x * NWAVES;
    const int nrows = (l == 0) ? NROW : NLAT;
    float* aff = (float*)(p.ws + WS_AFF);
    const int rpw = (nrows + NGW - 1) / NGW, r0 = gw * rpw, r1 = (r0 + rpw < nrows) ? r0 + rpw : nrows;
    { int cur = -1; f32x4 wv[8], sv[8], vn[8];
      if (r0 < r1) load_row8_bf16(vn, ws_xb(p) + (size_t)r0 * DM, lane);
      for (int row = r0; row < r1; ++row) {
          f32x4 v[8];
#pragma unroll
          for (int j = 0; j < 8; ++j) v[j] = vn[j];
          if (row + 1 < r1) load_row8_bf16(vn, ws_xb(p) + (size_t)(row + 1) * DM, lane);
          const int arow = (row < NLAT) ? (row >> 11) : 8;
          if (arow != cur) { const float* ad = ws_ada(p) + (size_t)(l * 9 + arow) * ADAW; load_coeffs(wv, sv, p.norm_ffn + l * DM, ad + 4 * 2048, ad + 3 * 2048, lane); cur = arow; }
          const float rstd = row_rstd(v);
#pragma unroll
          for (int j = 0; j < 8; ++j) v[j] = v[j] * rstd * wv[j] + sv[j];
          store_row8_bf16(v, ws_hb(p) + (size_t)row * DM, lane);
      } }
    asm volatile("s_waitcnt vmcnt(0)" ::: "memory");
    __syncthreads();
    if (tid < 64) { __builtin_amdgcn_fence(__ATOMIC_ACQUIRE, "agent"); asm volatile("s_waitcnt vmcnt(0)" ::: "memory"); }
    __syncthreads();
    const int R = rpw * NWAVES, R0 = blockIdx.x * R, R1 = (R0 + R < nrows) ? R0 + R : nrows;
    if (R0 + 16 * wave < R1) {
        const int fr = lane & 15, kg = lane >> 4;
        int arow_ = R0 + 16 * wave + fr; if (arow_ > R1 - 1) arow_ = R1 - 1;
        const bf16* ap = ws_hb(p) + (size_t)arow_ * DM + 8 * kg;
        LAS const unsigned char* bp = lds + fr * WPITCH + 16 * kg;
        f32x4 acc = {0.f, 0.f, 0.f, 0.f};
        for (int s0 = 0; s0 < 64; s0 += 8) {
            bf16x8 af[8];
#pragma unroll
            for (int s = 0; s < 8; ++s) af[s] = *(const bf16x8*)(ap + 32 * (s0 + s));
#pragma unroll
            for (int s = 0; s < 8; ++s) acc = __builtin_amdgcn_mfma_f32_16x16x32_bf16(af[s], *(LAS const bf16x8*)(bp + 64 * (s0 + s)), acc, 0, 0, 0);
        }
#pragma unroll
        for (int r = 0; r < 4; ++r) {
            float mx = acc[r];
#pragma unroll
            for (int o = 1; o < 16; o <<= 1) mx = fmaxf(mx, __shfl_xor(mx, o));
            const float ex = __expf(acc[r] - mx); float sum = ex;
#pragma unroll
            for (int o = 1; o < 16; o <<= 1) sum += __shfl_xor(sum, o);
            const int row = R0 + 16 * wave + 4 * kg + r;
            if (row < R1) aff[(size_t)row * 16 + fr] = ex / sum;
        }
    }
}

__device__ __forceinline__ int moe_mpe(int l) { return l == 0 ? 2304 : 2048; }
constexpr int CW_SCF = 8192;
constexpr int CW_TKF = 3072;
constexpr int RIDX_OFF = 131072 + 1024;
__device__ __forceinline__ void ph_topk(const Params& p, int l, LAS unsigned char* lds) {
    const int tid = tid_opaque(), lane = tid & 63, wave = __builtin_amdgcn_readfirstlane(tid >> 6);
    const int nprob = (l == 0) ? 256 : 128, MPE = moe_mpe(l);
    const float* aff = (const float*)(p.ws + WS_AFF); int* sel = (int*)(p.ws + WS_SEL); int* idx = (int*)(p.ws + WS_IDX); float* gatev = (float*)(p.ws + WS_GATEV);
    LAS int* lcnt = (LAS int*)lds;
    for (int prob = blockIdx.x; prob < nprob; prob += gridDim.x) {
        const bool isctx = prob >= 128; const int q = prob & 127, b = q >> 4, e = q & 15;
        const int T = isctx ? CTX : SEQ, cap = isctx ? 32 : 256, row0 = isctx ? NLAT + b * CTX : b * SEQ, slot0 = e * MPE + (isctx ? 2048 + b * 32 : b * 256);
        if (tid < 48) lcnt[tid] = 0;
        unsigned u[4];
#pragma unroll
        for (int k = 0; k < 4; ++k) { const int t = 256 * wave + 64 * k + lane; u[k] = (t < T) ? __float_as_uint(aff[(size_t)(row0 + t) * 16 + e]) : 0u; }
        __syncthreads();
        unsigned tau = 0u;
        for (int bit = 29; bit >= 0; --bit) {
            const unsigned cand = tau | (1u << bit); int cnt = 0;
#pragma unroll
            for (int k = 0; k < 4; ++k) cnt += __popcll(__ballot(u[k] >= cand));
            if (lane == 0 && cnt) __hip_atomic_fetch_add(&lcnt[bit], cnt, __ATOMIC_RELAXED, __HIP_MEMORY_SCOPE_WORKGROUP);
            __syncthreads();
            if (lcnt[bit] >= cap) tau = cand;
        }
        int ngt = 0, neq = 0;
#pragma unroll
        for (int k = 0; k < 4; ++k) { const int t = 256 * wave + 64 * k + lane; ngt += __popcll(__ballot(u[k] > tau)); neq += __popcll(__ballot((t < T) && u[k] == tau)); }
        if (lane == 0) { lcnt[32 + wave] = ngt; lcnt[40 + wave] = neq; }
        __syncthreads();
        int tgt = 0, eqb = 0;
#pragma unroll
        for (int w = 0; w < 8; ++w) { tgt += lcnt[32 + w]; }
        const int need_eq = cap - tgt;
        int base = 0;
#pragma unroll
        for (int w = 0; w < 8; ++w) if (w < wave) { const int ne = lcnt[40 + w]; int tk = need_eq - eqb; tk = tk < 0 ? 0 : (tk > ne ? ne : tk); base += lcnt[32 + w] + tk; eqb += ne; }
        const unsigned long long lt = (1ull << lane) - 1ull;
        int eqc = eqb;
#pragma unroll
        for (int k = 0; k < 4; ++k) { const int t = 256 * wave + 64 * k + lane; const bool valid = t < T;
            const bool gt = u[k] > tau, eq = valid && (u[k] == tau);
            const unsigned long long em = __ballot(eq);
            const bool take = gt || (eq && (eqc + __popcll(em & lt) < need_eq));
            const unsigned long long sm = __ballot(take);
            const int slot = base + __popcll(sm & lt);
            if (valid) { if (take) { idx[slot0 + slot] = row0 + t; gatev[slot0 + slot] = __uint_as_float(u[k]); }
                         sel[(size_t)(row0 + t) * 16 + e] = take ? slot : -1; }
            base += __popcll(sm); eqc += __popcll(em); }
        asm volatile("s_waitcnt vmcnt(0)" ::: "memory");
        __syncthreads();
        if (tid == 0) { __builtin_amdgcn_fence(__ATOMIC_RELEASE, "agent"); asm volatile("s_waitcnt vmcnt(0)" ::: "memory");
            __hip_atomic_store((unsigned*)(p.ws + WS_CTL) + CW_TKF + l * 256 + prob, 1u, __ATOMIC_RELAXED, __HIP_MEMORY_SCOPE_AGENT); }
    }
}
template <class Sched> __device__ __forceinline__ void topk_wait(const Params& p, int l, const Sched& S, int tpe, int tid) {
    if (tid < 64) {
        const int i = tid >> 3, sub = tid & 7; pg8::Unit u; int flag = -1;
        if (i < 6 && S.next(i, u)) { const int e = u.pm / tpe, j = u.pm % tpe; if (j < 8) { if (sub == 0) flag = j * 16 + e; } else flag = 128 + sub * 16 + e; }
        if (flag >= 0) { const unsigned* f = (const unsigned*)(p.ws + WS_CTL) + CW_TKF + l * 256 + flag; unsigned sp = 0;
            while (__hip_atomic_load(f, __ATOMIC_RELAXED, __HIP_MEMORY_SCOPE_AGENT) == 0u && ++sp < (1u << 20)) __builtin_amdgcn_s_sleep(2); }
        __builtin_amdgcn_fence(__ATOMIC_ACQUIRE, "agent"); asm volatile("s_waitcnt vmcnt(0)" ::: "memory");
    }
    __syncthreads();
}


__device__ __forceinline__ void ph_combine(const Params& p, int l, LAS unsigned char* lds) {
    const int tid_ = tid_opaque(), lane = tid_ & 63, wave = __builtin_amdgcn_readfirstlane(tid_ >> 6);
    const int gw = blockIdx.x * NWAVES + wave, NGW = gridDim.x * NWAVES;
    const int nrows = (l == 0) ? NROW : NLAT, MPE = moe_mpe(l);
    const int* sel = (const int*)(p.ws + WS_SEL); const bf16* YE = ws_z(p);
    const int rpw = (nrows + NGW - 1) / NGW, r0 = gw * rpw, r1 = (r0 + rpw < nrows) ? r0 + rpw : nrows;
    LAS float* CL = (LAS float*)lds;
    const int brow0 = blockIdx.x * NWAVES * rpw, brow1 = ((brow0 + NWAVES * rpw < nrows) ? brow0 + NWAVES * rpw : nrows) - 1;
    const int as0 = (brow0 >= NLAT) ? 8 : (brow0 >> 11), as1 = (brow1 >= NLAT) ? 8 : (brow1 >> 11);
    if (brow0 < nrows) {
#pragma unroll
        for (int s = 0; s < 2; ++s) { const int as = s ? as1 : as0; const float* ad = ws_ada(p) + (size_t)(l * 9 + as) * ADAW; const float* ad1 = ws_ada(p) + (size_t)(1 * 9 + as) * ADAW;
            for (int i = tid_; i < 2048; i += NTHR) { CL[s * 6144 + i] = ad[5 * 2048 + i];
                if (l == 0) { CL[s * 6144 + 2048 + i] = p.norm_mix[1 * DM + i] * (1.f + ad1[2048 + i]); CL[s * 6144 + 4096 + i] = ad1[i]; } } }
    }
    __syncthreads();
    f32x4 vn[8]; int seln = -1;
    f32x4 wfin[8];
    if (l != 0) {
#pragma unroll
        for (int j = 0; j < 8; ++j) wfin[j] = *(const f32x4*)(p.norm_final + 256 * j + 4 * lane); }
    if (r0 < r1) { load_row8_bf16(vn, ws_xb(p) + (size_t)r0 * DM, lane); seln = (lane < 16) ? sel[(size_t)r0 * 16 + lane] : -1; }
    for (int row = r0; row < r1; ++row) {
        f32x4 v[8];
#pragma unroll
        for (int j = 0; j < 8; ++j) v[j] = vn[j];
        const int selv = seln;
        if (row + 1 < r1) { load_row8_bf16(vn, ws_xb(p) + (size_t)(row + 1) * DM, lane); seln = (lane < 16) ? sel[(size_t)(row + 1) * 16 + lane] : -1; }
        const bool isctx = row >= NLAT;
        const int arow = isctx ? 8 : (row >> 11);
        const int sbase = isctx ? 2048 + ((row - NLAT) >> 8) * 32 : (row >> 11) * 256;
        LAS const float* cl = CL + ((arow == as0) ? 0 : 6144) + 4 * lane;
        f32x4 acc[8];
#pragma unroll
        for (int j = 0; j < 8; ++j) acc[j] = (f32x4){0.f, 0.f, 0.f, 0.f};
        unsigned long long mask = __ballot(selv >= 0);
        while (mask) {
            const int e0 = __builtin_ctzll(mask); mask &= mask - 1;
            const bool two = mask != 0ull; const int e1 = two ? __builtin_ctzll(mask) : e0; if (two) mask &= mask - 1;
            const int s0 = __builtin_amdgcn_readlane(selv, e0), s1 = __builtin_amdgcn_readlane(selv, e1);
            const bf16* y0 = YE + (size_t)(e0 * MPE + sbase + s0) * DM + 4 * lane; const bf16* y1 = YE + (size_t)(e1 * MPE + sbase + s1) * DM + 4 * lane;
            u32x2 a[8], bq[8];
#pragma unroll
            for (int j = 0; j < 8; ++j) a[j] = *(const u32x2*)(y0 + 256 * j);
            if (two) {
#pragma unroll
                for (int j = 0; j < 8; ++j) bq[j] = *(const u32x2*)(y1 + 256 * j); }
#pragma unroll
            for (int j = 0; j < 8; ++j) { acc[j].x += bf2f(a[j].x & 0xffffu); acc[j].y += __uint_as_float(a[j].x & 0xffff0000u); acc[j].z += bf2f(a[j].y & 0xffffu); acc[j].w += __uint_as_float(a[j].y & 0xffff0000u); }
            if (two) {
#pragma unroll
                for (int j = 0; j < 8; ++j) { acc[j].x += bf2f(bq[j].x & 0xffffu); acc[j].y += __uint_as_float(bq[j].x & 0xffff0000u); acc[j].z += bf2f(bq[j].y & 0xffffu); acc[j].w += __uint_as_float(bq[j].y & 0xffff0000u); } }
        }
#pragma unroll
        for (int j = 0; j < 8; ++j) v[j] = v[j] + *(LAS const f32x4*)(cl + 256 * j) * acc[j];
        const float rstd = row_rstd(v);
        if (l == 0) {
            store_row8_bf16(v, ws_xb(p) + (size_t)row * DM, lane);
#pragma unroll
            for (int j = 0; j < 8; ++j) v[j] = v[j] * rstd * *(LAS const f32x4*)(cl + 2048 + 256 * j) + *(LAS const f32x4*)(cl + 4096 + 256 * j);
            store_row8_bf16(v, ws_hb(p) + (size_t)row * DM, lane);
        } else {
#pragma unroll
            for (int j = 0; j < 8; ++j) *(f32x4*)(p.out + (size_t)row * DM + 256 * j + 4 * lane) = v[j] * rstd * wfin[j];
        }
    }
}

constexpr int N_PHASES = 12;
template <int PH> __device__ __forceinline__ void run_phase(const Params& p, int l, LAS unsigned char* lds, int rep) {
    const int G = gridDim.x, bid = blockIdx.x, tid = tid_opaque();
    const bool need_ctx = (l == 0);
    const int vb = (G % 8 == 0) ? (bid & 7) * (G >> 3) + (bid >> 3) : bid;
    if constexpr (PH == 0) ph_prologue(p, lds);
    if constexpr (PH == 1) ph_modnorm0(p);
    if constexpr (PH == 2) {
        pg8::Gemm g{ws_hb(p), (const bf16*)(p.ws + WS_WIN) + (size_t)l * INC * 2048, NROW, INC, DM};
        { LAS float* rl = (LAS float*)(lds + ROPE_LDS);
          for (int i = tid; i < 1024; i += NTHR) { rl[i] = ROPE_COS[i]; rl[1024 + i] = ROPE_SIN[i]; } }
        __syncthreads();
        pg8::EpiZRope E{ws_z(p), (LAS const float*)(lds + ROPE_LDS), (LAS const float*)(lds + ROPE_LDS) + 1024, ws_kvh(p)};
        if (l == DEPTH - 1) { pg8::SkipOrder S; S.init(G, bid);
            pg8::gemm_phase<pg8::EpiZRope, pg8::SkipOrder, true, true>(lds, g, S, E);
            pg8::QuadOrder Q; Q.init(G, bid);
            pg8::gemm_phase<pg8::EpiZRope, pg8::QuadOrder, true, true, false, true>(lds, g, Q, E); }
        else { pg8::StaticOrder S; S.init(NROW, INC, G, bid);
            pg8::gemm_phase<pg8::EpiZRope, pg8::StaticOrder, true, true>(lds, g, S, E); }
        if (l == 0 && !rep && G == 256 && bid >= 120 && TAIL_P2 > 0) tail_convert(p, TAIL_OFF_P2, TAIL_P2, bid - 120, G - 120, lds);
    }
    if constexpr (PH == 3) {
        const int nu = 512 + (need_ctx ? 64 : 0);
        if (rep != 3) for (int u = vb; u < nu; u += G) {
            if (u < 576) { const bool ic = u >= 512; const int q = u - 512; att::na_unit(p, l, ic ? q >> 3 : u >> 6, ic ? q & 7 : (u >> 3) & 7, ic ? 0 : u & 7, ic, lds, rep); }
        }
        const int gt = bid * NTHR + tid, NT = G * NTHR;
        const int crows = need_ctx ? NROW : NLAT;
        if (rep != 2 && rep < 4) conv_run(p, l, gt, NT, crows * 64);
    }
    if constexpr (PH == 4) {
        const int nsu = 512 + (need_ctx ? 64 : 0);
        if (rep != 3) for (int u = (vb + 128) % G; u < nsu; u += G) { const bool ic = u >= 512; const int q = u - 512;
            att::swa_unit(p, l, ic ? q >> 3 : u >> 6, ic ? (q >> 2) & 1 : (u >> 5) & 1, ic ? (q >> 1) & 1 : (u >> 1) & 15, ic ? q & 1 : u & 1, ic, lds); }
        __syncthreads();
        if (rep != 2) for (int u = bid; u < 1152; u += G) { const int bh = u / 18, c = u % 18; r1_unit(p, l, bh >> 3, bh & 7, c, lds); }
    }
    if constexpr (PH == 5) {
        const int c0 = need_ctx ? 0 : 1, npair = 9 - c0;
        unsigned* sflag = (unsigned*)(p.ws + WS_CTL) + CW_SCF + l * 1024;
        if (!rep) { ph_ret_scan(p, l);
            asm volatile("s_waitcnt vmcnt(0)" ::: "memory"); __syncthreads();
            if (tid == 0) { __builtin_amdgcn_fence(__ATOMIC_RELEASE, "agent"); asm volatile("s_waitcnt vmcnt(0)" ::: "memory"); __hip_atomic_store(sflag + bid, 1u, __ATOMIC_RELAXED, __HIP_MEMORY_SCOPE_AGENT); } }
        const float dfall = p.dec_f[l * 8 + (tid & 7)], dball = p.dec_b[l * 8 + (tid & 7)];
        for (int u = bid; u < 64 * npair; u += G) { const int bh = u / npair, cp = c0 + u % npair;
            if (!rep) {
                if (tid < 64) { const int nf = (G == 256) ? 4 : G, f0 = (G == 256) ? 4 * bh : 0;
                    for (int f = tid; f < nf; f += 64) { unsigned sp = 0; while (__hip_atomic_load(sflag + f0 + f, __ATOMIC_RELAXED, __HIP_MEMORY_SCOPE_AGENT) == 0u && ++sp < (1u << 20)) __builtin_amdgcn_s_sleep(2); }
                    __builtin_amdgcn_fence(__ATOMIC_ACQUIRE, "agent"); asm volatile("s_waitcnt vmcnt(0)" ::: "memory"); }
                __syncthreads(); }
            r3_pair(p, l, bh >> 3, bh & 7, cp, lds, __uint_as_float(__builtin_amdgcn_readlane(__float_as_uint(dfall), bh & 7)), __uint_as_float(__builtin_amdgcn_readlane(__float_as_uint(dball), bh & 7))); }
    }
    if constexpr (PH == 6) { if (!(rep && l == 1)) {
        const int M = need_ctx ? NROW : NLAT;
        pg8::Gemm g{ws_hb(p), (const bf16*)(p.ws + WS_WOUT) + (size_t)l * 2048 * 2048, M, DM, DM}; pg8::StaticOrder S; S.init(M, DM, G, bid);
        if (l == 0) { pg8::EpiResGate<true> E{p.x, p.ctx, ws_xb(p), ws_ada(p) + (size_t)l * 9 * ADAW, 2 * 2048};
            pg8::gemm_phase<pg8::EpiResGate<true>, pg8::StaticOrder, true, true>(lds, g, S, E);
            if (!rep && G == 256 && bid >= 64 && TAIL_P6 > 0) tail_convert(p, TAIL_OFF_P6, TAIL_P6, bid - 64, G - 64, lds); }
        else { pg8::EpiResGate<false> E{nullptr, nullptr, ws_xb(p), ws_ada(p) + (size_t)l * 9 * ADAW, 2 * 2048};
            pg8::gemm_phase<pg8::EpiResGate<false>, pg8::StaticOrder, true, true>(lds, g, S, E); }
    } }
    if constexpr (PH == 7) ph_norm_router(p, l, lds);
    if constexpr (PH == 9) {
        const int tpe = need_ctx ? 9 : 8;
        pg8::GroupedOrder S; S.init(tpe, G, bid);
        if (!rep) { ph_topk(p, l, lds); topk_wait(p, l, S, tpe, tid); }
        { LAS int* rl = (LAS int*)(lds + RIDX_OFF); const int* idx = (const int*)(p.ws + WS_IDX); pg8::Unit u;
          for (int i = 0; S.next(i, u); ++i) if (tid < 256) rl[i * 256 + tid] = idx[u.pm * 256 + tid];
          __syncthreads(); }
        pg8::Gemm g{ws_hb(p), (const bf16*)(p.ws + WS_WGU) + (size_t)l * 16 * 2048 * 2048, 16 * tpe * 256, 2048, DM, (const LAS int*)(lds + RIDX_OFF)};
        pg8::EpiSiluMul E{(bf16*)(p.ws + WS_ACT)};
        pg8::gemm_phase<pg8::EpiSiluMul, pg8::GroupedOrder, true, true, true>(lds, g, S, E);
        if (l == 0 && !rep && G == 256 && bid >= 128 && TAIL_P9 > 0) tail_convert(p, TAIL_OFF_P9, TAIL_P9, bid - 128, G - 128, lds);
    }
    if constexpr (PH == 10) {
        const int tpe = need_ctx ? 9 : 8;
        pg8::Gemm g{(const bf16*)(p.ws + WS_ACT), (const bf16*)(p.ws + WS_WD) + (size_t)l * 16 * 2048 * 1024, 16 * tpe * 256, 2048, EFF}; pg8::GroupedOrder S; S.init(tpe, G, bid);
        pg8::EpiDown E{ws_z(p), (const float*)(p.ws + WS_GATEV)};
        pg8::gemm_phase<pg8::EpiDown, pg8::GroupedOrder, true, true>(lds, g, S, E);
        if (l == 0 && !rep && G == 256 && bid >= 128 && TAIL_P10 > 0) tail_convert(p, TAIL_OFF_P10, TAIL_P10, bid - 128, G - 128, lds);
    }
    if constexpr (PH == 11) { if (!rep) ph_combine(p, l, lds); }
}

#ifndef MEGA
#define MEGA 1
#endif
template <int PH> __global__ void __launch_bounds__(NTHR, 2) k_phase(Params p, int l) {
    extern __shared__ __attribute__((aligned(16))) unsigned char lds_raw[];
    run_phase<PH>(p, l, (LAS unsigned char*)lds_raw, 0);
}

#if MEGA
__global__ void __launch_bounds__(NTHR, 2) k_mega(Params p) {
    extern __shared__ __attribute__((aligned(16))) unsigned char lds_raw[];
    LAS unsigned char* lds = (LAS unsigned char*)lds_raw;
    volatile LAS unsigned* MISC = (volatile LAS unsigned*)(lds + MISC_OFF);
    if (threadIdx.x < 32) MISC[threadIdx.x] = 0u;
    __syncthreads();
    XcdBarrier bar = xcd_barrier_post((unsigned*)(p.ws + WS_CTL) + CW_BAR, MISC + 8);
#ifndef REPEAT_MASK
#define REPEAT_MASK 0
#endif
#ifndef REPEAT_SUB
#define REPEAT_SUB 1
#endif
#define RP(k, l) do { run_phase<k>(p, l, lds, 0); xcd_barrier(bar); if ((REPEAT_MASK >> k) & 1) { run_phase<k>(p, l, lds, REPEAT_SUB); xcd_barrier(bar); } } while (0)
    RP(0, 0); RP(1, 0);
#ifdef EXTRA_BARRIERS
    for (int i_ = 0; i_ < EXTRA_BARRIERS; ++i_) xcd_barrier(bar);
#endif
#define LAYER_PHASES(l) RP(2, l); run_phase<3>(p, l, lds, 0); __syncthreads(); if ((REPEAT_MASK >> 3) & 1) { run_phase<3>(p, l, lds, REPEAT_SUB); __syncthreads(); } RP(4, l); RP(5, l); RP(6, l); RP(7, l); RP(9, l); RP(10, l);
    LAYER_PHASES(0) RP(11, 0);
    LAYER_PHASES(1) run_phase<11>(p, 1, lds, 0);
#undef RP
#undef LAYER_PHASES
}
#endif

template <int PH> static void launch_phase(const Params& p, int l, int grid, hipStream_t stream) {
    static bool attr_set = false;
    if (!attr_set) { (void)hipFuncSetAttribute((const void*)k_phase<PH>, hipFuncAttributeMaxDynamicSharedMemorySize, LDS_BYTES); attr_set = true; }
    hipLaunchKernelGGL(k_phase<PH>, dim3(grid), dim3(NTHR), LDS_BYTES, stream, p, l);
}

extern "C" void kernel_launch(void* const* d_in, const int* in_sizes, int n_in, void* d_out, int out_size, void* d_ws, size_t ws_size, hipStream_t stream) {
    static int grid = 0;
    if (grid == 0) {
        if (n_in != 20 || in_sizes[0] != NLAT * DM || out_size != NLAT * DM || ws_size < WS_END) {
            fprintf(stderr, "kernel_launch: unexpected problem shape (n_in %d, in0 %d, out %d, ws %zu; need ws >= %zu); nothing launched\n", n_in, n_in > 0 ? in_sizes[0] : -1, out_size, ws_size, (size_t)WS_END);
            grid = -1; return; }
        int dev = 0, cus = 0;
        if (hipGetDevice(&dev) != hipSuccess || hipDeviceGetAttribute(&cus, hipDeviceAttributeMultiprocessorCount, dev) != hipSuccess) { grid = -1; return; }
#if MEGA
        if (hipFuncSetAttribute((const void*)k_mega, hipFuncAttributeMaxDynamicSharedMemorySize, LDS_BYTES) != hipSuccess) { fprintf(stderr, "kernel_launch: hipFuncSetAttribute failed\n"); grid = -1; return; }
        int per_cu = 0;
        if (hipOccupancyMaxActiveBlocksPerMultiprocessor(&per_cu, (const void*)k_mega, NTHR, LDS_BYTES) != hipSuccess || per_cu < 1) { fprintf(stderr, "kernel_launch: occupancy query reports %d blocks per CU\n", per_cu); }
        (void)hipGetLastError();
#endif
        grid = cus;
    }
    if (grid < 0) return;
    Params p{};
    p.x = (const float*)d_in[0]; p.c = (const float*)d_in[1]; p.ctx = (const float*)d_in[2]; p.c_ctx = (const float*)d_in[3]; p.w_ada = (const float*)d_in[4]; p.b_ada = (const float*)d_in[5];
    p.norm_mix = (const float*)d_in[6]; p.norm_ffn = (const float*)d_in[7]; p.w_in = (const float*)d_in[8]; p.w_out = (const float*)d_in[9]; p.dec_f = (const float*)d_in[10]; p.dec_b = (const float*)d_in[11];
    p.conv_w = (const float*)d_in[12]; p.sink = (const float*)d_in[13]; p.rpb = (const float*)d_in[14]; p.w_router = (const float*)d_in[15]; p.w_gate = (const float*)d_in[16]; p.w_up = (const float*)d_in[17];
    p.w_down = (const float*)d_in[18]; p.norm_final = (const float*)d_in[19]; p.out = (float*)d_out; p.ws = (unsigned char*)d_ws;
    if (hipMemsetAsync((char*)d_ws + WS_CTL, 0, CTL_ZERO_BYTES, stream) != hipSuccess) { fprintf(stderr, "kernel_launch: memset failed\n"); return; }
#if MEGA
    hipLaunchKernelGGL(k_mega, dim3(grid), dim3(NTHR), LDS_BYTES, stream, p);
#else
    launch_phase<0>(p, 0, grid, stream); launch_phase<1>(p, 0, grid, stream);
    for (int l = 0; l < DEPTH; ++l) {
        launch_phase<2>(p, l, grid, stream); launch_phase<3>(p, l, grid, stream); launch_phase<4>(p, l, grid, stream); launch_phase<5>(p, l, grid, stream); launch_phase<6>(p, l, grid, stream);
        launch_phase<7>(p, l, grid, stream); launch_phase<9>(p, l, grid, stream); launch_phase<10>(p, l, grid, stream); launch_phase<11>(p, l, grid, stream);
    }
#endif
}
```
